# Optimizing an MI355X kernel written in HIP

```python
import math
import jax, jax.numpy as jnp
from jax import lax
import numpy as np

D_MODEL = 1024
BATCH = 8
SEQ = 4096
DEPTH = 4

GRID_W = 64
CTX_LEN = 256
HEAD_DIM = 64
N_MIXERS = 4
GROUP_HEADS = D_MODEL // (N_MIXERS * HEAD_DIM)
GROUP_W = GROUP_HEADS * HEAD_DIM
MIX_W = N_MIXERS * GROUP_W
ROPE_BASE = 10000.0
RET_CHUNK = 128
DIFF_QK_DIM = HEAD_DIM // 2
Q_BLOCK = 128
GDN_CHUNK = 64
SHORT_CONV = 3
WINDOW = 128
SWA_KV_HEADS = GROUP_HEADS // 2
N_EXPERTS = 16
CAPACITY_FACTOR = 2
EXPERT_FF = 2 * D_MODEL
LN_EPS = 1e-5
DEEPNORM_ALPHA = (2 * DEPTH) ** 0.25
DEEPNORM_BETA = (8 * DEPTH) ** -0.25

IN_COLS = (
    ('ret_q', GROUP_W), ('ret_k', GROUP_W), ('ret_v', GROUP_W), ('ret_g', GROUP_W),
    ('diff_q', GROUP_W), ('diff_k', GROUP_W), ('diff_v', GROUP_W),
    ('gdn_qkv', 3 * GROUP_W), ('gdn_g', GROUP_W), ('gdn_a', 2 * GROUP_HEADS), ('gdn_b', 2 * GROUP_HEADS),
    ('swa_q', GROUP_W), ('swa_k', SWA_KV_HEADS * HEAD_DIM), ('swa_v', SWA_KV_HEADS * HEAD_DIM),
)
IN_W = sum(w for _, w in IN_COLS)

kernel_name = 'hybrid_parallel_heads_diffusion_block'

F32 = jnp.float32


def split_cols(p):
    out, off = {}, 0
    for name, w in IN_COLS:
        out[name] = p[..., off:off + w]
        off += w
    return out


def layer_norm(x, g, b):
    xf = x.astype(F32)
    mu = jnp.mean(xf, -1, keepdims=True)
    var = jnp.mean(jnp.square(xf - mu), -1, keepdims=True)
    return ((xf - mu) * lax.rsqrt(var + LN_EPS) * g.astype(F32) + b.astype(F32)).astype(x.dtype)


def rms_norm(x, g=None, eps=1e-6):
    xf = x.astype(F32)
    y = xf * lax.rsqrt(jnp.mean(jnp.square(xf), -1, keepdims=True) + eps)
    if g is not None:
        y = y * g.astype(F32)
    return y


def l2_normalize(x, eps=1e-6):
    return x * lax.rsqrt(jnp.sum(jnp.square(x), -1, keepdims=True) + eps)


def axial_rope_angles(n, rot_dim):
    rows = n // GRID_W
    row = jnp.repeat(jnp.arange(rows, dtype=F32), GRID_W)
    col = jnp.tile(jnp.arange(GRID_W, dtype=F32), rows)
    n_freq = rot_dim // 4
    inv = ROPE_BASE ** (-jnp.arange(n_freq, dtype=F32) / n_freq)
    return jnp.concatenate([row[:, None] * inv, col[:, None] * inv], -1)


def retention_angles(n, dim):
    theta = 1.0 / (ROPE_BASE ** jnp.linspace(0.0, 1.0, dim // 2, dtype=F32))
    return jnp.arange(n, dtype=F32)[:, None] * theta


def rotate(x, ang):
    half = x.shape[-1] // 2
    cos, sin = jnp.cos(ang).astype(x.dtype), jnp.sin(ang).astype(x.dtype)
    x1, x2 = x[..., :half], x[..., half:]
    return jnp.concatenate([x1 * cos - x2 * sin, x1 * sin + x2 * cos], -1)


def flip_seq(t):
    return jnp.flip(t, axis=2)


def sink_softmax(s, sink):
    full = jnp.concatenate([s, jnp.broadcast_to(sink, s.shape[:-1] + (1,)).astype(s.dtype)], -1)
    return jax.nn.softmax(full, -1)[..., :-1]


def retention_scan(q, k, v, log_g, s0, with_out):
    b, h, n, dk = q.shape
    dv = v.shape[-1]
    c = RET_CHUNK
    nc = n // c
    qc, kc, vc = (t.reshape(b, h, nc, c, t.shape[-1]) for t in (q, k, v))
    pos = jnp.arange(c, dtype=F32)
    lg = log_g[:, None]
    k_decay = jnp.exp(lg * (c - 1 - pos))
    kv = jnp.einsum('bhncd,hc,bhnce->nbhde', kc, k_decay, vc)
    chunk_decay = jnp.exp(log_g * c)[None, :, None, None]

    def step(s, kv_n):
        return s * chunk_decay + kv_n, (s if with_out else None)

    s_last, s_prev = lax.scan(step, s0, kv)
    if not with_out:
        return None, s_last
    rel = pos[:, None] - pos[None, :]
    d_mat = jnp.where(rel >= 0, jnp.exp(lg[:, :, None] * jnp.maximum(rel, 0.0)), 0.0)
    q_decay = jnp.exp(lg * (pos + 1.0))
    scores = jnp.einsum('bhnid,bhnjd->bhnij', qc, kc) * d_mat[:, None]
    o = (jnp.einsum('bhnij,bhnje->bhnie', scores, vc)
         + jnp.einsum('bhnid,hi,nbhde->bhnie', qc, q_decay, s_prev))
    return o.reshape(b, h, n, dv), s_last


def retention_group(pl, pc, ret_decay, with_ctx_out):
    def heads(t):
        return t.reshape(t.shape[0], t.shape[1], GROUP_HEADS, HEAD_DIM).transpose(0, 2, 1, 3).astype(F32)
    scale = HEAD_DIM ** -0.5
    ang = retention_angles(pl['ret_q'].shape[1], HEAD_DIM)
    ql = rotate(heads(pl['ret_q']) * scale, ang)
    kl = rotate(heads(pl['ret_k']), ang)
    vl = heads(pl['ret_v'])
    qc, kc, vc = heads(pc['ret_q']) * scale, heads(pc['ret_k']), heads(pc['ret_v'])
    log_g = jax.nn.log_sigmoid(ret_decay.astype(F32))
    s0 = jnp.zeros((ql.shape[0], GROUP_HEADS, HEAD_DIM, HEAD_DIM), F32)
    o_l, o_c = 0.0, 0.0
    for dr in range(2):
        f = flip_seq if dr else (lambda t: t)
        oc, s_ctx = retention_scan(f(qc), f(kc), f(vc), log_g[dr], s0, with_ctx_out)
        ol, _ = retention_scan(f(ql), f(kl), f(vl), log_g[dr], s_ctx, True)
        o_l = o_l + f(ol)
        if with_ctx_out:
            o_c = o_c + f(oc)

    def finish(o, gate):
        y = rms_norm(o).transpose(0, 2, 1, 3).reshape(gate.shape)
        return (jax.nn.silu(gate.astype(F32)) * y).astype(gate.dtype)

    return finish(o_l, pl['ret_g']), (finish(o_c, pc['ret_g']) if with_ctx_out else None)


def diff_attention_group(pl, pc, lam_params, norm_g, layer_idx, ang_axial, with_ctx_out):
    h, dq = GROUP_HEADS, DIFF_QK_DIM
    scale = dq ** -0.5
    qk = lambda t: t.reshape(t.shape[0], t.shape[1], h, 2, dq)
    vv = lambda t: t.reshape(t.shape[0], t.shape[1], h, HEAD_DIM)
    ang = ang_axial[:, None, None, :]
    ql, kl = rotate(qk(pl['diff_q']), ang), rotate(qk(pl['diff_k']), ang)
    qc, kc = qk(pc['diff_q']), qk(pc['diff_k'])
    vl, vc = vv(pl['diff_v']), vv(pc['diff_v'])
    lam_init = 0.8 - 0.6 * math.exp(-0.3 * layer_idx)
    lp = lam_params.astype(F32)
    lam = jnp.exp(jnp.sum(lp[0] * lp[1])) - jnp.exp(jnp.sum(lp[2] * lp[3])) + lam_init

    def attend(q, k, v):
        s = jnp.einsum('bqhcd,bkhcd->bhcqk', q, k, preferred_element_type=F32) * scale
        p = jax.nn.softmax(s, -1)
        a = p[:, :, 0] - lam * p[:, :, 1]
        return jnp.einsum('bhqk,bkhe->bqhe', a.astype(v.dtype), v)

    k_all = jnp.concatenate([kl, kc], 1)
    v_all = jnp.concatenate([vl, vc], 1)
    b, n = ql.shape[:2]
    nb = n // Q_BLOCK
    q_blocks = ql.reshape(b, nb, Q_BLOCK, h, 2, dq).swapaxes(0, 1)
    o_l = lax.map(lambda qb: attend(qb, k_all, v_all), q_blocks)
    o_l = o_l.swapaxes(0, 1).reshape(b, n, h, HEAD_DIM)

    def finish(o):
        y = rms_norm(o, norm_g) * (1.0 - lam_init)
        return y.reshape(o.shape[0], o.shape[1], GROUP_W).astype(pl['diff_v'].dtype)

    return finish(o_l), (finish(attend(qc, kc, vc)) if with_ctx_out else None)


def short_conv(x, w):
    return lax.conv_general_dilated(
        x, w[:, None, :].astype(x.dtype), window_strides=(1,),
        padding=[(SHORT_CONV // 2, SHORT_CONV // 2)],
        dimension_numbers=('NWC', 'WIO', 'NWC'), feature_group_count=x.shape[-1])


def gdn_scan(q, k, v, log_a, beta, s0, with_out):
    b, h, n, dk = q.shape
    dv = v.shape[-1]
    c = GDN_CHUNK
    nc = n // c
    q, k, v = (t.reshape(b, h, nc, c, t.shape[-1]) for t in (q, k, v))
    log_a, beta = (t.reshape(b, h, nc, c) for t in (log_a, beta))
    g = jnp.cumsum(log_a, -1)
    idx = jnp.arange(c)
    incl = idx[:, None] >= idx[None, :]
    strict = idx[:, None] > idx[None, :]
    decay = jnp.exp(jnp.where(incl, g[..., :, None] - g[..., None, :], -jnp.inf))
    a_mat = jnp.where(strict, beta[..., :, None] * jnp.einsum('bhnid,bhnjd->bhnij', k, k) * decay, 0.0)
    rhs = jnp.concatenate([beta[..., None] * v, (beta * jnp.exp(g))[..., None] * k], -1)
    sol = lax.linalg.triangular_solve(a_mat + jnp.eye(c, dtype=a_mat.dtype), rhs, left_side=True, lower=True)
    u_base, w = sol[..., :dv], sol[..., dv:]
    k_tail = k * jnp.exp(g[..., -1:] - g)[..., None]
    chunk_decay = jnp.exp(g[..., -1])
    mv = lambda t: jnp.moveaxis(t, 2, 0)
    xs = (mv(u_base), mv(w), mv(k_tail), mv(chunk_decay))
    if with_out:
        qk = jnp.einsum('bhnid,bhnjd->bhnij', q, k) * decay
        xs = xs + (mv(qk), mv(q * jnp.exp(g)[..., None]))

    def step(s, xc):
        u = xc[0] - jnp.einsum('bhck,bhkv->bhcv', xc[1], s)
        s_new = s * xc[3][..., None, None] + jnp.einsum('bhck,bhcv->bhkv', xc[2], u)
        if not with_out:
            return s_new, None
        o = jnp.einsum('bhck,bhkv->bhcv', xc[5], s) + jnp.einsum('bhcj,bhjv->bhcv', xc[4], u)
        return s_new, o

    s_last, o = lax.scan(step, s0, xs)
    if not with_out:
        return None, s_last
    return jnp.moveaxis(o, 0, 2).reshape(b, h, n, dv), s_last


def gdn_group(pl, pc, conv_w, a_log, dt_bias, norm_g, with_ctx_out):
    def prep(p):
        b, n, _ = p['gdn_qkv'].shape
        qkv = jax.nn.silu(short_conv(p['gdn_qkv'], conv_w)).astype(F32)
        qkv = qkv.reshape(b, n, 3, GROUP_HEADS, HEAD_DIM).transpose(2, 0, 3, 1, 4)
        q = l2_normalize(qkv[0]) * HEAD_DIM ** -0.5
        k = l2_normalize(qkv[1])
        a = p['gdn_a'].astype(F32).reshape(b, n, 2, GROUP_HEADS).transpose(2, 0, 3, 1)
        log_a = -jnp.exp(a_log.astype(F32))[:, None, :, None] * jax.nn.softplus(
            a + dt_bias.astype(F32)[:, None, :, None])
        beta = jax.nn.sigmoid(p['gdn_b'].astype(F32).reshape(b, n, 2, GROUP_HEADS).transpose(2, 0, 3, 1))
        return q, k, qkv[2], log_a, beta

    ql, kl, vl, la_l, bt_l = prep(pl)
    qc, kc, vc, la_c, bt_c = prep(pc)
    s0 = jnp.zeros((ql.shape[0], GROUP_HEADS, HEAD_DIM, HEAD_DIM), F32)
    o_l, o_c = 0.0, 0.0
    for dr in range(2):
        f = flip_seq if dr else (lambda t: t)
        oc, s_ctx = gdn_scan(f(qc), f(kc), f(vc), f(la_c[dr]), f(bt_c[dr]), s0, with_ctx_out)
        ol, _ = gdn_scan(f(ql), f(kl), f(vl), f(la_l[dr]), f(bt_l[dr]), s_ctx, True)
        o_l = o_l + f(ol)
        if with_ctx_out:
            o_c = o_c + f(oc)

    def finish(o, gate):
        o = o.transpose(0, 2, 1, 3)
        gt = gate.astype(F32).reshape(o.shape)
        return (rms_norm(o, norm_g) * jax.nn.silu(gt)).reshape(gate.shape).astype(gate.dtype)

    return finish(o_l, pl['gdn_g']), (finish(o_c, pc['gdn_g']) if with_ctx_out else None)


def swa_group(pl, pc, sink, ang_axial, with_ctx_out):
    hkv = SWA_KV_HEADS
    grp = GROUP_HEADS // hkv
    scale = HEAD_DIM ** -0.5
    b, n, _ = pl['swa_q'].shape
    lc = pc['swa_q'].shape[1]
    ql = rotate(pl['swa_q'].reshape(b, n, hkv, grp, HEAD_DIM), ang_axial[:, None, None, :])
    kl = rotate(pl['swa_k'].reshape(b, n, hkv, HEAD_DIM), ang_axial[:, None, :])
    vl = pl['swa_v'].reshape(b, n, hkv, HEAD_DIM)
    qc = pc['swa_q'].reshape(b, lc, hkv, grp, HEAD_DIM)
    kc = pc['swa_k'].reshape(b, lc, hkv, HEAD_DIM)
    vc = pc['swa_v'].reshape(b, lc, hkv, HEAD_DIM)
    sink = sink.astype(F32).reshape(hkv, grp)[:, :, None, None]
    blk = WINDOW
    nb = n // blk

    def band(t):
        tp = jnp.pad(t, ((0, 0), (blk, blk), (0, 0), (0, 0))).reshape(b, nb + 2, blk, hkv, HEAD_DIM)
        return jnp.concatenate([tp[:, :-2], tp[:, 1:-1], tp[:, 2:]], axis=2)

    kb, vb = band(kl), band(vl)
    qb = ql.reshape(b, nb, blk, hkv, grp, HEAD_DIM)
    qpos = jnp.arange(nb)[:, None] * blk + jnp.arange(blk)[None]
    kpos = jnp.arange(nb)[:, None] * blk - blk + jnp.arange(3 * blk)[None]
    valid = ((jnp.abs(qpos[:, :, None] - kpos[:, None, :]) <= WINDOW)
             & (kpos[:, None, :] >= 0) & (kpos[:, None, :] < n))
    s_band = jnp.einsum('bnqhgd,bnkhd->bnhgqk', qb, kb, preferred_element_type=F32) * scale
    s_band = jnp.where(valid[None, :, None, None], s_band, -jnp.inf)
    s_ctx = jnp.einsum('bnqhgd,bkhd->bnhgqk', qb, kc, preferred_element_type=F32) * scale
    p = sink_softmax(jnp.concatenate([s_band, s_ctx], -1), sink)
    o = (jnp.einsum('bnhgqk,bnkhd->bnqhgd', p[..., :3 * blk].astype(vb.dtype), vb)
         + jnp.einsum('bnhgqk,bkhd->bnqhgd', p[..., 3 * blk:].astype(vc.dtype), vc))
    y_l = o.reshape(b, n, GROUP_W)
    y_c = None
    if with_ctx_out:
        sc = jnp.einsum('bqhgd,bkhd->bhgqk', qc, kc, preferred_element_type=F32) * scale
        pcx = sink_softmax(sc, sink)
        y_c = jnp.einsum('bhgqk,bkhd->bqhgd', pcx.astype(vc.dtype), vc).reshape(b, lc, GROUP_W)
    return y_l, y_c


def expert_choice_ffn(u, router_w, w_gate, w_up, w_down):
    b, n, d = u.shape
    cap = CAPACITY_FACTOR * n // N_EXPERTS
    aff = jax.nn.softmax(jnp.einsum('bnd,de->bne', u, router_w, preferred_element_type=F32), -1)
    weight, idx = lax.top_k(jnp.swapaxes(aff, 1, 2), cap)
    xin = jax.vmap(lambda ub, ib: ub[ib])(u, idx)
    hid = jax.nn.silu(jnp.einsum('becd,edf->becf', xin, w_gate)) * jnp.einsum('becd,edf->becf', xin, w_up)
    y = jnp.einsum('becf,efd->becd', hid, w_down) * weight[..., None].astype(u.dtype)
    flat = (jnp.arange(b)[:, None, None] * n + idx).reshape(-1)
    return jnp.zeros((b * n, d), u.dtype).at[flat].add(y.reshape(-1, d)).reshape(b, n, d)


def setup_inputs(seed: int = 0) -> dict:
    key = jax.random.key(seed)
    ks = jax.random.split(key, 24)
    D = D_MODEL
    nrm = lambda k, shape, s: jax.random.normal(k, shape, F32) * s
    x = nrm(ks[0], (BATCH, SEQ, D), 1.0)
    c = nrm(ks[1], (BATCH, D), 1.0)
    ctx = nrm(ks[2], (BATCH, CTX_LEN, D), 1.0)
    c_ctx = nrm(ks[3], (D,), 1.0)
    ada_w = nrm(ks[4], (DEPTH, D, 6 * D), 0.5 * D ** -0.5)
    ada_b = nrm(ks[5], (DEPTH, 6 * D), 0.02)
    w_in = nrm(ks[6], (DEPTH, D, IN_W), D ** -0.5)
    w_out = nrm(ks[7], (DEPTH, MIX_W, D), DEEPNORM_BETA * MIX_W ** -0.5)
    gamma_logit = jnp.log(2.0 ** (5.0 + jnp.arange(GROUP_HEADS, dtype=F32)) - 1.0)
    ret_decay = gamma_logit + nrm(ks[8], (DEPTH, 2, GROUP_HEADS), 0.1)
    diff_lambda = nrm(ks[9], (DEPTH, 4, DIFF_QK_DIM), 0.1)
    diff_norm = 1.0 + nrm(ks[10], (DEPTH, HEAD_DIM), 0.02)
    gdn_conv = nrm(ks[11], (DEPTH, SHORT_CONV, 3 * GROUP_W), SHORT_CONV ** -0.5)
    gdn_a_log = jnp.log(jax.random.uniform(ks[12], (DEPTH, 2, GROUP_HEADS), F32, 1.0, 16.0))
    dt = jnp.exp(jax.random.uniform(ks[13], (DEPTH, 2, GROUP_HEADS), F32, math.log(1e-3), math.log(1e-1)))
    gdn_dt_bias = dt + jnp.log(-jnp.expm1(-dt))
    gdn_norm = 1.0 + nrm(ks[14], (DEPTH, HEAD_DIM), 0.02)
    swa_sink = nrm(ks[15], (DEPTH, GROUP_HEADS), 0.5)
    ln_g = 1.0 + nrm(ks[16], (DEPTH, 2, D), 0.02)
    ln_b = nrm(ks[17], (DEPTH, 2, D), 0.02)
    router_w = nrm(ks[18], (DEPTH, D, N_EXPERTS), D ** -0.5)
    w_gate = nrm(ks[19], (DEPTH, N_EXPERTS, D, EXPERT_FF), D ** -0.5)
    w_up = nrm(ks[20], (DEPTH, N_EXPERTS, D, EXPERT_FF), D ** -0.5)
    w_down = nrm(ks[21], (DEPTH, N_EXPERTS, EXPERT_FF, D), DEEPNORM_BETA * EXPERT_FF ** -0.5)
    return {'x': x, 'c': c, 'ctx': ctx, 'c_ctx': c_ctx, 'ada_w': ada_w, 'ada_b': ada_b,
            'w_in': w_in, 'w_out': w_out, 'ret_decay': ret_decay, 'diff_lambda': diff_lambda,
            'diff_norm': diff_norm, 'gdn_conv': gdn_conv, 'gdn_a_log': gdn_a_log,
            'gdn_dt_bias': gdn_dt_bias, 'gdn_norm': gdn_norm, 'swa_sink': swa_sink,
            'ln_g': ln_g, 'ln_b': ln_b, 'router_w': router_w, 'w_gate': w_gate,
            'w_up': w_up, 'w_down': w_down}


def reference(x, c, ctx, c_ctx, ada_w, ada_b, w_in, w_out, ret_decay, diff_lambda, diff_norm,
              gdn_conv, gdn_a_log, gdn_dt_bias, gdn_norm, swa_sink, ln_g, ln_b,
              router_w, w_gate, w_up, w_down):
    b, n, d = x.shape
    ang_diff = axial_rope_angles(n, DIFF_QK_DIM)
    ang_swa = axial_rope_angles(n, HEAD_DIM)
    cond_l = jax.nn.silu(c)
    cond_c = jax.nn.silu(c_ctx)
    h, hc = x, ctx
    for layer in range(DEPTH):
        full_ctx = layer < DEPTH - 1
        mod_l = (cond_l @ ada_w[layer] + ada_b[layer]).reshape(b, 1, 6, d)
        mod_c = (cond_c @ ada_w[layer] + ada_b[layer]).reshape(1, 1, 6, d)
        u_l = h * (1.0 + mod_l[:, :, 1]) + mod_l[:, :, 0]
        u_c = hc * (1.0 + mod_c[:, :, 1]) + mod_c[:, :, 0]
        pl = split_cols(u_l @ w_in[layer])
        pc = split_cols(u_c @ w_in[layer])
        ya_l, ya_c = retention_group(pl, pc, ret_decay[layer], full_ctx)
        yb_l, yb_c = diff_attention_group(pl, pc, diff_lambda[layer], diff_norm[layer], layer, ang_diff, full_ctx)
        yc_l, yc_c = gdn_group(pl, pc, gdn_conv[layer], gdn_a_log[layer], gdn_dt_bias[layer], gdn_norm[layer], full_ctx)
        yd_l, yd_c = swa_group(pl, pc, swa_sink[layer], ang_swa, full_ctx)
        mix_l = jnp.concatenate([ya_l, yb_l, yc_l, yd_l], -1) @ w_out[layer]
        h = layer_norm(DEEPNORM_ALPHA * h + mod_l[:, :, 2] * mix_l, ln_g[layer, 0], ln_b[layer, 0])
        if full_ctx:
            mix_c = jnp.concatenate([ya_c, yb_c, yc_c, yd_c], -1) @ w_out[layer]
            hc = layer_norm(DEEPNORM_ALPHA * hc + mod_c[:, :, 2] * mix_c, ln_g[layer, 0], ln_b[layer, 0])
        f_l = expert_choice_ffn(h * (1.0 + mod_l[:, :, 4]) + mod_l[:, :, 3],
                                router_w[layer], w_gate[layer], w_up[layer], w_down[layer])
        h = layer_norm(DEEPNORM_ALPHA * h + mod_l[:, :, 5] * f_l, ln_g[layer, 1], ln_b[layer, 1])
        if full_ctx:
            f_c = expert_choice_ffn(hc * (1.0 + mod_c[:, :, 4]) + mod_c[:, :, 3],
                                    router_w[layer], w_gate[layer], w_up[layer], w_down[layer])
            hc = layer_norm(DEEPNORM_ALPHA * hc + mod_c[:, :, 5] * f_c, ln_g[layer, 1], ln_b[layer, 1])
    return h
```

```cpp
#ifndef EMU
#include <hip/hip_runtime.h>
#endif
#include <stdint.h>
#include <stddef.h>
#include <math.h>

#ifndef CFG_B
#define CFG_B 8
#define CFG_SEQ 4096
#define CFG_CTX 256
#define CFG_DEPTH 4
#define CFG_FF 2048
#endif

#define DI __device__ __forceinline__
typedef unsigned short bf16_t;
typedef short bf16x8 __attribute__((ext_vector_type(8)));
typedef short s16x4 __attribute__((ext_vector_type(4)));
typedef float f32x4 __attribute__((ext_vector_type(4)));
typedef unsigned u32x4 __attribute__((ext_vector_type(4)));
typedef unsigned u32x2 __attribute__((ext_vector_type(2)));

constexpr int NB = CFG_B, SEQ = CFG_SEQ, CTX = CFG_CTX, DEPTH = CFG_DEPTH, FF = CFG_FF, DM = 1024, NE = 16;
constexpr int RL = NB * SEQ, RC = NB * CTX, R = RL + RC;
constexpr int CAPL = SEQ / 8, CAPC = CTX / 8, ROWS_E = NB * (CAPL + CAPC);
constexpr int INW = 3344, PW = 3328;
constexpr int NT = 512;
constexpr int NCC = CTX / 128, NLC = SEQ / 128, NCHR = NCC + NLC;
constexpr int NCG = CTX / 64, NLG = SEQ / 64, NCHG = NCG + NLG;
constexpr float ALPHA = 1.681792830507429f;
constexpr float LOG2E = 1.4426950408889634f;
constexpr int C_RQ = 0, C_RK = 256, C_RV = 512, C_RG = 768, C_DQ = 1024, C_DK = 1280, C_DV = 1536, C_GQKV = 1792, C_GG = 2560, C_SQ = 2816, C_SK = 3072, C_SV = 3200;

constexpr size_t al256(size_t x) { return (x + 255) & ~(size_t)255; }
constexpr size_t OFF_BAR = 0;
constexpr size_t OFF_MOD = 16384;
constexpr size_t OFF_TAB = OFF_MOD + al256((size_t)DEPTH * (NB + 1) * 6144 * 4);
constexpr size_t OFF_WIN = OFF_TAB + al256((size_t)SEQ * 160 * 4);
constexpr size_t OFF_WOUT = OFF_WIN + al256((size_t)DEPTH * PW * 1024 * 2);
constexpr size_t OFF_WGU = OFF_WOUT + al256((size_t)DEPTH * 1024 * 1024 * 2);
constexpr size_t OFF_WDN = OFF_WGU + al256((size_t)DEPTH * 16 * 2 * FF * 1024 * 2);
constexpr size_t OFF_H = OFF_WDN + al256((size_t)DEPTH * 16 * 1024 * FF * 2);
constexpr size_t OFF_U = OFF_H + al256((size_t)R * 1024 * 4);
constexpr size_t OFF_GAB = OFF_U + al256((size_t)R * 1024 * 2);
constexpr size_t OFF_MIX = OFF_GAB + al256((size_t)R * 16 * 4);
constexpr size_t OFF_AFF = OFF_MIX + al256((size_t)R * 1024 * 2);
constexpr size_t OFF_IDX = OFF_AFF + al256((size_t)R * 16 * 4);
constexpr size_t OFF_WGT = OFF_IDX + al256((size_t)16 * ROWS_E * 4);
constexpr size_t OFF_INV = OFF_WGT + al256((size_t)16 * ROWS_E * 4);
constexpr size_t OFF_ARA = OFF_INV + al256((size_t)R * 16 * 4);
constexpr size_t SZ_P = (size_t)R * PW * 2, SZ_HID = (size_t)16 * ROWS_E * FF * 2;
constexpr size_t OFF_ARB = OFF_ARA + al256(SZ_P > SZ_HID ? SZ_P : SZ_HID);
constexpr size_t SZ_RKV = (size_t)NB * 4 * 2 * NCHR * 4096 * 4;
constexpr size_t GCH = (size_t)NB * 4 * 2 * NCHG;
constexpr size_t OB_RKV = 0, OB_RS = OB_RKV + al256(SZ_RKV), OB_GW = OB_RS + al256(SZ_RKV), OB_GQG = OB_GW + GCH * 8192, OB_GQK = OB_GQG + GCH * 8192,
                 OB_GKT = OB_GQK + GCH * 8192, OB_GUB = OB_GKT + GCH * 8192, OB_GCD = OB_GUB + GCH * 16384, OB_OG = OB_GCD + al256(GCH * 4), OB_END = OB_OG + (size_t)2 * R * 256 * 4;
constexpr size_t SZ_MIXO = (size_t)R * 1024 * 4, SZ_Y = (size_t)16 * ROWS_E * 1024 * 2;
constexpr size_t SZ_ARB = OB_END > SZ_MIXO ? (OB_END > SZ_Y ? OB_END : SZ_Y) : (SZ_MIXO > SZ_Y ? SZ_MIXO : SZ_Y);
constexpr size_t WS_TOTAL = OFF_ARB + al256(SZ_ARB);

struct Params {
    const float *x, *c, *ctx, *c_ctx, *ada_w, *ada_b, *w_in, *w_out, *ret_decay, *diff_lambda, *diff_norm, *gdn_conv, *gdn_a_log, *gdn_dt_bias,
        *gdn_norm, *swa_sink, *ln_g, *ln_b, *router_w, *w_gate, *w_up, *w_down;
    float* out; char* ws;
};

DI float bf2f(bf16_t v) { return __uint_as_float(((unsigned)v) << 16); }
DI bf16_t f2bf(float f) { unsigned u = __float_as_uint(f); u += 0x7fffu + ((u >> 16) & 1u); return (bf16_t)(u >> 16); }
DI unsigned pk2(float lo, float hi) {
#ifdef EMU
    return (unsigned)f2bf(lo) | ((unsigned)f2bf(hi) << 16);
#else
    unsigned r; asm("v_cvt_pk_bf16_f32 %0, %1, %2" : "=v"(r) : "v"(lo), "v"(hi)); return r;
#endif
}
DI float wsum(float v) {
#pragma unroll
    for (int m = 32; m >= 1; m >>= 1) v += __shfl_xor(v, m);
    return v;
}
DI float siluf(float x) { return x / (1.0f + __expf(-x)); }
DI float sigmoidf_(float x) { return 1.0f / (1.0f + __expf(-x)); }
DI float softplusf_(float x) { return x > 20.0f ? x : log1pf(__expf(x)); }
DI float ex2(float x) { return __builtin_amdgcn_exp2f(x); }
DI f32x4 MFMA16(bf16x8 a, bf16x8 b, f32x4 c) { return __builtin_amdgcn_mfma_f32_16x16x32_bf16(a, b, c, 0, 0, 0); }
#ifdef EMU
#define WAIT_V(n)
#define WAIT_L(n)
#else
#define WAIT_V(n) asm volatile("s_waitcnt vmcnt(" #n ")" ::: "memory")
#define WAIT_L(n) asm volatile("s_waitcnt lgkmcnt(" #n ")" ::: "memory")
#endif
#define BAR __builtin_amdgcn_s_barrier()
#define SCHED __builtin_amdgcn_sched_barrier(0)

#ifdef EMU
struct XcdBarrier { unsigned* bar; };
DI XcdBarrier xcd_barrier_post(unsigned* bar, void*) { XcdBarrier b; b.bar = bar; return b; }
DI void xcd_barrier(const XcdBarrier& b) {
    __syncthreads();
    if (threadIdx.x == 0) { unsigned g = __atomic_load_n(&b.bar[64], __ATOMIC_SEQ_CST);
        if (__atomic_fetch_add(&b.bar[0], 1u, __ATOMIC_SEQ_CST) == gridDim.x - 1) { __atomic_store_n(&b.bar[0], 0u, __ATOMIC_SEQ_CST); __atomic_fetch_add(&b.bar[64], 1u, __ATOMIC_SEQ_CST); }
        else while (__atomic_load_n(&b.bar[64], __ATOMIC_SEQ_CST) == g) sched_yield(); }
    __syncthreads();
}
#define XCD_BAR_WORDS 3456
#else
#define XB_TMO      128
#define XB_XCNT(j)  (256  + 64 * (j))
#define XB_XSUB(j)  (1280 + 64 * (j))
#define XB_XGEN(j)  (2304 + 64 * (j))
#define XB_TOP      3328
#define XB_TOPGEN   3392
#define XCD_BAR_WORDS 3456
#define XB_SPIN_CAP (1u << 22)
#define LAS __attribute__((address_space(3)))
DI unsigned xb_ld(unsigned* p)              { return __hip_atomic_load(p, __ATOMIC_RELAXED, __HIP_MEMORY_SCOPE_AGENT); }
DI unsigned xb_add(unsigned* p, unsigned v) { return __hip_atomic_fetch_add(p, v, __ATOMIC_RELAXED, __HIP_MEMORY_SCOPE_AGENT); }
DI unsigned xb_xcc_id() { return (unsigned)__builtin_amdgcn_s_getreg((3 << 11) | 20) & 0xFu; }
#define XB_SPIN(cond, bar) do { unsigned _sp = 0; while (cond) { __builtin_amdgcn_s_sleep(1); \
    if ((++_sp & 255u) == 0u) { if (xb_ld(&(bar)[XB_TMO])) break; if (_sp > XB_SPIN_CAP) { atomicAdd(&(bar)[XB_TMO], 1u); break; } } } } while (0)
struct XcdBarrier { unsigned* bar; unsigned x; volatile LAS unsigned* st; };
DI XcdBarrier xcd_barrier_post(unsigned* bar, volatile LAS unsigned* st) {
    XcdBarrier b; b.bar = bar; b.x = xb_xcc_id(); b.st = st;
    if (threadIdx.x == 0) (void)xb_add(&bar[XB_XCNT(b.x)], 1u);
    return b;
}
DI void xcd_barrier_complete(unsigned* bar, unsigned x, unsigned& nloc, unsigned& nx) {
    const unsigned G = gridDim.x * gridDim.y * gridDim.z;
    unsigned sum, cnt, mine, sp = 0u;
    for (;;) {
        sum = 0u; cnt = 0u; mine = 0u;
#pragma unroll
        for (unsigned j = 0; j < 16; ++j) { const unsigned c = xb_ld(&bar[XB_XCNT(j)]); sum += c; cnt += (c > 0u) ? 1u : 0u; mine = (j == x) ? c : mine; }
        if (sum == G) break;
        __builtin_amdgcn_s_sleep(1);
        if ((++sp & 255u) == 0u) { if (xb_ld(&bar[XB_TMO])) break; if (sp > XB_SPIN_CAP) { atomicAdd(&bar[XB_TMO], 1u); break; } }
    }
    nloc = mine > 0u ? mine : 1u; nx = cnt > 0u ? cnt : 1u;
}
DI void xcd_barrier(const XcdBarrier& b) {
    asm volatile("s_waitcnt vmcnt(0)" ::: "memory");
    __syncthreads();
    if (threadIdx.x == 0) {
        unsigned* bar = b.bar;
        __builtin_amdgcn_s_waitcnt(0);
        unsigned nloc = b.st[0], nx = b.st[1];
        if (nloc == 0u) { xcd_barrier_complete(bar, b.x, nloc, nx); b.st[0] = nloc; b.st[1] = nx; }
        const unsigned old = xb_add(&bar[XB_XSUB(b.x)], 1u);
        const unsigned gen = old / nloc;
        if (old + 1u == (gen + 1u) * nloc) {
            __builtin_amdgcn_fence(__ATOMIC_RELEASE, "agent");
            asm volatile("s_waitcnt vmcnt(0)" ::: "memory");
            const unsigned og = xb_add(&bar[XB_TOP], 1u);
            const unsigned tg = og / nx;
            if (og + 1u == (tg + 1u) * nx) xb_add(&bar[XB_TOPGEN], 1u);
            else XB_SPIN(xb_ld(&bar[XB_TOPGEN]) == tg, bar);
            __builtin_amdgcn_fence(__ATOMIC_ACQUIRE, "agent");
            xb_add(&bar[XB_XGEN(b.x)], 1u);
            asm volatile("s_waitcnt vmcnt(0)" ::: "memory");
        } else {
            XB_SPIN(xb_ld(&bar[XB_XGEN(b.x)]) == gen, bar);
            __builtin_amdgcn_fence(__ATOMIC_ACQUIRE, "agent");
            asm volatile("s_waitcnt vmcnt(0)" ::: "memory");
        }
    }
    __syncthreads();
}
#endif

struct WS {
    unsigned* bar; float* mod; float* tab; bf16_t* win; bf16_t* wout; bf16_t* wgu; bf16_t* wdn; float* h; bf16_t* u; float* gab; bf16_t* mix; float* aff;
    int* idx; float* wgt; int* inv; bf16_t* p; bf16_t* hid; float* rkv; float* rs; bf16_t* gw; bf16_t* gqg; bf16_t* gqk; bf16_t* gkt; float* gub; float* gcd; float* og; float* mixo; bf16_t* y;
};
DI WS ws_of(char* w) {
    WS s; s.bar = (unsigned*)(w + OFF_BAR); s.mod = (float*)(w + OFF_MOD); s.tab = (float*)(w + OFF_TAB); s.win = (bf16_t*)(w + OFF_WIN); s.wout = (bf16_t*)(w + OFF_WOUT);
    s.wgu = (bf16_t*)(w + OFF_WGU); s.wdn = (bf16_t*)(w + OFF_WDN); s.h = (float*)(w + OFF_H); s.u = (bf16_t*)(w + OFF_U); s.gab = (float*)(w + OFF_GAB); s.mix = (bf16_t*)(w + OFF_MIX);
    s.aff = (float*)(w + OFF_AFF); s.idx = (int*)(w + OFF_IDX); s.wgt = (float*)(w + OFF_WGT); s.inv = (int*)(w + OFF_INV); s.p = (bf16_t*)(w + OFF_ARA); s.hid = (bf16_t*)(w + OFF_ARA);
    char* b = w + OFF_ARB; s.rkv = (float*)(b + OB_RKV); s.rs = (float*)(b + OB_RS); s.gw = (bf16_t*)(b + OB_GW); s.gqg = (bf16_t*)(b + OB_GQG); s.gqk = (bf16_t*)(b + OB_GQK);
    s.gkt = (bf16_t*)(b + OB_GKT); s.gub = (float*)(b + OB_GUB); s.gcd = (float*)(b + OB_GCD); s.og = (float*)(b + OB_OG); s.mixo = (float*)b; s.y = (bf16_t*)b;
    return s;
}

DI void cvt_tile(const float* src, int src_ld, int k0, int c0, bf16_t* dst, int dst_ld, int drow0, float* tile) {
    const int tid = threadIdx.x;
#pragma unroll
    for (int i = 0; i < 8; ++i) { const int idx = tid + NT * i, kk = idx >> 6, cc = idx & 63; tile[kk * 65 + cc] = src[(size_t)(k0 + kk) * src_ld + c0 + cc]; }
    __syncthreads();
#pragma unroll
    for (int i = 0; i < 4; ++i) { const int idx = tid + NT * i, cc = idx >> 5, kp = idx & 31;
        *(unsigned*)(dst + (size_t)(drow0 + cc) * dst_ld + k0 + 2 * kp) = pk2(tile[(2 * kp) * 65 + cc], tile[(2 * kp + 1) * 65 + cc]); }
    __syncthreads();
}
DI void phase_cvt(const Params& p, char* smem) {
    const WS w = ws_of(p.ws); float* tile = (float*)smem;
    constexpr int FT = FF / 64, n_in = 16 * 52, n_out = 256, n_g = 16 * 16 * FT, tot_l = n_in + n_out + 3 * n_g, total = DEPTH * tot_l;
    for (int u = blockIdx.x; u < total; u += gridDim.x) {
        const int l = u / tot_l; int r = u % tot_l;
        if (r < n_in) { const int kt = r & 15, ct = r >> 4, c0 = ct < 44 ? ct * 64 : 2832 + (ct - 44) * 64;
            cvt_tile(p.w_in + (size_t)l * 1024 * INW, INW, kt * 64, c0, w.win + (size_t)l * PW * 1024, 1024, ct < 44 ? c0 : c0 - 16, tile);
        } else if (r < n_in + n_out) { r -= n_in; const int kt = r & 15, ct = r >> 4;
            cvt_tile(p.w_out + (size_t)l * 1024 * 1024, 1024, kt * 64, ct * 64, w.wout + (size_t)l * 1024 * 1024, 1024, ct * 64, tile);
        } else if (r < n_in + n_out + 2 * n_g) { r -= n_in + n_out; const int which = r / n_g, rr = r % n_g, e = rr / (16 * FT), r2 = rr % (16 * FT), kt = r2 & 15, ct = r2 >> 4, c0 = ct * 64;
            cvt_tile((which ? p.w_up : p.w_gate) + (size_t)(l * 16 + e) * 1024 * FF, FF, kt * 64, c0, w.wgu + (size_t)(l * 16 + e) * 2 * FF * 1024, 1024, (c0 >> 7) * 256 + which * 128 + (c0 & 127), tile);
        } else { r -= n_in + n_out + 2 * n_g; const int e = r / (16 * FT), r2 = r % (16 * FT), kt = r2 % FT, ct = r2 / FT;
            cvt_tile(p.w_down + (size_t)(l * 16 + e) * FF * 1024, 1024, kt * 64, ct * 64, w.wdn + (size_t)(l * 16 + e) * 1024 * FF, FF, ct * 64, tile);
        }
    }
    for (int i = blockIdx.x * NT + threadIdx.x; i < SEQ * 80; i += gridDim.x * NT) {
        const int n = i / 80, a = i % 80, row = n / 64, col = n % 64; float ang;
        if (a < 32) ang = (float)n * (1.0f / powf(10000.0f, (float)a / 31.0f));
        else if (a < 48) { const int ii = a - 32; ang = (float)(ii < 8 ? row : col) * powf(10000.0f, -(float)(ii & 7) / 8.0f); }
        else { const int ii = a - 48; ang = (float)(ii < 16 ? row : col) * powf(10000.0f, -(float)(ii & 15) / 16.0f); }
        w.tab[2 * i] = cosf(ang); w.tab[2 * i + 1] = sinf(ang);
    }
    float* cond = (float*)smem; float* red = cond + (NB + 1) * 1024;
    __syncthreads();
    for (int i = threadIdx.x; i < (NB + 1) * 1024; i += NT) { const int r = i >> 10, k = i & 1023; const float v = r < NB ? p.c[r * 1024 + k] : p.c_ctx[k]; cond[i] = siluf(v); }
    __syncthreads();
    for (int u = blockIdx.x; u < DEPTH * 96; u += gridDim.x) {
        const int l = u / 96, cg = u % 96, col = threadIdx.x & 63, kg = threadIdx.x >> 6;
        float acc[NB + 1];
#pragma unroll
        for (int r = 0; r <= NB; ++r) acc[r] = 0.f;
        const float* wp = p.ada_w + ((size_t)l * 1024 + kg * 128) * 6144 + cg * 64 + col;
        for (int k = 0; k < 128; ++k) { const float wv = wp[(size_t)k * 6144];
#pragma unroll
            for (int r = 0; r <= NB; ++r) acc[r] += cond[r * 1024 + kg * 128 + k] * wv; }
#pragma unroll
        for (int r = 0; r <= NB; ++r) red[(kg * (NB + 1) + r) * 64 + col] = acc[r];
        __syncthreads();
        for (int i = threadIdx.x; i < (NB + 1) * 64; i += NT) { const int r = i >> 6, cc = i & 63; float s = p.ada_b[l * 6144 + cg * 64 + cc];
#pragma unroll
            for (int g = 0; g < 8; ++g) s += red[(g * (NB + 1) + r) * 64 + cc];
            w.mod[((size_t)l * (NB + 1) + r) * 6144 + cg * 64 + cc] = s; }
        __syncthreads();
    }
}

template <int MODE> DI void phase_rows(const Params& p, int layer, char* smem) {
    const WS w = ws_of(p.ws); float* Wl = (float*)smem;
    const int tid = threadIdx.x, lane = tid & 63, wv = tid >> 6;
    const bool last = (layer == DEPTH - 1);
    __syncthreads();
    if (MODE == 0 || (MODE == 2 && !last)) { const int l2 = MODE == 0 ? 0 : layer + 1;
        for (int i = tid; i < 16 * 1024; i += NT) { const int o = i & 15, k = i >> 4; Wl[o * 1024 + k] = p.w_in[((size_t)l2 * 1024 + k) * INW + 2816 + o]; } }
    if (MODE == 1) for (int i = tid; i < 16 * 1024; i += NT) { const int o = i & 15, k = i >> 4; Wl[o * 1024 + k] = p.router_w[((size_t)layer * 1024 + k) * 16 + o]; }
    __syncthreads();
    const int nrows = (MODE != 0 && last) ? RL : R;
    for (int row = blockIdx.x * 8 + wv; row < nrows; row += gridDim.x * 8) {
        const bool isc = row >= RL; const int b = isc ? NB : row / SEQ;
        f32x4 hv[4];
        if (MODE == 0) { const float* src = isc ? p.ctx + (size_t)(row - RL) * 1024 : p.x + (size_t)row * 1024;
#pragma unroll
            for (int j = 0; j < 4; ++j) hv[j] = *(const f32x4*)(src + 256 * j + 4 * lane);
        } else {
            const float* mg = w.mod + ((size_t)layer * (NB + 1) + b) * 6144 + (MODE == 1 ? 2 : 5) * 1024;
            f32x4 br[4];
            if (MODE == 1) {
#pragma unroll
                for (int j = 0; j < 4; ++j) br[j] = *(const f32x4*)(w.mixo + (size_t)row * 1024 + 256 * j + 4 * lane);
            } else {
#pragma unroll
                for (int j = 0; j < 4; ++j) br[j] = (f32x4){0.f, 0.f, 0.f, 0.f};
                const int myinv = lane < 16 ? w.inv[(size_t)row * 16 + lane] : -1;
                for (int e = 0; e < 16; ++e) { const int sl = __shfl(myinv, e);
                    if (sl >= 0) { const bf16_t* yr = w.y + ((size_t)e * ROWS_E + sl) * 1024;
#pragma unroll
                        for (int j = 0; j < 4; ++j) { const u32x2 v = *(const u32x2*)(yr + 256 * j + 4 * lane);
                            br[j][0] += __uint_as_float(v[0] << 16); br[j][1] += __uint_as_float(v[0] & 0xffff0000u); br[j][2] += __uint_as_float(v[1] << 16); br[j][3] += __uint_as_float(v[1] & 0xffff0000u); } } }
            }
            float s = 0.f;
#pragma unroll
            for (int j = 0; j < 4; ++j) { const f32x4 ho = *(const f32x4*)(w.h + (size_t)row * 1024 + 256 * j + 4 * lane); const f32x4 g = *(const f32x4*)(mg + 256 * j + 4 * lane);
                hv[j] = ALPHA * ho + g * br[j]; s += hv[j][0] + hv[j][1] + hv[j][2] + hv[j][3]; }
            const float mean = wsum(s) * (1.0f / 1024.0f); float q = 0.f;
#pragma unroll
            for (int j = 0; j < 4; ++j) { hv[j] = hv[j] - mean; q += hv[j][0] * hv[j][0] + hv[j][1] * hv[j][1] + hv[j][2] * hv[j][2] + hv[j][3] * hv[j][3]; }
            const float rstd = 1.0f / sqrtf(wsum(q) * (1.0f / 1024.0f) + 1e-5f);
            const float* lg = p.ln_g + ((size_t)layer * 2 + (MODE == 1 ? 0 : 1)) * 1024; const float* lb = p.ln_b + ((size_t)layer * 2 + (MODE == 1 ? 0 : 1)) * 1024;
#pragma unroll
            for (int j = 0; j < 4; ++j) hv[j] = hv[j] * rstd * *(const f32x4*)(lg + 256 * j + 4 * lane) + *(const f32x4*)(lb + 256 * j + 4 * lane);
        }
        if (MODE == 2 && last) {
#pragma unroll
            for (int j = 0; j < 4; ++j) *(f32x4*)(p.out + (size_t)row * 1024 + 256 * j + 4 * lane) = hv[j];
            continue;
        }
#pragma unroll
        for (int j = 0; j < 4; ++j) *(f32x4*)(w.h + (size_t)row * 1024 + 256 * j + 4 * lane) = hv[j];
        const int lm = MODE == 2 ? layer + 1 : (MODE == 0 ? 0 : layer);
        const float* m0 = w.mod + ((size_t)lm * (NB + 1) + b) * 6144 + (MODE == 1 ? 3 : 0) * 1024; const float* m1 = m0 + 1024;
        f32x4 uv[4];
#pragma unroll
        for (int j = 0; j < 4; ++j) { uv[j] = hv[j] * (1.0f + *(const f32x4*)(m1 + 256 * j + 4 * lane)) + *(const f32x4*)(m0 + 256 * j + 4 * lane);
            u32x2 o; o[0] = pk2(uv[j][0], uv[j][1]); o[1] = pk2(uv[j][2], uv[j][3]); *(u32x2*)(w.u + (size_t)row * 1024 + 256 * j + 4 * lane) = o; }
        float mine = 0.f, lgt[16];
#pragma unroll
        for (int o = 0; o < 16; ++o) { float a = 0.f;
#pragma unroll
            for (int j = 0; j < 4; ++j) { const f32x4 wv4 = *(const f32x4*)(Wl + o * 1024 + 256 * j + 4 * lane); a += uv[j][0] * wv4[0] + uv[j][1] * wv4[1] + uv[j][2] * wv4[2] + uv[j][3] * wv4[3]; }
            lgt[o] = wsum(a); }
        if (MODE == 1) { float mx = lgt[0];
#pragma unroll
            for (int o = 1; o < 16; ++o) mx = fmaxf(mx, lgt[o]);
            float sm = 0.f;
#pragma unroll
            for (int o = 0; o < 16; ++o) { lgt[o] = __expf(lgt[o] - mx); sm += lgt[o]; }
            const float inv = 1.0f / sm;
#pragma unroll
            for (int o = 0; o < 16; ++o) if (lane == o) mine = lgt[o] * inv;
            if (lane < 16) { if (!isc) { const int bb = row / SEQ, n = row % SEQ; w.aff[((size_t)bb * 16 + lane) * SEQ + n] = mine; }
                             else { const int rr = row - RL, bb = rr / CTX, n = rr % CTX; w.aff[(size_t)RL * 16 + ((size_t)bb * 16 + lane) * CTX + n] = mine; } }
        } else {
#pragma unroll
            for (int o = 0; o < 16; ++o) if (lane == o) mine = lgt[o];
            if (lane < 16) w.gab[(size_t)row * 16 + lane] = mine;
        }
    }
}

constexpr int G_HT = 128 * 64;
DI int lds_byte(int r, int c) { const int st = (r >> 4) * 2 + (c >> 5), rr = r & 15, cc = c & 31, ob = rr * 64 + cc * 2; return st * 1024 + (ob ^ (((ob >> 9) & 1) << 5)); }
DI void stage_rc(int b, int& Rr, int& Cc) { const int st = b / 1024, sb = b % 1024, swz = sb ^ (((sb >> 9) & 1) << 5); Rr = (st >> 1) * 16 + swz / 64; Cc = (st & 1) * 32 + (swz % 64) / 2; }
#define GLDS16(g, l) __builtin_amdgcn_global_load_lds((const unsigned*)(g), (unsigned*)(l), 16, 0, 0)

struct EpiArgs { void* out; int ld; long orow0; const float* wgt; };
template <int EPI, bool GATHER>
DI void gemm_unit(const bf16_t* __restrict__ A, const bf16_t* __restrict__ Bt, const int K, const int brow, const int bcol, const int* __restrict__ gidx, const EpiArgs ea, char* smem) {
    bf16_t* shm = (bf16_t*)smem;
#define SA(b, h) (shm + ((b) * 2 + (h)) * G_HT)
#define SB(b, h) (shm + (4 + (b) * 2 + (h)) * G_HT)
#define STAGE_B(T, P, h, kt) do { _Pragma("unroll") for (int _i = 0; _i < 2; ++_i) { const int _b = (T) * 16 + _i * 8192; int _r, _c; stage_rc(_b, _r, _c); \
        GLDS16(Bt + (unsigned)((bcol + (h) * 128 + _r) * K + (kt) * 64 + _c), (char*)(P) + _b); } } while (0)
#define STAGE_A(T, P, h, kt) do { _Pragma("unroll") for (int _i = 0; _i < 2; ++_i) { const int _b = (T) * 16 + _i * 8192; int _r, _c; stage_rc(_b, _r, _c); \
        const int _ro = GATHER ? rid[h][_i] : (brow + (h) * 128 + _r); GLDS16(A + (unsigned)(_ro * K + (kt) * 64 + _c), (char*)(P) + _b); } } while (0)
#define LDA(dst, b, h) _Pragma("unroll") for (int m = 0; m < 4; ++m) _Pragma("unroll") for (int k = 0; k < 2; ++k) \
        dst[m][k] = *reinterpret_cast<const bf16x8*>((char*)SA(b, h) + lds_byte(wr * 64 + m * 16 + fr, k * 32 + fq * 8))
#define LDB(dst, b, h) _Pragma("unroll") for (int n = 0; n < 2; ++n) _Pragma("unroll") for (int k = 0; k < 2; ++k) \
        dst[n][k] = *reinterpret_cast<const bf16x8*>((char*)SB(b, h) + lds_byte(wc * 32 + n * 16 + fr, k * 32 + fq * 8))
#define MMA(ai, bj, At_, Bt_) do { __builtin_amdgcn_s_setprio(1); \
        _Pragma("unroll") for (int m = 0; m < 4; ++m) _Pragma("unroll") for (int n = 0; n < 2; ++n) _Pragma("unroll") for (int k = 0; k < 2; ++k) \
            acc[ai][bj][m][n] = MFMA16(Bt_[n][k], At_[m][k], acc[ai][bj][m][n]); \
        __builtin_amdgcn_s_setprio(0); } while (0)
    int tid = threadIdx.x;
#ifndef EMU
    asm volatile("" : "+v"(tid));
#endif
    int wid = tid >> 6, lane = tid & 63, wr = wid >> 2, wc = wid & 3, fr = lane & 15, fq = lane >> 4;
    int rid[2][2];
    if (GATHER) {
#pragma unroll
        for (int h = 0; h < 2; ++h)
#pragma unroll
            for (int i = 0; i < 2; ++i) { int r_, c_; stage_rc(tid * 16 + i * 8192, r_, c_); rid[h][i] = gidx[h * 128 + r_]; }
    }
    f32x4 acc[2][2][4][2];
#pragma unroll
    for (int a = 0; a < 2; ++a)
#pragma unroll
        for (int b = 0; b < 2; ++b)
#pragma unroll
            for (int m = 0; m < 4; ++m)
#pragma unroll
                for (int n = 0; n < 2; ++n) acc[a][b][m][n] = (f32x4){0.f, 0.f, 0.f, 0.f};
    bf16x8 At[4][2], B0[2][2], B1[2][2];
    const int nt = K / 64;
    STAGE_B(tid, SB(0, 0), 0, 0); STAGE_A(tid, SA(0, 0), 0, 0);
    STAGE_B(tid, SB(0, 1), 1, 0); STAGE_A(tid, SA(0, 1), 1, 0);
    if (wr == 1) BAR;
    WAIT_V(4); BAR;
    STAGE_B(tid, SB(1, 0), 0, 1); STAGE_A(tid, SA(1, 0), 0, 1); STAGE_B(tid, SB(1, 1), 1, 1);
    WAIT_V(6); BAR;
    for (int t = 0; t < nt - 2; t += 2) {
        LDB(B0, 0, 0); SCHED; LDA(At, 0, 0); STAGE_A(tid, SA(1, 1), 1, t + 1);
        WAIT_L(8); BAR; WAIT_L(0); MMA(0, 0, At, B0); BAR; SCHED;
        LDB(B1, 0, 1); STAGE_B(tid, SB(0, 0), 0, t + 2);
        BAR; WAIT_L(0); MMA(0, 1, At, B1); BAR;
        LDA(At, 0, 1); STAGE_A(tid, SA(0, 0), 0, t + 2);
        BAR; WAIT_L(0); MMA(1, 0, At, B0); BAR; SCHED;
        STAGE_B(tid, SB(0, 1), 1, t + 2);
        WAIT_V(6); BAR; MMA(1, 1, At, B1); BAR;
        LDB(B0, 1, 0); SCHED; LDA(At, 1, 0); STAGE_A(tid, SA(0, 1), 1, t + 2);
        WAIT_L(8); BAR; WAIT_L(0); MMA(0, 0, At, B0); BAR; SCHED;
        LDB(B1, 1, 1); STAGE_B(tid, SB(1, 0), 0, t + 3);
        BAR; WAIT_L(0); MMA(0, 1, At, B1); BAR;
        LDA(At, 1, 1); STAGE_A(tid, SA(1, 0), 0, t + 3);
        BAR; WAIT_L(0); MMA(1, 0, At, B0); BAR; SCHED;
        STAGE_B(tid, SB(1, 1), 1, t + 3);
        WAIT_V(6); BAR; MMA(1, 1, At, B1); BAR;
    }
    int tz = threadIdx.x;
#ifndef EMU
    asm volatile("" : "+v"(tz));
#endif
    wid = tz >> 6; lane = tz & 63; wr = wid >> 2; wc = wid & 3; fr = lane & 15; fq = lane >> 4;
    { LDB(B0, 0, 0); WAIT_V(0); LDA(At, 0, 0); STAGE_A(tz, SA(1, 1), 1, nt - 1);
      BAR; WAIT_L(0); MMA(0, 0, At, B0); BAR;
      LDB(B1, 0, 1); BAR; WAIT_L(0); MMA(0, 1, At, B1); BAR;
      LDA(At, 0, 1); WAIT_V(4); BAR; WAIT_L(0); MMA(1, 0, At, B0); MMA(1, 1, At, B1); BAR; }
    { LDB(B0, 1, 0); LDA(At, 1, 0); WAIT_V(2); BAR; WAIT_L(0); MMA(0, 0, At, B0); BAR;
      LDB(B1, 1, 1); WAIT_V(0); BAR; WAIT_L(0); MMA(0, 1, At, B1); BAR;
      LDA(At, 1, 1); BAR; WAIT_L(0); MMA(1, 0, At, B0); MMA(1, 1, At, B1); BAR; }
    if (wr == 0) BAR;
#pragma unroll
    for (int ai = 0; ai < 2; ++ai)
#pragma unroll
        for (int m = 0; m < 4; ++m) {
            const int lrow = ai * 128 + wr * 64 + m * 16 + fr; const long orow = ea.orow0 + lrow;
            float wg = 1.0f; if (EPI == 3) wg = ea.wgt[lrow];
#pragma unroll
            for (int n = 0; n < 2; ++n) {
                if (EPI == 2) { const f32x4 g = acc[ai][0][m][n], u = acc[ai][1][m][n]; const int col = (bcol >> 1) + wc * 32 + n * 16 + fq * 4;
                    u32x2 o; o[0] = pk2(siluf(g[0]) * u[0], siluf(g[1]) * u[1]); o[1] = pk2(siluf(g[2]) * u[2], siluf(g[3]) * u[3]);
                    *(u32x2*)((bf16_t*)ea.out + (size_t)orow * ea.ld + col) = o;
                } else {
#pragma unroll
                    for (int bj = 0; bj < 2; ++bj) { const f32x4 v = acc[ai][bj][m][n]; const int col = bcol + bj * 128 + wc * 32 + n * 16 + fq * 4;
                        if (EPI == 1) *(f32x4*)((float*)ea.out + (size_t)orow * ea.ld + col) = v;
                        else { u32x2 o; o[0] = pk2(v[0] * wg, v[1] * wg); o[1] = pk2(v[2] * wg, v[3] * wg); *(u32x2*)((bf16_t*)ea.out + (size_t)orow * ea.ld + col) = o; } }
                }
            }
        }
    __syncthreads();
#undef SA
#undef SB
#undef STAGE_A
#undef STAGE_B
#undef LDA
#undef LDB
#undef MMA
}

DI void phase_inproj(const Params& p, int layer, char* smem) {
    const WS w = ws_of(p.ws); constexpr int nN = PW / 256, nM = R / 256;
    for (int u = blockIdx.x; u < nM * nN; u += gridDim.x) { const int pm = u / nN, pn = u % nN;
        EpiArgs ea; ea.out = w.p; ea.ld = PW; ea.orow0 = (long)pm * 256; ea.wgt = nullptr;
        gemm_unit<0, false>(w.u, w.win + (size_t)layer * PW * 1024, 1024, pm * 256, pn * 256, nullptr, ea, smem); }
}
DI void phase_outproj(const Params& p, int layer, char* smem) {
    const WS w = ws_of(p.ws); constexpr int nN = 4; const int nM = (layer == DEPTH - 1 ? RL : R) / 256;
    for (int u = blockIdx.x; u < nM * nN; u += gridDim.x) { const int pm = u / nN, pn = u % nN;
        EpiArgs ea; ea.out = w.mixo; ea.ld = 1024; ea.orow0 = (long)pm * 256; ea.wgt = nullptr;
        gemm_unit<1, false>(w.mix, w.wout + (size_t)layer * 1024 * 1024, 1024, pm * 256, pn * 256, nullptr, ea, smem); }
}
DI int moe_tiles(int layer) { return layer == DEPTH - 1 ? (NB * CAPL + 255) / 256 : ROWS_E / 256; }
DI void phase_moe1(const Params& p, int layer, char* smem) {
    const WS w = ws_of(p.ws); constexpr int nN = 2 * FF / 256; const int tm = moe_tiles(layer);
    for (int u = blockIdx.x; u < 16 * tm * nN; u += gridDim.x) { const int e = u / (tm * nN), r = u % (tm * nN), pm = r / nN, pn = r % nN;
        EpiArgs ea; ea.out = w.hid; ea.ld = FF; ea.orow0 = (long)e * ROWS_E + pm * 256; ea.wgt = nullptr;
        gemm_unit<2, true>(w.u, w.wgu + (size_t)(layer * 16 + e) * 2 * FF * 1024, 1024, 0, pn * 256, w.idx + (size_t)e * ROWS_E + pm * 256, ea, smem); }
}
DI void phase_moe2(const Params& p, int layer, char* smem) {
    const WS w = ws_of(p.ws); constexpr int nN = 4; const int tm = moe_tiles(layer);
    for (int u = blockIdx.x; u < 16 * tm * nN; u += gridDim.x) { const int e = u / (tm * nN), r = u % (tm * nN), pm = r / nN, pn = r % nN;
        EpiArgs ea; ea.out = w.y; ea.ld = 1024; ea.orow0 = (long)e * ROWS_E + pm * 256; ea.wgt = w.wgt + (size_t)e * ROWS_E + pm * 256;
        gemm_unit<3, false>(w.hid, w.wdn + (size_t)(layer * 16 + e) * 1024 * FF, FF, e * ROWS_E + pm * 256, pn * 256, nullptr, ea, smem); }
}

DI void phase_prep(const Params& p, int layer, char* smem) {
    const WS w = ws_of(p.ws); const int lane = threadIdx.x & 63, wv = threadIdx.x >> 6;
    for (int row = blockIdx.x * 8 + wv; row < R; row += gridDim.x * 8) {
        const bool isc = row >= RL; const int n = isc ? 0 : row % SEQ; bf16_t* pr = w.p + (size_t)row * PW;
        for (int idx = lane; idx < 704; idx += 64) {
            int c1, dd, a; float sc;
            if (idx < 128) { const int h = idx >> 5, i = idx & 31; c1 = C_RQ + h * 64 + i; dd = 32; a = i; sc = 0.125f; }
            else if (idx < 256) { const int j = idx - 128, h = j >> 5, i = j & 31; c1 = C_RK + h * 64 + i; dd = 32; a = i; sc = 1.0f; }
            else if (idx < 384) { const int j = idx - 256, hc = j >> 4, i = j & 15; c1 = C_DQ + hc * 32 + i; dd = 16; a = 32 + i; sc = 0.17677669529663687f * LOG2E; }
            else if (idx < 512) { const int j = idx - 384, hc = j >> 4, i = j & 15; c1 = C_DK + hc * 32 + i; dd = 16; a = 32 + i; sc = 1.0f; }
            else if (idx < 640) { const int j = idx - 512, h = j >> 5, i = j & 31; c1 = C_SQ + h * 64 + i; dd = 32; a = 48 + i; sc = 0.125f * LOG2E; }
            else { const int j = idx - 640, h = j >> 5, i = j & 31; c1 = C_SK + h * 64 + i; dd = 32; a = 48 + i; sc = 1.0f; }
            float cs = 1.0f, sn = 0.0f; if (!isc) { cs = w.tab[((size_t)n * 80 + a) * 2]; sn = w.tab[((size_t)n * 80 + a) * 2 + 1]; }
            const float x1 = bf2f(pr[c1]), x2 = bf2f(pr[c1 + dd]);
            pr[c1] = f2bf((x1 * cs - x2 * sn) * sc); pr[c1 + dd] = f2bf((x1 * sn + x2 * cs) * sc);
        }
    }
}

constexpr int A_KS = 72, A_VS = 68;
template <int NC>
DI void attn_unit(const bf16_t* __restrict__ P, const int qrow0, const int qcol, const int kcol, const int vcol,
                  const int r1, const int n1, const int kp1, const bool mask1, const int r2, const int n2, const int qpos0,
                  const float m_init, const float l_init, const float lam, const float fin_scale, const float* __restrict__ norm_g,
                  bf16_t* __restrict__ outp  , char* smem) {
    bf16_t* Ks = (bf16_t*)smem; bf16_t* Vt = Ks + 64 * A_KS;
    const int tid = threadIdx.x, lane = tid & 63, wv = tid >> 6, fr = lane & 15, fq = lane >> 4;
    bf16x8 qf[2];
#pragma unroll
    for (int i = 0; i < 2; ++i) qf[i] = *(const bf16x8*)(P + (size_t)(qrow0 + wv * 16 + fr) * PW + qcol + i * 32 + fq * 8);
    f32x4 o[NC][4]; float mrun[NC], lrun[NC];
#pragma unroll
    for (int c = 0; c < NC; ++c) { mrun[c] = m_init; lrun[c] = l_init;
#pragma unroll
        for (int d = 0; d < 4; ++d) o[c][d] = (f32x4){0.f, 0.f, 0.f, 0.f}; }
    const int T = n1 + n2, skey = tid >> 3, sc8 = tid & 7;
    u32x4 kreg, vreg;
    { const int krow = (0 < n1) ? r1 : r2; const bf16_t* src = P + (size_t)(krow + skey) * PW; kreg = *(const u32x4*)(src + kcol + sc8 * 8); vreg = *(const u32x4*)(src + vcol + sc8 * 8); }
    const int qpos = qpos0 + wv * 16 + fr;
    for (int t = 0; t < T; ++t) {
        __syncthreads();
        *(u32x4*)(Ks + skey * A_KS + sc8 * 8) = kreg;
#pragma unroll
        for (int i = 0; i < 4; ++i) { Vt[(sc8 * 8 + 2 * i) * A_VS + skey] = (bf16_t)(vreg[i] & 0xffffu); Vt[(sc8 * 8 + 2 * i + 1) * A_VS + skey] = (bf16_t)(vreg[i] >> 16); }
        __syncthreads();
        if (t + 1 < T) { const int tn = t + 1; const int krow = (tn < n1) ? r1 + tn * 64 : r2 + (tn - n1) * 64; const bf16_t* src = P + (size_t)(krow + skey) * PW;
            kreg = *(const u32x4*)(src + kcol + sc8 * 8); vreg = *(const u32x4*)(src + vcol + sc8 * 8); }
        const bool msk = mask1 && (t < n1); const int kpos_t = kp1 + t * 64;
        f32x4 s[NC][4];
#pragma unroll
        for (int kt = 0; kt < 4; ++kt) {
            const bf16x8 k0 = *(const bf16x8*)(Ks + (kt * 16 + fr) * A_KS + fq * 8), k1 = *(const bf16x8*)(Ks + (kt * 16 + fr) * A_KS + 32 + fq * 8);
            const f32x4 z = (f32x4){0.f, 0.f, 0.f, 0.f};
            if (NC == 2) { s[0][kt] = MFMA16(k0, qf[0], z); s[NC - 1][kt] = MFMA16(k1, qf[1], z); }
            else s[0][kt] = MFMA16(k1, qf[1], MFMA16(k0, qf[0], z));
        }
#pragma unroll
        for (int c = 0; c < NC; ++c) {
            float mx = -INFINITY;
#pragma unroll
            for (int kt = 0; kt < 4; ++kt)
#pragma unroll
                for (int j = 0; j < 4; ++j) { if (msk) { const int kp = kpos_t + kt * 16 + fq * 4 + j; const int dlt = qpos - kp; if (dlt > 128 || dlt < -128) s[c][kt][j] = -INFINITY; } mx = fmaxf(mx, s[c][kt][j]); }
            mx = fmaxf(mx, __shfl_xor(mx, 16)); mx = fmaxf(mx, __shfl_xor(mx, 32));
            const float mn = fmaxf(mrun[c], mx), alpha = ex2(mrun[c] - mn); mrun[c] = mn; lrun[c] *= alpha;
#pragma unroll
            for (int d = 0; d < 4; ++d) o[c][d] *= alpha;
            float ls = 0.f;
#pragma unroll
            for (int kt = 0; kt < 4; ++kt)
#pragma unroll
                for (int j = 0; j < 4; ++j) { const float pv = ex2(s[c][kt][j] - mn); s[c][kt][j] = pv; ls += pv; }
            lrun[c] += ls;
#pragma unroll
            for (int k2 = 0; k2 < 2; ++k2) {
                u32x4 pp; pp[0] = pk2(s[c][2 * k2][0], s[c][2 * k2][1]); pp[1] = pk2(s[c][2 * k2][2], s[c][2 * k2][3]); pp[2] = pk2(s[c][2 * k2 + 1][0], s[c][2 * k2 + 1][1]); pp[3] = pk2(s[c][2 * k2 + 1][2], s[c][2 * k2 + 1][3]);
                const bf16x8 pb = __builtin_bit_cast(bf16x8, pp);
#pragma unroll
                for (int d = 0; d < 4; ++d) {
                    const u32x2 v0 = *(const u32x2*)(Vt + (d * 16 + fr) * A_VS + (2 * k2) * 16 + fq * 4), v1 = *(const u32x2*)(Vt + (d * 16 + fr) * A_VS + (2 * k2 + 1) * 16 + fq * 4);
                    u32x4 vv; vv[0] = v0[0]; vv[1] = v0[1]; vv[2] = v1[0]; vv[3] = v1[1];
                    o[c][d] = MFMA16(__builtin_bit_cast(bf16x8, vv), pb, o[c][d]);
                }
            }
        }
    }
    float linv[NC];
#pragma unroll
    for (int c = 0; c < NC; ++c) { float l = lrun[c]; l += __shfl_xor(l, 16); l += __shfl_xor(l, 32); linv[c] = 1.0f / l; }
    f32x4 val[4]; float ss = 0.f;
#pragma unroll
    for (int d = 0; d < 4; ++d) {
        if (NC == 2) val[d] = o[0][d] * linv[0] - lam * (o[NC - 1][d] * linv[NC - 1]); else val[d] = o[0][d] * linv[0];
        ss += val[d][0] * val[d][0] + val[d][1] * val[d][1] + val[d][2] * val[d][2] + val[d][3] * val[d][3];
    }
    float rs = 1.0f;
    if (NC == 2) { ss += __shfl_xor(ss, 16); ss += __shfl_xor(ss, 32); rs = fin_scale / sqrtf(ss * (1.0f / 64.0f) + 1e-6f); }
    bf16_t* orow = outp + (size_t)(wv * 16 + fr) * 1024;
#pragma unroll
    for (int d = 0; d < 4; ++d) { f32x4 v = val[d] * rs; if (NC == 2) v = v * *(const f32x4*)(norm_g + d * 16 + fq * 4);
        u32x2 ov; ov[0] = pk2(v[0], v[1]); ov[1] = pk2(v[2], v[3]); *(u32x2*)(orow + d * 16 + fq * 4) = ov; }
    __syncthreads();
}

DI void ret_kv_unit(const Params& p, const WS& w, int layer, int b, int h, int ci, char* smem) {
    float* Kf = (float*)smem; float* Vf = Kf + 128 * 64; float* dec = Vf + 128 * 64;
    const int tid = threadIdx.x; const bool isc = ci < NCC; const int row0 = isc ? RL + b * CTX + ci * 128 : b * SEQ + (ci - NCC) * 128;
    __syncthreads();
    for (int i = tid; i < 128 * 8; i += NT) { const int j = i >> 3, c8 = i & 7; const bf16_t* src = w.p + (size_t)(row0 + j) * PW + h * 64 + c8 * 8;
        const u32x4 kv = *(const u32x4*)(src + C_RK), vv = *(const u32x4*)(src + C_RV);
#pragma unroll
        for (int q = 0; q < 4; ++q) { Kf[j * 64 + c8 * 8 + 2 * q] = __uint_as_float(kv[q] << 16); Kf[j * 64 + c8 * 8 + 2 * q + 1] = __uint_as_float(kv[q] & 0xffff0000u);
            Vf[j * 64 + c8 * 8 + 2 * q] = __uint_as_float(vv[q] << 16); Vf[j * 64 + c8 * 8 + 2 * q + 1] = __uint_as_float(vv[q] & 0xffff0000u); } }
    if (tid < 256) { const int d = tid >> 7, j = tid & 127; const float x = p.ret_decay[(layer * 2 + d) * 4 + h]; const float lg = -softplusf_(-x) * LOG2E;
        dec[d * 128 + j] = ex2(lg * (float)(d == 0 ? 127 - j : j)); }
    __syncthreads();
    const int dk = tid & 63, eg = tid >> 6;
    f32x4 a0[2], a1[2];
#pragma unroll
    for (int q = 0; q < 2; ++q) { a0[q] = (f32x4){0.f, 0.f, 0.f, 0.f}; a1[q] = a0[q]; }
    for (int j = 0; j < 128; ++j) { const float kk = Kf[j * 64 + dk], k0 = kk * dec[j], k1 = kk * dec[128 + j];
        const f32x4 v0 = *(const f32x4*)(Vf + j * 64 + eg * 8), v1 = *(const f32x4*)(Vf + j * 64 + eg * 8 + 4);
        a0[0] += k0 * v0; a0[1] += k0 * v1; a1[0] += k1 * v0; a1[1] += k1 * v1; }
    float* o0 = w.rkv + ((size_t)((b * 4 + h) * 2 + 0) * NCHR + ci) * 4096 + dk * 64 + eg * 8; float* o1 = w.rkv + ((size_t)((b * 4 + h) * 2 + 1) * NCHR + ci) * 4096 + dk * 64 + eg * 8;
    *(f32x4*)o0 = a0[0]; *(f32x4*)(o0 + 4) = a0[1]; *(f32x4*)o1 = a1[0]; *(f32x4*)(o1 + 4) = a1[1];
}
DI void ret_scan(const Params& p, const WS& w, int layer) {
    for (int i = blockIdx.x * NT + threadIdx.x; i < NB * 4 * 2 * 4096; i += gridDim.x * NT) {
        const int chain = i >> 12, el = i & 4095, d = chain & 1, h = (chain >> 1) & 3;
        const float x = p.ret_decay[(layer * 2 + d) * 4 + h]; const float cd = ex2(-softplusf_(-x) * LOG2E * 128.0f);
        float s = 0.f;
        for (int st = 0; st < NCHR; ++st) { const int ci = d == 0 ? st : (st < NCC ? NCC - 1 - st : NCC + (NLC - 1 - (st - NCC)));
            const size_t off = ((size_t)chain * NCHR + ci) * 4096 + el; w.rs[off] = s; s = s * cd + w.rkv[off]; }
    }
}
constexpr int RO_KS = 72, RO_VS = 136;
DI void ret_out_unit(const Params& p, const WS& w, int layer, int b, int h, int ci, char* smem) {
    bf16_t* Ks = (bf16_t*)smem; bf16_t* Vt = Ks + 128 * RO_KS; bf16_t* St = Vt + 64 * RO_VS;
    const int tid = threadIdx.x, lane = tid & 63, wv = tid >> 6, fr = lane & 15, fq = lane >> 4;
    const bool isc = ci < NCC; const int row0 = isc ? RL + b * CTX + ci * 128 : b * SEQ + (ci - NCC) * 128;
    __syncthreads();
    for (int i = tid; i < 128 * 8; i += NT) { const int j = i >> 3, c8 = i & 7; const bf16_t* src = w.p + (size_t)(row0 + j) * PW + h * 64 + c8 * 8;
        *(u32x4*)(Ks + j * RO_KS + c8 * 8) = *(const u32x4*)(src + C_RK); const u32x4 vv = *(const u32x4*)(src + C_RV);
#pragma unroll
        for (int q = 0; q < 4; ++q) { Vt[(c8 * 8 + 2 * q) * RO_VS + j] = (bf16_t)(vv[q] & 0xffffu); Vt[(c8 * 8 + 2 * q + 1) * RO_VS + j] = (bf16_t)(vv[q] >> 16); } }
    for (int i = tid; i < 2 * 4096; i += NT) { const int d = i >> 12, el = i & 4095, dk = el >> 6, e = el & 63;
        St[(d * 64 + e) * RO_KS + dk] = f2bf(w.rs[((size_t)((b * 4 + h) * 2 + d) * NCHR + ci) * 4096 + el]); }
    __syncthreads();
    const float lg0 = -softplusf_(-p.ret_decay[(layer * 2 + 0) * 4 + h]) * LOG2E, lg1 = -softplusf_(-p.ret_decay[(layer * 2 + 1) * 4 + h]) * LOG2E;
    const int qi = wv * 16 + fr;
    bf16x8 qf[2];
#pragma unroll
    for (int i = 0; i < 2; ++i) qf[i] = *(const bf16x8*)(w.p + (size_t)(row0 + qi) * PW + C_RQ + h * 64 + i * 32 + fq * 8);
    f32x4 o[4], t0[4], t1[4];
#pragma unroll
    for (int d = 0; d < 4; ++d) { o[d] = (f32x4){0.f, 0.f, 0.f, 0.f}; t0[d] = o[d]; t1[d] = o[d]; }
#pragma unroll
    for (int k2 = 0; k2 < 4; ++k2) {
        f32x4 s[2];
#pragma unroll
        for (int q = 0; q < 2; ++q) { const int kt = 2 * k2 + q;
            const bf16x8 k0 = *(const bf16x8*)(Ks + (kt * 16 + fr) * RO_KS + fq * 8), k1 = *(const bf16x8*)(Ks + (kt * 16 + fr) * RO_KS + 32 + fq * 8);
            s[q] = MFMA16(k1, qf[1], MFMA16(k0, qf[0], (f32x4){0.f, 0.f, 0.f, 0.f}));
#pragma unroll
            for (int j = 0; j < 4; ++j) { const int kj = kt * 16 + fq * 4 + j, dl = qi - kj; const float dm = dl > 0 ? ex2(lg0 * (float)dl) : (dl < 0 ? ex2(lg1 * (float)(-dl)) : 2.0f); s[q][j] *= dm; } }
        u32x4 pp; pp[0] = pk2(s[0][0], s[0][1]); pp[1] = pk2(s[0][2], s[0][3]); pp[2] = pk2(s[1][0], s[1][1]); pp[3] = pk2(s[1][2], s[1][3]);
        const bf16x8 pb = __builtin_bit_cast(bf16x8, pp);
#pragma unroll
        for (int d = 0; d < 4; ++d) { const u32x2 v0 = *(const u32x2*)(Vt + (d * 16 + fr) * RO_VS + (2 * k2) * 16 + fq * 4), v1 = *(const u32x2*)(Vt + (d * 16 + fr) * RO_VS + (2 * k2 + 1) * 16 + fq * 4);
            u32x4 vv; vv[0] = v0[0]; vv[1] = v0[1]; vv[2] = v1[0]; vv[3] = v1[1]; o[d] = MFMA16(__builtin_bit_cast(bf16x8, vv), pb, o[d]); }
    }
#pragma unroll
    for (int d = 0; d < 4; ++d)
#pragma unroll
        for (int ks = 0; ks < 2; ++ks) { t0[d] = MFMA16(*(const bf16x8*)(St + (d * 16 + fr) * RO_KS + ks * 32 + fq * 8), qf[ks], t0[d]);
            t1[d] = MFMA16(*(const bf16x8*)(St + (64 + d * 16 + fr) * RO_KS + ks * 32 + fq * 8), qf[ks], t1[d]); }
    const float qd0 = ex2(lg0 * (float)(qi + 1)), qd1 = ex2(lg1 * (float)(128 - qi));
    float ss = 0.f;
#pragma unroll
    for (int d = 0; d < 4; ++d) { o[d] = o[d] + qd0 * t0[d] + qd1 * t1[d]; ss += o[d][0] * o[d][0] + o[d][1] * o[d][1] + o[d][2] * o[d][2] + o[d][3] * o[d][3]; }
    ss += __shfl_xor(ss, 16); ss += __shfl_xor(ss, 32);
    const float rs = 1.0f / sqrtf(ss * (1.0f / 64.0f) + 1e-6f);
    const bf16_t* gp = w.p + (size_t)(row0 + qi) * PW + C_RG + h * 64; bf16_t* op = w.mix + (size_t)(row0 + qi) * 1024 + h * 64;
#pragma unroll
    for (int d = 0; d < 4; ++d) { const u32x2 gv = *(const u32x2*)(gp + d * 16 + fq * 4);
        const float g0 = __uint_as_float(gv[0] << 16), g1 = __uint_as_float(gv[0] & 0xffff0000u), g2 = __uint_as_float(gv[1] << 16), g3 = __uint_as_float(gv[1] & 0xffff0000u);
        u32x2 ov; ov[0] = pk2(o[d][0] * rs * siluf(g0), o[d][1] * rs * siluf(g1)); ov[1] = pk2(o[d][2] * rs * siluf(g2), o[d][3] * rs * siluf(g3)); *(u32x2*)(op + d * 16 + fq * 4) = ov; }
}

constexpr int GS = 65;
DI void gdn_prep_unit(const Params& p, const WS& w, int layer, int b, int h, int cg, char* smem) {
    float* Qs = (float*)smem; float* Ks = Qs + 64 * GS; float* Vs = Ks + 64 * GS; float* Raw = Vs + 64 * GS;
    float* KK = Raw; float* QK = KK + 64 * GS; float* A0 = QK + 64 * GS; float* A1 = Raw + 66 * 192; float* gt = A1 + 4096;
    const int tid = threadIdx.x; const bool isc = cg < NCG; const int nseq = isc ? CTX : SEQ, t0 = (isc ? cg : cg - NCG) * 64, base = isc ? RL + b * CTX : b * SEQ;
    __syncthreads();
    for (int i = tid; i < 66 * 24; i += NT) { const int tt = i / 24, c8 = i % 24, part = c8 >> 3, tok = t0 - 1 + tt; u32x4 v = (u32x4){0u, 0u, 0u, 0u};
        if (tok >= 0 && tok < nseq) v = *(const u32x4*)(w.p + (size_t)(base + tok) * PW + C_GQKV + part * 256 + h * 64 + (c8 & 7) * 8);
#pragma unroll
        for (int q = 0; q < 4; ++q) { Raw[tt * 192 + c8 * 8 + 2 * q] = __uint_as_float(v[q] << 16); Raw[tt * 192 + c8 * 8 + 2 * q + 1] = __uint_as_float(v[q] & 0xffff0000u); } }
    if (tid < 128) { const int dr = tid >> 6, s = tid & 63; const float* ga = w.gab + (size_t)(base + t0 + s) * 16;
        gt[dr * 64 + s] = -__expf(p.gdn_a_log[(layer * 2 + dr) * 4 + h]) * softplusf_(ga[dr * 4 + h] + p.gdn_dt_bias[(layer * 2 + dr) * 4 + h]);
        gt[128 + dr * 64 + s] = sigmoidf_(ga[8 + dr * 4 + h]); }
    __syncthreads();
    for (int i = tid; i < 64 * 192; i += NT) { const int s = i / 192, ch = i % 192, part = ch >> 6, d = ch & 63, chg = part * 256 + h * 64 + d; const float* cw = p.gdn_conv + (size_t)layer * 3 * 768 + chg;
        const float x = cw[0] * Raw[s * 192 + ch] + cw[768] * Raw[(s + 1) * 192 + ch] + cw[1536] * Raw[(s + 2) * 192 + ch];
        (part == 0 ? Qs : (part == 1 ? Ks : Vs))[s * GS + d] = siluf(x); }
    if (tid < 2) { const int dr = tid; float a = 0.f; for (int s = 0; s < 64; ++s) { a += gt[dr * 64 + (dr ? 63 - s : s)]; gt[256 + dr * 64 + s] = a; } }
    __syncthreads();
    { const int wv = tid >> 6, lane = tid & 63;
      for (int rr = wv; rr < 128; rr += 8) { float* rowp = (rr < 64 ? Qs + rr * GS : Ks + (rr - 64) * GS); const float v = rowp[lane]; const float ss = wsum(v * v);
          rowp[lane] = v * (1.0f / sqrtf(ss + 1e-6f)) * (rr < 64 ? 0.125f : 1.0f); } }
    __syncthreads();
    { const int i = tid >> 3, jg = tid & 7; float kk[8], qk[8];
#pragma unroll
      for (int q = 0; q < 8; ++q) { kk[q] = 0.f; qk[q] = 0.f; }
      for (int d = 0; d < 64; ++d) { const float ki = Ks[i * GS + d], qi = Qs[i * GS + d];
#pragma unroll
          for (int q = 0; q < 8; ++q) { const float kj = Ks[(jg * 8 + q) * GS + d]; kk[q] += ki * kj; qk[q] += qi * kj; } }
#pragma unroll
      for (int q = 0; q < 8; ++q) { KK[i * GS + jg * 8 + q] = kk[q]; QK[i * GS + jg * 8 + q] = qk[q]; } }
    __syncthreads();
    for (int i = tid; i < 2 * 4096; i += NT) { const int dr = i >> 12, s = (i >> 6) & 63, s2 = i & 63; float v = 0.f;
        if (s > s2) { const int ts = dr ? 63 - s : s, ts2 = dr ? 63 - s2 : s2; v = gt[128 + dr * 64 + ts] * KK[ts * GS + ts2] * __expf(gt[256 + dr * 64 + s] - gt[256 + dr * 64 + s2]); }
        (dr ? A1 : A0)[s * 64 + s2] = v; }
    __syncthreads();
    const size_t cbase = (size_t)((b * 4 + h) * 2) * NCHG;
    {
        const int dr = tid >> 8, col = (tid & 255) >> 2, q = tid & 3; const float* Am = dr ? A1 : A0; const float* gg = gt + 256 + dr * 64; const float* bt = gt + 128 + dr * 64;
        const int sc = dr == 0 ? cg : (cg < NCG ? NCG - 1 - cg : NCG + (NLG - 1 - (cg - NCG))); const size_t ch = cbase + (size_t)dr * NCHG + sc;
        for (int pass = 0; pass < 2; ++pass) {
            float xq[16];
#pragma unroll
            for (int i = 0; i < 16; ++i) xq[i] = 0.f;
#pragma unroll 1
            for (int sb = 0; sb < 4; ++sb) {
#pragma unroll
                for (int si = 0; si < 16; ++si) { const int s = sb * 16 + si, ts = dr ? 63 - s : s; float part = 0.f;
#pragma unroll
                    for (int i4 = 0; i4 < 4; ++i4) { const f32x4 a = *(const f32x4*)(Am + s * 64 + q * 16 + i4 * 4); part += a[0] * xq[i4 * 4] + a[1] * xq[i4 * 4 + 1] + a[2] * xq[i4 * 4 + 2] + a[3] * xq[i4 * 4 + 3]; }
                    part += __shfl_xor(part, 1); part += __shfl_xor(part, 2);
                    const float rhs = pass == 0 ? bt[ts] * Vs[ts * GS + col] : bt[ts] * __expf(gg[s]) * Ks[ts * GS + col];
                    if (q == sb) xq[si] = rhs - part; }
            }
            if (pass == 0) { float* ub = w.gub + ch * 4096 + col * 64 + q * 16;
#pragma unroll
                for (int i = 0; i < 16; i += 4) *(f32x4*)(ub + i) = (f32x4){xq[i], xq[i + 1], xq[i + 2], xq[i + 3]};
            } else { bf16_t* wp = w.gw + ch * 4096 + (size_t)(q * 16) * 64 + col;
#pragma unroll
                for (int i = 0; i < 16; ++i) wp[i * 64] = f2bf(xq[i]); }
        }
    }
    for (int i = tid; i < 2 * 4096; i += NT) { const int dr = i >> 12, s = (i >> 6) & 63, c = i & 63, ts = dr ? 63 - s : s; const float* gg = gt + 256 + dr * 64;
        const int sc = dr == 0 ? cg : (cg < NCG ? NCG - 1 - cg : NCG + (NLG - 1 - (cg - NCG))); const size_t ch = cbase + (size_t)dr * NCHG + sc;
        w.gqg[ch * 4096 + s * 64 + c] = f2bf(Qs[ts * GS + c] * __expf(gg[s]));
        const int tc = dr ? 63 - c : c; w.gqk[ch * 4096 + s * 64 + c] = f2bf(s >= c ? QK[ts * GS + tc] * __expf(gg[s] - gg[c]) : 0.f);
        w.gkt[ch * 4096 + s * 64 + c] = f2bf(Ks[tc * GS + s] * __expf(gg[63] - gg[c]));
        if (s == 0 && c == 0) w.gcd[ch] = __expf(gg[63]); }
}
DI void gdn_scan_unit(const Params& p, const WS& w, int layer, int b, int h, int dr, int vs, char* smem) {
    bf16_t* Sb = (bf16_t*)smem; bf16_t* Ub = Sb + 2 * 16 * 72;
    const int tid = threadIdx.x, lane = tid & 63, wv = tid >> 6, fr = lane & 15, fq = lane >> 4; const bool act = wv < 4;
    const bool full_ctx = layer < DEPTH - 1; const size_t cb = (size_t)((b * 4 + h) * 2 + dr) * NCHG;
    f32x4 sacc = (f32x4){0.f, 0.f, 0.f, 0.f};
    __syncthreads();
    for (int sc = 0; sc < NCHG; ++sc) {
        const int par = sc & 1; const size_t ch = cb + sc; bf16_t* Sp = Sb + par * 16 * 72; bf16_t* Up = Ub + par * 16 * 72;
        bf16x8 aw[2], aqg[2], aqk[2], akt[2]; f32x4 ub; float cd = 0.f;
        if (act) {
#pragma unroll
            for (int ks = 0; ks < 2; ++ks) { const size_t o = ch * 4096 + (size_t)(wv * 16 + fr) * 64 + ks * 32 + fq * 8;
                aw[ks] = *(const bf16x8*)(w.gw + o); aqg[ks] = *(const bf16x8*)(w.gqg + o); aqk[ks] = *(const bf16x8*)(w.gqk + o); akt[ks] = *(const bf16x8*)(w.gkt + o); }
            ub = *(const f32x4*)(w.gub + ch * 4096 + (size_t)(vs * 16 + fr) * 64 + wv * 16 + fq * 4); cd = w.gcd[ch];
            u32x2 sv; sv[0] = pk2(sacc[0], sacc[1]); sv[1] = pk2(sacc[2], sacc[3]); *(u32x2*)(Sp + fr * 72 + wv * 16 + fq * 4) = sv;
        }
        __syncthreads();
        bf16x8 sb[2]; f32x4 u = (f32x4){0.f, 0.f, 0.f, 0.f};
        if (act) {
#pragma unroll
            for (int ks = 0; ks < 2; ++ks) { sb[ks] = *(const bf16x8*)(Sp + fr * 72 + ks * 32 + fq * 8); u = MFMA16(aw[ks], sb[ks], u); }
            u = ub - u;
            u32x2 uvv; uvv[0] = pk2(u[0], u[1]); uvv[1] = pk2(u[2], u[3]); *(u32x2*)(Up + fr * 72 + wv * 16 + fq * 4) = uvv;
        }
        __syncthreads();
        if (act) {
            f32x4 oo = (f32x4){0.f, 0.f, 0.f, 0.f}, sn = sacc * cd;
#pragma unroll
            for (int ks = 0; ks < 2; ++ks) { const bf16x8 ubf = *(const bf16x8*)(Up + fr * 72 + ks * 32 + fq * 8);
                oo = MFMA16(aqg[ks], sb[ks], oo); oo = MFMA16(aqk[ks], ubf, oo); sn = MFMA16(akt[ks], ubf, sn); }
            sacc = sn;
            const int cgi = dr == 0 ? sc : (sc < NCG ? NCG - 1 - sc : NCG + (NLG - 1 - (sc - NCG))); const bool isc = cgi < NCG;
            if (!isc || full_ctx) { const int rbase = isc ? RL + b * CTX + cgi * 64 : b * SEQ + (cgi - NCG) * 64;
#pragma unroll
                for (int j = 0; j < 4; ++j) { const int s = wv * 16 + fq * 4 + j, tok = dr ? 63 - s : s; w.og[((size_t)dr * R + rbase + tok) * 256 + h * 64 + vs * 16 + fr] = oo[j]; } }
        }
    }
}
DI void gdn_finish(const Params& p, const WS& w, int layer) {
    const int lane = threadIdx.x & 63, wv = threadIdx.x >> 6; const int nrows = layer == DEPTH - 1 ? RL : R;
    for (int row = blockIdx.x * 8 + wv; row < nrows; row += gridDim.x * 8) {
        const f32x4 a = *(const f32x4*)(w.og + (size_t)row * 256 + lane * 4), c = *(const f32x4*)(w.og + ((size_t)R + row) * 256 + lane * 4); const f32x4 o = a + c;
        float ss = o[0] * o[0] + o[1] * o[1] + o[2] * o[2] + o[3] * o[3];
        ss += __shfl_xor(ss, 1); ss += __shfl_xor(ss, 2); ss += __shfl_xor(ss, 4); ss += __shfl_xor(ss, 8);
        const float rs = 1.0f / sqrtf(ss * (1.0f / 64.0f) + 1e-6f); const f32x4 ng = *(const f32x4*)(p.gdn_norm + layer * 64 + (lane & 15) * 4);
        const u32x2 gv = *(const u32x2*)(w.p + (size_t)row * PW + C_GG + lane * 4);
        const float g0 = __uint_as_float(gv[0] << 16), g1 = __uint_as_float(gv[0] & 0xffff0000u), g2 = __uint_as_float(gv[1] << 16), g3 = __uint_as_float(gv[1] & 0xffff0000u);
        u32x2 ov; ov[0] = pk2(o[0] * rs * ng[0] * siluf(g0), o[1] * rs * ng[1] * siluf(g1)); ov[1] = pk2(o[2] * rs * ng[2] * siluf(g2), o[3] * rs * ng[3] * siluf(g3));
        *(u32x2*)(w.mix + (size_t)row * 1024 + 512 + lane * 4) = ov;
    }
}

DI void phase_mix1(const Params& p, int layer, char* smem) {
    const WS w = ws_of(p.ws); const bool full_ctx = layer < DEPTH - 1;
    constexpr int QB = SEQ / 128, QC = CTX / 128;
    const int n_diff = NB * 4 * QB, n_diffc = full_ctx ? NB * 4 * QC : 0, n_swa = NB * 4 * QB, n_swac = full_ctx ? NB * 4 * QC : 0, n_gdn = NB * 4 * NCHG, n_rkv = NB * 4 * NCHR;
    const float lam_init = 0.8f - 0.6f * __expf(-0.3f * (float)layer);
    float lam; { const float* lp = p.diff_lambda + layer * 128; float s1 = 0.f, s2 = 0.f; for (int i = 0; i < 32; ++i) { s1 += lp[i] * lp[32 + i]; s2 += lp[64 + i] * lp[96 + i]; } lam = __expf(s1) - __expf(s2) + lam_init; }
    for (int r = blockIdx.x; r < n_diff + n_diffc; r += gridDim.x) {
        const bool isc = r >= n_diff; const int rr = isc ? r - n_diff : r, nq = isc ? QC : QB, qb = rr % nq, h = (rr / nq) & 3, b = rr / (nq * 4);
        const int qrow = (isc ? RL + b * CTX : b * SEQ) + qb * 128;
        attn_unit<2>(w.p, qrow, C_DQ + h * 64, C_DK + h * 64, C_DV + h * 64, isc ? RL + b * CTX : b * SEQ, isc ? CTX / 64 : SEQ / 64, 0, false, RL + b * CTX, isc ? 0 : CTX / 64, 0,
                     -1e30f, 0.f, lam, 1.0f - lam_init, p.diff_norm + layer * 64, w.mix + (size_t)qrow * 1024 + 256 + h * 64, smem);
    }
    for (int r = blockIdx.x; r < n_swa + n_swac; r += gridDim.x) {
        const bool isc = r >= n_swa; const int rr = isc ? r - n_swa : r, nq = isc ? QC : QB, qb = rr % nq, hh = (rr / nq) & 3, b = rr / (nq * 4), hk = hh >> 1;
        const int qrow = (isc ? RL + b * CTX : b * SEQ) + qb * 128;
        const int ks = qb * 128 - 128 < 0 ? 0 : qb * 128 - 128, ke = qb * 128 + 256 > SEQ ? SEQ : qb * 128 + 256;
        attn_unit<1>(w.p, qrow, C_SQ + hh * 64, C_SK + hk * 64, C_SV + hk * 64, isc ? RL + b * CTX : b * SEQ + ks, isc ? CTX / 64 : (ke - ks) / 64, isc ? 0 : ks, !isc, RL + b * CTX, isc ? 0 : CTX / 64, qb * 128,
                     p.swa_sink[layer * 4 + hh] * LOG2E, 1.0f, 0.f, 1.0f, nullptr, w.mix + (size_t)qrow * 1024 + 768 + hh * 64, smem);
    }
    for (int r = blockIdx.x; r < n_gdn; r += gridDim.x) { const int cg = r % NCHG, h = (r / NCHG) & 3, b = r / (NCHG * 4); gdn_prep_unit(p, w, layer, b, h, cg, smem); }
    for (int r = blockIdx.x; r < n_rkv; r += gridDim.x) { const int ci = r % NCHR, h = (r / NCHR) & 3, b = r / (NCHR * 4); ret_kv_unit(p, w, layer, b, h, ci, smem); }
}
DI void phase_mix2(const Params& p, int layer, char* smem) {
    const WS w = ws_of(p.ws);
    for (int u = blockIdx.x; u < NB * 4 * 2 * 4; u += gridDim.x) { const int vs = u & 3, dr = (u >> 2) & 1, h = (u >> 3) & 3, b = u >> 5; gdn_scan_unit(p, w, layer, b, h, dr, vs, smem); }
    ret_scan(p, w, layer);
}
DI void phase_mix3(const Params& p, int layer, char* smem) {
    const WS w = ws_of(p.ws); const bool full_ctx = layer < DEPTH - 1;
    for (int u = blockIdx.x; u < NB * 4 * NCHR; u += gridDim.x) { const int ci = u % NCHR, h = (u / NCHR) & 3, b = u / (NCHR * 4); if (ci < NCC && !full_ctx) continue; ret_out_unit(p, w, layer, b, h, ci, smem); }
    gdn_finish(p, w, layer);
}

DI int block_sum(int v, int* red) {
    const int lane = threadIdx.x & 63, wv = threadIdx.x >> 6;
    int s = v;
#pragma unroll
    for (int m = 32; m >= 1; m >>= 1) s += __shfl_xor(s, m);
    __syncthreads(); if (lane == 0) red[wv] = s; __syncthreads();
    int t = 0;
#pragma unroll
    for (int i = 0; i < 8; ++i) t += red[i];
    return t;
}
DI int block_exscan(int v, int* red) {
    const int lane = threadIdx.x & 63, wv = threadIdx.x >> 6;
    int s = v;
#pragma unroll
    for (int d = 1; d < 64; d <<= 1) { const int o = __shfl(s, lane >= d ? lane - d : lane); if (lane >= d) s += o; }
    __syncthreads(); if (lane == 63) red[wv] = s; __syncthreads();
    int off = 0;
#pragma unroll
    for (int i = 0; i < 8; ++i) if (i < wv) off += red[i];
    return off + s - v;
}
template <int N, int CAP> DI void topk_unit(const WS& w, const float* __restrict__ aff, int rowbase, int slotbase, int e, int* red) {
    constexpr int PT = (N + NT - 1) / NT;
    const int tid = threadIdx.x; unsigned key[PT];
#pragma unroll
    for (int i = 0; i < PT; ++i) { const int n = tid * PT + i; key[i] = n < N ? __float_as_uint(aff[n]) : 0u; }
    unsigned T = 0u;
    for (int bit = 30; bit >= 0; --bit) { const unsigned cand = T | (1u << bit); int c = 0;
#pragma unroll
        for (int i = 0; i < PT; ++i) c += (tid * PT + i < N && key[i] >= cand) ? 1 : 0;
        if (block_sum(c, red) >= CAP) T = cand; }
    int cg = 0, ce = 0;
#pragma unroll
    for (int i = 0; i < PT; ++i) { const bool in = tid * PT + i < N; cg += (in && key[i] > T) ? 1 : 0; ce += (in && key[i] == T) ? 1 : 0; }
    const int need = CAP - block_sum(cg, red); const int eoff = block_exscan(ce, red);
    int sel = 0, er = eoff; bool flag[PT];
#pragma unroll
    for (int i = 0; i < PT; ++i) { const bool in = tid * PT + i < N; bool f = in && key[i] > T; if (in && key[i] == T) { f = er < need; ++er; } flag[i] = f; sel += f ? 1 : 0; }
    int slot = block_exscan(sel, red);
#pragma unroll
    for (int i = 0; i < PT; ++i) { const int n = tid * PT + i; int iv = -1;
        if (n < N) { if (flag[i]) { iv = slotbase + slot; w.idx[(size_t)e * ROWS_E + iv] = rowbase + n; w.wgt[(size_t)e * ROWS_E + iv] = __uint_as_float(key[i]); ++slot; }
            w.inv[(size_t)(rowbase + n) * 16 + e] = iv; } }
}
DI void phase_topk(const Params& p, int layer, char* smem) {
    const WS w = ws_of(p.ws); int* red = (int*)smem; const bool full_ctx = layer < DEPTH - 1;
    for (int u = blockIdx.x; u < 2 * NB * 16; u += gridDim.x) {
        const bool isc = u >= NB * 16; const int v = isc ? u - NB * 16 : u, b = v >> 4, e = v & 15;
        if (!isc) topk_unit<SEQ, CAPL>(w, w.aff + ((size_t)b * 16 + e) * SEQ, b * SEQ, b * CAPL, e, red);
        else if (full_ctx) topk_unit<CTX, CAPC>(w, w.aff + (size_t)RL * 16 + ((size_t)b * 16 + e) * CTX, RL + b * CTX, NB * CAPL + b * CAPC, e, red);
        else { for (int i = threadIdx.x; i < CAPC; i += NT) { w.idx[(size_t)e * ROWS_E + NB * CAPL + b * CAPC + i] = 0; w.wgt[(size_t)e * ROWS_E + NB * CAPL + b * CAPC + i] = 0.f; } }
    }
}

enum { PH_CVT = 0, PH_INIT, PH_INPROJ, PH_PREP, PH_MIX1, PH_MIX2, PH_MIX3, PH_OUTPROJ, PH_LN0, PH_TOPK, PH_MOE1, PH_MOE2, PH_LN1 };
#ifdef EMU
#define SMEM_PTR(s) char* s = emu::B->lds
#else
extern __shared__ __attribute__((aligned(16))) char dyn_smem[];
#define SMEM_PTR(s) char* s = dyn_smem
#endif
template <int PH> DI void run_phase(const Params& p, int layer, char* smem) {
    if (PH == PH_CVT) phase_cvt(p, smem);
    else if (PH == PH_INIT) phase_rows<0>(p, 0, smem);
    else if (PH == PH_INPROJ) phase_inproj(p, layer, smem);
    else if (PH == PH_PREP) phase_prep(p, layer, smem);
    else if (PH == PH_MIX1) phase_mix1(p, layer, smem);
    else if (PH == PH_MIX2) phase_mix2(p, layer, smem);
    else if (PH == PH_MIX3) phase_mix3(p, layer, smem);
    else if (PH == PH_OUTPROJ) phase_outproj(p, layer, smem);
    else if (PH == PH_LN0) phase_rows<1>(p, layer, smem);
    else if (PH == PH_TOPK) phase_topk(p, layer, smem);
    else if (PH == PH_MOE1) phase_moe1(p, layer, smem);
    else if (PH == PH_MOE2) phase_moe2(p, layer, smem);
    else if (PH == PH_LN1) phase_rows<2>(p, layer, smem);
}
constexpr int LDS_BYTES = 8 * G_HT * 2 + 1024;
template <int PH> __global__ void __launch_bounds__(NT, 2) k_phase(Params p, int layer) { SMEM_PTR(smem); run_phase<PH>(p, layer, smem); }

#ifdef EMU
void (*emu_hook)(const char* tag, int layer, char* ws) = nullptr;
#define HOOK(t, l) do { if (emu_hook) emu_hook(t, l, (char*)d_ws); } while (0)
#else
#define HOOK(t, l)
#endif
template <int PH> static void launch_phase(const Params& p, int layer, int grid, hipStream_t stream) {
#ifndef EMU
    static bool done = false; if (!done) { hipFuncSetAttribute((const void*)k_phase<PH>, hipFuncAttributeMaxDynamicSharedMemorySize, LDS_BYTES); done = true; }
#endif
    hipLaunchKernelGGL(k_phase<PH>, dim3(grid), dim3(NT), LDS_BYTES, stream, p, layer);
}

extern "C" void kernel_launch(void* const* d_in, const int* in_sizes, int n_in, void* d_out, int out_size, void* d_ws, size_t ws_size, hipStream_t stream) {
    Params p{};
    const float* const* in = (const float* const*)d_in;
    p.x = in[0]; p.c = in[1]; p.ctx = in[2]; p.c_ctx = in[3]; p.ada_w = in[4]; p.ada_b = in[5]; p.w_in = in[6]; p.w_out = in[7]; p.ret_decay = in[8]; p.diff_lambda = in[9];
    p.diff_norm = in[10]; p.gdn_conv = in[11]; p.gdn_a_log = in[12]; p.gdn_dt_bias = in[13]; p.gdn_norm = in[14]; p.swa_sink = in[15]; p.ln_g = in[16]; p.ln_b = in[17];
    p.router_w = in[18]; p.w_gate = in[19]; p.w_up = in[20]; p.w_down = in[21]; p.out = (float*)d_out; p.ws = (char*)d_ws;
    int dev = 0, cus = 256; hipGetDevice(&dev); hipDeviceGetAttribute(&cus, hipDeviceAttributeMultiprocessorCount, dev);
    const int grid = cus;
    launch_phase<PH_CVT>(p, 0, grid, stream); HOOK("cvt", 0);
    launch_phase<PH_INIT>(p, 0, grid, stream); HOOK("init", 0);
    for (int l = 0; l < DEPTH; ++l) {
        launch_phase<PH_INPROJ>(p, l, grid, stream); HOOK("inproj", l);
        launch_phase<PH_PREP>(p, l, grid, stream);
        launch_phase<PH_MIX1>(p, l, grid, stream);
        launch_phase<PH_MIX2>(p, l, grid, stream);
        launch_phase<PH_MIX3>(p, l, grid, stream); HOOK("mix", l);
        launch_phase<PH_OUTPROJ>(p, l, grid, stream);
        launch_phase<PH_LN0>(p, l, grid, stream); HOOK("ln0", l);
        launch_phase<PH_TOPK>(p, l, grid, stream);
        launch_phase<PH_MOE1>(p, l, grid, stream);
        launch_phase<PH_MOE2>(p, l, grid, stream);
        launch_phase<PH_LN1>(p, l, grid, stream); HOOK("ln1", l);
    }
}
```

```cpp
#ifndef EMU
#include <hip/hip_runtime.h>
#endif
#include <stdint.h>
#include <stddef.h>
#include <math.h>

#ifndef CFG_B
#define CFG_B 8
#define CFG_SEQ 4096
#define CFG_CTX 256
#define CFG_DEPTH 4
#define CFG_FF 2048
#endif

#ifndef PROBE_REP
#define PROBE_REP 0
#endif
#define DI __device__ __forceinline__
typedef unsigned short bf16_t;
typedef short bf16x8 __attribute__((ext_vector_type(8)));
typedef short s16x4 __attribute__((ext_vector_type(4)));
typedef float f32x4 __attribute__((ext_vector_type(4)));
typedef unsigned u32x4 __attribute__((ext_vector_type(4)));
typedef unsigned u32x2 __attribute__((ext_vector_type(2)));

constexpr int NB = CFG_B, SEQ = CFG_SEQ, CTX = CFG_CTX, DEPTH = CFG_DEPTH, FF = CFG_FF, DM = 1024, NE = 16;
constexpr int RL = NB * SEQ, RC = NB * CTX, R = RL + RC;
constexpr int CAPL = SEQ / 8, CAPC = CTX / 8, ROWS_E = NB * (CAPL + CAPC);
constexpr int INW = 3344, PW = 3328;
constexpr int NT = 512;
constexpr int NCC = CTX / 128, NLC = SEQ / 128, NCHR = NCC + NLC;
constexpr int NCG = CTX / 64, NLG = SEQ / 64, NCHG = NCG + NLG;
constexpr float ALPHA = 1.681792830507429f;
constexpr float LOG2E = 1.4426950408889634f;
constexpr int C_RQ = 0, C_RK = 256, C_RV = 512, C_RG = 768, C_DQ = 1024, C_DK = 1280, C_DV = 1536, C_GQKV = 1792, C_GG = 2560, C_SQ = 2816, C_SK = 3072, C_SV = 3200;

constexpr size_t al256(size_t x) { return (x + 255) & ~(size_t)255; }
constexpr size_t OFF_BAR = 0;
constexpr size_t OFF_MOD = 16384;
constexpr size_t OFF_TAB = OFF_MOD + al256((size_t)DEPTH * (NB + 1) * 6144 * 4);
constexpr size_t OFF_WIN = OFF_TAB + al256((size_t)SEQ * 160 * 4);
constexpr size_t OFF_WOUT = OFF_WIN + al256((size_t)DEPTH * PW * 1024 * 2);
constexpr size_t OFF_WGU = OFF_WOUT + al256((size_t)DEPTH * 1024 * 1024 * 2);
constexpr size_t OFF_WDN = OFF_WGU + al256((size_t)DEPTH * 16 * 2 * FF * 1024 * 2);
constexpr size_t OFF_H = OFF_WDN + al256((size_t)DEPTH * 16 * 1024 * FF * 2);
constexpr size_t OFF_U = OFF_H + al256((size_t)R * 1024 * 4);
constexpr size_t OFF_GAB = OFF_U + al256((size_t)R * 1024 * 2);
constexpr size_t OFF_MIX = OFF_GAB + al256((size_t)R * 16 * 4);
constexpr size_t OFF_AFF = OFF_MIX + al256((size_t)R * 1024 * 2);
constexpr size_t OFF_IDX = OFF_AFF + al256((size_t)R * 16 * 4);
constexpr size_t OFF_WGT = OFF_IDX + al256((size_t)16 * ROWS_E * 4);
constexpr size_t OFF_INV = OFF_WGT + al256((size_t)16 * ROWS_E * 4);
constexpr size_t OFF_U8 = OFF_INV + al256((size_t)R * 16 * 4);
constexpr size_t OFF_ARA = OFF_U8 + al256((size_t)R * 1024);
constexpr size_t SZ_P = (size_t)R * PW * 2, SZ_HID8 = al256((size_t)16 * ROWS_E * FF), SZ_XIN8 = al256((size_t)16 * ROWS_E * 1024), SZ_HID = SZ_HID8 + SZ_XIN8;
constexpr size_t OFF_ARB = OFF_ARA + al256(SZ_P > SZ_HID ? SZ_P : SZ_HID);
constexpr size_t SZ_RKV = (size_t)NB * 4 * 2 * NCHR * 4096 * 4;
constexpr size_t GCH = (size_t)NB * 4 * 2 * NCHG;
constexpr size_t OB_RKV = 0, OB_RS = OB_RKV + al256(SZ_RKV), OB_GW = OB_RS + al256(SZ_RKV), OB_GQG = OB_GW + GCH * 8192, OB_GQK = OB_GQG + GCH * 8192,
                 OB_GKT = OB_GQK + GCH * 8192, OB_GUB = OB_GKT + GCH * 8192, OB_GCD = OB_GUB + GCH * 16384, OB_OG = OB_GCD + al256(GCH * 4), OB_END = OB_OG + (size_t)2 * R * 256 * 4;
constexpr size_t SZ_MIXO = (size_t)R * 1024 * 4, SZ_Y = (size_t)16 * ROWS_E * 1024 * 2;
constexpr size_t SZ_ARB = OB_END > SZ_MIXO ? (OB_END > SZ_Y ? OB_END : SZ_Y) : (SZ_MIXO > SZ_Y ? SZ_MIXO : SZ_Y);
constexpr size_t WS_TOTAL = OFF_ARB + al256(SZ_ARB);

struct Params {
    const float *x, *c, *ctx, *c_ctx, *ada_w, *ada_b, *w_in, *w_out, *ret_decay, *diff_lambda, *diff_norm, *gdn_conv, *gdn_a_log, *gdn_dt_bias,
        *gdn_norm, *swa_sink, *ln_g, *ln_b, *router_w, *w_gate, *w_up, *w_down;
    float* out; char* ws;
};

#ifdef EMU
#define NT_LOAD(p) (*(p))
#define NT_STORE(v, p) (*(p) = (v))
#else
#define NT_LOAD(p) __builtin_nontemporal_load(p)
#define NT_STORE(v, p) __builtin_nontemporal_store((v), (p))
#endif
DI float bf2f(bf16_t v) { return __uint_as_float(((unsigned)v) << 16); }
DI bf16_t f2bf(float f) { unsigned u = __float_as_uint(f); u += 0x7fffu + ((u >> 16) & 1u); return (bf16_t)(u >> 16); }
DI unsigned pk2(float lo, float hi) {
#ifdef EMU
    return (unsigned)f2bf(lo) | ((unsigned)f2bf(hi) << 16);
#else
    typedef float f32x2_ __attribute__((ext_vector_type(2))); typedef __bf16 bf16x2_ __attribute__((ext_vector_type(2)));
    const f32x2_ v = {lo, hi}; return __builtin_bit_cast(unsigned, __builtin_convertvector(v, bf16x2_));
#endif
}
#ifdef EMU
DI int max(int a, int b) { return a > b ? a : b; }
DI int tidx() { return (int)threadIdx.x; }
DI int bidx() { return (int)blockIdx.x; }
#else
DI int tidx() { int t = threadIdx.x; asm volatile("" : "+v"(t)); return t; }
DI int bidx() { int b = blockIdx.x; asm volatile("" : "+s"(b)); return b; }
#endif
constexpr float SW1 = 32.0f, SW2 = 64.0f, SH = 8.0f;
DI unsigned pk4_fp8(float a, float b, float c, float d) {
    a = fminf(fmaxf(a, -448.f), 448.f); b = fminf(fmaxf(b, -448.f), 448.f); c = fminf(fmaxf(c, -448.f), 448.f); d = fminf(fmaxf(d, -448.f), 448.f);
    int r = __builtin_amdgcn_cvt_pk_fp8_f32(a, b, 0, false); r = __builtin_amdgcn_cvt_pk_fp8_f32(c, d, r, true); return (unsigned)r; }
#ifdef EMU
DI float sum8(float v) { for (int m = 4; m >= 1; m >>= 1) v += __shfl_xor(v, m); return v; }
DI float sum16(float v) { for (int m = 8; m >= 1; m >>= 1) v += __shfl_xor(v, m); return v; }
DI float wsum(float v) { for (int m = 32; m >= 1; m >>= 1) v += __shfl_xor(v, m); return v; }
DI int wsum_i(int v) { for (int m = 32; m >= 1; m >>= 1) v += __shfl_xor(v, m); return v; }
DI int lane_bcast(int v, int src) { return __shfl(v, src); }
DI int lane_shfl_i(int v, int src) { return __shfl(v, src); }
DI float lane_shfl_f(float v, int src) { return __shfl(v, src); }
#else
template <int CTRL> DI float dpp_f(float x) { return __int_as_float(__builtin_amdgcn_update_dpp(0, __float_as_int(x), CTRL, 0xF, 0xF, true)); }
template <int CTRL> DI int dpp_i(int x) { return __builtin_amdgcn_update_dpp(0, x, CTRL, 0xF, 0xF, true); }
DI float sum8(float x) { x += dpp_f<0xB1>(x); x += dpp_f<0x4E>(x); x += dpp_f<0x141>(x); return x; }
DI float sum16(float x) { x += dpp_f<0xB1>(x); x += dpp_f<0x4E>(x); x += dpp_f<0x141>(x); x += dpp_f<0x140>(x); return x; }
DI float wsum(float x) { x = sum16(x);
    auto a = __builtin_amdgcn_permlane16_swap(__float_as_uint(x), __float_as_uint(x), false, false); x = __uint_as_float(a[0]) + __uint_as_float(a[1]);
    auto b = __builtin_amdgcn_permlane32_swap(__float_as_uint(x), __float_as_uint(x), false, false); return __uint_as_float(b[0]) + __uint_as_float(b[1]); }
DI int wsum_i(int x) { x += dpp_i<0xB1>(x); x += dpp_i<0x4E>(x); x += dpp_i<0x141>(x); x += dpp_i<0x140>(x);
    auto a = __builtin_amdgcn_permlane16_swap((unsigned)x, (unsigned)x, false, false); x = (int)a[0] + (int)a[1];
    auto b = __builtin_amdgcn_permlane32_swap((unsigned)x, (unsigned)x, false, false); return (int)b[0] + (int)b[1]; }
DI int lane_bcast(int v, int src) { return __builtin_amdgcn_readlane(v, src); }
DI int lane_shfl_i(int v, int src) { return __builtin_amdgcn_ds_bpermute(src << 2, v); }
DI float lane_shfl_f(float v, int src) { return __int_as_float(__builtin_amdgcn_ds_bpermute(src << 2, __float_as_int(v))); }
#endif
DI float siluf(float x) { return x * __builtin_amdgcn_rcpf(1.0f + __builtin_amdgcn_exp2f(-LOG2E * x)); }
DI float sigmoidf_(float x) { return __builtin_amdgcn_rcpf(1.0f + __builtin_amdgcn_exp2f(-LOG2E * x)); }
DI float softplusf_(float x) { return x > 20.0f ? x : 0.6931471805599453f * __builtin_amdgcn_logf(1.0f + __builtin_amdgcn_exp2f(x * LOG2E)); }
DI float ex2(float x) { return __builtin_amdgcn_exp2f(x); }
DI f32x4 MFMA16(bf16x8 a, bf16x8 b, f32x4 c) { return __builtin_amdgcn_mfma_f32_16x16x32_bf16(a, b, c, 0, 0, 0); }
typedef int i32x8 __attribute__((ext_vector_type(8)));
typedef unsigned u32x8 __attribute__((ext_vector_type(8)));
DI f32x4 mfma_fp8(u32x8 a, u32x8 b, f32x4 c) {
    return __builtin_amdgcn_mfma_scale_f32_16x16x128_f8f6f4(__builtin_bit_cast(i32x8, a), __builtin_bit_cast(i32x8, b), c, 0, 0, 0, 0x7F7F7F7F, 0, 0x7F7F7F7F); }
DI bf16x8 frag_lo(u32x8 v) { const u32x4 h = __builtin_shufflevector(v, v, 0, 1, 2, 3); return __builtin_bit_cast(bf16x8, h); }
DI bf16x8 frag_hi(u32x8 v) { const u32x4 h = __builtin_shufflevector(v, v, 4, 5, 6, 7); return __builtin_bit_cast(bf16x8, h); }
#ifdef EMU
#define WAIT_V(n)
#define WAIT_L(n)
#else
#define WAIT_V(n) asm volatile("s_waitcnt vmcnt(" #n ")" ::: "memory")
#define WAIT_L(n) asm volatile("s_waitcnt lgkmcnt(" #n ")" ::: "memory")
#endif
#define BAR __builtin_amdgcn_s_barrier()
#define SCHED __builtin_amdgcn_sched_barrier(0)

#ifdef EMU
#define LDS_BARRIER() __syncthreads()
#else
#define LDS_BARRIER() do { asm volatile("s_waitcnt lgkmcnt(0)" ::: "memory"); __builtin_amdgcn_s_barrier(); asm volatile("" ::: "memory"); } while (0)
#endif
#ifdef EMU
DI float grp_max(float x) { x = fmaxf(x, __shfl_xor(x, 16)); return fmaxf(x, __shfl_xor(x, 32)); }
DI float grp_sum(float x) { x += __shfl_xor(x, 16); return x + __shfl_xor(x, 32); }
DI int grp_imax(int x) { int y = __shfl_xor(x, 16); x = x > y ? x : y; y = __shfl_xor(x, 32); return x > y ? x : y; }
DI s16x4 lds_tr16(const bf16_t* p) { return emu_lds_tr16(p); }
#else
DI float grp_max(float x) {
    auto a = __builtin_amdgcn_permlane16_swap(__float_as_uint(x), __float_as_uint(x), false, false); x = fmaxf(__uint_as_float(a[0]), __uint_as_float(a[1]));
    auto b = __builtin_amdgcn_permlane32_swap(__float_as_uint(x), __float_as_uint(x), false, false); return fmaxf(__uint_as_float(b[0]), __uint_as_float(b[1])); }
DI float grp_sum(float x) {
    auto a = __builtin_amdgcn_permlane16_swap(__float_as_uint(x), __float_as_uint(x), false, false); x = __uint_as_float(a[0]) + __uint_as_float(a[1]);
    auto b = __builtin_amdgcn_permlane32_swap(__float_as_uint(x), __float_as_uint(x), false, false); return __uint_as_float(b[0]) + __uint_as_float(b[1]); }
DI int grp_imax(int x) {
    auto a = __builtin_amdgcn_permlane16_swap((unsigned)x, (unsigned)x, false, false); x = max((int)a[0], (int)a[1]);
    auto b = __builtin_amdgcn_permlane32_swap((unsigned)x, (unsigned)x, false, false); return max((int)b[0], (int)b[1]); }
typedef short v4i16_t_ __attribute__((ext_vector_type(4)));
DI s16x4 lds_tr16(const bf16_t* p) { return __builtin_bit_cast(s16x4, __builtin_amdgcn_ds_read_tr16_b64_v4i16((__attribute__((address_space(3))) v4i16_t_*)p)); }
#endif
#ifdef EMU
struct XcdBarrier { unsigned* bar; };
DI XcdBarrier xcd_barrier_post(unsigned* bar, void*) { XcdBarrier b; b.bar = bar; return b; }
DI void xcd_barrier(const XcdBarrier& b) {
    __syncthreads();
    if (threadIdx.x == 0) { unsigned g = __atomic_load_n(&b.bar[64], __ATOMIC_SEQ_CST);
        if (__atomic_fetch_add(&b.bar[0], 1u, __ATOMIC_SEQ_CST) == gridDim.x - 1) { __atomic_store_n(&b.bar[0], 0u, __ATOMIC_SEQ_CST); __atomic_fetch_add(&b.bar[64], 1u, __ATOMIC_SEQ_CST); }
        else while (__atomic_load_n(&b.bar[64], __ATOMIC_SEQ_CST) == g) sched_yield(); }
    __syncthreads();
}
#define XCD_BAR_WORDS 3456
#else
#define XB_TMO      128
#define XB_XCNT(j)  (256  + 64 * (j))
#define XB_XSUB(j)  (1280 + 64 * (j))
#define XB_XGEN(j)  (2304 + 64 * (j))
#define XB_TOP      3328
#define XB_TOPGEN   3392
#define XCD_BAR_WORDS 3456
#define XB_SPIN_CAP (1u << 22)
#define LAS __attribute__((address_space(3)))
DI unsigned xb_ld(unsigned* p)              { return __hip_atomic_load(p, __ATOMIC_RELAXED, __HIP_MEMORY_SCOPE_AGENT); }
DI unsigned xb_add(unsigned* p, unsigned v) { return __hip_atomic_fetch_add(p, v, __ATOMIC_RELAXED, __HIP_MEMORY_SCOPE_AGENT); }
DI unsigned xb_xcc_id() { return (unsigned)__builtin_amdgcn_s_getreg((3 << 11) | 20) & 0xFu; }
#define XB_SPIN(cond, bar) do { unsigned _sp = 0; while (cond) { __builtin_amdgcn_s_sleep(1); \
    if ((++_sp & 255u) == 0u) { if (xb_ld(&(bar)[XB_TMO])) break; if (_sp > XB_SPIN_CAP) { atomicAdd(&(bar)[XB_TMO], 1u); break; } } } } while (0)
struct XcdBarrier { unsigned* bar; unsigned x; volatile LAS unsigned* st; };
DI XcdBarrier xcd_barrier_post(unsigned* bar, volatile LAS unsigned* st) {
    XcdBarrier b; b.bar = bar; b.x = xb_xcc_id(); b.st = st;
    if (threadIdx.x == 0) (void)xb_add(&bar[XB_XCNT(b.x)], 1u);
    return b;
}
DI void xcd_barrier_complete(unsigned* bar, unsigned x, unsigned& nloc, unsigned& nx) {
    const unsigned G = gridDim.x * gridDim.y * gridDim.z;
    unsigned sum, cnt, mine, sp = 0u;
    for (;;) {
        sum = 0u; cnt = 0u; mine = 0u;
#pragma unroll
        for (unsigned j = 0; j < 16; ++j) { const unsigned c = xb_ld(&bar[XB_XCNT(j)]); sum += c; cnt += (c > 0u) ? 1u : 0u; mine = (j == x) ? c : mine; }
        if (sum == G) break;
        __builtin_amdgcn_s_sleep(1);
        if ((++sp & 255u) == 0u) { if (xb_ld(&bar[XB_TMO])) break; if (sp > XB_SPIN_CAP) { atomicAdd(&bar[XB_TMO], 1u); break; } }
    }
    nloc = mine > 0u ? mine : 1u; nx = cnt > 0u ? cnt : 1u;
}
DI void xcd_barrier(const XcdBarrier& b) {
    asm volatile("s_waitcnt vmcnt(0)" ::: "memory");
    __syncthreads();
    if (threadIdx.x == 0) {
        unsigned* bar = b.bar;
        __builtin_amdgcn_s_waitcnt(0);
        unsigned nloc = b.st[0], nx = b.st[1];
        if (nloc == 0u) { xcd_barrier_complete(bar, b.x, nloc, nx); b.st[0] = nloc; b.st[1] = nx; }
        const unsigned old = xb_add(&bar[XB_XSUB(b.x)], 1u);
        const unsigned gen = old / nloc;
        if (old + 1u == (gen + 1u) * nloc) {
            __builtin_amdgcn_fence(__ATOMIC_RELEASE, "agent");
            asm volatile("s_waitcnt vmcnt(0)" ::: "memory");
            const unsigned og = xb_add(&bar[XB_TOP], 1u);
            const unsigned tg = og / nx;
            if (og + 1u == (tg + 1u) * nx) xb_add(&bar[XB_TOPGEN], 1u);
            else XB_SPIN(xb_ld(&bar[XB_TOPGEN]) == tg, bar);
            __builtin_amdgcn_fence(__ATOMIC_ACQUIRE, "agent");
            xb_add(&bar[XB_XGEN(b.x)], 1u);
            asm volatile("s_waitcnt vmcnt(0)" ::: "memory");
        } else {
            XB_SPIN(xb_ld(&bar[XB_XGEN(b.x)]) == gen, bar);
            __builtin_amdgcn_fence(__ATOMIC_ACQUIRE, "agent");
            asm volatile("s_waitcnt vmcnt(0)" ::: "memory");
        }
    }
    __syncthreads();
}
#endif

struct WS {
    unsigned* bar; float* mod; float* tab; bf16_t* win; bf16_t* wout; unsigned char* wgu; unsigned char* wdn; float* h; bf16_t* u; unsigned char* u8; float* gab; bf16_t* mix; float* aff;
    int* idx; float* wgt; int* inv; bf16_t* p; unsigned char* hid; unsigned char* xin; float* rkv; float* rs; bf16_t* gw; bf16_t* gqg; bf16_t* gqk; bf16_t* gkt; float* gub; float* gcd; float* og; bf16_t* mixo; bf16_t* y;
};
DI WS ws_of(char* w) {
    WS s; s.bar = (unsigned*)(w + OFF_BAR); s.mod = (float*)(w + OFF_MOD); s.tab = (float*)(w + OFF_TAB); s.win = (bf16_t*)(w + OFF_WIN); s.wout = (bf16_t*)(w + OFF_WOUT);
    s.wgu = (unsigned char*)(w + OFF_WGU); s.wdn = (unsigned char*)(w + OFF_WDN); s.u8 = (unsigned char*)(w + OFF_U8); s.h = (float*)(w + OFF_H); s.u = (bf16_t*)(w + OFF_U); s.gab = (float*)(w + OFF_GAB); s.mix = (bf16_t*)(w + OFF_MIX);
    s.aff = (float*)(w + OFF_AFF); s.idx = (int*)(w + OFF_IDX); s.wgt = (float*)(w + OFF_WGT); s.inv = (int*)(w + OFF_INV); s.p = (bf16_t*)(w + OFF_ARA); s.hid = (unsigned char*)(w + OFF_ARA); s.xin = (unsigned char*)(w + OFF_ARA + SZ_HID8);
    char* b = w + OFF_ARB; s.rkv = (float*)(b + OB_RKV); s.rs = (float*)(b + OB_RS); s.gw = (bf16_t*)(b + OB_GW); s.gqg = (bf16_t*)(b + OB_GQG); s.gqk = (bf16_t*)(b + OB_GQK);
    s.gkt = (bf16_t*)(b + OB_GKT); s.gub = (float*)(b + OB_GUB); s.gcd = (float*)(b + OB_GCD); s.og = (float*)(b + OB_OG); s.mixo = (bf16_t*)b; s.y = (bf16_t*)b;
    return s;
}

struct CvtJob { const float* src; char* dst; int src_ld, dst_ld  , mode  ; float scale; };
DI CvtJob cvt_job(const Params& p, const WS& w, int u) {
    constexpr int FT = FF / 128, n_in = 8 * 52, n_out = 8 * 16, n_g = 16 * 8 * (FF / 64), n_d = 16 * FT * 16, tot_l = n_in + n_out + 2 * n_g + n_d;
    const int l = u / tot_l; int r = u % tot_l; CvtJob j; j.scale = 1.0f;
    if (r < n_in) { const int kt = r & 7, ct = r >> 3, c0 = ct < 44 ? ct * 64 : 2832 + (ct - 44) * 64;
        j.src = p.w_in + (size_t)l * 1024 * INW + (size_t)(kt * 128) * INW + c0; j.src_ld = INW; j.dst = (char*)(w.win + (size_t)l * PW * 1024 + (size_t)(ct < 44 ? c0 : c0 - 16) * 1024 + kt * 128); j.dst_ld = 2048;
        j.mode = (ct < 8 || (ct >= 44 && ct < 50)) ? 1 : ((ct >= 16 && ct < 24) ? 3 : 0);
    } else if (r < n_in + n_out) { r -= n_in; const int kt = r & 7, ct = r >> 3;
        j.src = p.w_out + (size_t)l * 1024 * 1024 + (size_t)(kt * 128) * 1024 + ct * 64; j.src_ld = 1024; j.dst = (char*)(w.wout + (size_t)l * 1024 * 1024 + (size_t)(ct * 64) * 1024 + kt * 128); j.dst_ld = 2048; j.mode = 0;
    } else if (r < n_in + n_out + 2 * n_g) { r -= n_in + n_out; const int which = r / n_g, rr = r % n_g, e = rr / (8 * (FF / 64)), r2 = rr % (8 * (FF / 64)), kt = r2 & 7, ct = r2 >> 3, c0 = ct * 64;
        j.src = (which ? p.w_up : p.w_gate) + (size_t)(l * 16 + e) * 1024 * FF + (size_t)(kt * 128) * FF + c0; j.src_ld = FF;
        j.dst = (char*)(w.wgu + (size_t)(l * 16 + e) * 2 * FF * 1024 + (size_t)((c0 >> 7) * 256 + which * 128 + (c0 & 127)) * 1024 + kt * 128); j.dst_ld = 1024; j.mode = 2; j.scale = SW1;
    } else { r -= n_in + n_out + 2 * n_g; const int e = r / (16 * FT), r2 = r % (16 * FT), kt = r2 % FT, ct = r2 / FT;
        j.src = p.w_down + (size_t)(l * 16 + e) * FF * 1024 + (size_t)(kt * 128) * 1024 + ct * 64; j.src_ld = 1024; j.dst = (char*)(w.wdn + (size_t)(l * 16 + e) * 1024 * FF + (size_t)(ct * 64) * FF + kt * 128); j.dst_ld = FF; j.mode = 2; j.scale = SW2;
    }
    return j;
}
#define CVT_LOAD(j, v) _Pragma("unroll") for (int i = 0; i < 16; ++i) { const int idx = tid + NT * i, kk = idx >> 6, cc = idx & 63; v[i] = NT_LOAD((j).src + (size_t)kk * (j).src_ld + cc); }
constexpr int CVT_TOT_L = 8 * 52 + 8 * 16 + 2 * 16 * 8 * (FF / 64) + 16 * (FF / 128) * 16;
#ifndef CVT_PER_B
#define CVT_PER_B 16
#endif
#ifndef CVT_PER_D
#define CVT_PER_D 16
#endif
#ifndef CVT_PER_A
#define CVT_PER_A 16
#endif
#ifndef CVT_PER_T
#define CVT_PER_T 10
#endif
constexpr int cvt_share(int pct, int n) { return (CVT_TOT_L * pct / 100) < n ? (CVT_TOT_L * pct / 100) : n; }
constexpr int CVT_TAIL_B = cvt_share(30, 224 * CVT_PER_B), CVT_TAIL_D = cvt_share(25, 192 * CVT_PER_D), CVT_TAIL_A = cvt_share(3, 24 * CVT_PER_A), CVT_TAIL_T = cvt_share(12, 128 * CVT_PER_T);
constexpr int CVT_AHEAD = CVT_TAIL_B + CVT_TAIL_D + CVT_TAIL_A + CVT_TAIL_T, CVT_P0 = DEPTH * (CVT_TOT_L - CVT_AHEAD) + CVT_TAIL_D;
static_assert(CVT_TOT_L - CVT_AHEAD + CVT_TAIL_D >= 8 * 52 + 8 * 16, "a layer's in-proj / out-proj tiles must be converted before its own windows");
template <int KIND> DI int cvt_tile_id(int q, int layer) {
    if (KIND == 0) return q;
    return CVT_P0 + layer * CVT_AHEAD + (KIND == 3 ? 0 : (KIND == 1 ? CVT_TAIL_A : (KIND == 4 ? CVT_TAIL_A + CVT_TAIL_B : CVT_TAIL_A + CVT_TAIL_B + CVT_TAIL_T))) + q;
}
template <int KIND> DI void cvt_stream(const Params& p, const WS& w, char* smem, int layer, int rank, int nranks) {
    float* tile = (float*)smem;
    constexpr int total = KIND == 0 ? CVT_P0 : (KIND == 1 ? CVT_TAIL_B : (KIND == 2 ? CVT_TAIL_D : (KIND == 3 ? CVT_TAIL_A : CVT_TAIL_T)));
    const int tid = tidx(); int q = rank;
    if (q < total) {
        CvtJob j = cvt_job(p, w, cvt_tile_id<KIND>(q, layer)); float v[16];
        CVT_LOAD(j, v);
        for (;;) {
#pragma unroll
            for (int i = 0; i < 16; ++i) { const int idx = tid + NT * i, kk = idx >> 6, cc = idx & 63; tile[kk * 65 + cc] = v[i] * j.scale; }
            const int qn = q + nranks; CvtJob jn = j;
            if (qn < total) { jn = cvt_job(p, w, cvt_tile_id<KIND>(qn, layer)); CVT_LOAD(jn, v); }
            LDS_BARRIER();
            if (j.mode == 2) {
#pragma unroll
                for (int i = 0; i < 4; ++i) { const int idx = tid + NT * i, cc = idx >> 5, kq = idx & 31;
                    *(unsigned*)(j.dst + (size_t)cc * j.dst_ld + 4 * kq) = pk4_fp8(tile[(4 * kq) * 65 + cc], tile[(4 * kq + 1) * 65 + cc], tile[(4 * kq + 2) * 65 + cc], tile[(4 * kq + 3) * 65 + cc]); }
            } else {
#pragma unroll
                for (int i = 0; i < 8; ++i) { const int idx = tid + NT * i, cc = idx >> 6, kp = idx & 63;
                    const int pc = j.mode == 1 ? 32 * ((cc >> 4) & 1) + 8 * ((cc >> 2) & 3) + 4 * (cc >> 5) + (cc & 3) : (j.mode == 3 ? 32 * (cc >> 5) + 8 * ((cc >> 2) & 3) + 4 * ((cc >> 4) & 1) + (cc & 3) : cc);
                    *(unsigned*)(j.dst + (size_t)pc * j.dst_ld + 4 * kp) = pk2(tile[(2 * kp) * 65 + cc], tile[(2 * kp + 1) * 65 + cc]); }
            }
            LDS_BARRIER();
            if (qn >= total) break;
            q = qn; j = jn;
        }
    }
    __syncthreads();
}
DI void phase_cvt(const Params& p, char* smem) {
    const WS w = ws_of(p.ws);
    cvt_stream<0>(p, w, smem, 0, bidx(), gridDim.x);
    for (int i = bidx() * NT + tidx(); i < SEQ * 80; i += gridDim.x * NT) {
        const int n = i / 80, a = i % 80, row = n / 64, col = n % 64; float ang;
        if (a < 32) ang = (float)n * (1.0f / powf(10000.0f, (float)a / 31.0f));
        else if (a < 48) { const int ii = a - 32; ang = (float)(ii < 8 ? row : col) * powf(10000.0f, -(float)(ii & 7) / 8.0f); }
        else { const int ii = a - 48; ang = (float)(ii < 16 ? row : col) * powf(10000.0f, -(float)(ii & 15) / 16.0f); }
        w.tab[2 * i] = cosf(ang); w.tab[2 * i + 1] = sinf(ang);
    }
    float* cond = (float*)smem; float* red = cond + (NB + 1) * 1024;
    __syncthreads();
    for (int i = tidx(); i < (NB + 1) * 1024; i += NT) { const int r = i >> 10, k = i & 1023; const float v = r < NB ? p.c[r * 1024 + k] : p.c_ctx[k]; cond[i] = siluf(v); }
    __syncthreads();
    for (int u = bidx(); u < DEPTH * 96; u += gridDim.x) {
        const int l = u / 96, cg = u % 96, col = tidx() & 63, kg = tidx() >> 6;
        float acc[NB + 1];
#pragma unroll
        for (int r = 0; r <= NB; ++r) acc[r] = 0.f;
        const float* wp = p.ada_w + ((size_t)l * 1024 + kg * 128) * 6144 + cg * 64 + col;
        for (int k = 0; k < 128; ++k) { const float wv = wp[(size_t)k * 6144];
#pragma unroll
            for (int r = 0; r <= NB; ++r) acc[r] += cond[r * 1024 + kg * 128 + k] * wv; }
#pragma unroll
        for (int r = 0; r <= NB; ++r) red[(kg * (NB + 1) + r) * 64 + col] = acc[r];
        __syncthreads();
        for (int i = tidx(); i < (NB + 1) * 64; i += NT) { const int r = i >> 6, cc = i & 63; float s = p.ada_b[l * 6144 + cg * 64 + cc];
#pragma unroll
            for (int g = 0; g < 8; ++g) s += red[(g * (NB + 1) + r) * 64 + cc];
            w.mod[((size_t)l * (NB + 1) + r) * 6144 + cg * 64 + cc] = s; }
        __syncthreads();
    }
}

template <int MODE> DI void phase_rows(const Params& p, int layer, char* smem) {
    const WS w = ws_of(p.ws); float* Wl = (float*)smem;
    const int tid = tidx(), lane = tid & 63, wv = tid >> 6;
    const bool last = (layer == DEPTH - 1);
    __syncthreads();
    if (MODE == 0 || (MODE == 2 && !last)) { const int l2 = MODE == 0 ? 0 : layer + 1;
        for (int i = tid; i < 16 * 1024; i += NT) { const int o = i & 15, k = i >> 4; Wl[o * 1024 + k] = p.w_in[((size_t)l2 * 1024 + k) * INW + 2816 + o]; } }
    if (MODE == 1) for (int i = tid; i < 16 * 1024; i += NT) { const int o = i & 15, k = i >> 4; Wl[o * 1024 + k] = p.router_w[((size_t)layer * 1024 + k) * 16 + o]; }
    __syncthreads();
    const int nrows = (MODE != 0 && last) ? RL : R;
    const int nwaves = gridDim.x * 8, chunk = (nrows + nwaves - 1) / nwaves, row_beg = (bidx() * 8 + wv) * chunk, row_end = row_beg + chunk < nrows ? row_beg + chunk : nrows;
    if (row_beg >= row_end) return;
    f32x4 lg4[4], lb4[4], mg4[4], m04[4], m14[4];
    if (MODE != 0) { const float* lg = p.ln_g + ((size_t)layer * 2 + (MODE == 1 ? 0 : 1)) * 1024; const float* lb = p.ln_b + ((size_t)layer * 2 + (MODE == 1 ? 0 : 1)) * 1024;
#pragma unroll
        for (int j = 0; j < 4; ++j) { lg4[j] = *(const f32x4*)(lg + 256 * j + 4 * lane); lb4[j] = *(const f32x4*)(lb + 256 * j + 4 * lane); } }
    int bcur = -1;
    const int lm = MODE == 2 ? layer + 1 : (MODE == 0 ? 0 : layer);
    const bool write_u = !(MODE == 2 && last);
    auto batch_of = [&](int r) { return r >= RL ? NB : r / SEQ; };
    f32x4 hn[2][4]; u32x2 bn[2][4]; int invn[2] = {-1, -1};
#define ROW_FETCH(Q, ROW) do { const int r_ = (ROW); const bool isc_ = r_ >= RL; \
        const float* src_ = MODE == 0 ? (isc_ ? p.ctx + (size_t)(r_ - RL) * 1024 : p.x + (size_t)r_ * 1024) : w.h + (size_t)r_ * 1024; \
        _Pragma("unroll") for (int j = 0; j < 4; ++j) hn[Q][j] = NT_LOAD((const f32x4*)(src_ + 256 * j + 4 * lane)); \
        if (MODE == 1) { _Pragma("unroll") for (int j = 0; j < 4; ++j) bn[Q][j] = NT_LOAD((const u32x2*)(w.mixo + (size_t)r_ * 1024 + 256 * j + 4 * lane)); } \
        if (MODE == 2) invn[Q] = lane < 16 ? w.inv[(size_t)r_ * 16 + lane] : -1; } while (0)
    int row = row_beg, nr = (row + 1 < row_end && batch_of(row + 1) == batch_of(row)) ? 2 : 1;
    ROW_FETCH(0, row); ROW_FETCH(1, nr == 2 ? row + 1 : row);
    while (row < row_end) {
        const bool isc = row >= RL; const int b = isc ? NB : row / SEQ;
        if (b != bcur) { bcur = b;
            if (MODE != 0) { const float* mg = w.mod + ((size_t)layer * (NB + 1) + b) * 6144 + (MODE == 1 ? 2 : 5) * 1024;
#pragma unroll
                for (int j = 0; j < 4; ++j) mg4[j] = *(const f32x4*)(mg + 256 * j + 4 * lane); }
            if (write_u) { const float* m0 = w.mod + ((size_t)lm * (NB + 1) + b) * 6144 + (MODE == 1 ? 3 : 0) * 1024;
#pragma unroll
                for (int j = 0; j < 4; ++j) { m04[j] = *(const f32x4*)(m0 + 256 * j + 4 * lane); m14[j] = *(const f32x4*)(m0 + 1024 + 256 * j + 4 * lane); } } }
        f32x4 hv[2][4]; u32x2 bc[2][4]; int myinv[2];
#pragma unroll
        for (int q = 0; q < 2; ++q) { myinv[q] = invn[q];
#pragma unroll
            for (int j = 0; j < 4; ++j) { hv[q][j] = hn[q][j]; bc[q][j] = bn[q][j]; } }
        const int row_cur = row, nr_cur = nr;
        row += nr;
        if (row < row_end) { nr = (row + 1 < row_end && batch_of(row + 1) == batch_of(row)) ? 2 : 1; ROW_FETCH(0, row); ROW_FETCH(1, nr == 2 ? row + 1 : row); }
        f32x4 uv[2][4];
#pragma unroll
        for (int q = 0; q < 2; ++q) {
            const int rw_ = row_cur + (q < nr_cur ? q : 0);
            if (MODE != 0) {
                f32x4 br[4];
                if (MODE == 1) {
#pragma unroll
                    for (int j = 0; j < 4; ++j) br[j] = (f32x4){__uint_as_float(bc[q][j][0] << 16), __uint_as_float(bc[q][j][0] & 0xffff0000u), __uint_as_float(bc[q][j][1] << 16), __uint_as_float(bc[q][j][1] & 0xffff0000u)};
                } else {
#pragma unroll
                    for (int j = 0; j < 4; ++j) br[j] = (f32x4){0.f, 0.f, 0.f, 0.f};
                    for (int e = 0; e < 16; ++e) { const int sl = lane_bcast(myinv[q], e);
                        if (sl >= 0) { const bf16_t* yr = w.y + ((size_t)e * ROWS_E + sl) * 1024;
#pragma unroll
                            for (int j = 0; j < 4; ++j) { const u32x2 v = NT_LOAD((const u32x2*)(yr + 256 * j + 4 * lane));
                                br[j][0] += __uint_as_float(v[0] << 16); br[j][1] += __uint_as_float(v[0] & 0xffff0000u); br[j][2] += __uint_as_float(v[1] << 16); br[j][3] += __uint_as_float(v[1] & 0xffff0000u); } } }
                }
                float sm_ = 0.f;
#pragma unroll
                for (int j = 0; j < 4; ++j) { hv[q][j] = ALPHA * hv[q][j] + mg4[j] * br[j]; sm_ += hv[q][j][0] + hv[q][j][1] + hv[q][j][2] + hv[q][j][3]; }
                const float mean = wsum(sm_) * (1.0f / 1024.0f); float qq = 0.f;
#pragma unroll
                for (int j = 0; j < 4; ++j) { hv[q][j] = hv[q][j] - mean; qq += hv[q][j][0] * hv[q][j][0] + hv[q][j][1] * hv[q][j][1] + hv[q][j][2] * hv[q][j][2] + hv[q][j][3] * hv[q][j][3]; }
                const float rstd = 1.0f / sqrtf(wsum(qq) * (1.0f / 1024.0f) + 1e-5f);
#pragma unroll
                for (int j = 0; j < 4; ++j) hv[q][j] = hv[q][j] * rstd * lg4[j] + lb4[j];
            }
            if (q < nr_cur) {
                if (MODE == 2 && last) {
#pragma unroll
                    for (int j = 0; j < 4; ++j) *(f32x4*)(p.out + (size_t)rw_ * 1024 + 256 * j + 4 * lane) = hv[q][j];
                } else {
#pragma unroll
                    for (int j = 0; j < 4; ++j) NT_STORE(hv[q][j], (f32x4*)(w.h + (size_t)rw_ * 1024 + 256 * j + 4 * lane));
                }
            }
#pragma unroll
            for (int j = 0; j < 4; ++j) { uv[q][j] = hv[q][j] * (1.0f + m14[j]) + m04[j];
                if (write_u && q < nr_cur) { if (MODE == 1) *(unsigned*)(w.u8 + (size_t)rw_ * 1024 + 256 * j + 4 * lane) = pk4_fp8(uv[q][j][0], uv[q][j][1], uv[q][j][2], uv[q][j][3]);
                    else { u32x2 o; o[0] = pk2(uv[q][j][0], uv[q][j][1]); o[1] = pk2(uv[q][j][2], uv[q][j][3]); *(u32x2*)(w.u + (size_t)rw_ * 1024 + 256 * j + 4 * lane) = o; } } }
        }
        if (!write_u) continue;
        float lgt[2][16];
#pragma unroll
        for (int o = 0; o < 16; ++o) { float a0 = 0.f, a1 = 0.f;
#pragma unroll
            for (int j = 0; j < 4; ++j) { const f32x4 wv4 = *(const f32x4*)(Wl + o * 1024 + 256 * j + 4 * lane);
                a0 += uv[0][j][0] * wv4[0] + uv[0][j][1] * wv4[1] + uv[0][j][2] * wv4[2] + uv[0][j][3] * wv4[3]; a1 += uv[1][j][0] * wv4[0] + uv[1][j][1] * wv4[1] + uv[1][j][2] * wv4[2] + uv[1][j][3] * wv4[3]; }
            lgt[0][o] = wsum(a0); lgt[1][o] = wsum(a1); SCHED; }
#pragma unroll
        for (int q = 0; q < 2; ++q) {
            if (q >= nr_cur) continue;
            const int rw_ = row_cur + q; float mine = 0.f;
            if (MODE == 1) { float mx = lgt[q][0];
#pragma unroll
                for (int o = 1; o < 16; ++o) mx = fmaxf(mx, lgt[q][o]);
                float sm = 0.f;
#pragma unroll
                for (int o = 0; o < 16; ++o) { lgt[q][o] = __expf(lgt[q][o] - mx); sm += lgt[q][o]; }
                const float inv = 1.0f / sm;
#pragma unroll
                for (int o = 0; o < 16; ++o) if (lane == o) mine = lgt[q][o] * inv;
                if (lane < 16) { if (rw_ < RL) { const int bb = rw_ / SEQ, n = rw_ % SEQ; w.aff[((size_t)bb * 16 + lane) * SEQ + n] = mine; }
                                 else { const int rr = rw_ - RL, bb = rr / CTX, n = rr % CTX; w.aff[(size_t)RL * 16 + ((size_t)bb * 16 + lane) * CTX + n] = mine; } }
            } else {
#pragma unroll
                for (int o = 0; o < 16; ++o) if (lane == o) mine = lgt[q][o];
                if (lane < 16) w.gab[(size_t)rw_ * 16 + lane] = mine;
            }
        }
    }
#undef ROW_FETCH
}

constexpr int G_HT = 128 * 64;
DI int lds_byte(int r, int c) { const int st = (r >> 4) * 2 + (c >> 5), rr = r & 15, cc = c & 31, ob = rr * 64 + cc * 2; return st * 1024 + (ob ^ (((ob >> 9) & 1) << 5)); }
DI void stage_rc(int b, int& Rr, int& Cc) { const int st = b / 1024, sb = b % 1024, swz = sb ^ (((sb >> 9) & 1) << 5); Rr = (st >> 1) * 16 + swz / 64; Cc = (st & 1) * 32 + (swz % 64) / 2; }
#define GLDS16(g, l) __builtin_amdgcn_global_load_lds((const unsigned*)(g), (unsigned*)(l), 16, 0, 0)

struct EpiArgs { void* out; int ld; long orow0; const float* wgt; const float* tab; int kind0, kind1; float sc0, sc1; };
template <int EPI, bool GATHER>
DI void gemm_unit(const bf16_t* __restrict__ A, const bf16_t* __restrict__ Bt, const int K, const int brow, const int bcol, const int* __restrict__ gidx, const EpiArgs ea, char* smem) {
    bf16_t* shm = (bf16_t*)smem;
#define SA(b, h) (shm + ((b) * 2 + (h)) * G_HT)
#define SB(b, h) (shm + (4 + (b) * 2 + (h)) * G_HT)
#define STAGE_B(T, P, h, kt) do { _Pragma("unroll") for (int _i = 0; _i < 2; ++_i) { const int _b = (T) * 16 + _i * 8192; int _r, _c; stage_rc(_b, _r, _c); \
        GLDS16(Bt + (unsigned)((bcol + (h) * 128 + _r) * K + (kt) * 64 + _c), (char*)(P) + _b); } } while (0)
#define STAGE_A(T, P, h, kt) do { _Pragma("unroll") for (int _i = 0; _i < 2; ++_i) { const int _b = (T) * 16 + _i * 8192; int _r, _c; stage_rc(_b, _r, _c); \
        const int _ro = GATHER ? rid[h][_i] : (brow + (h) * 128 + _r); GLDS16(A + (unsigned)(_ro * K + (kt) * 64 + _c), (char*)(P) + _b); } } while (0)
#define LDA(dst, b, h) _Pragma("unroll") for (int m = 0; m < 4; ++m) _Pragma("unroll") for (int k = 0; k < 2; ++k) \
        dst[m][k] = *reinterpret_cast<const bf16x8*>((char*)SA(b, h) + lds_byte(wr * 64 + m * 16 + fr, k * 32 + fq * 8))
#define LDB(dst, b, h) _Pragma("unroll") for (int n = 0; n < 2; ++n) _Pragma("unroll") for (int k = 0; k < 2; ++k) \
        dst[n][k] = *reinterpret_cast<const bf16x8*>((char*)SB(b, h) + lds_byte(wc * 32 + n * 16 + fr, k * 32 + fq * 8))
#define MMA(ai, bj, At_, Bt_) do { __builtin_amdgcn_s_setprio(1); \
        _Pragma("unroll") for (int m = 0; m < 4; ++m) _Pragma("unroll") for (int n = 0; n < 2; ++n) _Pragma("unroll") for (int k = 0; k < 2; ++k) \
            acc[ai][bj][m][n] = MFMA16(Bt_[n][k], At_[m][k], acc[ai][bj][m][n]); \
        __builtin_amdgcn_s_setprio(0); } while (0)
    int tid = tidx();
#ifndef EMU
    asm volatile("" : "+v"(tid));
#endif
    int wid = tid >> 6, lane = tid & 63, wr = wid >> 2, wc = wid & 3, fr = lane & 15, fq = lane >> 4;
    int rid[2][2];
    if (GATHER) {
#pragma unroll
        for (int h = 0; h < 2; ++h)
#pragma unroll
            for (int i = 0; i < 2; ++i) { int r_, c_; stage_rc(tid * 16 + i * 8192, r_, c_); rid[h][i] = gidx[h * 128 + r_]; }
    }
    f32x4 acc[2][2][4][2];
#pragma unroll
    for (int a = 0; a < 2; ++a)
#pragma unroll
        for (int b = 0; b < 2; ++b)
#pragma unroll
            for (int m = 0; m < 4; ++m)
#pragma unroll
                for (int n = 0; n < 2; ++n) acc[a][b][m][n] = (f32x4){0.f, 0.f, 0.f, 0.f};
    bf16x8 At[4][2], B0[2][2], B1[2][2];
    const int nt = K / 64;
    STAGE_B(tid, SB(0, 0), 0, 0); STAGE_A(tid, SA(0, 0), 0, 0);
    STAGE_B(tid, SB(0, 1), 1, 0); STAGE_A(tid, SA(0, 1), 1, 0);
    if (wr == 1) BAR;
    WAIT_V(4); BAR;
    STAGE_B(tid, SB(1, 0), 0, 1); STAGE_A(tid, SA(1, 0), 0, 1); STAGE_B(tid, SB(1, 1), 1, 1);
    WAIT_V(6); BAR;
    for (int t = 0; t < nt - 2; t += 2) {
        LDB(B0, 0, 0); SCHED; LDA(At, 0, 0); STAGE_A(tid, SA(1, 1), 1, t + 1);
        WAIT_L(8); BAR; WAIT_L(0); MMA(0, 0, At, B0); BAR; SCHED;
        LDB(B1, 0, 1); STAGE_B(tid, SB(0, 0), 0, t + 2);
        BAR; WAIT_L(0); MMA(0, 1, At, B1); BAR;
        LDA(At, 0, 1); STAGE_A(tid, SA(0, 0), 0, t + 2);
        BAR; WAIT_L(0); MMA(1, 0, At, B0); BAR; SCHED;
        STAGE_B(tid, SB(0, 1), 1, t + 2);
        WAIT_V(6); BAR; MMA(1, 1, At, B1); BAR;
        LDB(B0, 1, 0); SCHED; LDA(At, 1, 0); STAGE_A(tid, SA(0, 1), 1, t + 2);
        WAIT_L(8); BAR; WAIT_L(0); MMA(0, 0, At, B0); BAR; SCHED;
        LDB(B1, 1, 1); STAGE_B(tid, SB(1, 0), 0, t + 3);
        BAR; WAIT_L(0); MMA(0, 1, At, B1); BAR;
        LDA(At, 1, 1); STAGE_A(tid, SA(1, 0), 0, t + 3);
        BAR; WAIT_L(0); MMA(1, 0, At, B0); BAR; SCHED;
        STAGE_B(tid, SB(1, 1), 1, t + 3);
        WAIT_V(6); BAR; MMA(1, 1, At, B1); BAR;
    }
    int tz = tidx();
#ifndef EMU
    asm volatile("" : "+v"(tz));
#endif
    wid = tz >> 6; lane = tz & 63; wr = wid >> 2; wc = wid & 3; fr = lane & 15; fq = lane >> 4;
    { LDB(B0, 0, 0); WAIT_V(0); LDA(At, 0, 0); STAGE_A(tz, SA(1, 1), 1, nt - 1);
      BAR; WAIT_L(0); MMA(0, 0, At, B0); BAR;
      LDB(B1, 0, 1); BAR; WAIT_L(0); MMA(0, 1, At, B1); BAR;
      LDA(At, 0, 1); WAIT_V(4); BAR; WAIT_L(0); MMA(1, 0, At, B0); MMA(1, 1, At, B1); BAR; }
    { LDB(B0, 1, 0); LDA(At, 1, 0); WAIT_V(2); BAR; WAIT_L(0); MMA(0, 0, At, B0); BAR;
      LDB(B1, 1, 1); WAIT_V(0); BAR; WAIT_L(0); MMA(0, 1, At, B1); BAR;
      LDA(At, 1, 1); BAR; WAIT_L(0); MMA(1, 0, At, B0); MMA(1, 1, At, B1); BAR; }
    if (wr == 0) BAR;
#pragma unroll
    for (int ai = 0; ai < 2; ++ai)
#pragma unroll
        for (int m = 0; m < 4; ++m) {
            const int lrow = ai * 128 + wr * 64 + m * 16 + fr; const long orow = ea.orow0 + lrow;
            float wg = 1.0f; if (EPI == 3) wg = ea.wgt[lrow];
            if (EPI == 4) {
                const bool isc = orow >= RL; const int tokn = isc ? 0 : (int)(orow % SEQ);
#pragma unroll
                for (int bj = 0; bj < 2; ++bj) { const int kind = bj ? ea.kind1 : ea.kind0; const float sc = bj ? ea.sc1 : ea.sc0;
                    f32x4 x1 = acc[ai][bj][m][0], x2 = acc[ai][bj][m][1];
                    if (kind != 0) {
                        f32x4 t0 = (f32x4){1.f, 0.f, 1.f, 0.f}, t1 = t0;
                        if (!isc) { const int a0 = (kind == 1 ? 0 : (kind == 2 ? 32 : 48)) + (kind != 2 ? (wc & 1) * 16 : 0) + fq * 4; const float* tp = ea.tab + ((size_t)tokn * 80 + a0) * 2; t0 = *(const f32x4*)tp; t1 = *(const f32x4*)(tp + 4); }
                        const f32x4 cs = (f32x4){t0[0], t0[2], t1[0], t1[2]} * sc, sn = (f32x4){t0[1], t0[3], t1[1], t1[3]} * sc;
                        const f32x4 y1 = x1 * cs - x2 * sn, y2 = x1 * sn + x2 * cs; x1 = y1; x2 = y2;
                    }
                    const int col = bcol + bj * 128 + wc * 32 + fq * 4; bf16_t* op = (bf16_t*)ea.out + (size_t)orow * ea.ld + col;
                    u32x2 o; o[0] = pk2(x1[0], x1[1]); o[1] = pk2(x1[2], x1[3]); *(u32x2*)op = o; o[0] = pk2(x2[0], x2[1]); o[1] = pk2(x2[2], x2[3]); *(u32x2*)(op + 16) = o; }
                continue;
            }
#pragma unroll
            for (int n = 0; n < 2; ++n) {
                if (EPI == 2) { const f32x4 g = acc[ai][0][m][n], u = acc[ai][1][m][n]; const int col = (bcol >> 1) + wc * 32 + n * 16 + fq * 4;
                    u32x2 o; o[0] = pk2(siluf(g[0]) * u[0], siluf(g[1]) * u[1]); o[1] = pk2(siluf(g[2]) * u[2], siluf(g[3]) * u[3]);
                    *(u32x2*)((bf16_t*)ea.out + (size_t)orow * ea.ld + col) = o;
                } else {
#pragma unroll
                    for (int bj = 0; bj < 2; ++bj) { const f32x4 v = acc[ai][bj][m][n]; const int col = bcol + bj * 128 + wc * 32 + n * 16 + fq * 4;
                        if (EPI == 1) *(f32x4*)((float*)ea.out + (size_t)orow * ea.ld + col) = v;
                        else { u32x2 o; o[0] = pk2(v[0] * wg, v[1] * wg); o[1] = pk2(v[2] * wg, v[3] * wg); *(u32x2*)((bf16_t*)ea.out + (size_t)orow * ea.ld + col) = o; } }
                }
            }
        }
    __syncthreads();
#undef SA
#undef SB
#undef STAGE_A
#undef STAGE_B
#undef LDA
#undef LDB
#undef MMA
}

struct GUnit { const char* B; const int* gidx; const float* wgt; long orow0; int brow, bcol, pn; };
DI bool tile_order(int i, int G, int c, int nM, int nN, int& pm, int& pn) {
    const int nwg = nM * nN; const long L = (long)i * G + c; if (L >= nwg) return false;
    int wgid = (int)L; { const int q = nwg / 8, r = nwg % 8, xcd = wgid % 8, off = wgid / 8; wgid = (xcd < r ? xcd * (q + 1) : r * (q + 1) + (xcd - r) * q) + off; }
    const int nig = 8 * nN, gid = wgid / nig, fm = gid * 8, gsz = (nM - fm) < 8 ? (nM - fm) : 8;
    pm = fm + ((wgid % nig) % gsz); pn = (wgid % nig) / gsz; return true;
}
DI int moe_tiles(int layer) { return layer == DEPTH - 1 ? (NB * CAPL + 255) / 256 : ROWS_E / 256; }
template <int PHK> DI bool gemm_next(const WS& w, int layer, int i, int G, int c, GUnit& u) {
    int pm, pn; u.gidx = nullptr; u.wgt = nullptr;
    if (PHK == 0) { if (!tile_order(i, G, c, R / 256, PW / 256, pm, pn)) return false; u.B = (const char*)(w.win + (size_t)layer * PW * 1024 + (size_t)pn * 256 * 1024); u.brow = pm * 256; u.orow0 = (long)pm * 256; }
    else if (PHK == 1) { if (!tile_order(i, G, c, (layer == DEPTH - 1 ? RL : R) / 256, 4, pm, pn)) return false; u.B = (const char*)(w.wout + (size_t)layer * 1024 * 1024 + (size_t)pn * 256 * 1024); u.brow = pm * 256; u.orow0 = (long)pm * 256; }
    else { const int tm = moe_tiles(layer); constexpr int nN = PHK == 2 ? 2 * FF / 256 : 4;
        if (!tile_order(i, G, c, 16 * tm, nN, pm, pn)) return false;
        constexpr int TM_FULL = ROWS_E / 256, TM_LAST = (NB * CAPL + 255) / 256;
        int e, pme; if (layer == DEPTH - 1) { e = pm / TM_LAST; pme = pm % TM_LAST; } else { e = pm / TM_FULL; pme = pm % TM_FULL; }
        u.orow0 = (long)e * ROWS_E + pme * 256; u.brow = e * ROWS_E + pme * 256;
        if (PHK == 2) { u.B = (const char*)(w.wgu + (size_t)(layer * 16 + e) * 2 * FF * 1024 + (size_t)pn * 256 * 1024); }
        else { u.B = (const char*)(w.wdn + (size_t)(layer * 16 + e) * 1024 * FF + (size_t)pn * 256 * FF); u.wgt = w.wgt + (size_t)e * ROWS_E + pme * 256; } }
    u.bcol = pn * 256; u.pn = pn; return true;
}
template <int PHK> DI void gemm_stream(const Params& p, int layer, char* smem) {
    constexpr bool GATHER = false, FP8 = PHK >= 2;       constexpr int K = PHK == 2 ? 1024 : (PHK == 3 ? FF : 2048)  , nt = K / 128;
    const WS w = ws_of(p.ws); bf16_t* shm = (bf16_t*)smem;
    const char* Abase = PHK == 0 ? (const char*)w.u : (PHK == 1 ? (const char*)w.mix : (PHK == 2 ? (const char*)w.xin : (const char*)w.hid));
    const int G = gridDim.x, c = bidx();
    int tid = tidx();
    int wid = tid >> 6, lane = tid & 63, wr = wid >> 2, wc = wid & 3, fr = lane & 15, fq = lane >> 4;
    GUnit cur, nxt;
    if (!gemm_next<PHK>(w, layer, 0, G, c, cur)) return;
    unsigned voff[2];
#pragma unroll
    for (int i = 0; i < 2; ++i) { int R_, C_; stage_rc(tid * 16 + i * 8192, R_, C_); voff[i] = (unsigned)(R_ * K + C_ * 2); }
    u32x4 ga = (u32x4){0u, 0u, 0u, 0u};
    unsigned gc2[2];
#pragma unroll
    for (int i = 0; i < 2; ++i) { int R_, C_; stage_rc(tid * 16 + i * 8192, R_, C_); gc2[i] = (unsigned)C_ * 2u; }
#define G_GOFF(dst, U) do { _Pragma("unroll") for (int h_ = 0; h_ < 2; ++h_) _Pragma("unroll") for (int i_ = 0; i_ < 2; ++i_) { int R_, C_; stage_rc(tid * 16 + i_ * 8192, R_, C_); \
        dst[h_ * 2 + i_] = (unsigned)(U).gidx[h_ * 128 + R_]; } } while (0)
    if (GATHER) G_GOFF(ga, cur);
#ifdef EMU
#define UBASE(p)
#else
#define UBASE(p) asm volatile("" : "+s"(p))
#endif
#define SA(b, h) (shm + ((b) * 2 + (h)) * G_HT)
#define SB(b, h) (shm + (4 + (b) * 2 + (h)) * G_HT)
#define STG_A(P, U, GAo, h, koff) do { _Pragma("unroll") for (int _i = 0; _i < 2; ++_i) { \
        const char* ub_ = GATHER ? Abase + (size_t)(koff) : Abase + ((size_t)((U).brow + (h) * 128) * K + (koff)); UBASE(ub_); GLDS16(ub_ + (GATHER ? (GAo)[(h) * 2 + _i] * (unsigned)K + gc2[_i] : voff[_i]), (char*)(P) + tid * 16 + _i * 8192); } } while (0)
#define STG_B(P, BP, h, koff) do { _Pragma("unroll") for (int _i = 0; _i < 2; ++_i) { const char* ub_ = (BP) + ((size_t)(h) * 128 * K + (koff)); UBASE(ub_); GLDS16(ub_ + voff[_i], (char*)(P) + tid * 16 + _i * 8192); } } while (0)
#define LDA(dst, b, h) _Pragma("unroll") for (int m = 0; m < 4; ++m) { \
        const u32x4 lo_ = *reinterpret_cast<const u32x4*>((char*)SA(b, h) + lds_byte(wr * 64 + m * 16 + fr, fq * 8)), hi_ = *reinterpret_cast<const u32x4*>((char*)SA(b, h) + lds_byte(wr * 64 + m * 16 + fr, 32 + fq * 8)); \
        dst[m] = __builtin_shufflevector(lo_, hi_, 0, 1, 2, 3, 4, 5, 6, 7); }
#define LDB_ROW(n) (wc * 32 + 8 * (fr >> 2) + 4 * (n) + (fr & 3))
#define LDB(dst, b, h) _Pragma("unroll") for (int n = 0; n < 2; ++n) { \
        const u32x4 lo_ = *reinterpret_cast<const u32x4*>((char*)SB(b, h) + lds_byte(LDB_ROW(n), fq * 8)), hi_ = *reinterpret_cast<const u32x4*>((char*)SB(b, h) + lds_byte(LDB_ROW(n), 32 + fq * 8)); \
        dst[n] = __builtin_shufflevector(lo_, hi_, 0, 1, 2, 3, 4, 5, 6, 7); }
#define MMA(ai, bj, At_, Bt_) do { __builtin_amdgcn_s_setprio(1); \
        _Pragma("unroll") for (int m = 0; m < 4; ++m) _Pragma("unroll") for (int n = 0; n < 2; ++n) { \
            if (FP8) acc[ai][bj][m][n] = mfma_fp8(Bt_[n], At_[m], acc[ai][bj][m][n]);     \
            else { acc[ai][bj][m][n] = MFMA16(frag_lo(Bt_[n]), frag_lo(At_[m]), acc[ai][bj][m][n]); acc[ai][bj][m][n] = MFMA16(frag_hi(Bt_[n]), frag_hi(At_[m]), acc[ai][bj][m][n]); } } \
        __builtin_amdgcn_s_setprio(0); } while (0)
#define K_TILE_PAIR(UA2, GA2, B2, k1, k2, k3) do { \
            LDB(B0, 0, 0); SCHED; LDA(At, 0, 0); STG_A(SA(1, 1), cur, ga, 1, k1); \
            WAIT_L(8); BAR; WAIT_L(0); MMA(0, 0, At, B0); BAR; SCHED; \
            LDB(B1, 0, 1); STG_B(SB(0, 0), B2, 0, k2); \
            BAR; WAIT_L(0); MMA(0, 1, At, B1); BAR; \
            LDA(At, 0, 1); STG_A(SA(0, 0), UA2, GA2, 0, k2); \
            BAR; WAIT_L(0); MMA(1, 0, At, B0); BAR; SCHED; \
            STG_B(SB(0, 1), B2, 1, k2); \
            WAIT_V(6); BAR; MMA(1, 1, At, B1); BAR; \
            LDB(B0, 1, 0); SCHED; LDA(At, 1, 0); STG_A(SA(0, 1), UA2, GA2, 1, k2); \
            WAIT_L(8); BAR; WAIT_L(0); MMA(0, 0, At, B0); BAR; SCHED; \
            LDB(B1, 1, 1); STG_B(SB(1, 0), B2, 0, k3); \
            BAR; WAIT_L(0); MMA(0, 1, At, B1); BAR; \
            LDA(At, 1, 1); STG_A(SA(1, 0), UA2, GA2, 0, k3); \
            BAR; WAIT_L(0); MMA(1, 0, At, B0); BAR; SCHED; \
            STG_B(SB(1, 1), B2, 1, k3); \
            WAIT_V(6); BAR; MMA(1, 1, At, B1); BAR; } while (0)
    f32x4 acc[2][2][4][2];
#pragma unroll
    for (int a = 0; a < 2; ++a)
#pragma unroll
        for (int b = 0; b < 2; ++b)
#pragma unroll
            for (int m = 0; m < 4; ++m)
#pragma unroll
                for (int n = 0; n < 2; ++n) acc[a][b][m][n] = (f32x4){0.f, 0.f, 0.f, 0.f};
    u32x8 At[4], B0[2], B1[2];
    __syncthreads();
    STG_B(SB(0, 0), cur.B, 0, 0); STG_A(SA(0, 0), cur, ga, 0, 0); STG_B(SB(0, 1), cur.B, 1, 0); STG_A(SA(0, 1), cur, ga, 1, 0);
    if (wr == 1) BAR;
    WAIT_V(4); BAR;
    STG_B(SB(1, 0), cur.B, 0, 128); STG_A(SA(1, 0), cur, ga, 0, 128); STG_B(SB(1, 1), cur.B, 1, 128);
    WAIT_V(6); BAR;
    for (int ui = 0;; ++ui) {
#pragma unroll
        for (int i = 0; i < 2; ++i) { int R_, C_; stage_rc(tid * 16 + i * 8192, R_, C_); voff[i] = (unsigned)(R_ * K + C_ * 2); gc2[i] = (unsigned)C_ * 2u; }
        const bool has_next = gemm_next<PHK>(w, layer, ui + 1, G, c, nxt);
        if (!has_next) nxt = cur;
        u32x4 gn = ga;
#pragma unroll 1
        for (int t = 0; t < nt; t += 2) {
            const bool lastp = (t == nt - 2);
            if (GATHER && t == (nt >= 4 ? nt - 4 : 0)) G_GOFF(gn, nxt);
#ifndef EMU
            if (GATHER && lastp && nt >= 4) __builtin_amdgcn_s_waitcnt(0x0F7C);
#endif
            GUnit u2 = cur; u32x4 g2 = ga; if (lastp) { u2 = nxt; g2 = gn; }
            const int k2 = lastp ? 0 : (t + 2) * 128;
            K_TILE_PAIR(u2, g2, u2.B, (t + 1) * 128, k2, k2 + 128);
        }
#ifndef EMU
        asm volatile("" : "+v"(tid));
#endif
        wid = tid >> 6; lane = tid & 63; wr = wid >> 2; wc = wid & 3; fr = lane & 15; fq = lane >> 4;
        const int kd = PHK == 0 ? (cur.pn <= 1 ? 1 : ((cur.pn == 4 || cur.pn == 5) ? 2 : ((cur.pn == 11 || cur.pn == 12) ? 3 : 0))) : 0;
        const float qsc = PHK == 0 ? (cur.pn == 0 ? 0.125f : (cur.pn == 4 ? 0.17677669529663687f * LOG2E : (cur.pn == 11 ? 0.125f * LOG2E : 1.0f))) : 1.0f;
#pragma unroll
        for (int ai = 0; ai < 2; ++ai) {
            f32x4 rt0[4], rt1[4];
            if (PHK == 0 && kd != 0) {
#pragma unroll
                for (int m = 0; m < 4; ++m) { const long orow = cur.orow0 + ai * 128 + wr * 64 + m * 16 + fr; const bool isc = orow >= RL; const int tokn = isc ? 0 : (int)(orow % SEQ);
                    const int a0 = (kd == 1 ? 0 : (kd == 2 ? 32 : 48)) + (kd != 2 ? (wc & 1) * 16 : 0) + fq * 4; const float* tp = w.tab + ((size_t)tokn * 80 + a0) * 2;
                    rt0[m] = *(const f32x4*)tp; rt1[m] = *(const f32x4*)(tp + 4); }
            }
#pragma unroll
            for (int m = 0; m < 4; ++m) {
                const int lrow = ai * 128 + wr * 64 + m * 16 + fr; const long orow = cur.orow0 + lrow;
                if (PHK == 0) {
                    const bool isc = orow >= RL; const int tokn = isc ? 0 : (int)(orow % SEQ);
                    f32x4 cs = (f32x4){qsc, qsc, qsc, qsc}, sn = (f32x4){0.f, 0.f, 0.f, 0.f};
                    if (kd != 0 && !isc) {
                        const f32x4 t0 = rt0[m], t1 = rt1[m]; cs = (f32x4){t0[0], t0[2], t1[0], t1[2]} * qsc; sn = (f32x4){t0[1], t0[3], t1[1], t1[3]} * qsc; }
#pragma unroll
                    for (int bj = 0; bj < 2; ++bj) { const int kind = (cur.pn == 12 && bj == 1) ? 0 : kd;
                        f32x4 x1 = acc[ai][bj][m][0], x2 = acc[ai][bj][m][1];
                        if (kind != 0) { const f32x4 y1 = x1 * cs - x2 * sn, y2 = x1 * sn + x2 * cs; x1 = y1; x2 = y2; }
                        u32x4 o; o[0] = pk2(x1[0], x1[1]); o[1] = pk2(x1[2], x1[3]); o[2] = pk2(x2[0], x2[1]); o[3] = pk2(x2[2], x2[3]);
                        *(u32x4*)(w.p + (size_t)orow * PW + cur.bcol + bj * 128 + wc * 32 + fq * 8) = o; }
                } else if (PHK == 2) {
                    const f32x4 g0 = acc[ai][0][m][0] * (1.0f / SW1), u0 = acc[ai][1][m][0] * (SH / SW1), g1 = acc[ai][0][m][1] * (1.0f / SW1), u1 = acc[ai][1][m][1] * (SH / SW1);
                    u32x2 o; o[0] = pk4_fp8(siluf(g0[0]) * u0[0], siluf(g0[1]) * u0[1], siluf(g0[2]) * u0[2], siluf(g0[3]) * u0[3]); o[1] = pk4_fp8(siluf(g1[0]) * u1[0], siluf(g1[1]) * u1[1], siluf(g1[2]) * u1[2], siluf(g1[3]) * u1[3]);
                    *(u32x2*)(w.hid + (size_t)orow * FF + (cur.bcol >> 1) + wc * 32 + fq * 8) = o;
                } else {
                    float wg = 1.0f; if (PHK == 3) wg = cur.wgt[lrow] * (1.0f / (SH * SW2));
#pragma unroll
                    for (int bj = 0; bj < 2; ++bj) { const f32x4 v0 = acc[ai][bj][m][0], v1 = acc[ai][bj][m][1];
                        u32x4 o; o[0] = pk2(v0[0] * wg, v0[1] * wg); o[1] = pk2(v0[2] * wg, v0[3] * wg); o[2] = pk2(v1[0] * wg, v1[1] * wg); o[3] = pk2(v1[2] * wg, v1[3] * wg);
                        *(u32x4*)((PHK == 1 ? w.mixo : w.y) + (size_t)orow * 1024 + cur.bcol + bj * 128 + wc * 32 + fq * 8) = o; }
                }
            }
        }
        if (!has_next) break;
#pragma unroll
        for (int a = 0; a < 2; ++a)
#pragma unroll
            for (int b = 0; b < 2; ++b)
#pragma unroll
                for (int m = 0; m < 4; ++m)
#pragma unroll
                    for (int n = 0; n < 2; ++n) acc[a][b][m][n] = (f32x4){0.f, 0.f, 0.f, 0.f};
        cur = nxt;
        ga = gn;
#ifndef EMU
        asm volatile("" : "+v"(tid));
#endif
        wid = tid >> 6; lane = tid & 63; wr = wid >> 2; wc = wid & 3; fr = lane & 15; fq = lane >> 4;
    }
    WAIT_V(0);
    if (wr == 0) BAR;
    BAR;
    __syncthreads();
#undef G_GOFF
#undef K_TILE_PAIR
#undef UBASE
#undef SA
#undef SB
#undef STG_A
#undef STG_B
#undef LDA
#undef LDB
#undef LDB_ROW
#undef MMA
}
DI void cvt_tail_a(const Params& p, int layer, char* smem);
DI void phase_inproj(const Params& p, int layer, char* smem) { gemm_stream<0>(p, layer, smem); cvt_tail_a(p, layer, smem); }
DI void cvt_tail_b(const Params& p, int layer, char* smem) {
    const int G = gridDim.x, rem = (((layer == DEPTH - 1 ? RL : R) / 256) * 4) % G, c = bidx(); if (c < rem) return;
    cvt_stream<1>(p, ws_of(p.ws), smem, layer, c - rem, G - rem);
}
DI void cvt_tail_a(const Params& p, int layer, char* smem) {
    const int G = gridDim.x, rem = ((R / 256) * (PW / 256)) % G, c = bidx(); if (c < rem) return;
    cvt_stream<3>(p, ws_of(p.ws), smem, layer, c - rem, G - rem);
}
DI void cvt_tail_d(const Params& p, int layer, char* smem) {
    if (layer + 1 >= DEPTH) return;
    const int G = gridDim.x, rem = (16 * (ROWS_E / 256) * 4) % G, c = bidx(); if (c < rem) return;
    cvt_stream<2>(p, ws_of(p.ws), smem, layer, c - rem, G - rem);
}
DI void phase_outproj(const Params& p, int layer, char* smem) { gemm_stream<1>(p, layer, smem); cvt_tail_b(p, layer, smem); }
DI void phase_moe1(const Params& p, int layer, char* smem) { gemm_stream<2>(p, layer, smem); }
DI void phase_moe2(const Params& p, int layer, char* smem) { gemm_stream<3>(p, layer, smem); cvt_tail_d(p, layer, smem); }

DI void phase_prep(const Params& p, int layer, char* smem) {
    const WS w = ws_of(p.ws); const int lane = tidx() & 63, wv = tidx() >> 6;
    for (int row = bidx() * 8 + wv; row < R; row += gridDim.x * 8) {
        const bool isc = row >= RL; const int n = isc ? 0 : row % SEQ; bf16_t* pr = w.p + (size_t)row * PW;
        for (int idx = lane; idx < 704; idx += 64) {
            int c1, dd, a; float sc;
            if (idx < 128) { const int h = idx >> 5, i = idx & 31; c1 = C_RQ + h * 64 + i; dd = 32; a = i; sc = 0.125f; }
            else if (idx < 256) { const int j = idx - 128, h = j >> 5, i = j & 31; c1 = C_RK + h * 64 + i; dd = 32; a = i; sc = 1.0f; }
            else if (idx < 384) { const int j = idx - 256, hc = j >> 4, i = j & 15; c1 = C_DQ + hc * 32 + i; dd = 16; a = 32 + i; sc = 0.17677669529663687f * LOG2E; }
            else if (idx < 512) { const int j = idx - 384, hc = j >> 4, i = j & 15; c1 = C_DK + hc * 32 + i; dd = 16; a = 32 + i; sc = 1.0f; }
            else if (idx < 640) { const int j = idx - 512, h = j >> 5, i = j & 31; c1 = C_SQ + h * 64 + i; dd = 32; a = 48 + i; sc = 0.125f * LOG2E; }
            else { const int j = idx - 640, h = j >> 5, i = j & 31; c1 = C_SK + h * 64 + i; dd = 32; a = 48 + i; sc = 1.0f; }
            float cs = 1.0f, sn = 0.0f; if (!isc) { cs = w.tab[((size_t)n * 80 + a) * 2]; sn = w.tab[((size_t)n * 80 + a) * 2 + 1]; }
            const float x1 = bf2f(pr[c1]), x2 = bf2f(pr[c1 + dd]);
            pr[c1] = f2bf((x1 * cs - x2 * sn) * sc); pr[c1 + dd] = f2bf((x1 * sn + x2 * cs) * sc);
        }
    }
}

constexpr int A_KS = 72;
constexpr int A_TILE = 64 * A_KS;
constexpr float A_THR = 6.0f;
template <int NC>
DI void attn_unit(const bf16_t* __restrict__ P, const int qrow0, const int qcol, const int kcol, const int vcol,
                  const int r1, const int n1, const int kp1, const bool mask1, const int r2, const int n2, const int qpos0,
                  const float m_init, const float l_init, const float lam, const float fin_scale, const float* __restrict__ norm_g,
                  bf16_t* __restrict__ outp  , char* smem) {
    bf16_t* Kb = (bf16_t*)smem; bf16_t* Vb = Kb + 2 * A_TILE;
    const int tid = tidx(), lane = tid & 63, wv = tid >> 6, fr = lane & 15, fq = lane >> 4;
    bf16x8 qf[2][2];
#pragma unroll
    for (int g = 0; g < 2; ++g)
#pragma unroll
        for (int i = 0; i < 2; ++i) qf[g][i] = *(const bf16x8*)(P + (size_t)(qrow0 + g * 128 + wv * 16 + fr) * PW + qcol + i * 32 + fq * 8);
    f32x4 o[2][NC][4], ol[2][NC], negm[2][NC]; float mrun[2][NC];
    const int T = n1 + n2, skey = tid >> 3, sc8 = tid & 7;
    const int soff = skey * A_KS + sc8 * 8;
    const int voff = (fq * 4 + (fr >> 2)) * A_KS + (fr & 3) * 4;
    u32x4 kr0, vr0, kr1, vr1;
#define A_LOAD(TN, KR, VR) do { const int tn_ = (TN); const int krow_ = (tn_ < n1) ? r1 + tn_ * 64 : r2 + (tn_ - n1) * 64; const bf16_t* src_ = P + (size_t)(krow_ + skey) * PW; \
        KR = *(const u32x4*)(src_ + kcol + sc8 * 8); VR = *(const u32x4*)(src_ + vcol + sc8 * 8); } while (0)
    A_LOAD(0, kr0, vr0);
    *(u32x4*)(Kb + soff) = kr0; *(u32x4*)(Vb + soff) = vr0;
    if (1 < T) A_LOAD(1, kr1, vr1);
    const int qposb = qpos0 + wv * 16 + fr;
    LDS_BARRIER();
    {
#pragma unroll
        for (int g = 0; g < 2; ++g)
#pragma unroll
            for (int c = 0; c < NC; ++c) { float mx = -INFINITY;
#pragma unroll
                for (int kt = 0; kt < 4; ++kt) {
                    const bf16x8 k0 = *(const bf16x8*)(Kb + (kt * 16 + fr) * A_KS + fq * 8), k1 = *(const bf16x8*)(Kb + (kt * 16 + fr) * A_KS + 32 + fq * 8);
                    const f32x4 z = (f32x4){0.f, 0.f, 0.f, 0.f};
                    f32x4 sv; if (NC == 2) sv = c == 0 ? MFMA16(k0, qf[g][0], z) : MFMA16(k1, qf[g][1], z); else sv = MFMA16(k1, qf[g][1], MFMA16(k0, qf[g][0], z));
#pragma unroll
                    for (int j = 0; j < 4; ++j) { const int dlt = qposb + g * 128 - (kp1 + kt * 16 + fq * 4 + j); if (!(mask1 && n1 > 0 && (dlt > 128 || dlt < -128))) mx = fmaxf(mx, sv[j]); } }
                mx = grp_max(mx); mrun[g][c] = fmaxf(m_init, mx); const float l0 = l_init * ex2(m_init - mrun[g][c]);
                negm[g][c] = (f32x4){-mrun[g][c], -mrun[g][c], -mrun[g][c], -mrun[g][c]}; ol[g][c] = (f32x4){l0, l0, l0, l0};
#pragma unroll
                for (int d = 0; d < 4; ++d) o[g][c][d] = (f32x4){0.f, 0.f, 0.f, 0.f}; }
    }
    bf16x8 onesf; { const u32x4 ov = (u32x4){0x3F803F80u, 0x3F803F80u, 0x3F803F80u, 0x3F803F80u}; onesf = __builtin_bit_cast(bf16x8, ov); }
    auto tile_step = [&](const int t, u32x4& kl, u32x4& vl, const u32x4& kw, const u32x4& vw) {
        LDS_BARRIER();
        const bf16_t* Kt = Kb + (t & 1) * A_TILE; const bf16_t* Vt = Vb + (t & 1) * A_TILE;
        A_LOAD((t + 2 < T ? t + 2 : T - 1), kl, vl);
        const bool msk = mask1 && (t < n1); const int kpos_t = kp1 + t * 64;
        bf16x8 kf[4][2], vf[2][4];
#pragma unroll
        for (int kt = 0; kt < 4; ++kt) { kf[kt][0] = *(const bf16x8*)(Kt + (kt * 16 + fr) * A_KS + fq * 8); kf[kt][1] = *(const bf16x8*)(Kt + (kt * 16 + fr) * A_KS + 32 + fq * 8); }
#pragma unroll
        for (int k2 = 0; k2 < 2; ++k2)
#pragma unroll
            for (int d = 0; d < 4; ++d) { const s16x4 a = lds_tr16(Vt + voff + (2 * k2) * 16 * A_KS + d * 16), b = lds_tr16(Vt + voff + (2 * k2 + 1) * 16 * A_KS + d * 16);
                vf[k2][d] = __builtin_shufflevector(a, b, 0, 1, 2, 3, 4, 5, 6, 7); }
#pragma unroll
        for (int g = 0; g < 2; ++g)
#pragma unroll
            for (int c = 0; c < NC; ++c) {
                f32x4 s[4];
#pragma unroll
                for (int kt = 0; kt < 4; ++kt) { if (NC == 2) s[kt] = MFMA16(kf[kt][c], qf[g][c], negm[g][c]); else s[kt] = MFMA16(kf[kt][1], qf[g][1], MFMA16(kf[kt][0], qf[g][0], negm[g][0])); }
                if (msk) { const int qpos = qposb + g * 128;
#pragma unroll
                    for (int kt = 0; kt < 4; ++kt)
#pragma unroll
                        for (int j = 0; j < 4; ++j) { const int dlt = qpos - (kpos_t + kt * 16 + fq * 4 + j); if (dlt > 128 || dlt < -128) s[kt][j] = -INFINITY; } }
                int im = max(max(__float_as_int(s[0][0]), __float_as_int(s[0][1])), max(__float_as_int(s[0][2]), __float_as_int(s[0][3])));
#pragma unroll
                for (int kt = 1; kt < 4; ++kt) im = max(max(im, __float_as_int(s[kt][0])), max(max(__float_as_int(s[kt][1]), __float_as_int(s[kt][2])), __float_as_int(s[kt][3])));
                const float tm = __int_as_float(grp_imax(im));
                if (__any(tm > A_THR)) {
                    const float delta = fmaxf(tm, 0.f), alpha = ex2(-delta); mrun[g][c] += delta; negm[g][c] = (f32x4){-mrun[g][c], -mrun[g][c], -mrun[g][c], -mrun[g][c]}; ol[g][c] *= alpha;
#pragma unroll
                    for (int d = 0; d < 4; ++d) o[g][c][d] *= alpha;
#pragma unroll
                    for (int kt = 0; kt < 4; ++kt) s[kt] = s[kt] - delta;
                }
#pragma unroll
                for (int kt = 0; kt < 4; ++kt)
#pragma unroll
                    for (int j = 0; j < 4; ++j) s[kt][j] = ex2(s[kt][j]);
#pragma unroll
                for (int k2 = 0; k2 < 2; ++k2) {
                    u32x4 pp; pp[0] = pk2(s[2 * k2][0], s[2 * k2][1]); pp[1] = pk2(s[2 * k2][2], s[2 * k2][3]); pp[2] = pk2(s[2 * k2 + 1][0], s[2 * k2 + 1][1]); pp[3] = pk2(s[2 * k2 + 1][2], s[2 * k2 + 1][3]);
                    const bf16x8 pb = __builtin_bit_cast(bf16x8, pp);
#pragma unroll
                    for (int d = 0; d < 4; ++d) o[g][c][d] = MFMA16(vf[k2][d], pb, o[g][c][d]);
                    ol[g][c] = MFMA16(onesf, pb, ol[g][c]);
                }
            }
        { bf16_t* Kn = Kb + ((t + 1) & 1) * A_TILE + soff; bf16_t* Vn = Vb + ((t + 1) & 1) * A_TILE + soff;
            *(u32x4*)Kn = kw; *(u32x4*)Vn = vw; }
    };
#ifndef EMU
    __builtin_amdgcn_s_waitcnt(0x0F70);
#endif
    for (int t = 0; t < T; t += 2) { tile_step(t, kr0, vr0, kr1, vr1); if (t + 1 < T) tile_step(t + 1, kr1, vr1, kr0, vr0); }
#undef A_LOAD
#pragma unroll
    for (int g = 0; g < 2; ++g) {
        float linv[NC];
#pragma unroll
        for (int c = 0; c < NC; ++c) linv[c] = 1.0f / ol[g][c][0];
        f32x4 val[4]; float ss = 0.f;
#pragma unroll
        for (int d = 0; d < 4; ++d) {
            if (NC == 2) val[d] = o[g][0][d] * linv[0] - lam * (o[g][NC - 1][d] * linv[NC - 1]); else val[d] = o[g][0][d] * linv[0];
            ss += val[d][0] * val[d][0] + val[d][1] * val[d][1] + val[d][2] * val[d][2] + val[d][3] * val[d][3];
        }
        float rs = 1.0f;
        if (NC == 2) { ss = grp_sum(ss); rs = fin_scale / sqrtf(ss * (1.0f / 64.0f) + 1e-6f); }
        bf16_t* orow = outp + (size_t)(g * 128 + wv * 16 + fr) * 1024;
#pragma unroll
        for (int d = 0; d < 4; ++d) { f32x4 v = val[d] * rs; if (NC == 2) v = v * *(const f32x4*)(norm_g + d * 16 + fq * 4);
            u32x2 ov; ov[0] = pk2(v[0], v[1]); ov[1] = pk2(v[2], v[3]); *(u32x2*)(orow + d * 16 + fq * 4) = ov; }
    }
    __syncthreads();
}

DI void ret_kv_unit(const Params& p, const WS& w, int layer, int b, int h, int ci, char* smem) {
    bf16_t* Kr = (bf16_t*)smem; bf16_t* V0 = Kr + 128 * 72; bf16_t* V1 = V0 + 128 * 72;
    const int tid = tidx(), lane = tid & 63, wv = tid >> 6, fr = lane & 15, fq = lane >> 4; const bool isc = ci < NCC; const int row0 = isc ? RL + b * CTX + ci * 128 : b * SEQ + (ci - NCC) * 128;
    const float lg0 = -softplusf_(-p.ret_decay[(layer * 2 + 0) * 4 + h]) * LOG2E, lg1 = -softplusf_(-p.ret_decay[(layer * 2 + 1) * 4 + h]) * LOG2E;
    __syncthreads();
    for (int i = tid; i < 128 * 8; i += NT) { const int j = i >> 3, c8 = i & 7; const bf16_t* src = w.p + (size_t)(row0 + j) * PW + h * 64 + c8 * 8;
        *(u32x4*)(Kr + j * 72 + c8 * 8) = *(const u32x4*)(src + C_RK); const u32x4 vv = *(const u32x4*)(src + C_RV);
        const float d0 = ex2(lg0 * (float)(127 - j)), d1 = ex2(lg1 * (float)j); u32x4 a, c;
#pragma unroll
        for (int q = 0; q < 4; ++q) { const float lo = __uint_as_float(vv[q] << 16), hi = __uint_as_float(vv[q] & 0xffff0000u); a[q] = pk2(lo * d0, hi * d0); c[q] = pk2(lo * d1, hi * d1); }
        *(u32x4*)(V0 + j * 72 + c8 * 8) = a; *(u32x4*)(V1 + j * 72 + c8 * 8) = c; }
    __syncthreads();
    const int dir = wv >> 2, et = wv & 3; const bf16_t* Vd = dir ? V1 : V0; const int toff = (fq * 8 + (fr >> 2)) * 72 + (fr & 3) * 4;
    f32x4 acc[4];
#pragma unroll
    for (int n = 0; n < 4; ++n) acc[n] = (f32x4){0.f, 0.f, 0.f, 0.f};
#pragma unroll
    for (int ks = 0; ks < 4; ++ks) {
        const s16x4 va = lds_tr16(Vd + toff + (ks * 32) * 72 + et * 16), vb = lds_tr16(Vd + toff + (ks * 32 + 4) * 72 + et * 16); const bf16x8 vfr = __builtin_shufflevector(va, vb, 0, 1, 2, 3, 4, 5, 6, 7);
#pragma unroll
        for (int n = 0; n < 4; ++n) { const s16x4 ka = lds_tr16(Kr + toff + (ks * 32) * 72 + n * 16), kb = lds_tr16(Kr + toff + (ks * 32 + 4) * 72 + n * 16);
            acc[n] = MFMA16(vfr, __builtin_shufflevector(ka, kb, 0, 1, 2, 3, 4, 5, 6, 7), acc[n]); }
    }
    float* ob = w.rkv + ((size_t)((b * 4 + h) * 2 + dir) * NCHR + ci) * 4096;
#pragma unroll
    for (int n = 0; n < 4; ++n) *(f32x4*)(ob + (n * 16 + fr) * 64 + et * 16 + fq * 4) = acc[n];
}
DI void ret_scan(const Params& p, const WS& w, int layer) {
    for (int i = bidx() * NT + tidx(); i < NB * 4 * 2 * 4096; i += gridDim.x * NT) {
        const int chain = i >> 12, el = i & 4095, d = chain & 1, h = (chain >> 1) & 3;
        const float x = p.ret_decay[(layer * 2 + d) * 4 + h]; const float cd = ex2(-softplusf_(-x) * LOG2E * 128.0f);
        float kv[NCHR];
#pragma unroll
        for (int st = 0; st < NCHR; ++st) { const int ci = d == 0 ? st : (st < NCC ? NCC - 1 - st : NCC + (NLC - 1 - (st - NCC))); kv[st] = w.rkv[((size_t)chain * NCHR + ci) * 4096 + el]; }
        float s = 0.f;
#pragma unroll
        for (int st = 0; st < NCHR; ++st) { const int ci = d == 0 ? st : (st < NCC ? NCC - 1 - st : NCC + (NLC - 1 - (st - NCC))); w.rs[((size_t)chain * NCHR + ci) * 4096 + el] = s; s = s * cd + kv[st]; }
    }
}
constexpr int RO_KS = 72, RO_VS = 136;
DI void ret_out_unit(const Params& p, const WS& w, int layer, int b, int h, int ci, char* smem) {
    bf16_t* Ks = (bf16_t*)smem; bf16_t* Vr = Ks + 128 * RO_KS; bf16_t* Sr = Vr + 128 * RO_KS;
    const int tid = tidx(), lane = tid & 63, wv = tid >> 6, fr = lane & 15, fq = lane >> 4;
    const bool isc = ci < NCC; const int row0 = isc ? RL + b * CTX + ci * 128 : b * SEQ + (ci - NCC) * 128;
    __syncthreads();
    for (int i = tid; i < 128 * 8; i += NT) { const int j = i >> 3, c8 = i & 7; const bf16_t* src = w.p + (size_t)(row0 + j) * PW + h * 64 + c8 * 8;
        *(u32x4*)(Ks + j * RO_KS + c8 * 8) = *(const u32x4*)(src + C_RK); *(u32x4*)(Vr + j * RO_KS + c8 * 8) = *(const u32x4*)(src + C_RV); }
    for (int i = tid; i < 2 * 64 * 8; i += NT) { const int d = i >> 9, dk = (i >> 3) & 63, e8 = i & 7; const float* src = w.rs + ((size_t)((b * 4 + h) * 2 + d) * NCHR + ci) * 4096 + dk * 64 + e8 * 8;
        const f32x4 x0 = *(const f32x4*)src, x1 = *(const f32x4*)(src + 4); u32x4 o; o[0] = pk2(x0[0], x0[1]); o[1] = pk2(x0[2], x0[3]); o[2] = pk2(x1[0], x1[1]); o[3] = pk2(x1[2], x1[3]);
        *(u32x4*)(Sr + (d * 64 + dk) * RO_KS + e8 * 8) = o; }
    __syncthreads();
    const float lg0 = -softplusf_(-p.ret_decay[(layer * 2 + 0) * 4 + h]) * LOG2E, lg1 = -softplusf_(-p.ret_decay[(layer * 2 + 1) * 4 + h]) * LOG2E;
    const int qi = wv * 16 + fr;
    const int voff = (fq * 4 + (fr >> 2)) * RO_KS + (fr & 3) * 4;
    const int soffs = (fq * 8 + (fr >> 2)) * RO_KS + (fr & 3) * 4;
    bf16x8 qf[2];
#pragma unroll
    for (int i = 0; i < 2; ++i) qf[i] = *(const bf16x8*)(w.p + (size_t)(row0 + qi) * PW + C_RQ + h * 64 + i * 32 + fq * 8);
    f32x4 o[4], t0[4], t1[4];
#pragma unroll
    for (int d = 0; d < 4; ++d) { o[d] = (f32x4){0.f, 0.f, 0.f, 0.f}; t0[d] = o[d]; t1[d] = o[d]; }
#pragma unroll
    for (int k2 = 0; k2 < 4; ++k2) {
        f32x4 s[2];
#pragma unroll
        for (int q = 0; q < 2; ++q) { const int kt = 2 * k2 + q;
            const bf16x8 k0 = *(const bf16x8*)(Ks + (kt * 16 + fr) * RO_KS + fq * 8), k1 = *(const bf16x8*)(Ks + (kt * 16 + fr) * RO_KS + 32 + fq * 8);
            s[q] = MFMA16(k1, qf[1], MFMA16(k0, qf[0], (f32x4){0.f, 0.f, 0.f, 0.f}));
#pragma unroll
            for (int j = 0; j < 4; ++j) { const int kj = kt * 16 + fq * 4 + j, dl = qi - kj; const float dm = dl > 0 ? ex2(lg0 * (float)dl) : (dl < 0 ? ex2(lg1 * (float)(-dl)) : 2.0f); s[q][j] *= dm; } }
        u32x4 pp; pp[0] = pk2(s[0][0], s[0][1]); pp[1] = pk2(s[0][2], s[0][3]); pp[2] = pk2(s[1][0], s[1][1]); pp[3] = pk2(s[1][2], s[1][3]);
        const bf16x8 pb = __builtin_bit_cast(bf16x8, pp);
#pragma unroll
        for (int d = 0; d < 4; ++d) { const s16x4 v0 = lds_tr16(Vr + voff + (2 * k2) * 16 * RO_KS + d * 16), v1 = lds_tr16(Vr + voff + (2 * k2 + 1) * 16 * RO_KS + d * 16);
            o[d] = MFMA16(__builtin_shufflevector(v0, v1, 0, 1, 2, 3, 4, 5, 6, 7), pb, o[d]); }
    }
#pragma unroll
    for (int d = 0; d < 4; ++d)
#pragma unroll
        for (int ks = 0; ks < 2; ++ks) {
            const s16x4 a0 = lds_tr16(Sr + soffs + (ks * 32) * RO_KS + d * 16), a1 = lds_tr16(Sr + soffs + (ks * 32 + 4) * RO_KS + d * 16);
            const s16x4 b0 = lds_tr16(Sr + soffs + (64 + ks * 32) * RO_KS + d * 16), b1 = lds_tr16(Sr + soffs + (64 + ks * 32 + 4) * RO_KS + d * 16);
            t0[d] = MFMA16(__builtin_shufflevector(a0, a1, 0, 1, 2, 3, 4, 5, 6, 7), qf[ks], t0[d]); t1[d] = MFMA16(__builtin_shufflevector(b0, b1, 0, 1, 2, 3, 4, 5, 6, 7), qf[ks], t1[d]); }
    const float qd0 = ex2(lg0 * (float)(qi + 1)), qd1 = ex2(lg1 * (float)(128 - qi));
    float ss = 0.f;
#pragma unroll
    for (int d = 0; d < 4; ++d) { o[d] = o[d] + qd0 * t0[d] + qd1 * t1[d]; ss += o[d][0] * o[d][0] + o[d][1] * o[d][1] + o[d][2] * o[d][2] + o[d][3] * o[d][3]; }
    ss = grp_sum(ss);
    const float rs = 1.0f / sqrtf(ss * (1.0f / 64.0f) + 1e-6f);
    const bf16_t* gp = w.p + (size_t)(row0 + qi) * PW + C_RG + h * 64; bf16_t* op = w.mix + (size_t)(row0 + qi) * 1024 + h * 64;
#pragma unroll
    for (int d = 0; d < 4; ++d) { const u32x2 gv = *(const u32x2*)(gp + d * 16 + fq * 4);
        const float g0 = __uint_as_float(gv[0] << 16), g1 = __uint_as_float(gv[0] & 0xffff0000u), g2 = __uint_as_float(gv[1] << 16), g3 = __uint_as_float(gv[1] & 0xffff0000u);
        u32x2 ov; ov[0] = pk2(o[d][0] * rs * siluf(g0), o[d][1] * rs * siluf(g1)); ov[1] = pk2(o[d][2] * rs * siluf(g2), o[d][3] * rs * siluf(g3)); *(u32x2*)(op + d * 16 + fq * 4) = ov; }
}

constexpr int GS = 68, GNA = 72, GDI = 24;
DI bf16x8 pack8f(const float* p) {
    const f32x4 a = *(const f32x4*)p, b = *(const f32x4*)(p + 4); u32x4 r; r[0] = pk2(a[0], a[1]); r[1] = pk2(a[2], a[3]); r[2] = pk2(b[0], b[1]); r[3] = pk2(b[2], b[3]); return __builtin_bit_cast(bf16x8, r);
}
DI void gdn_prep_unit(const Params& p, const WS& w, int layer, int b, int h, int cg, char* smem) {
    float* Qs = (float*)smem; float* Ks = Qs + 64 * GS; float* Vs = Ks + 64 * GS; float* Raw = Vs + 64 * GS;
    float* KK = Raw; float* QK = KK + 64 * GS; float* gt = Raw + 66 * 192;
    bf16_t* NA = (bf16_t*)(gt + 384); bf16_t* DIm = NA + 2 * 64 * GNA;
    const int tid = tidx(), lane = tid & 63, wv = tid >> 6, fr = lane & 15, fq = lane >> 4;
    const bool isc = cg < NCG; const int nseq = isc ? CTX : SEQ, t0 = (isc ? cg : cg - NCG) * 64, base = isc ? RL + b * CTX : b * SEQ;
    __syncthreads();
    for (int i = tid; i < 66 * 24; i += NT) { const int tt = i / 24, c8 = i % 24, part = c8 >> 3, tok = t0 - 1 + tt; u32x4 v = (u32x4){0u, 0u, 0u, 0u};
        if (tok >= 0 && tok < nseq) v = *(const u32x4*)(w.p + (size_t)(base + tok) * PW + C_GQKV + part * 256 + h * 64 + (c8 & 7) * 8);
#pragma unroll
        for (int q = 0; q < 4; ++q) { Raw[tt * 192 + c8 * 8 + 2 * q] = __uint_as_float(v[q] << 16); Raw[tt * 192 + c8 * 8 + 2 * q + 1] = __uint_as_float(v[q] & 0xffff0000u); } }
    if (tid < 128) { const int dr = tid >> 6, s = tid & 63; const float* ga = w.gab + (size_t)(base + t0 + s) * 16;
        gt[dr * 64 + s] = -__expf(p.gdn_a_log[(layer * 2 + dr) * 4 + h]) * softplusf_(ga[dr * 4 + h] + p.gdn_dt_bias[(layer * 2 + dr) * 4 + h]);
        gt[128 + dr * 64 + s] = sigmoidf_(ga[8 + dr * 4 + h]); }
    __syncthreads();
    if (tid < 384) {
        const int ch = tid % 192, half = tid / 192, part = ch >> 6, d = ch & 63, chg = part * 256 + h * 64 + d; const float* cw = p.gdn_conv + (size_t)layer * 3 * 768 + chg;
        const float w0 = cw[0], w1 = cw[768], w2 = cw[1536]; float* dst = (part == 0 ? Qs : (part == 1 ? Ks : Vs)) + d;
        float x0 = Raw[(half * 32) * 192 + ch], x1 = Raw[(half * 32 + 1) * 192 + ch];
#pragma unroll 8
        for (int s = half * 32; s < half * 32 + 32; ++s) { const float x2 = Raw[(s + 2) * 192 + ch]; dst[s * GS] = siluf(w0 * x0 + w1 * x1 + w2 * x2); x0 = x1; x1 = x2; }
    } else if (tid >= 384 && tid < 512) {
        const int dr = (tid - 384) >> 6, sl = tid & 63; float a = gt[dr * 64 + (dr ? 63 - sl : sl)];
#pragma unroll
        for (int dd = 1; dd < 64; dd <<= 1) { const float o = lane_shfl_f(a, sl >= dd ? sl - dd : sl); if (sl >= dd) a += o; }
        gt[256 + dr * 64 + sl] = a; }
    __syncthreads();
#pragma unroll
    for (int pass = 0; pass < 2; ++pass) {
        float* rowp = (pass == 0 ? Qs : Ks) + (tid >> 3) * GS + (tid & 7) * 8; f32x4 x0 = *(const f32x4*)rowp, x1 = *(const f32x4*)(rowp + 4);
        float ss = x0[0] * x0[0] + x0[1] * x0[1] + x0[2] * x0[2] + x0[3] * x0[3] + x1[0] * x1[0] + x1[1] * x1[1] + x1[2] * x1[2] + x1[3] * x1[3];
        ss = sum8(ss); const float rs = (1.0f / sqrtf(ss + 1e-6f)) * (pass == 0 ? 0.125f : 1.0f);
        *(f32x4*)rowp = x0 * rs; *(f32x4*)(rowp + 4) = x1 * rs; }
    __syncthreads();
#pragma unroll
    for (int tt = 0; tt < 4; ++tt) { const int t = wv * 4 + tt, which = t >> 4, mt = (t >> 2) & 3, nt = t & 3; const float* Am = which ? Qs : Ks;
        f32x4 d = (f32x4){0.f, 0.f, 0.f, 0.f};
#pragma unroll
        for (int ks = 0; ks < 2; ++ks) d = MFMA16(pack8f(Am + (mt * 16 + fr) * GS + ks * 32 + fq * 8), pack8f(Ks + (nt * 16 + fr) * GS + ks * 32 + fq * 8), d);
        float* G = which ? QK : KK;
#pragma unroll
        for (int jj = 0; jj < 4; ++jj) G[(mt * 16 + fq * 4 + jj) * GS + nt * 16 + fr] = d[jj]; }
    __syncthreads();
    for (int i = tid; i < 2 * 4096; i += NT) { const int dr = i >> 12, s = (i >> 6) & 63, s2 = i & 63; float v = 0.f;
        if (s > s2) { const int ts = dr ? 63 - s : s, ts2 = dr ? 63 - s2 : s2; v = -gt[128 + dr * 64 + ts] * KK[ts * GS + ts2] * __expf(gt[256 + dr * 64 + s] - gt[256 + dr * 64 + s2]); }
        NA[(dr * 64 + s) * GNA + s2] = f2bf(v); }
    __syncthreads();
    if (tid < 128) {
        const int dr = tid >> 6, blk = (tid >> 4) & 3, c = tid & 15; const bf16_t* Ab = NA + (dr * 64 + blk * 16) * GNA + blk * 16; float x[16];
#pragma unroll
        for (int r = 0; r < 16; ++r) { float a = (r == c) ? 1.0f : 0.0f;
            const u32x4 lo = *(const u32x4*)(Ab + r * GNA), hi = *(const u32x4*)(Ab + r * GNA + 8);
#pragma unroll
            for (int r2 = 0; r2 < r; ++r2) { const unsigned wd = r2 < 8 ? lo[r2 >> 1] : hi[(r2 - 8) >> 1]; a += __uint_as_float((r2 & 1) ? (wd & 0xffff0000u) : (wd << 16)) * x[r2]; }
            x[r] = a; DIm[((dr * 4 + blk) * 16 + r) * GDI + c] = f2bf(a); }
    }
    __syncthreads();
    const size_t cbase = (size_t)((b * 4 + h) * 2) * NCHG;
#pragma unroll 1
    for (int tk = 0; tk < 2; ++tk) {
        const int task = wv + tk * 8, dr = task >> 3, ntile = task & 7, col = ntile * 16 + fr; const bool isw = ntile >= 4;
        const int sc = dr == 0 ? cg : (cg < NCG ? NCG - 1 - cg : NCG + (NLG - 1 - (cg - NCG))); const size_t ch = cbase + (size_t)dr * NCHG + sc;
        const float* gg = gt + 256 + dr * 64; const float* bt = gt + 128 + dr * 64; const float* Rm = isw ? Ks + (col - 64) : Vs + col;
        u32x2 xb[4];
#pragma unroll
        for (int i = 0; i < 4; ++i) {
            f32x4 acc;
#pragma unroll
            for (int jj = 0; jj < 4; ++jj) { const int sidx = 16 * i + fq * 4 + jj, ts = dr ? 63 - sidx : sidx; float r = bt[ts] * Rm[ts * GS]; if (isw) r *= __expf(gg[sidx]); acc[jj] = r; }
#pragma unroll
            for (int j0 = 0; j0 < i; j0 += 2) {
                const u32x2 a0 = *(const u32x2*)(NA + (dr * 64 + 16 * i + fr) * GNA + 16 * j0 + fq * 4);
                u32x2 a1 = (u32x2){0u, 0u}, b1 = (u32x2){0u, 0u};
                if (j0 + 1 < i) { a1 = *(const u32x2*)(NA + (dr * 64 + 16 * i + fr) * GNA + 16 * (j0 + 1) + fq * 4); b1 = xb[j0 + 1]; }
                u32x4 av; av[0] = a0[0]; av[1] = a0[1]; av[2] = a1[0]; av[3] = a1[1]; u32x4 bv; bv[0] = xb[j0][0]; bv[1] = xb[j0][1]; bv[2] = b1[0]; bv[3] = b1[1];
                acc = MFMA16(__builtin_bit_cast(bf16x8, av), __builtin_bit_cast(bf16x8, bv), acc);
            }
            const u32x2 dd = *(const u32x2*)(DIm + ((dr * 4 + i) * 16 + fr) * GDI + fq * 4);
            u32x4 av; av[0] = dd[0]; av[1] = dd[1]; av[2] = 0u; av[3] = 0u; u32x4 bv; bv[0] = pk2(acc[0], acc[1]); bv[1] = pk2(acc[2], acc[3]); bv[2] = 0u; bv[3] = 0u;
            const f32x4 x = MFMA16(__builtin_bit_cast(bf16x8, av), __builtin_bit_cast(bf16x8, bv), (f32x4){0.f, 0.f, 0.f, 0.f});
            xb[i][0] = pk2(x[0], x[1]); xb[i][1] = pk2(x[2], x[3]);
            if (!isw) *(f32x4*)(w.gub + ch * 4096 + (size_t)col * 64 + 16 * i + fq * 4) = x;
            else { bf16_t* wp = w.gw + ch * 4096 + (size_t)(16 * i + fq * 4) * 64 + (col - 64);
#pragma unroll
                for (int jj = 0; jj < 4; ++jj) wp[jj * 64] = f2bf(x[jj]); }
        }
    }
    for (int i = tid; i < 2 * 4096; i += NT) { const int dr = i >> 12, s = (i >> 6) & 63, c = i & 63, ts = dr ? 63 - s : s; const float* gg = gt + 256 + dr * 64;
        const int sc = dr == 0 ? cg : (cg < NCG ? NCG - 1 - cg : NCG + (NLG - 1 - (cg - NCG))); const size_t ch = cbase + (size_t)dr * NCHG + sc;
        w.gqg[ch * 4096 + s * 64 + c] = f2bf(Qs[ts * GS + c] * __expf(gg[s]));
        const int tc = dr ? 63 - c : c; w.gqk[ch * 4096 + s * 64 + c] = f2bf(s >= c ? QK[ts * GS + tc] * __expf(gg[s] - gg[c]) : 0.f);
        w.gkt[ch * 4096 + s * 64 + c] = f2bf(Ks[tc * GS + s] * __expf(gg[63] - gg[c]));
        if (s == 0 && c == 0) w.gcd[ch] = __expf(gg[63]); }
}
struct GdnOps { bf16x8 aw[2], aqg[2], aqk[2], akt[2]; f32x4 ub; float cd; };
DI void gdn_load_ops(GdnOps& g, const WS& w, size_t ch, int wv, int fr, int fq, int vs) {
#pragma unroll
    for (int ks = 0; ks < 2; ++ks) { const size_t o = ch * 4096 + (size_t)(wv * 16 + fr) * 64 + ks * 32 + fq * 8;
        g.aw[ks] = *(const bf16x8*)(w.gw + o); g.aqg[ks] = *(const bf16x8*)(w.gqg + o); g.aqk[ks] = *(const bf16x8*)(w.gqk + o); g.akt[ks] = *(const bf16x8*)(w.gkt + o); }
    g.ub = *(const f32x4*)(w.gub + ch * 4096 + (size_t)(vs * 16 + fr) * 64 + wv * 16 + fq * 4); g.cd = w.gcd[ch];
}
DI void gdn_scan_step(const GdnOps& g, f32x4& sacc, bf16_t* Sp, bf16_t* Up, const WS& w, int rbase, int dr, int h, int vs, int wv, int fr, int fq) {
    { u32x2 sv; sv[0] = pk2(sacc[0], sacc[1]); sv[1] = pk2(sacc[2], sacc[3]); *(u32x2*)(Sp + fr * 72 + wv * 16 + fq * 4) = sv; }
    LDS_BARRIER();
    bf16x8 sb[2]; f32x4 u = (f32x4){0.f, 0.f, 0.f, 0.f};
#pragma unroll
    for (int ks = 0; ks < 2; ++ks) { sb[ks] = *(const bf16x8*)(Sp + fr * 72 + ks * 32 + fq * 8); u = MFMA16(g.aw[ks], sb[ks], u); }
    u = g.ub - u;
    { u32x2 uvv; uvv[0] = pk2(u[0], u[1]); uvv[1] = pk2(u[2], u[3]); *(u32x2*)(Up + fr * 72 + wv * 16 + fq * 4) = uvv; }
    LDS_BARRIER();
    f32x4 oo = (f32x4){0.f, 0.f, 0.f, 0.f}, sn = sacc * g.cd;
#pragma unroll
    for (int ks = 0; ks < 2; ++ks) { const bf16x8 ubf = *(const bf16x8*)(Up + fr * 72 + ks * 32 + fq * 8);
        oo = MFMA16(g.aqg[ks], sb[ks], oo); oo = MFMA16(g.aqk[ks], ubf, oo); sn = MFMA16(g.akt[ks], ubf, sn); }
    sacc = sn;
#pragma unroll
    for (int j = 0; j < 4; ++j) { const int s = wv * 16 + fq * 4 + j, tok = dr ? 63 - s : s; w.og[((size_t)dr * R + rbase + tok) * 256 + h * 64 + vs * 16 + fr] = oo[j]; }
}
DI void gdn_scan_unit(const Params& p, const WS& w, int layer, int b, int h, int dr, int vs, char* smem) {
    static_assert(NCHG % 4 == 0, "scan ring assumes a multiple of 4 chunks");
    bf16_t* Sb = (bf16_t*)smem; bf16_t* Ub = Sb + 2 * 16 * 72;
    const int tid = tidx(), lane = tid & 63, wv = tid >> 6, fr = lane & 15, fq = lane >> 4;
    const size_t cb = (size_t)((b * 4 + h) * 2 + dr) * NCHG;
    __syncthreads();
    if (wv < 4) {
        f32x4 sacc = (f32x4){0.f, 0.f, 0.f, 0.f};
        GdnOps r0, r1, r2, r3;
        gdn_load_ops(r0, w, cb, wv, fr, fq, vs); gdn_load_ops(r1, w, cb + 1, wv, fr, fq, vs); gdn_load_ops(r2, w, cb + 2, wv, fr, fq, vs); gdn_load_ops(r3, w, cb + 3, wv, fr, fq, vs);
#define GDN_STEP(RG, K) do { const int sc_ = sc + (K); const int cgi = dr == 0 ? sc_ : (sc_ < NCG ? NCG - 1 - sc_ : NCG + (NLG - 1 - (sc_ - NCG))); \
        gdn_scan_step(RG, sacc, Sb + (K & 1) * 16 * 72, Ub + (K & 1) * 16 * 72, w, cgi < NCG ? RL + b * CTX + cgi * 64 : b * SEQ + (cgi - NCG) * 64, dr, h, vs, wv, fr, fq); \
        gdn_load_ops(RG, w, cb + (sc_ + 4 < NCHG ? sc_ + 4 : NCHG - 1), wv, fr, fq, vs); } while (0)
#pragma unroll 1
        for (int sc = 0; sc < NCHG; sc += 4) { GDN_STEP(r0, 0); GDN_STEP(r1, 1); GDN_STEP(r2, 2); GDN_STEP(r3, 3); }
#undef GDN_STEP
    } else {
#pragma unroll 1
        for (int sc = 0; sc < NCHG; ++sc) { LDS_BARRIER(); LDS_BARRIER(); }
    }
    __syncthreads();
}
DI void gdn_finish(const Params& p, const WS& w, int layer, int skip) {
    const int lane = tidx() & 63, wv = tidx() >> 6; const int nrows = layer == DEPTH - 1 ? RL : R;
    if (bidx() < skip) return;
    for (int row = (bidx() - skip) * 8 + wv; row < nrows; row += (gridDim.x - skip) * 8) {
        const f32x4 a = *(const f32x4*)(w.og + (size_t)row * 256 + lane * 4), c = *(const f32x4*)(w.og + ((size_t)R + row) * 256 + lane * 4); const f32x4 o = a + c;
        float ss = o[0] * o[0] + o[1] * o[1] + o[2] * o[2] + o[3] * o[3];
        ss = sum16(ss);
        const float rs = 1.0f / sqrtf(ss * (1.0f / 64.0f) + 1e-6f); const f32x4 ng = *(const f32x4*)(p.gdn_norm + layer * 64 + (lane & 15) * 4);
        const u32x2 gv = *(const u32x2*)(w.p + (size_t)row * PW + C_GG + lane * 4);
        const float g0 = __uint_as_float(gv[0] << 16), g1 = __uint_as_float(gv[0] & 0xffff0000u), g2 = __uint_as_float(gv[1] << 16), g3 = __uint_as_float(gv[1] & 0xffff0000u);
        u32x2 ov; ov[0] = pk2(o[0] * rs * ng[0] * siluf(g0), o[1] * rs * ng[1] * siluf(g1)); ov[1] = pk2(o[2] * rs * ng[2] * siluf(g2), o[3] * rs * ng[3] * siluf(g3));
        *(u32x2*)(w.mix + (size_t)row * 1024 + 512 + lane * 4) = ov;
    }
}

DI void phase_diff(const Params& p, int layer, char* smem) {
    const WS w = ws_of(p.ws); const bool full_ctx = layer < DEPTH - 1;
    constexpr int QB = SEQ / 256, QC = CTX / 256;
    const int n_diff = NB * 4 * QB, n_diffc = full_ctx ? NB * 4 * QC : 0;
    int lyr = layer;
#ifndef EMU
    asm volatile("" : "+s"(lyr));
#endif
    const float lam_init = 0.8f - 0.6f * __expf(-0.3f * (float)lyr);
    float lam; { const float* lp = p.diff_lambda + layer * 128; const int ln = tidx() & 63; float s1 = 0.f, s2 = 0.f; if (ln < 32) { s1 = lp[ln] * lp[32 + ln]; s2 = lp[64 + ln] * lp[96 + ln]; }
        s1 = wsum(s1); s2 = wsum(s2); lam = __expf(s1) - __expf(s2) + lam_init; }
    for (int r0 = bidx(); r0 < n_diff + n_diffc; r0 += gridDim.x) {
        int r = r0; if (r0 < n_diff && (NB * 4) % 8 == 0) { const int x = r0 & 7, y = r0 >> 3, bh = x + 8 * (y / QB), qb_ = y % QB; r = bh * QB + qb_; }
        const bool isc = r >= n_diff; const int rr = isc ? r - n_diff : r, nq = isc ? QC : QB, qb = rr % nq, h = (rr / nq) & 3, b = rr / (nq * 4);
        const int qrow = (isc ? RL + b * CTX : b * SEQ) + qb * 256;
        attn_unit<2>(w.p, qrow, C_DQ + h * 64, C_DK + h * 64, C_DV + h * 64, isc ? RL + b * CTX : b * SEQ, isc ? CTX / 64 : SEQ / 64, 0, false, RL + b * CTX, isc ? 0 : CTX / 64, 0,
                     -1e30f, 0.f, lam, 1.0f - lam_init, p.diff_norm + layer * 64, w.mix + (size_t)qrow * 1024 + 256 + h * 64, smem);
    }
}
DI void phase_swa(const Params& p, int layer, char* smem) {
    const WS w = ws_of(p.ws); const bool full_ctx = layer < DEPTH - 1;
    constexpr int QB = SEQ / 256, QC = CTX / 256;
    const int n_swa = NB * 4 * QB, n_swac = full_ctx ? NB * 4 * QC : 0;
    for (int r0 = bidx(); r0 < n_swa + n_swac; r0 += gridDim.x) {
        int r = r0; if (r0 < n_swa && (NB * 4) % 8 == 0) { const int x = r0 & 7, y = r0 >> 3, bh = x + 8 * (y / QB), qb_ = y % QB; r = bh * QB + qb_; }
        const bool isc = r >= n_swa; const int rr = isc ? r - n_swa : r, nq = isc ? QC : QB, qb = rr % nq, hh = (rr / nq) & 3, b = rr / (nq * 4), hk = hh >> 1;
        const int qrow = (isc ? RL + b * CTX : b * SEQ) + qb * 256;
        const int ks = qb * 256 - 128 < 0 ? 0 : qb * 256 - 128, ke = qb * 256 + 384 > SEQ ? SEQ : qb * 256 + 384;
        attn_unit<1>(w.p, qrow, C_SQ + hh * 64, C_SK + hk * 64, C_SV + hk * 64, isc ? RL + b * CTX : b * SEQ + ks, isc ? CTX / 64 : (ke - ks) / 64, isc ? 0 : ks, !isc, RL + b * CTX, isc ? 0 : CTX / 64, qb * 256,
                     p.swa_sink[layer * 4 + hh] * LOG2E, 1.0f, 0.f, 1.0f, nullptr, w.mix + (size_t)qrow * 1024 + 768 + hh * 64, smem);
    }
}
DI void phase_gdnp(const Params& p, int layer, char* smem) {
    const WS w = ws_of(p.ws);
    for (int r = bidx(); r < NB * 4 * NCHG; r += gridDim.x) { const int cg = r % NCHG, h = (r / NCHG) & 3, b = r / (NCHG * 4); gdn_prep_unit(p, w, layer, b, h, cg, smem); }
}
DI void phase_rkv(const Params& p, int layer, char* smem) {
    const WS w = ws_of(p.ws);
    const int G = gridDim.x;
    for (int r = (bidx() + G / 2) % G; r < NB * 4 * NCHR; r += G) { const int ci = r % NCHR, h = (r / NCHR) & 3, b = r / (NCHR * 4); ret_kv_unit(p, w, layer, b, h, ci, smem); }
}
DI void phase_mix2(const Params& p, int layer, char* smem) {
    const WS w = ws_of(p.ws);
    for (int u = bidx(); u < NB * 4 * 2 * 4; u += gridDim.x) {
        const int x = u & 7, y = u >> 3, vs = y & 3, chain = x + 8 * (y >> 2), dr = chain & 1, h = (chain >> 1) & 3, b = chain >> 3;
        gdn_scan_unit(p, w, layer, b, h, dr, vs, smem); }
    ret_scan(p, w, layer);
}
DI void phase_mix3(const Params& p, int layer, char* smem) {
    const WS w = ws_of(p.ws); const bool full_ctx = layer < DEPTH - 1;
    for (int u = bidx(); u < NB * 4 * NCHR; u += gridDim.x) { const int ci = u % NCHR, h = (u / NCHR) & 3, b = u / (NCHR * 4); if (ci < NCC && !full_ctx) continue; ret_out_unit(p, w, layer, b, h, ci, smem); }
    const int G = gridDim.x, nun = NB * 4 * (full_ctx ? NCHR : NLC), rem = nun % G;
    gdn_finish(p, w, layer, (rem > 0 && rem <= G / 2) ? rem : 0);
}

DI int block_sum(int v, int* red) {
    const int lane = tidx() & 63, wv = tidx() >> 6;
    const int s = wsum_i(v);
    __syncthreads(); if (lane == 0) red[wv] = s; __syncthreads();
    int t = 0;
#pragma unroll
    for (int i = 0; i < 8; ++i) t += red[i];
    return t;
}
DI int block_exscan(int v, int* red) {
    const int lane = tidx() & 63, wv = tidx() >> 6;
    int s = v;
#pragma unroll
    for (int d = 1; d < 64; d <<= 1) { const int o = lane_shfl_i(s, lane >= d ? lane - d : lane); if (lane >= d) s += o; }
    __syncthreads(); if (lane == 63) red[wv] = s; __syncthreads();
    int off = 0;
#pragma unroll
    for (int i = 0; i < 8; ++i) if (i < wv) off += red[i];
    return off + s - v;
}
template <int N, int CAP> DI void topk_unit(const WS& w, const float* __restrict__ aff, int rowbase, int slotbase, int e, int* red) {
    constexpr int PT = (N + NT - 1) / NT;
    const int tid = tidx(); unsigned key[PT];
#pragma unroll
    for (int i = 0; i < PT; ++i) { const int n = tid * PT + i; key[i] = n < N ? __float_as_uint(aff[n]) : 0u; }
    unsigned T = 0u;
    for (int bit = 30; bit >= 0; --bit) { const unsigned cand = T | (1u << bit); int c = 0;
#pragma unroll
        for (int i = 0; i < PT; ++i) c += (tid * PT + i < N && key[i] >= cand) ? 1 : 0;
        if (block_sum(c, red) >= CAP) T = cand; }
    int cg = 0, ce = 0;
#pragma unroll
    for (int i = 0; i < PT; ++i) { const bool in = tid * PT + i < N; cg += (in && key[i] > T) ? 1 : 0; ce += (in && key[i] == T) ? 1 : 0; }
    const int need = CAP - block_sum(cg, red); const int eoff = block_exscan(ce, red);
    int sel = 0, er = eoff; bool flag[PT];
#pragma unroll
    for (int i = 0; i < PT; ++i) { const bool in = tid * PT + i < N; bool f = in && key[i] > T; if (in && key[i] == T) { f = er < need; ++er; } flag[i] = f; sel += f ? 1 : 0; }
    int slot = block_exscan(sel, red);
    int* selrow = red + 32;
#pragma unroll
    for (int i = 0; i < PT; ++i) { const int n = tid * PT + i; int iv = -1;
        if (n < N) { if (flag[i]) { iv = slotbase + slot; w.idx[(size_t)e * ROWS_E + iv] = rowbase + n; w.wgt[(size_t)e * ROWS_E + iv] = __uint_as_float(key[i]); selrow[slot] = rowbase + n; ++slot; }
            w.inv[(size_t)(rowbase + n) * 16 + e] = iv; } }
    __syncthreads();
    for (int i = tid; i < CAP * 64; i += NT) { const int r = i >> 6, c16 = i & 63;
        *(u32x4*)(w.xin + ((size_t)e * ROWS_E + slotbase + r) * 1024 + c16 * 16) = *(const u32x4*)(w.u8 + (size_t)selrow[r] * 1024 + c16 * 16); }
    __syncthreads();
}
DI void phase_topk(const Params& p, int layer, char* smem) {
    const WS w = ws_of(p.ws); int* red = (int*)smem; const bool full_ctx = layer < DEPTH - 1;
    for (int u = bidx(); u < 2 * NB * 16; u += gridDim.x) {
        const bool isc = u >= NB * 16; const int v = isc ? u - NB * 16 : u, b = v >> 4, e = v & 15;
        if (!isc) topk_unit<SEQ, CAPL>(w, w.aff + ((size_t)b * 16 + e) * SEQ, b * SEQ, b * CAPL, e, red);
        else if (full_ctx) topk_unit<CTX, CAPC>(w, w.aff + (size_t)RL * 16 + ((size_t)b * 16 + e) * CTX, RL + b * CTX, NB * CAPL + b * CAPC, e, red);
        else { for (int i = tidx(); i < CAPC; i += NT) { w.idx[(size_t)e * ROWS_E + NB * CAPL + b * CAPC + i] = 0; w.wgt[(size_t)e * ROWS_E + NB * CAPL + b * CAPC + i] = 0.f; } }
    }
    {
        const int G = gridDim.x, c = bidx(), first = G > NB * 16 ? NB * 16 : 0;
        if (c >= first) { __syncthreads(); cvt_stream<4>(p, w, smem, layer, c - first, G - first); }
    }
}

enum { PH_CVT = 0, PH_INIT, PH_INPROJ, PH_PREP, PH_DIFF, PH_MIX2, PH_MIX3, PH_OUTPROJ, PH_LN0, PH_TOPK, PH_MOE1, PH_MOE2, PH_LN1, PH_SWA, PH_GDNP, PH_RKV };
#ifdef EMU
#define SMEM_PTR(s) char* s = emu::B->lds
#else
extern __shared__ __attribute__((aligned(16))) char dyn_smem[];
#define SMEM_PTR(s) char* s = dyn_smem
#endif
template <int PH> DI void run_phase(const Params& p, int layer, char* smem) {
    if (PH == PH_CVT) phase_cvt(p, smem);
    else if (PH == PH_INIT) phase_rows<0>(p, 0, smem);
    else if (PH == PH_INPROJ) phase_inproj(p, layer, smem);
    else if (PH == PH_PREP) phase_prep(p, layer, smem);
    else if (PH == PH_DIFF) phase_diff(p, layer, smem);
    else if (PH == PH_SWA) phase_swa(p, layer, smem);
    else if (PH == PH_GDNP) phase_gdnp(p, layer, smem);
    else if (PH == PH_RKV) phase_rkv(p, layer, smem);
    else if (PH == PH_MIX2) phase_mix2(p, layer, smem);
    else if (PH == PH_MIX3) phase_mix3(p, layer, smem);
    else if (PH == PH_OUTPROJ) phase_outproj(p, layer, smem);
    else if (PH == PH_LN0) phase_rows<1>(p, layer, smem);
    else if (PH == PH_TOPK) phase_topk(p, layer, smem);
    else if (PH == PH_MOE1) phase_moe1(p, layer, smem);
    else if (PH == PH_MOE2) phase_moe2(p, layer, smem);
    else if (PH == PH_LN1) phase_rows<2>(p, layer, smem);
}
constexpr int LDS_BYTES = 8 * G_HT * 2 + 1024;
template <int PH> __global__ void __launch_bounds__(NT, 2) k_phase(Params p, int layer) { SMEM_PTR(smem); run_phase<PH>(p, layer, smem); }

#ifdef EMU
void (*emu_hook)(const char* tag, int layer, char* ws) = nullptr;
#define HOOK(t, l) do { if (emu_hook) emu_hook(t, l, (char*)d_ws); } while (0)
#else
#define HOOK(t, l)
#endif
template <int PH> static void launch_phase1(const Params& p, int layer, int grid, hipStream_t stream);
template <int PH> static void launch_phase(const Params& p, int layer, int grid, hipStream_t stream) { launch_phase1<PH>(p, layer, grid, stream); if ((PROBE_REP >> PH) & 1) launch_phase1<PH>(p, layer, grid, stream); }
template <int PH> static void launch_phase1(const Params& p, int layer, int grid, hipStream_t stream) {
#ifndef EMU
    static bool done = false; if (!done) { hipFuncSetAttribute((const void*)k_phase<PH>, hipFuncAttributeMaxDynamicSharedMemorySize, LDS_BYTES); done = true; }
#endif
    hipLaunchKernelGGL(k_phase<PH>, dim3(grid), dim3(NT), LDS_BYTES, stream, p, layer);
}

#ifndef MK_MULTI
#define MK_MULTI 0
#endif
#ifdef EMU
#define PHASE(PH, l) run_phase<PH>(p, l, emu::B->lds)
#define GRID_BARRIER() do { XcdBarrier bar_; bar_.bar = (unsigned*)(p.ws + OFF_BAR); xcd_barrier(bar_); } while (0)
#else
typedef const __attribute__((address_space(4))) Params* KParams;
DI KParams kparams() { KParams kp = (KParams)__builtin_amdgcn_kernarg_segment_ptr(); asm volatile("" : "+s"(kp)); return kp; }
template <int PH> DI void run_phase_k(int layer) { const Params* gp = (const Params*)kparams(); const Params p = *gp; run_phase<PH>(p, layer, dyn_smem); }
DI void grid_barrier_k() { XcdBarrier b; b.bar = (unsigned*)(kparams()->ws + OFF_BAR); b.x = xb_xcc_id(); b.st = (volatile LAS unsigned*)&dyn_smem[8 * G_HT * 2]; xcd_barrier(b); }
#define PHASE(PH, l) run_phase_k<PH>(l)
#define GRID_BARRIER() grid_barrier_k()
#endif
#if !MK_MULTI
__global__ void __launch_bounds__(NT, 2) k_mega(Params p) {
#ifndef EMU
    {   volatile LAS unsigned* st = (volatile LAS unsigned*)&dyn_smem[8 * G_HT * 2];
        if (threadIdx.x == 0) { st[0] = 0u; st[1] = 0u; st[2] = 0u; st[3] = 0u; }
        __syncthreads();
        (void)xcd_barrier_post((unsigned*)(kparams()->ws + OFF_BAR), st); }
#endif
#define PHASE_R(PH, l) do { PHASE(PH, l); if ((PROBE_REP >> PH) & 1) { GRID_BARRIER(); PHASE(PH, l); } } while (0)
    PHASE_R(PH_CVT, 0); GRID_BARRIER();
    PHASE_R(PH_INIT, 0); GRID_BARRIER();
    for (int l = 0; l < DEPTH; ++l) {
        PHASE_R(PH_INPROJ, l); GRID_BARRIER();
        PHASE_R(PH_DIFF, l); PHASE_R(PH_SWA, l); PHASE_R(PH_GDNP, l); PHASE_R(PH_RKV, l); GRID_BARRIER();
        PHASE_R(PH_MIX2, l); GRID_BARRIER();
        PHASE_R(PH_MIX3, l); GRID_BARRIER();
        PHASE_R(PH_OUTPROJ, l); GRID_BARRIER();
        PHASE(PH_LN0, l); GRID_BARRIER();
        PHASE_R(PH_TOPK, l); GRID_BARRIER();
        PHASE_R(PH_MOE1, l); GRID_BARRIER();
        PHASE_R(PH_MOE2, l); GRID_BARRIER();
        PHASE(PH_LN1, l); if (l + 1 < DEPTH) GRID_BARRIER();
    }
}
#endif

extern "C" void kernel_launch(void* const* d_in, const int* in_sizes, int n_in, void* d_out, int out_size, void* d_ws, size_t ws_size, hipStream_t stream) {
    Params p{};
    const float* const* in = (const float* const*)d_in;
    p.x = in[0]; p.c = in[1]; p.ctx = in[2]; p.c_ctx = in[3]; p.ada_w = in[4]; p.ada_b = in[5]; p.w_in = in[6]; p.w_out = in[7]; p.ret_decay = in[8]; p.diff_lambda = in[9];
    p.diff_norm = in[10]; p.gdn_conv = in[11]; p.gdn_a_log = in[12]; p.gdn_dt_bias = in[13]; p.gdn_norm = in[14]; p.swa_sink = in[15]; p.ln_g = in[16]; p.ln_b = in[17];
    p.router_w = in[18]; p.w_gate = in[19]; p.w_up = in[20]; p.w_down = in[21]; p.out = (float*)d_out; p.ws = (char*)d_ws;
    static int cus = 0;
    if (!cus) { int dev = 0; hipGetDevice(&dev); hipDeviceGetAttribute(&cus, hipDeviceAttributeMultiprocessorCount, dev); if (cus <= 0) cus = 256; }
    const int grid = cus;
#if MK_MULTI
    launch_phase<PH_CVT>(p, 0, grid, stream); HOOK("cvt", 0);
    launch_phase<PH_INIT>(p, 0, grid, stream); HOOK("init", 0);
    for (int l = 0; l < DEPTH; ++l) {
        launch_phase<PH_INPROJ>(p, l, grid, stream); HOOK("inproj", l);
        launch_phase<PH_DIFF>(p, l, grid, stream); launch_phase<PH_SWA>(p, l, grid, stream); launch_phase<PH_GDNP>(p, l, grid, stream); launch_phase<PH_RKV>(p, l, grid, stream);
        launch_phase<PH_MIX2>(p, l, grid, stream);
        launch_phase<PH_MIX3>(p, l, grid, stream); HOOK("mix", l);
        launch_phase<PH_OUTPROJ>(p, l, grid, stream);
        launch_phase<PH_LN0>(p, l, grid, stream); HOOK("ln0", l);
        launch_phase<PH_TOPK>(p, l, grid, stream);
        launch_phase<PH_MOE1>(p, l, grid, stream);
        launch_phase<PH_MOE2>(p, l, grid, stream);
        launch_phase<PH_LN1>(p, l, grid, stream); HOOK("ln1", l);
    }
#else
    hipMemsetAsync((char*)d_ws + OFF_BAR, 0, XCD_BAR_WORDS * sizeof(unsigned), stream);
#ifndef EMU
    static bool attr = false; if (!attr) { hipFuncSetAttribute((const void*)k_mega, hipFuncAttributeMaxDynamicSharedMemorySize, LDS_BYTES); attr = true; }
#endif
    hipLaunchKernelGGL(k_mega, dim3(grid), dim3(NT), LDS_BYTES, stream, p);
#endif
}
```

```cpp
#ifndef EMU
#include <hip/hip_runtime.h>
#endif
#include <stdint.h>
#include <stddef.h>
#include <math.h>

#ifndef CFG_B
#define CFG_B 8
#define CFG_SEQ 4096
#define CFG_CTX 256
#define CFG_DEPTH 4
#define CFG_FF 2048
#endif

#ifndef PROBE_REP
#define PROBE_REP 0
#endif
#define DI __device__ __forceinline__
typedef unsigned short bf16_t;
typedef short bf16x8 __attribute__((ext_vector_type(8)));
typedef short s16x4 __attribute__((ext_vector_type(4)));
typedef float f32x4 __attribute__((ext_vector_type(4)));
typedef unsigned u32x4 __attribute__((ext_vector_type(4)));
typedef unsigned u32x2 __attribute__((ext_vector_type(2)));

constexpr int NB = CFG_B, SEQ = CFG_SEQ, CTX = CFG_CTX, DEPTH = CFG_DEPTH, FF = CFG_FF, DM = 1024, NE = 16;
constexpr int RL = NB * SEQ, RC = NB * CTX, R = RL + RC;
constexpr int CAPL = SEQ / 8, CAPC = CTX / 8, ROWS_E = NB * (CAPL + CAPC);
constexpr int INW = 3344, PW = 3328;
constexpr int NT = 512;
constexpr int NCC = CTX / 128, NLC = SEQ / 128, NCHR = NCC + NLC;
constexpr int NCG = CTX / 64, NLG = SEQ / 64, NCHG = NCG + NLG;
constexpr float ALPHA = 1.681792830507429f;
constexpr float LOG2E = 1.4426950408889634f;
constexpr int C_RQ = 0, C_RK = 256, C_RV = 512, C_RG = 768, C_DQ = 1024, C_DK = 1280, C_DV = 1536, C_GQKV = 1792, C_GG = 2560, C_SQ = 2816, C_SK = 3072, C_SV = 3200;

constexpr size_t al256(size_t x) { return (x + 255) & ~(size_t)255; }
constexpr size_t OFF_BAR = 0;
constexpr size_t OFF_MOD = 16384;
constexpr size_t OFF_TAB = OFF_MOD + al256((size_t)DEPTH * (NB + 1) * 6144 * 4);
constexpr size_t OFF_WIN = OFF_TAB + al256((size_t)SEQ * 160 * 4);
constexpr size_t OFF_WOUT = OFF_WIN + al256((size_t)DEPTH * PW * 1024 * 2);
constexpr size_t OFF_WGU = OFF_WOUT + al256((size_t)DEPTH * 1024 * 1024 * 2);
constexpr size_t OFF_WDN = OFF_WGU + al256((size_t)DEPTH * 16 * 2 * FF * 1024 * 2);
constexpr size_t OFF_H = OFF_WDN + al256((size_t)DEPTH * 16 * 1024 * FF * 2);
constexpr size_t OFF_U = OFF_H + al256((size_t)R * 1024 * 4);
constexpr size_t OFF_GAB = OFF_U + al256((size_t)R * 1024 * 2);
constexpr size_t OFF_MIX = OFF_GAB + al256((size_t)R * 16 * 4);
constexpr size_t OFF_AFF = OFF_MIX + al256((size_t)R * 1024 * 2);
constexpr size_t OFF_IDX = OFF_AFF + al256((size_t)R * 16 * 4);
constexpr size_t OFF_WGT = OFF_IDX + al256((size_t)16 * ROWS_E * 4);
constexpr size_t OFF_INV = OFF_WGT + al256((size_t)16 * ROWS_E * 4);
constexpr size_t OFF_U8 = OFF_INV + al256((size_t)R * 16 * 4);
constexpr size_t OFF_ARA = OFF_U8 + al256((size_t)R * 1024);
constexpr size_t SZ_P = (size_t)R * PW * 2, SZ_HID8 = al256((size_t)16 * ROWS_E * FF), SZ_XIN8 = al256((size_t)16 * ROWS_E * 1024), SZ_HID = SZ_HID8 + SZ_XIN8;
constexpr size_t OFF_ARB = OFF_ARA + al256(SZ_P > SZ_HID ? SZ_P : SZ_HID);
constexpr size_t SZ_RKV = (size_t)NB * 4 * 2 * NCHR * 4096 * 4;
constexpr size_t GCH = (size_t)NB * 4 * 2 * NCHG;
constexpr size_t OB_RKV = 0, OB_RS = OB_RKV + al256(SZ_RKV), OB_GW = OB_RS + al256(SZ_RKV), OB_GQG = OB_GW + GCH * 8192, OB_GQK = OB_GQG + GCH * 8192,
                 OB_GKT = OB_GQK + GCH * 8192, OB_GUB = OB_GKT + GCH * 8192, OB_GCD = OB_GUB + GCH * 16384, OB_OG = OB_GCD + al256(GCH * 4), OB_END = OB_OG + (size_t)2 * R * 256 * 4;
constexpr size_t SZ_MIXO = (size_t)R * 1024 * 4, SZ_Y = (size_t)16 * ROWS_E * 1024 * 2;
constexpr size_t SZ_ARB = OB_END > SZ_MIXO ? (OB_END > SZ_Y ? OB_END : SZ_Y) : (SZ_MIXO > SZ_Y ? SZ_MIXO : SZ_Y);
constexpr size_t WS_TOTAL = OFF_ARB + al256(SZ_ARB);

struct Params {
    const float *x, *c, *ctx, *c_ctx, *ada_w, *ada_b, *w_in, *w_out, *ret_decay, *diff_lambda, *diff_norm, *gdn_conv, *gdn_a_log, *gdn_dt_bias,
        *gdn_norm, *swa_sink, *ln_g, *ln_b, *router_w, *w_gate, *w_up, *w_down;
    float* out; char* ws;
};

#ifdef EMU
#define NT_LOAD(p) (*(p))
#define NT_STORE(v, p) (*(p) = (v))
#else
#define NT_LOAD(p) __builtin_nontemporal_load(p)
#define NT_STORE(v, p) __builtin_nontemporal_store((v), (p))
#endif
DI float bf2f(bf16_t v) { return __uint_as_float(((unsigned)v) << 16); }
DI bf16_t f2bf(float f) { unsigned u = __float_as_uint(f); u += 0x7fffu + ((u >> 16) & 1u); return (bf16_t)(u >> 16); }
DI unsigned pk2(float lo, float hi) {
#ifdef EMU
    return (unsigned)f2bf(lo) | ((unsigned)f2bf(hi) << 16);
#else
    typedef float f32x2_ __attribute__((ext_vector_type(2))); typedef __bf16 bf16x2_ __attribute__((ext_vector_type(2)));
    const f32x2_ v = {lo, hi}; return __builtin_bit_cast(unsigned, __builtin_convertvector(v, bf16x2_));
#endif
}
#ifdef EMU
DI int max(int a, int b) { return a > b ? a : b; }
DI int tidx() { return (int)threadIdx.x; }
DI int bidx() { return (int)blockIdx.x; }
#else
DI int tidx() { int t = threadIdx.x; asm volatile("" : "+v"(t)); return t; }
DI int bidx() { int b = blockIdx.x; asm volatile("" : "+s"(b)); return b; }
#endif
constexpr float SW1 = 32.0f, SW2 = 64.0f, SH = 8.0f, SY = 64.0f;
DI unsigned pk4_fp8(float a, float b, float c, float d) {
    a = fminf(fmaxf(a, -448.f), 448.f); b = fminf(fmaxf(b, -448.f), 448.f); c = fminf(fmaxf(c, -448.f), 448.f); d = fminf(fmaxf(d, -448.f), 448.f);
    int r = __builtin_amdgcn_cvt_pk_fp8_f32(a, b, 0, false); r = __builtin_amdgcn_cvt_pk_fp8_f32(c, d, r, true); return (unsigned)r; }
#ifdef EMU
DI float sum8(float v) { for (int m = 4; m >= 1; m >>= 1) v += __shfl_xor(v, m); return v; }
DI float sum16(float v) { for (int m = 8; m >= 1; m >>= 1) v += __shfl_xor(v, m); return v; }
DI float wsum(float v) { for (int m = 32; m >= 1; m >>= 1) v += __shfl_xor(v, m); return v; }
DI int wsum_i(int v) { for (int m = 32; m >= 1; m >>= 1) v += __shfl_xor(v, m); return v; }
DI int lane_bcast(int v, int src) { return __shfl(v, src); }
DI int lane_shfl_i(int v, int src) { return __shfl(v, src); }
DI float lane_shfl_f(float v, int src) { return __shfl(v, src); }
#else
template <int CTRL> DI float dpp_f(float x) { return __int_as_float(__builtin_amdgcn_update_dpp(0, __float_as_int(x), CTRL, 0xF, 0xF, true)); }
template <int CTRL> DI int dpp_i(int x) { return __builtin_amdgcn_update_dpp(0, x, CTRL, 0xF, 0xF, true); }
DI float sum8(float x) { x += dpp_f<0xB1>(x); x += dpp_f<0x4E>(x); x += dpp_f<0x141>(x); return x; }
DI float sum16(float x) { x += dpp_f<0xB1>(x); x += dpp_f<0x4E>(x); x += dpp_f<0x141>(x); x += dpp_f<0x140>(x); return x; }
DI float wsum(float x) { x = sum16(x);
    auto a = __builtin_amdgcn_permlane16_swap(__float_as_uint(x), __float_as_uint(x), false, false); x = __uint_as_float(a[0]) + __uint_as_float(a[1]);
    auto b = __builtin_amdgcn_permlane32_swap(__float_as_uint(x), __float_as_uint(x), false, false); return __uint_as_float(b[0]) + __uint_as_float(b[1]); }
DI int wsum_i(int x) { x += dpp_i<0xB1>(x); x += dpp_i<0x4E>(x); x += dpp_i<0x141>(x); x += dpp_i<0x140>(x);
    auto a = __builtin_amdgcn_permlane16_swap((unsigned)x, (unsigned)x, false, false); x = (int)a[0] + (int)a[1];
    auto b = __builtin_amdgcn_permlane32_swap((unsigned)x, (unsigned)x, false, false); return (int)b[0] + (int)b[1]; }
DI int lane_bcast(int v, int src) { return __builtin_amdgcn_readlane(v, src); }
DI int lane_shfl_i(int v, int src) { return __builtin_amdgcn_ds_bpermute(src << 2, v); }
DI float lane_shfl_f(float v, int src) { return __int_as_float(__builtin_amdgcn_ds_bpermute(src << 2, __float_as_int(v))); }
#endif
#ifdef EMU
DI float lane_xor1_f(float x) { return __shfl_xor(x, 1); }
#else
DI float lane_xor1_f(float x) { return __int_as_float(__builtin_amdgcn_update_dpp(0, __float_as_int(x), 0xB1, 0xF, 0xF, true)); }
#endif
DI float bf_lo(unsigned v) { return __uint_as_float(v << 16); }
DI float bf_hi(unsigned v) { return __uint_as_float(v & 0xffff0000u); }
DI float siluf(float x) { return x * __builtin_amdgcn_rcpf(1.0f + __builtin_amdgcn_exp2f(-LOG2E * x)); }
DI float sigmoidf_(float x) { return __builtin_amdgcn_rcpf(1.0f + __builtin_amdgcn_exp2f(-LOG2E * x)); }
DI float softplusf_(float x) { return x > 20.0f ? x : 0.6931471805599453f * __builtin_amdgcn_logf(1.0f + __builtin_amdgcn_exp2f(x * LOG2E)); }
DI float ex2(float x) { return __builtin_amdgcn_exp2f(x); }
DI f32x4 MFMA16(bf16x8 a, bf16x8 b, f32x4 c) { return __builtin_amdgcn_mfma_f32_16x16x32_bf16(a, b, c, 0, 0, 0); }
typedef int i32x8 __attribute__((ext_vector_type(8)));
typedef unsigned u32x8 __attribute__((ext_vector_type(8)));
DI f32x4 mfma_fp8(u32x8 a, u32x8 b, f32x4 c) {
    return __builtin_amdgcn_mfma_scale_f32_16x16x128_f8f6f4(__builtin_bit_cast(i32x8, a), __builtin_bit_cast(i32x8, b), c, 0, 0, 0, 0x7F7F7F7F, 0, 0x7F7F7F7F); }
DI bf16x8 frag_lo(u32x8 v) { const u32x4 h = __builtin_shufflevector(v, v, 0, 1, 2, 3); return __builtin_bit_cast(bf16x8, h); }
DI bf16x8 frag_hi(u32x8 v) { const u32x4 h = __builtin_shufflevector(v, v, 4, 5, 6, 7); return __builtin_bit_cast(bf16x8, h); }
#ifdef EMU
#define WAIT_V(n)
#define STAGGER_SLEEP(flag)
#define WAIT_L(n)
#else
#define WAIT_V(n) asm volatile("s_waitcnt vmcnt(" #n ")" ::: "memory")
#ifndef STAG_N
#define STAG_N 6
#endif
#define STAG_STR2(x) #x
#define STAG_STR(x) STAG_STR2(x)
#define STAGGER_SLEEP(flag) asm volatile("s_cmp_eq_u32 %0, 0\n\ts_cbranch_scc1 .Lstg%=\n\ts_sleep " STAG_STR(STAG_N) "\n.Lstg%=:" :: "s"(flag) : "memory", "scc")
#define WAIT_L(n) asm volatile("s_waitcnt lgkmcnt(" #n ")" ::: "memory")
#endif
#define BAR __builtin_amdgcn_s_barrier()
#define SCHED __builtin_amdgcn_sched_barrier(0)

#ifdef EMU
#define LDS_BARRIER() __syncthreads()
#else
#define LDS_BARRIER() do { asm volatile("s_waitcnt lgkmcnt(0)" ::: "memory"); __builtin_amdgcn_s_barrier(); asm volatile("" ::: "memory"); } while (0)
#endif
#ifdef EMU
DI float grp_max(float x) { x = fmaxf(x, __shfl_xor(x, 16)); return fmaxf(x, __shfl_xor(x, 32)); }
DI float grp_sum(float x) { x += __shfl_xor(x, 16); return x + __shfl_xor(x, 32); }
DI int grp_imax(int x) { int y = __shfl_xor(x, 16); x = x > y ? x : y; y = __shfl_xor(x, 32); return x > y ? x : y; }
DI s16x4 lds_tr16(const bf16_t* p) { return emu_lds_tr16(p); }
#else
DI float grp_max(float x) {
    auto a = __builtin_amdgcn_permlane16_swap(__float_as_uint(x), __float_as_uint(x), false, false); x = fmaxf(__uint_as_float(a[0]), __uint_as_float(a[1]));
    auto b = __builtin_amdgcn_permlane32_swap(__float_as_uint(x), __float_as_uint(x), false, false); return fmaxf(__uint_as_float(b[0]), __uint_as_float(b[1])); }
DI float grp_sum(float x) {
    auto a = __builtin_amdgcn_permlane16_swap(__float_as_uint(x), __float_as_uint(x), false, false); x = __uint_as_float(a[0]) + __uint_as_float(a[1]);
    auto b = __builtin_amdgcn_permlane32_swap(__float_as_uint(x), __float_as_uint(x), false, false); return __uint_as_float(b[0]) + __uint_as_float(b[1]); }
DI int grp_imax(int x) {
    auto a = __builtin_amdgcn_permlane16_swap((unsigned)x, (unsigned)x, false, false); x = max((int)a[0], (int)a[1]);
    auto b = __builtin_amdgcn_permlane32_swap((unsigned)x, (unsigned)x, false, false); return max((int)b[0], (int)b[1]); }
typedef short v4i16_t_ __attribute__((ext_vector_type(4)));
DI s16x4 lds_tr16(const bf16_t* p) { return __builtin_bit_cast(s16x4, __builtin_amdgcn_ds_read_tr16_b64_v4i16((__attribute__((address_space(3))) v4i16_t_*)p)); }
#endif
#ifdef EMU
struct XcdBarrier { unsigned* bar; };
DI XcdBarrier xcd_barrier_post(unsigned* bar, void*) { XcdBarrier b; b.bar = bar; return b; }
DI void xcd_barrier(const XcdBarrier& b) {
    __syncthreads();
    if (threadIdx.x == 0) { unsigned g = __atomic_load_n(&b.bar[64], __ATOMIC_SEQ_CST);
        if (__atomic_fetch_add(&b.bar[0], 1u, __ATOMIC_SEQ_CST) == gridDim.x - 1) { __atomic_store_n(&b.bar[0], 0u, __ATOMIC_SEQ_CST); __atomic_fetch_add(&b.bar[64], 1u, __ATOMIC_SEQ_CST); }
        else while (__atomic_load_n(&b.bar[64], __ATOMIC_SEQ_CST) == g) sched_yield(); }
    __syncthreads();
}
#define XCD_BAR_WORDS 3456
#else
#define XB_TMO      128
#define XB_XCNT(j)  (256  + 64 * (j))
#define XB_XSUB(j)  (1280 + 64 * (j))
#define XB_XGEN(j)  (2304 + 64 * (j))
#define XB_TOP      3328
#define XB_TOPGEN   3392
#define XCD_BAR_WORDS 3456
#define XB_SPIN_CAP (1u << 22)
#define LAS __attribute__((address_space(3)))
DI unsigned xb_ld(unsigned* p)              { return __hip_atomic_load(p, __ATOMIC_RELAXED, __HIP_MEMORY_SCOPE_AGENT); }
DI unsigned xb_add(unsigned* p, unsigned v) { return __hip_atomic_fetch_add(p, v, __ATOMIC_RELAXED, __HIP_MEMORY_SCOPE_AGENT); }
DI unsigned xb_xcc_id() { return (unsigned)__builtin_amdgcn_s_getreg((3 << 11) | 20) & 0xFu; }
#define XB_SPIN(cond, bar) do { unsigned _sp = 0; while (cond) { __builtin_amdgcn_s_sleep(1); \
    if ((++_sp & 255u) == 0u) { if (xb_ld(&(bar)[XB_TMO])) break; if (_sp > XB_SPIN_CAP) { atomicAdd(&(bar)[XB_TMO], 1u); break; } } } } while (0)
struct XcdBarrier { unsigned* bar; unsigned x; volatile LAS unsigned* st; };
DI XcdBarrier xcd_barrier_post(unsigned* bar, volatile LAS unsigned* st) {
    XcdBarrier b; b.bar = bar; b.x = xb_xcc_id(); b.st = st;
    if (threadIdx.x == 0) (void)xb_add(&bar[XB_XCNT(b.x)], 1u);
    return b;
}
DI void xcd_barrier_complete(unsigned* bar, unsigned x, unsigned& nloc, unsigned& nx) {
    const unsigned G = gridDim.x * gridDim.y * gridDim.z;
    unsigned sum, cnt, mine, sp = 0u;
    for (;;) {
        sum = 0u; cnt = 0u; mine = 0u;
#pragma unroll
        for (unsigned j = 0; j < 16; ++j) { const unsigned c = xb_ld(&bar[XB_XCNT(j)]); sum += c; cnt += (c > 0u) ? 1u : 0u; mine = (j == x) ? c : mine; }
        if (sum == G) break;
        __builtin_amdgcn_s_sleep(1);
        if ((++sp & 255u) == 0u) { if (xb_ld(&bar[XB_TMO])) break; if (sp > XB_SPIN_CAP) { atomicAdd(&bar[XB_TMO], 1u); break; } }
    }
    nloc = mine > 0u ? mine : 1u; nx = cnt > 0u ? cnt : 1u;
}
DI void xcd_barrier(const XcdBarrier& b) {
    asm volatile("s_waitcnt vmcnt(0)" ::: "memory");
    __syncthreads();
    if (threadIdx.x == 0) {
        unsigned* bar = b.bar;
        __builtin_amdgcn_s_waitcnt(0);
        unsigned nloc = b.st[0], nx = b.st[1];
        if (nloc == 0u) { xcd_barrier_complete(bar, b.x, nloc, nx); b.st[0] = nloc; b.st[1] = nx; }
        const unsigned old = xb_add(&bar[XB_XSUB(b.x)], 1u);
        const unsigned gen = old / nloc;
        if (old + 1u == (gen + 1u) * nloc) {
            __builtin_amdgcn_fence(__ATOMIC_RELEASE, "agent");
            asm volatile("s_waitcnt vmcnt(0)" ::: "memory");
            const unsigned og = xb_add(&bar[XB_TOP], 1u);
            const unsigned tg = og / nx;
            if (og + 1u == (tg + 1u) * nx) xb_add(&bar[XB_TOPGEN], 1u);
            else XB_SPIN(xb_ld(&bar[XB_TOPGEN]) == tg, bar);
            __builtin_amdgcn_fence(__ATOMIC_ACQUIRE, "agent");
            xb_add(&bar[XB_XGEN(b.x)], 1u);
            asm volatile("s_waitcnt vmcnt(0)" ::: "memory");
        } else {
            XB_SPIN(xb_ld(&bar[XB_XGEN(b.x)]) == gen, bar);
            __builtin_amdgcn_fence(__ATOMIC_ACQUIRE, "agent");
            asm volatile("s_waitcnt vmcnt(0)" ::: "memory");
        }
    }
    __syncthreads();
}
#endif

struct WS {
    unsigned* bar; float* mod; float* tab; bf16_t* win; bf16_t* wout; unsigned char* wgu; unsigned char* wdn; float* h; bf16_t* u; unsigned char* u8; float* gab; bf16_t* mix; float* aff;
    int* idx; float* wgt; int* inv; bf16_t* p; unsigned char* hid; unsigned char* xin; bf16_t* rkv; bf16_t* rs; bf16_t* gw; bf16_t* gqg; bf16_t* gqk; bf16_t* gkt; bf16_t* gub; float* gcd; bf16_t* og; bf16_t* mixo; unsigned char* y;
};
DI WS ws_of(char* w) {
    WS s; s.bar = (unsigned*)(w + OFF_BAR); s.mod = (float*)(w + OFF_MOD); s.tab = (float*)(w + OFF_TAB); s.win = (bf16_t*)(w + OFF_WIN); s.wout = (bf16_t*)(w + OFF_WOUT);
    s.wgu = (unsigned char*)(w + OFF_WGU); s.wdn = (unsigned char*)(w + OFF_WDN); s.u8 = (unsigned char*)(w + OFF_U8); s.h = (float*)(w + OFF_H); s.u = (bf16_t*)(w + OFF_U); s.gab = (float*)(w + OFF_GAB); s.mix = (bf16_t*)(w + OFF_MIX);
    s.aff = (float*)(w + OFF_AFF); s.idx = (int*)(w + OFF_IDX); s.wgt = (float*)(w + OFF_WGT); s.inv = (int*)(w + OFF_INV); s.p = (bf16_t*)(w + OFF_ARA); s.hid = (unsigned char*)(w + OFF_ARA); s.xin = (unsigned char*)(w + OFF_ARA + SZ_HID8);
    char* b = w + OFF_ARB; s.rkv = (bf16_t*)(b + OB_RKV); s.rs = (bf16_t*)(b + OB_RS); s.gw = (bf16_t*)(b + OB_GW); s.gqg = (bf16_t*)(b + OB_GQG); s.gqk = (bf16_t*)(b + OB_GQK);
    s.gkt = (bf16_t*)(b + OB_GKT); s.gub = (bf16_t*)(b + OB_GUB); s.gcd = (float*)(b + OB_GCD); s.og = (bf16_t*)(b + OB_OG); s.mixo = (bf16_t*)b; s.y = (unsigned char*)b;
    return s;
}

struct CvtJob { const float* src; char* dst; int src_ld, dst_ld  , mode  ; float scale; };
DI CvtJob cvt_job(const Params& p, const WS& w, int u) {
    constexpr int FT = FF / 128, n_in = 8 * 52, n_out = 8 * 16, n_g = 16 * 8 * (FF / 64), n_d = 16 * FT * 16, tot_l = n_in + n_out + 2 * n_g + n_d;
    const int l = u / tot_l; int r = u % tot_l; CvtJob j; j.scale = 1.0f;
    if (r < n_in) { const int kt = r & 7, ct = r >> 3, c0 = ct < 44 ? ct * 64 : 2832 + (ct - 44) * 64;
        j.src = p.w_in + (size_t)l * 1024 * INW + (size_t)(kt * 128) * INW + c0; j.src_ld = INW; j.dst = (char*)(w.win + (size_t)l * PW * 1024 + (size_t)(ct < 44 ? c0 : c0 - 16) * 1024 + kt * 128); j.dst_ld = 2048;
        j.mode = (ct < 8 || (ct >= 44 && ct < 50)) ? 1 : ((ct >= 16 && ct < 24) ? 3 : 0);
    } else if (r < n_in + n_out) { r -= n_in; const int kt = r & 7, ct = r >> 3;
        j.src = p.w_out + (size_t)l * 1024 * 1024 + (size_t)(kt * 128) * 1024 + ct * 64; j.src_ld = 1024; j.dst = (char*)(w.wout + (size_t)l * 1024 * 1024 + (size_t)(ct * 64) * 1024 + kt * 128); j.dst_ld = 2048; j.mode = 0;
    } else if (r < n_in + n_out + 2 * n_g) { r -= n_in + n_out; const int which = r / n_g, rr = r % n_g, e = rr / (8 * (FF / 64)), r2 = rr % (8 * (FF / 64)), kt = r2 & 7, ct = r2 >> 3, c0 = ct * 64;
        j.src = (which ? p.w_up : p.w_gate) + (size_t)(l * 16 + e) * 1024 * FF + (size_t)(kt * 128) * FF + c0; j.src_ld = FF;
        j.dst = (char*)(w.wgu + (size_t)(l * 16 + e) * 2 * FF * 1024 + (size_t)((c0 >> 7) * 256 + which * 128 + (c0 & 127)) * 1024 + kt * 128); j.dst_ld = 1024; j.mode = 2; j.scale = SW1;
    } else { r -= n_in + n_out + 2 * n_g; const int e = r / (16 * FT), r2 = r % (16 * FT), kt = r2 % FT, ct = r2 / FT;
        j.src = p.w_down + (size_t)(l * 16 + e) * FF * 1024 + (size_t)(kt * 128) * 1024 + ct * 64; j.src_ld = 1024; j.dst = (char*)(w.wdn + (size_t)(l * 16 + e) * 1024 * FF + (size_t)(ct * 64) * FF + kt * 128); j.dst_ld = FF; j.mode = 2; j.scale = SW2;
    }
    return j;
}
#define CVT_LOAD(j, v) _Pragma("unroll") for (int i = 0; i < 16; ++i) { const int idx = tid + NT * i, kk = idx >> 6, cc = idx & 63; v[i] = NT_LOAD((j).src + (size_t)kk * (j).src_ld + cc); }
constexpr int CVT_TOT_L = 8 * 52 + 8 * 16 + 2 * 16 * 8 * (FF / 64) + 16 * (FF / 128) * 16;
#ifndef CVT_PER_B
#define CVT_PER_B 16
#endif
#ifndef CVT_PER_D
#define CVT_PER_D 16
#endif
#ifndef CVT_PER_A
#define CVT_PER_A 16
#endif
#ifndef CVT_PER_T
#define CVT_PER_T 0
#endif
constexpr int cvt_share(int pct, int n) { return (CVT_TOT_L * pct / 100) < n ? (CVT_TOT_L * pct / 100) : n; }
constexpr int CVT_TAIL_B = cvt_share(30, 224 * CVT_PER_B), CVT_TAIL_D = cvt_share(25, 192 * CVT_PER_D), CVT_TAIL_A = cvt_share(3, 24 * CVT_PER_A), CVT_TAIL_T = cvt_share(12, 128 * CVT_PER_T);
constexpr int CVT_AHEAD = CVT_TAIL_B + CVT_TAIL_D + CVT_TAIL_A + CVT_TAIL_T, CVT_P0 = DEPTH * (CVT_TOT_L - CVT_AHEAD) + CVT_TAIL_D;
static_assert(CVT_TOT_L - CVT_AHEAD + CVT_TAIL_D >= 8 * 52 + 8 * 16, "a layer's in-proj / out-proj tiles must be converted before its own windows");
template <int KIND> DI int cvt_tile_id(int q, int layer) {
    if (KIND == 0) return q;
    return CVT_P0 + layer * CVT_AHEAD + (KIND == 3 ? 0 : (KIND == 1 ? CVT_TAIL_A : (KIND == 4 ? CVT_TAIL_A + CVT_TAIL_B : CVT_TAIL_A + CVT_TAIL_B + CVT_TAIL_T))) + q;
}
template <int KIND> DI void cvt_stream(const Params& p, const WS& w, char* smem, int layer, int rank, int nranks) {
    float* tile = (float*)smem;
    constexpr int total = KIND == 0 ? CVT_P0 : (KIND == 1 ? CVT_TAIL_B : (KIND == 2 ? CVT_TAIL_D : (KIND == 3 ? CVT_TAIL_A : CVT_TAIL_T)));
    const int tid = tidx(); int q = rank;
    if (q < total) {
        CvtJob j = cvt_job(p, w, cvt_tile_id<KIND>(q, layer)); float v[16];
        CVT_LOAD(j, v);
        for (;;) {
#pragma unroll
            for (int i = 0; i < 16; ++i) { const int idx = tid + NT * i, kk = idx >> 6, cc = idx & 63; tile[kk * 65 + cc] = v[i] * j.scale; }
            const int qn = q + nranks; CvtJob jn = j;
            if (qn < total) { jn = cvt_job(p, w, cvt_tile_id<KIND>(qn, layer)); CVT_LOAD(jn, v); }
            LDS_BARRIER();
            if (j.mode == 2) {
#pragma unroll
                for (int i = 0; i < 4; ++i) { const int idx = tid + NT * i, cc = idx >> 5, kq = idx & 31;
                    *(unsigned*)(j.dst + (size_t)cc * j.dst_ld + 4 * kq) = pk4_fp8(tile[(4 * kq) * 65 + cc], tile[(4 * kq + 1) * 65 + cc], tile[(4 * kq + 2) * 65 + cc], tile[(4 * kq + 3) * 65 + cc]); }
            } else {
#pragma unroll
                for (int i = 0; i < 8; ++i) { const int idx = tid + NT * i, cc = idx >> 6, kp = idx & 63;
                    const int pc = j.mode == 1 ? 32 * ((cc >> 4) & 1) + 8 * ((cc >> 2) & 3) + 4 * (cc >> 5) + (cc & 3) : (j.mode == 3 ? 32 * (cc >> 5) + 8 * ((cc >> 2) & 3) + 4 * ((cc >> 4) & 1) + (cc & 3) : cc);
                    *(unsigned*)(j.dst + (size_t)pc * j.dst_ld + 4 * kp) = pk2(tile[(2 * kp) * 65 + cc], tile[(2 * kp + 1) * 65 + cc]); }
            }
            LDS_BARRIER();
            if (qn >= total) break;
            q = qn; j = jn;
        }
    }
    __syncthreads();
}
DI void phase_cvt(const Params& p, char* smem) {
    const WS w = ws_of(p.ws);
    cvt_stream<0>(p, w, smem, 0, bidx(), gridDim.x);
    for (int i = bidx() * NT + tidx(); i < SEQ * 80; i += gridDim.x * NT) {
        const int n = i / 80, a = i % 80, row = n / 64, col = n % 64; float ang;
        if (a < 32) ang = (float)n * (1.0f / powf(10000.0f, (float)a / 31.0f));
        else if (a < 48) { const int ii = a - 32; ang = (float)(ii < 8 ? row : col) * powf(10000.0f, -(float)(ii & 7) / 8.0f); }
        else { const int ii = a - 48; ang = (float)(ii < 16 ? row : col) * powf(10000.0f, -(float)(ii & 15) / 16.0f); }
        w.tab[2 * i] = cosf(ang); w.tab[2 * i + 1] = sinf(ang);
    }
    float* cond = (float*)smem; float* red = cond + (NB + 1) * 1024;
    __syncthreads();
    for (int i = tidx(); i < (NB + 1) * 1024; i += NT) { const int r = i >> 10, k = i & 1023; const float v = r < NB ? p.c[r * 1024 + k] : p.c_ctx[k]; cond[i] = siluf(v); }
    __syncthreads();
    for (int u = bidx(); u < DEPTH * 96; u += gridDim.x) {
        const int l = u / 96, cg = u % 96, col = tidx() & 63, kg = tidx() >> 6;
        float acc[NB + 1];
#pragma unroll
        for (int r = 0; r <= NB; ++r) acc[r] = 0.f;
        const float* wp = p.ada_w + ((size_t)l * 1024 + kg * 128) * 6144 + cg * 64 + col;
        for (int k = 0; k < 128; ++k) { const float wv = wp[(size_t)k * 6144];
#pragma unroll
            for (int r = 0; r <= NB; ++r) acc[r] += cond[r * 1024 + kg * 128 + k] * wv; }
#pragma unroll
        for (int r = 0; r <= NB; ++r) red[(kg * (NB + 1) + r) * 64 + col] = acc[r];
        __syncthreads();
        for (int i = tidx(); i < (NB + 1) * 64; i += NT) { const int r = i >> 6, cc = i & 63; float s = p.ada_b[l * 6144 + cg * 64 + cc];
#pragma unroll
            for (int g = 0; g < 8; ++g) s += red[(g * (NB + 1) + r) * 64 + cc];
            w.mod[((size_t)l * (NB + 1) + r) * 6144 + cg * 64 + cc] = s; }
        __syncthreads();
    }
}

template <int MODE> DI void phase_rows(const Params& p, int layer, char* smem) {
    const WS w = ws_of(p.ws); float* Wl = (float*)smem;
    const int tid = tidx(), lane = tid & 63, wv = tid >> 6;
    const bool last = (layer == DEPTH - 1);
    __syncthreads();
    if (MODE == 0 || (MODE == 2 && !last)) { const int l2 = MODE == 0 ? 0 : layer + 1;
        for (int i = tid; i < 16 * 1024; i += NT) { const int o = i & 15, k = i >> 4; Wl[o * 1024 + k] = p.w_in[((size_t)l2 * 1024 + k) * INW + 2816 + o]; } }
    if (MODE == 1) for (int i = tid; i < 16 * 1024; i += NT) { const int o = i & 15, k = i >> 4; Wl[o * 1024 + k] = p.router_w[((size_t)layer * 1024 + k) * 16 + o]; }
    __syncthreads();
    const int nrows = (MODE != 0 && last) ? RL : R;
    const int nwaves = gridDim.x * 8, chunk = (nrows + nwaves - 1) / nwaves, row_beg = (bidx() * 8 + wv) * chunk, row_end = row_beg + chunk < nrows ? row_beg + chunk : nrows;
    if (row_beg >= row_end) return;
    f32x4 lg4[4], lb4[4], mg4[4], m04[4], m14[4];
    if (MODE != 0) { const float* lg = p.ln_g + ((size_t)layer * 2 + (MODE == 1 ? 0 : 1)) * 1024; const float* lb = p.ln_b + ((size_t)layer * 2 + (MODE == 1 ? 0 : 1)) * 1024;
#pragma unroll
        for (int j = 0; j < 4; ++j) { lg4[j] = *(const f32x4*)(lg + 256 * j + 4 * lane); lb4[j] = *(const f32x4*)(lb + 256 * j + 4 * lane); } }
    int bcur = -1;
    const int lm = MODE == 2 ? layer + 1 : (MODE == 0 ? 0 : layer);
    const bool write_u = !(MODE == 2 && last);
    auto batch_of = [&](int r) { return r >= RL ? NB : r / SEQ; };
    unsigned short* h_hi = (unsigned short*)w.h; unsigned char* h_lo = (unsigned char*)w.h + (size_t)R * 2048;
    f32x4 hn[2][4]; u32x2 hh[2][4]; unsigned hl[2][4]; u32x2 bn[2][4]; int invn[2] = {-1, -1};
#define ROW_FETCH(Q, ROW) do { const int r_ = (ROW); const bool isc_ = r_ >= RL; \
        const float* src_ = MODE == 0 ? (isc_ ? p.ctx + (size_t)(r_ - RL) * 1024 : p.x + (size_t)r_ * 1024) : w.h + (size_t)r_ * 1024; \
        if (MODE == 0) { _Pragma("unroll") for (int j = 0; j < 4; ++j) hn[Q][j] = NT_LOAD((const f32x4*)(src_ + 256 * j + 4 * lane)); } \
        else { _Pragma("unroll") for (int j = 0; j < 4; ++j) { hh[Q][j] = NT_LOAD((const u32x2*)(h_hi + (size_t)r_ * 1024 + 256 * j + 4 * lane)); hl[Q][j] = NT_LOAD((const unsigned*)(h_lo + (size_t)r_ * 1024 + 256 * j + 4 * lane)); } } \
        if (MODE == 1) { _Pragma("unroll") for (int j = 0; j < 4; ++j) bn[Q][j] = NT_LOAD((const u32x2*)(w.mixo + (size_t)r_ * 1024 + 256 * j + 4 * lane)); } \
        if (MODE == 2) invn[Q] = lane < 16 ? w.inv[(size_t)r_ * 16 + lane] : -1; } while (0)
    int row = row_beg, nr = (row + 1 < row_end && batch_of(row + 1) == batch_of(row)) ? 2 : 1;
    ROW_FETCH(0, row); ROW_FETCH(1, nr == 2 ? row + 1 : row);
    while (row < row_end) {
        const bool isc = row >= RL; const int b = isc ? NB : row / SEQ;
        if (b != bcur) { bcur = b;
            if (MODE != 0) { const float* mg = w.mod + ((size_t)layer * (NB + 1) + b) * 6144 + (MODE == 1 ? 2 : 5) * 1024;
#pragma unroll
                for (int j = 0; j < 4; ++j) mg4[j] = *(const f32x4*)(mg + 256 * j + 4 * lane); }
            if (write_u) { const float* m0 = w.mod + ((size_t)lm * (NB + 1) + b) * 6144 + (MODE == 1 ? 3 : 0) * 1024;
#pragma unroll
                for (int j = 0; j < 4; ++j) { m04[j] = *(const f32x4*)(m0 + 256 * j + 4 * lane); m14[j] = *(const f32x4*)(m0 + 1024 + 256 * j + 4 * lane); } } }
        f32x4 hv[2][4]; u32x2 bc[2][4]; int myinv[2];
#pragma unroll
        for (int q = 0; q < 2; ++q) { myinv[q] = invn[q];
#pragma unroll
            for (int j = 0; j < 4; ++j) { bc[q][j] = bn[q][j];
                if (MODE == 0) hv[q][j] = hn[q][j];
                else { const u32x2 a_ = hh[q][j]; const unsigned b_ = hl[q][j];
                    hv[q][j] = (f32x4){__uint_as_float((a_[0] << 16) | ((b_ & 0xffu) << 8)), __uint_as_float((a_[0] & 0xffff0000u) | (b_ & 0xff00u)),
                                       __uint_as_float((a_[1] << 16) | ((b_ >> 8) & 0xff00u)), __uint_as_float((a_[1] & 0xffff0000u) | ((b_ >> 16) & 0xff00u))}; } } }
        const int row_cur = row, nr_cur = nr;
        row += nr;
        if (row < row_end) { nr = (row + 1 < row_end && batch_of(row + 1) == batch_of(row)) ? 2 : 1; ROW_FETCH(0, row); ROW_FETCH(1, nr == 2 ? row + 1 : row); }
        f32x4 uv[2][4];
#pragma unroll
        for (int q = 0; q < 2; ++q) {
            const int rw_ = row_cur + (q < nr_cur ? q : 0);
            if (MODE != 0) {
                f32x4 br[4];
                if (MODE == 1) {
#pragma unroll
                    for (int j = 0; j < 4; ++j) br[j] = (f32x4){__uint_as_float(bc[q][j][0] << 16), __uint_as_float(bc[q][j][0] & 0xffff0000u), __uint_as_float(bc[q][j][1] << 16), __uint_as_float(bc[q][j][1] & 0xffff0000u)};
                } else {
#pragma unroll
                    for (int j = 0; j < 4; ++j) br[j] = (f32x4){0.f, 0.f, 0.f, 0.f};
                    for (int e = 0; e < 16; ++e) { const int sl = lane_bcast(myinv[q], e);
                        if (sl >= 0) { const unsigned char* yr = w.y + ((size_t)e * ROWS_E + sl) * 1024;
#pragma unroll
                            for (int j = 0; j < 4; ++j) { const int v = (int)NT_LOAD((const unsigned*)(yr + 256 * j + 4 * lane));
                                const auto lo_ = __builtin_amdgcn_cvt_pk_f32_fp8(v, false), hi_ = __builtin_amdgcn_cvt_pk_f32_fp8(v, true);
                                br[j][0] += lo_[0]; br[j][1] += lo_[1]; br[j][2] += hi_[0]; br[j][3] += hi_[1]; } } }
#pragma unroll
                    for (int j = 0; j < 4; ++j) br[j] = br[j] * (1.0f / SY);
                }
                float sm_ = 0.f;
#pragma unroll
                for (int j = 0; j < 4; ++j) { hv[q][j] = ALPHA * hv[q][j] + mg4[j] * br[j]; sm_ += hv[q][j][0] + hv[q][j][1] + hv[q][j][2] + hv[q][j][3]; }
                const float mean = wsum(sm_) * (1.0f / 1024.0f); float qq = 0.f;
#pragma unroll
                for (int j = 0; j < 4; ++j) { hv[q][j] = hv[q][j] - mean; qq += hv[q][j][0] * hv[q][j][0] + hv[q][j][1] * hv[q][j][1] + hv[q][j][2] * hv[q][j][2] + hv[q][j][3] * hv[q][j][3]; }
                const float rstd = 1.0f / sqrtf(wsum(qq) * (1.0f / 1024.0f) + 1e-5f);
#pragma unroll
                for (int j = 0; j < 4; ++j) hv[q][j] = hv[q][j] * rstd * lg4[j] + lb4[j];
            }
            if (q < nr_cur) {
                if (MODE == 2 && last) {
#pragma unroll
                    for (int j = 0; j < 4; ++j) *(f32x4*)(p.out + (size_t)rw_ * 1024 + 256 * j + 4 * lane) = hv[q][j];
                } else {
#pragma unroll
                    for (int j = 0; j < 4; ++j) { const unsigned u0 = __float_as_uint(hv[q][j][0]) + 0x80u, u1 = __float_as_uint(hv[q][j][1]) + 0x80u, u2 = __float_as_uint(hv[q][j][2]) + 0x80u, u3 = __float_as_uint(hv[q][j][3]) + 0x80u;
                        u32x2 a_; a_[0] = (u0 >> 16) | (u1 & 0xffff0000u); a_[1] = (u2 >> 16) | (u3 & 0xffff0000u);
                        const unsigned b_ = ((u0 >> 8) & 0xffu) | (u1 & 0xff00u) | ((u2 << 8) & 0xff0000u) | ((u3 << 16) & 0xff000000u);
                        NT_STORE(a_, (u32x2*)(h_hi + (size_t)rw_ * 1024 + 256 * j + 4 * lane)); NT_STORE(b_, (unsigned*)(h_lo + (size_t)rw_ * 1024 + 256 * j + 4 * lane)); }
                }
            }
#pragma unroll
            for (int j = 0; j < 4; ++j) { uv[q][j] = hv[q][j] * (1.0f + m14[j]) + m04[j];
                if (write_u && q < nr_cur) { if (MODE == 1) *(unsigned*)(w.u8 + (size_t)rw_ * 1024 + 256 * j + 4 * lane) = pk4_fp8(uv[q][j][0], uv[q][j][1], uv[q][j][2], uv[q][j][3]);
                    else { u32x2 o; o[0] = pk2(uv[q][j][0], uv[q][j][1]); o[1] = pk2(uv[q][j][2], uv[q][j][3]); *(u32x2*)(w.u + (size_t)rw_ * 1024 + 256 * j + 4 * lane) = o; } } }
        }
        if (!write_u) continue;
        float lgt[2][16];
#pragma unroll
        for (int o = 0; o < 16; ++o) { float a0 = 0.f, a1 = 0.f;
#pragma unroll
            for (int j = 0; j < 4; ++j) { const f32x4 wv4 = *(const f32x4*)(Wl + o * 1024 + 256 * j + 4 * lane);
                a0 += uv[0][j][0] * wv4[0] + uv[0][j][1] * wv4[1] + uv[0][j][2] * wv4[2] + uv[0][j][3] * wv4[3]; a1 += uv[1][j][0] * wv4[0] + uv[1][j][1] * wv4[1] + uv[1][j][2] * wv4[2] + uv[1][j][3] * wv4[3]; }
            lgt[0][o] = wsum(a0); lgt[1][o] = wsum(a1); SCHED; }
#pragma unroll
        for (int q = 0; q < 2; ++q) {
            if (q >= nr_cur) continue;
            const int rw_ = row_cur + q; float mine = 0.f;
            if (MODE == 1) { float mx = lgt[q][0];
#pragma unroll
                for (int o = 1; o < 16; ++o) mx = fmaxf(mx, lgt[q][o]);
                float sm = 0.f;
#pragma unroll
                for (int o = 0; o < 16; ++o) { lgt[q][o] = __expf(lgt[q][o] - mx); sm += lgt[q][o]; }
                const float inv = 1.0f / sm;
#pragma unroll
                for (int o = 0; o < 16; ++o) if (lane == o) mine = lgt[q][o] * inv;
                if (lane < 16) { if (rw_ < RL) { const int bb = rw_ / SEQ, n = rw_ % SEQ; w.aff[((size_t)bb * 16 + lane) * SEQ + n] = mine; }
                                 else { const int rr = rw_ - RL, bb = rr / CTX, n = rr % CTX; w.aff[(size_t)RL * 16 + ((size_t)bb * 16 + lane) * CTX + n] = mine; } }
            } else {
#pragma unroll
                for (int o = 0; o < 16; ++o) if (lane == o) mine = lgt[q][o];
                if (lane < 16) w.gab[(size_t)rw_ * 16 + lane] = mine;
            }
        }
    }
#undef ROW_FETCH
}

constexpr int G_HT = 128 * 64;
DI int lds_byte(int r, int c) { const int st = (r >> 4) * 2 + (c >> 5), rr = r & 15, cc = c & 31, ob = rr * 64 + cc * 2; return st * 1024 + (ob ^ (((ob >> 9) & 1) << 5)); }
DI void stage_rc(int b, int& Rr, int& Cc) { const int st = b / 1024, sb = b % 1024, swz = sb ^ (((sb >> 9) & 1) << 5); Rr = (st >> 1) * 16 + swz / 64; Cc = (st & 1) * 32 + (swz % 64) / 2; }
#define GLDS16(g, l) __builtin_amdgcn_global_load_lds((const unsigned*)(g), (unsigned*)(l), 16, 0, 0)

struct EpiArgs { void* out; int ld; long orow0; const float* wgt; const float* tab; int kind0, kind1; float sc0, sc1; };
template <int EPI, bool GATHER>
DI void gemm_unit(const bf16_t* __restrict__ A, const bf16_t* __restrict__ Bt, const int K, const int brow, const int bcol, const int* __restrict__ gidx, const EpiArgs ea, char* smem) {
    bf16_t* shm = (bf16_t*)smem;
#define SA(b, h) (shm + ((b) * 2 + (h)) * G_HT)
#define SB(b, h) (shm + (4 + (b) * 2 + (h)) * G_HT)
#define STAGE_B(T, P, h, kt) do { _Pragma("unroll") for (int _i = 0; _i < 2; ++_i) { const int _b = (T) * 16 + _i * 8192; int _r, _c; stage_rc(_b, _r, _c); \
        GLDS16(Bt + (unsigned)((bcol + (h) * 128 + _r) * K + (kt) * 64 + _c), (char*)(P) + _b); } } while (0)
#define STAGE_A(T, P, h, kt) do { _Pragma("unroll") for (int _i = 0; _i < 2; ++_i) { const int _b = (T) * 16 + _i * 8192; int _r, _c; stage_rc(_b, _r, _c); \
        const int _ro = GATHER ? rid[h][_i] : (brow + (h) * 128 + _r); GLDS16(A + (unsigned)(_ro * K + (kt) * 64 + _c), (char*)(P) + _b); } } while (0)
#define LDA(dst, b, h) _Pragma("unroll") for (int m = 0; m < 4; ++m) _Pragma("unroll") for (int k = 0; k < 2; ++k) \
        dst[m][k] = *reinterpret_cast<const bf16x8*>((char*)SA(b, h) + lds_byte(wr * 64 + m * 16 + fr, k * 32 + fq * 8))
#define LDB(dst, b, h) _Pragma("unroll") for (int n = 0; n < 2; ++n) _Pragma("unroll") for (int k = 0; k < 2; ++k) \
        dst[n][k] = *reinterpret_cast<const bf16x8*>((char*)SB(b, h) + lds_byte(wc * 32 + n * 16 + fr, k * 32 + fq * 8))
#define MMA(ai, bj, At_, Bt_) do { __builtin_amdgcn_s_setprio(1); \
        _Pragma("unroll") for (int m = 0; m < 4; ++m) _Pragma("unroll") for (int n = 0; n < 2; ++n) _Pragma("unroll") for (int k = 0; k < 2; ++k) \
            acc[ai][bj][m][n] = MFMA16(Bt_[n][k], At_[m][k], acc[ai][bj][m][n]); \
        __builtin_amdgcn_s_setprio(0); } while (0)
    int tid = tidx();
#ifndef EMU
    asm volatile("" : "+v"(tid));
#endif
    int wid = tid >> 6, lane = tid & 63, wr = wid >> 2, wc = wid & 3, fr = lane & 15, fq = lane >> 4;
    int rid[2][2];
    if (GATHER) {
#pragma unroll
        for (int h = 0; h < 2; ++h)
#pragma unroll
            for (int i = 0; i < 2; ++i) { int r_, c_; stage_rc(tid * 16 + i * 8192, r_, c_); rid[h][i] = gidx[h * 128 + r_]; }
    }
    f32x4 acc[2][2][4][2];
#pragma unroll
    for (int a = 0; a < 2; ++a)
#pragma unroll
        for (int b = 0; b < 2; ++b)
#pragma unroll
            for (int m = 0; m < 4; ++m)
#pragma unroll
                for (int n = 0; n < 2; ++n) acc[a][b][m][n] = (f32x4){0.f, 0.f, 0.f, 0.f};
    bf16x8 At[4][2], B0[2][2], B1[2][2];
    const int nt = K / 64;
    STAGE_B(tid, SB(0, 0), 0, 0); STAGE_A(tid, SA(0, 0), 0, 0);
    STAGE_B(tid, SB(0, 1), 1, 0); STAGE_A(tid, SA(0, 1), 1, 0);
    if (wr == 1) BAR;
    WAIT_V(4); BAR;
    STAGE_B(tid, SB(1, 0), 0, 1); STAGE_A(tid, SA(1, 0), 0, 1); STAGE_B(tid, SB(1, 1), 1, 1);
    WAIT_V(6); BAR;
    for (int t = 0; t < nt - 2; t += 2) {
        LDB(B0, 0, 0); SCHED; LDA(At, 0, 0); STAGE_A(tid, SA(1, 1), 1, t + 1);
        WAIT_L(8); BAR; WAIT_L(0); MMA(0, 0, At, B0); BAR; SCHED;
        LDB(B1, 0, 1); STAGE_B(tid, SB(0, 0), 0, t + 2);
        BAR; WAIT_L(0); MMA(0, 1, At, B1); BAR;
        LDA(At, 0, 1); STAGE_A(tid, SA(0, 0), 0, t + 2);
        BAR; WAIT_L(0); MMA(1, 0, At, B0); BAR; SCHED;
        STAGE_B(tid, SB(0, 1), 1, t + 2);
        WAIT_V(6); BAR; MMA(1, 1, At, B1); BAR;
        LDB(B0, 1, 0); SCHED; LDA(At, 1, 0); STAGE_A(tid, SA(0, 1), 1, t + 2);
        WAIT_L(8); BAR; WAIT_L(0); MMA(0, 0, At, B0); BAR; SCHED;
        LDB(B1, 1, 1); STAGE_B(tid, SB(1, 0), 0, t + 3);
        BAR; WAIT_L(0); MMA(0, 1, At, B1); BAR;
        LDA(At, 1, 1); STAGE_A(tid, SA(1, 0), 0, t + 3);
        BAR; WAIT_L(0); MMA(1, 0, At, B0); BAR; SCHED;
        STAGE_B(tid, SB(1, 1), 1, t + 3);
        WAIT_V(6); BAR; MMA(1, 1, At, B1); BAR;
    }
    int tz = tidx();
#ifndef EMU
    asm volatile("" : "+v"(tz));
#endif
    wid = tz >> 6; lane = tz & 63; wr = wid >> 2; wc = wid & 3; fr = lane & 15; fq = lane >> 4;
    { LDB(B0, 0, 0); WAIT_V(0); LDA(At, 0, 0); STAGE_A(tz, SA(1, 1), 1, nt - 1);
      BAR; WAIT_L(0); MMA(0, 0, At, B0); BAR;
      LDB(B1, 0, 1); BAR; WAIT_L(0); MMA(0, 1, At, B1); BAR;
      LDA(At, 0, 1); WAIT_V(4); BAR; WAIT_L(0); MMA(1, 0, At, B0); MMA(1, 1, At, B1); BAR; }
    { LDB(B0, 1, 0); LDA(At, 1, 0); WAIT_V(2); BAR; WAIT_L(0); MMA(0, 0, At, B0); BAR;
      LDB(B1, 1, 1); WAIT_V(0); BAR; WAIT_L(0); MMA(0, 1, At, B1); BAR;
      LDA(At, 1, 1); BAR; WAIT_L(0); MMA(1, 0, At, B0); MMA(1, 1, At, B1); BAR; }
    if (wr == 0) BAR;
#pragma unroll
    for (int ai = 0; ai < 2; ++ai)
#pragma unroll
        for (int m = 0; m < 4; ++m) {
            const int lrow = ai * 128 + wr * 64 + m * 16 + fr; const long orow = ea.orow0 + lrow;
            float wg = 1.0f; if (EPI == 3) wg = ea.wgt[lrow];
            if (EPI == 4) {
                const bool isc = orow >= RL; const int tokn = isc ? 0 : (int)(orow % SEQ);
#pragma unroll
                for (int bj = 0; bj < 2; ++bj) { const int kind = bj ? ea.kind1 : ea.kind0; const float sc = bj ? ea.sc1 : ea.sc0;
                    f32x4 x1 = acc[ai][bj][m][0], x2 = acc[ai][bj][m][1];
                    if (kind != 0) {
                        f32x4 t0 = (f32x4){1.f, 0.f, 1.f, 0.f}, t1 = t0;
                        if (!isc) { const int a0 = (kind == 1 ? 0 : (kind == 2 ? 32 : 48)) + (kind != 2 ? (wc & 1) * 16 : 0) + fq * 4; const float* tp = ea.tab + ((size_t)tokn * 80 + a0) * 2; t0 = *(const f32x4*)tp; t1 = *(const f32x4*)(tp + 4); }
                        const f32x4 cs = (f32x4){t0[0], t0[2], t1[0], t1[2]} * sc, sn = (f32x4){t0[1], t0[3], t1[1], t1[3]} * sc;
                        const f32x4 y1 = x1 * cs - x2 * sn, y2 = x1 * sn + x2 * cs; x1 = y1; x2 = y2;
                    }
                    const int col = bcol + bj * 128 + wc * 32 + fq * 4; bf16_t* op = (bf16_t*)ea.out + (size_t)orow * ea.ld + col;
                    u32x2 o; o[0] = pk2(x1[0], x1[1]); o[1] = pk2(x1[2], x1[3]); *(u32x2*)op = o; o[0] = pk2(x2[0], x2[1]); o[1] = pk2(x2[2], x2[3]); *(u32x2*)(op + 16) = o; }
                continue;
            }
#pragma unroll
            for (int n = 0; n < 2; ++n) {
                if (EPI == 2) { const f32x4 g = acc[ai][0][m][n], u = acc[ai][1][m][n]; const int col = (bcol >> 1) + wc * 32 + n * 16 + fq * 4;
                    u32x2 o; o[0] = pk2(siluf(g[0]) * u[0], siluf(g[1]) * u[1]); o[1] = pk2(siluf(g[2]) * u[2], siluf(g[3]) * u[3]);
                    *(u32x2*)((bf16_t*)ea.out + (size_t)orow * ea.ld + col) = o;
                } else {
#pragma unroll
                    for (int bj = 0; bj < 2; ++bj) { const f32x4 v = acc[ai][bj][m][n]; const int col = bcol + bj * 128 + wc * 32 + n * 16 + fq * 4;
                        if (EPI == 1) *(f32x4*)((float*)ea.out + (size_t)orow * ea.ld + col) = v;
                        else { u32x2 o; o[0] = pk2(v[0] * wg, v[1] * wg); o[1] = pk2(v[2] * wg, v[3] * wg); *(u32x2*)((bf16_t*)ea.out + (size_t)orow * ea.ld + col) = o; } }
                }
            }
        }
    __syncthreads();
#undef SA
#undef SB
#undef STAGE_A
#undef STAGE_B
#undef LDA
#undef LDB
#undef MMA
}

struct GUnit { const char* B; const int* gidx; const float* wgt; long orow0; int brow, bcol, pn; };
DI bool tile_order(int i, int G, int c, int nM, int nN, int& pm, int& pn) {
    const int nwg = nM * nN; const long L = (long)i * G + c; if (L >= nwg) return false;
    int wgid = (int)L; { const int q = nwg / 8, r = nwg % 8, xcd = wgid % 8, off = wgid / 8; wgid = (xcd < r ? xcd * (q + 1) : r * (q + 1) + (xcd - r) * q) + off; }
    const int nig = 8 * nN, gid = wgid / nig, fm = gid * 8, gsz = (nM - fm) < 8 ? (nM - fm) : 8;
    pm = fm + ((wgid % nig) % gsz); pn = (wgid % nig) / gsz; return true;
}
DI int moe_tiles(int layer) { return layer == DEPTH - 1 ? (NB * CAPL + 255) / 256 : ROWS_E / 256; }
template <int PHK> DI bool gemm_next(const WS& w, int layer, int i, int G, int c, GUnit& u) {
    int pm, pn; u.gidx = nullptr; u.wgt = nullptr;
    if (PHK == 0) { if (!tile_order(i, G, c, R / 256, PW / 256, pm, pn)) return false; u.B = (const char*)(w.win + (size_t)layer * PW * 1024 + (size_t)pn * 256 * 1024); u.brow = pm * 256; u.orow0 = (long)pm * 256; }
    else if (PHK == 1) { if (!tile_order(i, G, c, (layer == DEPTH - 1 ? RL : R) / 256, 4, pm, pn)) return false; u.B = (const char*)(w.wout + (size_t)layer * 1024 * 1024 + (size_t)pn * 256 * 1024); u.brow = pm * 256; u.orow0 = (long)pm * 256; }
    else { const int tm = moe_tiles(layer); constexpr int nN = PHK == 2 ? 2 * FF / 256 : 4;
        if (!tile_order(i, G, c, 16 * tm, nN, pm, pn)) return false;
        constexpr int TM_FULL = ROWS_E / 256, TM_LAST = (NB * CAPL + 255) / 256;
        int e, pme; if (layer == DEPTH - 1) { e = pm / TM_LAST; pme = pm % TM_LAST; } else { e = pm / TM_FULL; pme = pm % TM_FULL; }
        u.orow0 = (long)e * ROWS_E + pme * 256; u.brow = e * ROWS_E + pme * 256;
        if (PHK == 2) { u.B = (const char*)(w.wgu + (size_t)(layer * 16 + e) * 2 * FF * 1024 + (size_t)pn * 256 * 1024); u.gidx = w.idx + (size_t)e * ROWS_E + pme * 256; }
        else { u.B = (const char*)(w.wdn + (size_t)(layer * 16 + e) * 1024 * FF + (size_t)pn * 256 * FF); u.wgt = w.wgt + (size_t)e * ROWS_E + pme * 256; } }
    u.bcol = pn * 256; u.pn = pn; return true;
}
template <int PHK> DI void gemm_stream(const Params& p, int layer, char* smem) {
    constexpr bool GATHER = PHK == 2, FP8 = PHK >= 2;       constexpr int K = PHK == 2 ? 1024 : (PHK == 3 ? FF : 2048)  , nt = K / 128;
    const WS w = ws_of(p.ws); bf16_t* shm = (bf16_t*)smem;
    const char* Abase = PHK == 0 ? (const char*)w.u : (PHK == 1 ? (const char*)w.mix : (PHK == 2 ? (const char*)w.u8 : (const char*)w.hid));
    const int G = gridDim.x, c = bidx();
    int tid = tidx();
    int wid = tid >> 6, lane = tid & 63, wr = wid >> 2, wc = wid & 3, fr = lane & 15, fq = lane >> 4;
    GUnit cur, nxt;
    if (!gemm_next<PHK>(w, layer, 0, G, c, cur)) return;
    unsigned voff[2];
#pragma unroll
    for (int i = 0; i < 2; ++i) { int R_, C_; stage_rc(tid * 16 + i * 8192, R_, C_); voff[i] = (unsigned)(R_ * K + C_ * 2); }
    u32x4 ga = (u32x4){0u, 0u, 0u, 0u};
    unsigned gc2[2];
#pragma unroll
    for (int i = 0; i < 2; ++i) { int R_, C_; stage_rc(tid * 16 + i * 8192, R_, C_); gc2[i] = (unsigned)C_ * 2u; }
#define G_GOFF(dst, U) do { _Pragma("unroll") for (int h_ = 0; h_ < 2; ++h_) _Pragma("unroll") for (int i_ = 0; i_ < 2; ++i_) { int R_, C_; stage_rc(tid * 16 + i_ * 8192, R_, C_); \
        dst[h_ * 2 + i_] = (unsigned)(U).gidx[h_ * 128 + R_]; } } while (0)
    if (GATHER) G_GOFF(ga, cur);
    const int* idbuf = (const int*)(smem + 8 * G_HT * 2 + 1024);
#ifdef EMU
#define UBASE(p)
#else
#define UBASE(p) asm volatile("" : "+s"(p))
#endif
#define SA(b, h) (shm + ((b) * 2 + (h)) * G_HT)
#define SB(b, h) (shm + (4 + (b) * 2 + (h)) * G_HT)
#define STG_A(P, U, GAo, h, koff) do { _Pragma("unroll") for (int _i = 0; _i < 2; ++_i) { \
        const char* ub_ = GATHER ? Abase + (size_t)(koff) : Abase + ((size_t)((U).brow + (h) * 128) * K + (koff)); UBASE(ub_); GLDS16(ub_ + (GATHER ? (GAo)[(h) * 2 + _i] * (unsigned)K + gc2[_i] : voff[_i]), (char*)(P) + tid * 16 + _i * 8192); } } while (0)
#define STG_B(P, BP, h, koff) do { _Pragma("unroll") for (int _i = 0; _i < 2; ++_i) { const char* ub_ = (BP) + ((size_t)(h) * 128 * K + (koff)); UBASE(ub_); GLDS16(ub_ + voff[_i], (char*)(P) + tid * 16 + _i * 8192); } } while (0)
#define LDA(dst, b, h) _Pragma("unroll") for (int m = 0; m < 4; ++m) { \
        const u32x4 lo_ = *reinterpret_cast<const u32x4*>((char*)SA(b, h) + lds_byte(wr * 64 + m * 16 + fr, fq * 8)), hi_ = *reinterpret_cast<const u32x4*>((char*)SA(b, h) + lds_byte(wr * 64 + m * 16 + fr, 32 + fq * 8)); \
        dst[m] = __builtin_shufflevector(lo_, hi_, 0, 1, 2, 3, 4, 5, 6, 7); }
#define LDB_ROW(n) (wc * 32 + 8 * (fr >> 2) + 4 * (n) + (fr & 3))
#define LDB(dst, b, h) _Pragma("unroll") for (int n = 0; n < 2; ++n) { \
        const u32x4 lo_ = *reinterpret_cast<const u32x4*>((char*)SB(b, h) + lds_byte(LDB_ROW(n), fq * 8)), hi_ = *reinterpret_cast<const u32x4*>((char*)SB(b, h) + lds_byte(LDB_ROW(n), 32 + fq * 8)); \
        dst[n] = __builtin_shufflevector(lo_, hi_, 0, 1, 2, 3, 4, 5, 6, 7); }
#define MMA(ai, bj, At_, Bt_) do { __builtin_amdgcn_s_setprio(1); \
        _Pragma("unroll") for (int m = 0; m < 4; ++m) _Pragma("unroll") for (int n = 0; n < 2; ++n) { \
            if (FP8) acc[ai][bj][m][n] = mfma_fp8(Bt_[n], At_[m], acc[ai][bj][m][n]);     \
            else { acc[ai][bj][m][n] = MFMA16(frag_lo(Bt_[n]), frag_lo(At_[m]), acc[ai][bj][m][n]); acc[ai][bj][m][n] = MFMA16(frag_hi(Bt_[n]), frag_hi(At_[m]), acc[ai][bj][m][n]); } } \
        __builtin_amdgcn_s_setprio(0); } while (0)
#define K_TILE_PAIR(UA2, GA2, B2, k1, k2, k3) do { \
            LDB(B0, 0, 0); SCHED; LDA(At, 0, 0); STG_A(SA(1, 1), cur, ga, 1, k1); \
            WAIT_L(8); BAR; WAIT_L(0); MMA(0, 0, At, B0); BAR; SCHED; \
            LDB(B1, 0, 1); STG_B(SB(0, 0), B2, 0, k2); \
            BAR; WAIT_L(0); MMA(0, 1, At, B1); BAR; \
            LDA(At, 0, 1); STG_A(SA(0, 0), UA2, GA2, 0, k2); \
            BAR; WAIT_L(0); MMA(1, 0, At, B0); BAR; SCHED; \
            STG_B(SB(0, 1), B2, 1, k2); \
            WAIT_V(6); BAR; MMA(1, 1, At, B1); BAR; \
            LDB(B0, 1, 0); SCHED; LDA(At, 1, 0); STG_A(SA(0, 1), UA2, GA2, 1, k2); \
            WAIT_L(8); BAR; WAIT_L(0); MMA(0, 0, At, B0); BAR; SCHED; \
            LDB(B1, 1, 1); STG_B(SB(1, 0), B2, 0, k3); \
            BAR; WAIT_L(0); MMA(0, 1, At, B1); BAR; \
            LDA(At, 1, 1); STG_A(SA(1, 0), UA2, GA2, 0, k3); \
            BAR; WAIT_L(0); MMA(1, 0, At, B0); BAR; SCHED; \
            STG_B(SB(1, 1), B2, 1, k3); \
            WAIT_V(6); BAR; MMA(1, 1, At, B1); BAR; } while (0)
    f32x4 acc[2][2][4][2];
#pragma unroll
    for (int a = 0; a < 2; ++a)
#pragma unroll
        for (int b = 0; b < 2; ++b)
#pragma unroll
            for (int m = 0; m < 4; ++m)
#pragma unroll
                for (int n = 0; n < 2; ++n) acc[a][b][m][n] = (f32x4){0.f, 0.f, 0.f, 0.f};
    u32x8 At[4], B0[2], B1[2];
    __syncthreads();
    STG_B(SB(0, 0), cur.B, 0, 0); STG_A(SA(0, 0), cur, ga, 0, 0); STG_B(SB(0, 1), cur.B, 1, 0); STG_A(SA(0, 1), cur, ga, 1, 0);
    if (wr == 1) BAR;
    WAIT_V(4); BAR;
    STG_B(SB(1, 0), cur.B, 0, 128); STG_A(SA(1, 0), cur, ga, 0, 128); STG_B(SB(1, 1), cur.B, 1, 128);
    WAIT_V(6); BAR;
    for (int ui = 0;; ++ui) {
#pragma unroll
        for (int i = 0; i < 2; ++i) { int R_, C_; stage_rc(tid * 16 + i * 8192, R_, C_); voff[i] = (unsigned)(R_ * K + C_ * 2); gc2[i] = (unsigned)C_ * 2u; }
        const bool has_next = gemm_next<PHK>(w, layer, ui + 1, G, c, nxt);
        if (!has_next) nxt = cur;
        u32x4 gn = ga;
#pragma unroll 1
        for (int t = 0; t < nt; t += 2) {
            const bool lastp = (t == nt - 2);
            if (GATHER && t == 0 && wid == 0) GLDS16((const char*)nxt.gidx + lane * 16, (char*)idbuf + lane * 16);
            if (GATHER && t == nt - 4) { _Pragma("unroll") for (int h_ = 0; h_ < 2; ++h_) _Pragma("unroll") for (int i_ = 0; i_ < 2; ++i_) { int R_, C_; stage_rc(tid * 16 + i_ * 8192, R_, C_); gn[h_ * 2 + i_] = (unsigned)idbuf[h_ * 128 + R_]; } }
#ifndef EMU
#endif
            GUnit u2 = cur; u32x4 g2 = ga; if (lastp) { u2 = nxt; g2 = gn; }
            const int k2 = lastp ? 0 : (t + 2) * 128;
            K_TILE_PAIR(u2, g2, u2.B, (t + 1) * 128, k2, k2 + 128);
        }
#ifndef EMU
        asm volatile("" : "+v"(tid));
#endif
        wid = tid >> 6; lane = tid & 63; wr = wid >> 2; wc = wid & 3; fr = lane & 15; fq = lane >> 4;
        const int kd = PHK == 0 ? (cur.pn <= 1 ? 1 : ((cur.pn == 4 || cur.pn == 5) ? 2 : ((cur.pn == 11 || cur.pn == 12) ? 3 : 0))) : 0;
        const float qsc = PHK == 0 ? (cur.pn == 0 ? 0.125f : (cur.pn == 4 ? 0.17677669529663687f * LOG2E : (cur.pn == 11 ? 0.125f * LOG2E : 1.0f))) : 1.0f;
#pragma unroll
        for (int ai = 0; ai < 2; ++ai) {
            f32x4 rt0[4], rt1[4];
            if (PHK == 0 && kd != 0) {
#pragma unroll
                for (int m = 0; m < 4; ++m) { const long orow = cur.orow0 + ai * 128 + wr * 64 + m * 16 + fr; const bool isc = orow >= RL; const int tokn = isc ? 0 : (int)(orow % SEQ);
                    const int a0 = (kd == 1 ? 0 : (kd == 2 ? 32 : 48)) + (kd != 2 ? (wc & 1) * 16 : 0) + fq * 4; const float* tp = w.tab + ((size_t)tokn * 80 + a0) * 2;
                    rt0[m] = *(const f32x4*)tp; rt1[m] = *(const f32x4*)(tp + 4); }
            }
#pragma unroll
            for (int m = 0; m < 4; ++m) {
                const int lrow = ai * 128 + wr * 64 + m * 16 + fr; const long orow = cur.orow0 + lrow;
                if (PHK == 0) {
                    const bool isc = orow >= RL; const int tokn = isc ? 0 : (int)(orow % SEQ);
                    f32x4 cs = (f32x4){qsc, qsc, qsc, qsc}, sn = (f32x4){0.f, 0.f, 0.f, 0.f};
                    if (kd != 0 && !isc) {
                        const f32x4 t0 = rt0[m], t1 = rt1[m]; cs = (f32x4){t0[0], t0[2], t1[0], t1[2]} * qsc; sn = (f32x4){t0[1], t0[3], t1[1], t1[3]} * qsc; }
#pragma unroll
                    for (int bj = 0; bj < 2; ++bj) { const int kind = (cur.pn == 12 && bj == 1) ? 0 : kd;
                        f32x4 x1 = acc[ai][bj][m][0], x2 = acc[ai][bj][m][1];
                        if (kind != 0) { const f32x4 y1 = x1 * cs - x2 * sn, y2 = x1 * sn + x2 * cs; x1 = y1; x2 = y2; }
                        u32x4 o; o[0] = pk2(x1[0], x1[1]); o[1] = pk2(x1[2], x1[3]); o[2] = pk2(x2[0], x2[1]); o[3] = pk2(x2[2], x2[3]);
                        *(u32x4*)(w.p + (size_t)orow * PW + cur.bcol + bj * 128 + wc * 32 + fq * 8) = o; }
                } else if (PHK == 2) {
                    const f32x4 g0 = acc[ai][0][m][0] * (1.0f / SW1), u0 = acc[ai][1][m][0] * (SH / SW1), g1 = acc[ai][0][m][1] * (1.0f / SW1), u1 = acc[ai][1][m][1] * (SH / SW1);
                    u32x2 o; o[0] = pk4_fp8(siluf(g0[0]) * u0[0], siluf(g0[1]) * u0[1], siluf(g0[2]) * u0[2], siluf(g0[3]) * u0[3]); o[1] = pk4_fp8(siluf(g1[0]) * u1[0], siluf(g1[1]) * u1[1], siluf(g1[2]) * u1[2], siluf(g1[3]) * u1[3]);
                    *(u32x2*)(w.hid + (size_t)orow * FF + (cur.bcol >> 1) + wc * 32 + fq * 8) = o;
                } else {
                    float wg = 1.0f; if (PHK == 3) wg = cur.wgt[lrow] * (SY / (SH * SW2));
#pragma unroll
                    for (int bj = 0; bj < 2; ++bj) { const f32x4 v0 = acc[ai][bj][m][0], v1 = acc[ai][bj][m][1];
                        if (PHK == 3) { u32x2 o; o[0] = pk4_fp8(v0[0] * wg, v0[1] * wg, v0[2] * wg, v0[3] * wg); o[1] = pk4_fp8(v1[0] * wg, v1[1] * wg, v1[2] * wg, v1[3] * wg);
                            *(u32x2*)(w.y + (size_t)orow * 1024 + cur.bcol + bj * 128 + wc * 32 + fq * 8) = o;
                        } else { u32x4 o; o[0] = pk2(v0[0] * wg, v0[1] * wg); o[1] = pk2(v0[2] * wg, v0[3] * wg); o[2] = pk2(v1[0] * wg, v1[1] * wg); o[3] = pk2(v1[2] * wg, v1[3] * wg);
                            *(u32x4*)(w.mixo + (size_t)orow * 1024 + cur.bcol + bj * 128 + wc * 32 + fq * 8) = o; } }
                }
            }
        }
        if (!has_next) break;
#pragma unroll
        for (int a = 0; a < 2; ++a)
#pragma unroll
            for (int b = 0; b < 2; ++b)
#pragma unroll
                for (int m = 0; m < 4; ++m)
#pragma unroll
                    for (int n = 0; n < 2; ++n) acc[a][b][m][n] = (f32x4){0.f, 0.f, 0.f, 0.f};
        cur = nxt;
        ga = gn;
#ifndef EMU
        asm volatile("" : "+v"(tid));
#endif
        wid = tid >> 6; lane = tid & 63; wr = wid >> 2; wc = wid & 3; fr = lane & 15; fq = lane >> 4;
    }
    WAIT_V(0);
    if (wr == 0) BAR;
    BAR;
    __syncthreads();
#undef G_GOFF
#undef K_TILE_PAIR
#undef UBASE
#undef SA
#undef SB
#undef STG_A
#undef STG_B
#undef LDA
#undef LDB
#undef LDB_ROW
#undef MMA
}
DI void cvt_tail_a(const Params& p, int layer, char* smem);
DI void phase_inproj(const Params& p, int layer, char* smem) { gemm_stream<0>(p, layer, smem); cvt_tail_a(p, layer, smem); }
DI void cvt_tail_b(const Params& p, int layer, char* smem) {
    const int G = gridDim.x, rem = (((layer == DEPTH - 1 ? RL : R) / 256) * 4) % G, c = bidx(); if (c < rem) return;
    cvt_stream<1>(p, ws_of(p.ws), smem, layer, c - rem, G - rem);
}
DI void cvt_tail_a(const Params& p, int layer, char* smem) {
    const int G = gridDim.x, rem = ((R / 256) * (PW / 256)) % G, c = bidx(); if (c < rem) return;
    cvt_stream<3>(p, ws_of(p.ws), smem, layer, c - rem, G - rem);
}
DI void cvt_tail_d(const Params& p, int layer, char* smem) {
    if (layer + 1 >= DEPTH) return;
    const int G = gridDim.x, rem = (16 * (ROWS_E / 256) * 4) % G, c = bidx(); if (c < rem) return;
    cvt_stream<2>(p, ws_of(p.ws), smem, layer, c - rem, G - rem);
}
DI void phase_outproj(const Params& p, int layer, char* smem) { gemm_stream<1>(p, layer, smem); cvt_tail_b(p, layer, smem); }
DI void phase_moe1(const Params& p, int layer, char* smem) { gemm_stream<2>(p, layer, smem); }
DI void phase_moe2(const Params& p, int layer, char* smem) { gemm_stream<3>(p, layer, smem); cvt_tail_d(p, layer, smem); }

DI void phase_prep(const Params& p, int layer, char* smem) {
    const WS w = ws_of(p.ws); const int lane = tidx() & 63, wv = tidx() >> 6;
    for (int row = bidx() * 8 + wv; row < R; row += gridDim.x * 8) {
        const bool isc = row >= RL; const int n = isc ? 0 : row % SEQ; bf16_t* pr = w.p + (size_t)row * PW;
        for (int idx = lane; idx < 704; idx += 64) {
            int c1, dd, a; float sc;
            if (idx < 128) { const int h = idx >> 5, i = idx & 31; c1 = C_RQ + h * 64 + i; dd = 32; a = i; sc = 0.125f; }
            else if (idx < 256) { const int j = idx - 128, h = j >> 5, i = j & 31; c1 = C_RK + h * 64 + i; dd = 32; a = i; sc = 1.0f; }
            else if (idx < 384) { const int j = idx - 256, hc = j >> 4, i = j & 15; c1 = C_DQ + hc * 32 + i; dd = 16; a = 32 + i; sc = 0.17677669529663687f * LOG2E; }
            else if (idx < 512) { const int j = idx - 384, hc = j >> 4, i = j & 15; c1 = C_DK + hc * 32 + i; dd = 16; a = 32 + i; sc = 1.0f; }
            else if (idx < 640) { const int j = idx - 512, h = j >> 5, i = j & 31; c1 = C_SQ + h * 64 + i; dd = 32; a = 48 + i; sc = 0.125f * LOG2E; }
            else { const int j = idx - 640, h = j >> 5, i = j & 31; c1 = C_SK + h * 64 + i; dd = 32; a = 48 + i; sc = 1.0f; }
            float cs = 1.0f, sn = 0.0f; if (!isc) { cs = w.tab[((size_t)n * 80 + a) * 2]; sn = w.tab[((size_t)n * 80 + a) * 2 + 1]; }
            const float x1 = bf2f(pr[c1]), x2 = bf2f(pr[c1 + dd]);
            pr[c1] = f2bf((x1 * cs - x2 * sn) * sc); pr[c1 + dd] = f2bf((x1 * sn + x2 * cs) * sc);
        }
    }
}

constexpr int A_KS = 72;
constexpr int A_TILE = 64 * A_KS;
constexpr float A_THR = 6.0f;
template <int NC>
DI void attn_unit(const bf16_t* __restrict__ P, const int qrow0, const int qcol, const int kcol, const int vcol,
                  const int r1, const int n1, const int kp1, const bool mask1, const int r2, const int n2, const int qpos0,
                  const float m_init, const float l_init, const float lam, const float fin_scale, const float* __restrict__ norm_g,
                  bf16_t* __restrict__ outp  , char* smem) {
    bf16_t* Kb = (bf16_t*)smem; bf16_t* Vb = Kb + 2 * A_TILE;
    const int tid = tidx(), lane = tid & 63, wv = tid >> 6, fr = lane & 15, fq = lane >> 4;
    bf16x8 qf[2][2];
#pragma unroll
    for (int g = 0; g < 2; ++g)
#pragma unroll
        for (int i = 0; i < 2; ++i) qf[g][i] = *(const bf16x8*)(P + (size_t)(qrow0 + g * 128 + wv * 16 + fr) * PW + qcol + i * 32 + fq * 8);
    f32x4 o[2][NC][4], ol[2][NC], negm[2][NC]; float mrun[2][NC];
    const int T = n1 + n2, skey = tid >> 3, sc8 = tid & 7;
    const int soff = skey * A_KS + sc8 * 8;
    const int voff = (fq * 4 + (fr >> 2)) * A_KS + (fr & 3) * 4;
    u32x4 kr0, vr0, kr1, vr1;
#define A_LOAD(TN, KR, VR) do { const int tn_ = (TN); const int krow_ = (tn_ < n1) ? r1 + tn_ * 64 : r2 + (tn_ - n1) * 64; const bf16_t* src_ = P + (size_t)(krow_ + skey) * PW; \
        KR = *(const u32x4*)(src_ + kcol + sc8 * 8); VR = *(const u32x4*)(src_ + vcol + sc8 * 8); } while (0)
    A_LOAD(0, kr0, vr0);
    *(u32x4*)(Kb + soff) = kr0; *(u32x4*)(Vb + soff) = vr0;
    if (1 < T) A_LOAD(1, kr1, vr1);
    const int qposb = qpos0 + wv * 16 + fr;
    LDS_BARRIER();
    {
#pragma unroll
        for (int g = 0; g < 2; ++g)
#pragma unroll
            for (int c = 0; c < NC; ++c) { float mx = -INFINITY;
#pragma unroll
                for (int kt = 0; kt < 4; ++kt) {
                    const bf16x8 k0 = *(const bf16x8*)(Kb + (kt * 16 + fr) * A_KS + fq * 8), k1 = *(const bf16x8*)(Kb + (kt * 16 + fr) * A_KS + 32 + fq * 8);
                    const f32x4 z = (f32x4){0.f, 0.f, 0.f, 0.f};
                    f32x4 sv; if (NC == 2) sv = c == 0 ? MFMA16(k0, qf[g][0], z) : MFMA16(k1, qf[g][1], z); else sv = MFMA16(k1, qf[g][1], MFMA16(k0, qf[g][0], z));
#pragma unroll
                    for (int j = 0; j < 4; ++j) { const int dlt = qposb + g * 128 - (kp1 + kt * 16 + fq * 4 + j); if (!(mask1 && n1 > 0 && (dlt > 128 || dlt < -128))) mx = fmaxf(mx, sv[j]); } }
                mx = grp_max(mx); mrun[g][c] = fmaxf(m_init, mx); const float l0 = l_init * ex2(m_init - mrun[g][c]);
                negm[g][c] = (f32x4){-mrun[g][c], -mrun[g][c], -mrun[g][c], -mrun[g][c]}; ol[g][c] = (f32x4){l0, l0, l0, l0};
#pragma unroll
                for (int d = 0; d < 4; ++d) o[g][c][d] = (f32x4){0.f, 0.f, 0.f, 0.f}; }
    }
    bf16x8 onesf; { const u32x4 ov = (u32x4){0x3F803F80u, 0x3F803F80u, 0x3F803F80u, 0x3F803F80u}; onesf = __builtin_bit_cast(bf16x8, ov); }
    const int stag = __builtin_amdgcn_readfirstlane(tid >> 8);
    auto tile_step = [&](const int t, u32x4& kl, u32x4& vl, const u32x4& kw, const u32x4& vw) {
        LDS_BARRIER();
        STAGGER_SLEEP(stag);
        const bf16_t* Kt = Kb + (t & 1) * A_TILE; const bf16_t* Vt = Vb + (t & 1) * A_TILE;
        A_LOAD((t + 2 < T ? t + 2 : T - 1), kl, vl);
        const bool msk = mask1 && (t < n1); const int kpos_t = kp1 + t * 64;
        bf16x8 kf[4][2], vf[2][4];
#pragma unroll
        for (int kt = 0; kt < 4; ++kt) { kf[kt][0] = *(const bf16x8*)(Kt + (kt * 16 + fr) * A_KS + fq * 8); kf[kt][1] = *(const bf16x8*)(Kt + (kt * 16 + fr) * A_KS + 32 + fq * 8); }
#pragma unroll
        for (int k2 = 0; k2 < 2; ++k2)
#pragma unroll
            for (int d = 0; d < 4; ++d) { const s16x4 a = lds_tr16(Vt + voff + (2 * k2) * 16 * A_KS + d * 16), b = lds_tr16(Vt + voff + (2 * k2 + 1) * 16 * A_KS + d * 16);
                vf[k2][d] = __builtin_shufflevector(a, b, 0, 1, 2, 3, 4, 5, 6, 7); }
#pragma unroll
        for (int g = 0; g < 2; ++g)
#pragma unroll
            for (int c = 0; c < NC; ++c) {
                f32x4 s[4];
#pragma unroll
                for (int kt = 0; kt < 4; ++kt) { if (NC == 2) s[kt] = MFMA16(kf[kt][c], qf[g][c], negm[g][c]); else s[kt] = MFMA16(kf[kt][1], qf[g][1], MFMA16(kf[kt][0], qf[g][0], negm[g][0])); }
                if (msk) { const int qpos = qposb + g * 128;
#pragma unroll
                    for (int kt = 0; kt < 4; ++kt)
#pragma unroll
                        for (int j = 0; j < 4; ++j) { const int dlt = qpos - (kpos_t + kt * 16 + fq * 4 + j); if (dlt > 128 || dlt < -128) s[kt][j] = -INFINITY; } }
                int im = max(max(__float_as_int(s[0][0]), __float_as_int(s[0][1])), max(__float_as_int(s[0][2]), __float_as_int(s[0][3])));
#pragma unroll
                for (int kt = 1; kt < 4; ++kt) im = max(max(im, __float_as_int(s[kt][0])), max(max(__float_as_int(s[kt][1]), __float_as_int(s[kt][2])), __float_as_int(s[kt][3])));
                const float tm = __int_as_float(grp_imax(im));
                if (__any(tm > A_THR)) {
                    const float delta = fmaxf(tm, 0.f), alpha = ex2(-delta); mrun[g][c] += delta; negm[g][c] = (f32x4){-mrun[g][c], -mrun[g][c], -mrun[g][c], -mrun[g][c]}; ol[g][c] *= alpha;
#pragma unroll
                    for (int d = 0; d < 4; ++d) o[g][c][d] *= alpha;
#pragma unroll
                    for (int kt = 0; kt < 4; ++kt) s[kt] = s[kt] - delta;
                }
#pragma unroll
                for (int kt = 0; kt < 4; ++kt)
#pragma unroll
                    for (int j = 0; j < 4; ++j) s[kt][j] = ex2(s[kt][j]);
#pragma unroll
                for (int k2 = 0; k2 < 2; ++k2) {
                    u32x4 pp; pp[0] = pk2(s[2 * k2][0], s[2 * k2][1]); pp[1] = pk2(s[2 * k2][2], s[2 * k2][3]); pp[2] = pk2(s[2 * k2 + 1][0], s[2 * k2 + 1][1]); pp[3] = pk2(s[2 * k2 + 1][2], s[2 * k2 + 1][3]);
                    const bf16x8 pb = __builtin_bit_cast(bf16x8, pp);
#pragma unroll
                    for (int d = 0; d < 4; ++d) o[g][c][d] = MFMA16(vf[k2][d], pb, o[g][c][d]);
                    ol[g][c] = MFMA16(onesf, pb, ol[g][c]);
                }
            }
        { bf16_t* Kn = Kb + ((t + 1) & 1) * A_TILE + soff; bf16_t* Vn = Vb + ((t + 1) & 1) * A_TILE + soff;
            *(u32x4*)Kn = kw; *(u32x4*)Vn = vw; }
    };
#ifndef EMU
    __builtin_amdgcn_s_waitcnt(0x0F70);
#endif
    for (int t = 0; t < T; t += 2) { tile_step(t, kr0, vr0, kr1, vr1); if (t + 1 < T) tile_step(t + 1, kr1, vr1, kr0, vr0); }
#undef A_LOAD
#pragma unroll
    for (int g = 0; g < 2; ++g) {
        float linv[NC];
#pragma unroll
        for (int c = 0; c < NC; ++c) linv[c] = 1.0f / ol[g][c][0];
        f32x4 val[4]; float ss = 0.f;
#pragma unroll
        for (int d = 0; d < 4; ++d) {
            if (NC == 2) val[d] = o[g][0][d] * linv[0] - lam * (o[g][NC - 1][d] * linv[NC - 1]); else val[d] = o[g][0][d] * linv[0];
            ss += val[d][0] * val[d][0] + val[d][1] * val[d][1] + val[d][2] * val[d][2] + val[d][3] * val[d][3];
        }
        float rs = 1.0f;
        if (NC == 2) { ss = grp_sum(ss); rs = fin_scale / sqrtf(ss * (1.0f / 64.0f) + 1e-6f); }
        bf16_t* orow = outp + (size_t)(g * 128 + wv * 16 + fr) * 1024;
#pragma unroll
        for (int d = 0; d < 4; ++d) { f32x4 v = val[d] * rs; if (NC == 2) v = v * *(const f32x4*)(norm_g + d * 16 + fq * 4);
            u32x2 ov; ov[0] = pk2(v[0], v[1]); ov[1] = pk2(v[2], v[3]); *(u32x2*)(orow + d * 16 + fq * 4) = ov; }
    }
    __syncthreads();
}

DI void ret_kv_unit(const Params& p, const WS& w, int layer, int b, int h, int ci, char* smem) {
    bf16_t* Kr = (bf16_t*)smem; bf16_t* V0 = Kr + 128 * 72; bf16_t* V1 = V0 + 128 * 72;
    const int tid = tidx(), lane = tid & 63, wv = tid >> 6, fr = lane & 15, fq = lane >> 4; const bool isc = ci < NCC; const int row0 = isc ? RL + b * CTX + ci * 128 : b * SEQ + (ci - NCC) * 128;
    const float lg0 = -softplusf_(-p.ret_decay[(layer * 2 + 0) * 4 + h]) * LOG2E, lg1 = -softplusf_(-p.ret_decay[(layer * 2 + 1) * 4 + h]) * LOG2E;
    __syncthreads();
    for (int i = tid; i < 128 * 8; i += NT) { const int j = i >> 3, c8 = i & 7; const bf16_t* src = w.p + (size_t)(row0 + j) * PW + h * 64 + c8 * 8;
        *(u32x4*)(Kr + j * 72 + c8 * 8) = *(const u32x4*)(src + C_RK); const u32x4 vv = *(const u32x4*)(src + C_RV);
        const float d0 = ex2(lg0 * (float)(127 - j)), d1 = ex2(lg1 * (float)j); u32x4 a, c;
#pragma unroll
        for (int q = 0; q < 4; ++q) { const float lo = __uint_as_float(vv[q] << 16), hi = __uint_as_float(vv[q] & 0xffff0000u); a[q] = pk2(lo * d0, hi * d0); c[q] = pk2(lo * d1, hi * d1); }
        *(u32x4*)(V0 + j * 72 + c8 * 8) = a; *(u32x4*)(V1 + j * 72 + c8 * 8) = c; }
    __syncthreads();
    const int dir = wv >> 2, et = wv & 3; const bf16_t* Vd = dir ? V1 : V0; const int toff = (fq * 8 + (fr >> 2)) * 72 + (fr & 3) * 4;
    f32x4 acc[4];
#pragma unroll
    for (int n = 0; n < 4; ++n) acc[n] = (f32x4){0.f, 0.f, 0.f, 0.f};
#pragma unroll
    for (int ks = 0; ks < 4; ++ks) {
        const s16x4 va = lds_tr16(Vd + toff + (ks * 32) * 72 + et * 16), vb = lds_tr16(Vd + toff + (ks * 32 + 4) * 72 + et * 16); const bf16x8 vfr = __builtin_shufflevector(va, vb, 0, 1, 2, 3, 4, 5, 6, 7);
#pragma unroll
        for (int n = 0; n < 4; ++n) { const s16x4 ka = lds_tr16(Kr + toff + (ks * 32) * 72 + n * 16), kb = lds_tr16(Kr + toff + (ks * 32 + 4) * 72 + n * 16);
            acc[n] = MFMA16(vfr, __builtin_shufflevector(ka, kb, 0, 1, 2, 3, 4, 5, 6, 7), acc[n]); }
    }
    bf16_t* ob = w.rkv + ((size_t)((b * 4 + h) * 2 + dir) * NCHR + ci) * 4096;
#pragma unroll
    for (int n = 0; n < 4; ++n) { u32x2 o; o[0] = pk2(acc[n][0], acc[n][1]); o[1] = pk2(acc[n][2], acc[n][3]); *(u32x2*)(ob + (n * 16 + fr) * 64 + et * 16 + fq * 4) = o; }
}
DI void ret_scan(const Params& p, const WS& w, int layer) {
    for (int i = bidx() * NT + tidx(); i < NB * 4 * 2 * 4096; i += gridDim.x * NT) {
        const int chain = i >> 12, el = i & 4095, d = chain & 1, h = (chain >> 1) & 3;
        const float x = p.ret_decay[(layer * 2 + d) * 4 + h]; const float cd = ex2(-softplusf_(-x) * LOG2E * 128.0f);
        float kv[NCHR];
#pragma unroll
        for (int st = 0; st < NCHR; ++st) { const int ci = d == 0 ? st : (st < NCC ? NCC - 1 - st : NCC + (NLC - 1 - (st - NCC))); kv[st] = __uint_as_float((unsigned)w.rkv[((size_t)chain * NCHR + ci) * 4096 + el] << 16); }
        float s = 0.f;
#pragma unroll
        for (int st = 0; st < NCHR; ++st) { const int ci = d == 0 ? st : (st < NCC ? NCC - 1 - st : NCC + (NLC - 1 - (st - NCC))); w.rs[((size_t)chain * NCHR + ci) * 4096 + el] = f2bf(s); s = s * cd + kv[st]; }
    }
}
constexpr int RO_KS = 72, RO_VS = 136;
DI void ret_out_unit(const Params& p, const WS& w, int layer, int b, int h, int ci, char* smem) {
    bf16_t* Ks = (bf16_t*)smem; bf16_t* Vr = Ks + 128 * RO_KS; bf16_t* Sr = Vr + 128 * RO_KS;
    const int tid = tidx(), lane = tid & 63, wv = tid >> 6, fr = lane & 15, fq = lane >> 4;
    const bool isc = ci < NCC; const int row0 = isc ? RL + b * CTX + ci * 128 : b * SEQ + (ci - NCC) * 128;
    __syncthreads();
    for (int i = tid; i < 128 * 8; i += NT) { const int j = i >> 3, c8 = i & 7; const bf16_t* src = w.p + (size_t)(row0 + j) * PW + h * 64 + c8 * 8;
        *(u32x4*)(Ks + j * RO_KS + c8 * 8) = *(const u32x4*)(src + C_RK); *(u32x4*)(Vr + j * RO_KS + c8 * 8) = *(const u32x4*)(src + C_RV); }
    for (int i = tid; i < 2 * 64 * 8; i += NT) { const int d = i >> 9, dk = (i >> 3) & 63, e8 = i & 7; const bf16_t* src = w.rs + ((size_t)((b * 4 + h) * 2 + d) * NCHR + ci) * 4096 + dk * 64 + e8 * 8;
        *(u32x4*)(Sr + (d * 64 + dk) * RO_KS + e8 * 8) = *(const u32x4*)src; }
    __syncthreads();
    const float lg0 = -softplusf_(-p.ret_decay[(layer * 2 + 0) * 4 + h]) * LOG2E, lg1 = -softplusf_(-p.ret_decay[(layer * 2 + 1) * 4 + h]) * LOG2E;
    const int qi = wv * 16 + fr;
    const int voff = (fq * 4 + (fr >> 2)) * RO_KS + (fr & 3) * 4;
    const int soffs = (fq * 8 + (fr >> 2)) * RO_KS + (fr & 3) * 4;
    bf16x8 qf[2];
#pragma unroll
    for (int i = 0; i < 2; ++i) qf[i] = *(const bf16x8*)(w.p + (size_t)(row0 + qi) * PW + C_RQ + h * 64 + i * 32 + fq * 8);
    f32x4 o[4], t0[4], t1[4];
#pragma unroll
    for (int d = 0; d < 4; ++d) { o[d] = (f32x4){0.f, 0.f, 0.f, 0.f}; t0[d] = o[d]; t1[d] = o[d]; }
#pragma unroll
    for (int k2 = 0; k2 < 4; ++k2) {
        f32x4 s[2];
#pragma unroll
        for (int q = 0; q < 2; ++q) { const int kt = 2 * k2 + q;
            const bf16x8 k0 = *(const bf16x8*)(Ks + (kt * 16 + fr) * RO_KS + fq * 8), k1 = *(const bf16x8*)(Ks + (kt * 16 + fr) * RO_KS + 32 + fq * 8);
            s[q] = MFMA16(k1, qf[1], MFMA16(k0, qf[0], (f32x4){0.f, 0.f, 0.f, 0.f}));
#pragma unroll
            for (int j = 0; j < 4; ++j) { const int kj = kt * 16 + fq * 4 + j, dl = qi - kj; const float dm = dl > 0 ? ex2(lg0 * (float)dl) : (dl < 0 ? ex2(lg1 * (float)(-dl)) : 2.0f); s[q][j] *= dm; } }
        u32x4 pp; pp[0] = pk2(s[0][0], s[0][1]); pp[1] = pk2(s[0][2], s[0][3]); pp[2] = pk2(s[1][0], s[1][1]); pp[3] = pk2(s[1][2], s[1][3]);
        const bf16x8 pb = __builtin_bit_cast(bf16x8, pp);
#pragma unroll
        for (int d = 0; d < 4; ++d) { const s16x4 v0 = lds_tr16(Vr + voff + (2 * k2) * 16 * RO_KS + d * 16), v1 = lds_tr16(Vr + voff + (2 * k2 + 1) * 16 * RO_KS + d * 16);
            o[d] = MFMA16(__builtin_shufflevector(v0, v1, 0, 1, 2, 3, 4, 5, 6, 7), pb, o[d]); }
    }
#pragma unroll
    for (int d = 0; d < 4; ++d)
#pragma unroll
        for (int ks = 0; ks < 2; ++ks) {
            const s16x4 a0 = lds_tr16(Sr + soffs + (ks * 32) * RO_KS + d * 16), a1 = lds_tr16(Sr + soffs + (ks * 32 + 4) * RO_KS + d * 16);
            const s16x4 b0 = lds_tr16(Sr + soffs + (64 + ks * 32) * RO_KS + d * 16), b1 = lds_tr16(Sr + soffs + (64 + ks * 32 + 4) * RO_KS + d * 16);
            t0[d] = MFMA16(__builtin_shufflevector(a0, a1, 0, 1, 2, 3, 4, 5, 6, 7), qf[ks], t0[d]); t1[d] = MFMA16(__builtin_shufflevector(b0, b1, 0, 1, 2, 3, 4, 5, 6, 7), qf[ks], t1[d]); }
    const float qd0 = ex2(lg0 * (float)(qi + 1)), qd1 = ex2(lg1 * (float)(128 - qi));
    float ss = 0.f;
#pragma unroll
    for (int d = 0; d < 4; ++d) { o[d] = o[d] + qd0 * t0[d] + qd1 * t1[d]; ss += o[d][0] * o[d][0] + o[d][1] * o[d][1] + o[d][2] * o[d][2] + o[d][3] * o[d][3]; }
    ss = grp_sum(ss);
    const float rs = 1.0f / sqrtf(ss * (1.0f / 64.0f) + 1e-6f);
    const bf16_t* gp = w.p + (size_t)(row0 + qi) * PW + C_RG + h * 64; bf16_t* op = w.mix + (size_t)(row0 + qi) * 1024 + h * 64;
#pragma unroll
    for (int d = 0; d < 4; ++d) { const u32x2 gv = *(const u32x2*)(gp + d * 16 + fq * 4);
        const float g0 = __uint_as_float(gv[0] << 16), g1 = __uint_as_float(gv[0] & 0xffff0000u), g2 = __uint_as_float(gv[1] << 16), g3 = __uint_as_float(gv[1] & 0xffff0000u);
        u32x2 ov; ov[0] = pk2(o[d][0] * rs * siluf(g0), o[d][1] * rs * siluf(g1)); ov[1] = pk2(o[d][2] * rs * siluf(g2), o[d][3] * rs * siluf(g3)); *(u32x2*)(op + d * 16 + fq * 4) = ov; }
}

constexpr int GS = 68, GNA = 72, GDI = 24;
DI bf16x8 pack8f(const float* p) {
    const f32x4 a = *(const f32x4*)p, b = *(const f32x4*)(p + 4); u32x4 r; r[0] = pk2(a[0], a[1]); r[1] = pk2(a[2], a[3]); r[2] = pk2(b[0], b[1]); r[3] = pk2(b[2], b[3]); return __builtin_bit_cast(bf16x8, r);
}
DI void gdn_prep_unit(const Params& p, const WS& w, int layer, int b, int h, int cg, char* smem) {
    float* Qs = (float*)smem; float* Ks = Qs + 64 * GS; float* Vs = Ks + 64 * GS; float* Raw = Vs + 64 * GS;
    float* KK = Raw; float* QK = KK + 64 * GS; float* gt = Raw + 66 * 192;
    bf16_t* NA = (bf16_t*)(gt + 384); bf16_t* DIm = NA + 2 * 64 * GNA;
    const int tid = tidx(), lane = tid & 63, wv = tid >> 6, fr = lane & 15, fq = lane >> 4;
    const bool isc = cg < NCG; const int nseq = isc ? CTX : SEQ, t0 = (isc ? cg : cg - NCG) * 64, base = isc ? RL + b * CTX : b * SEQ;
    __syncthreads();
    for (int i = tid; i < 66 * 24; i += NT) { const int tt = i / 24, c8 = i % 24, part = c8 >> 3, tok = t0 - 1 + tt; u32x4 v = (u32x4){0u, 0u, 0u, 0u};
        if (tok >= 0 && tok < nseq) v = *(const u32x4*)(w.p + (size_t)(base + tok) * PW + C_GQKV + part * 256 + h * 64 + (c8 & 7) * 8);
#pragma unroll
        for (int q = 0; q < 4; ++q) { Raw[tt * 192 + c8 * 8 + 2 * q] = __uint_as_float(v[q] << 16); Raw[tt * 192 + c8 * 8 + 2 * q + 1] = __uint_as_float(v[q] & 0xffff0000u); } }
    if (tid < 128) { const int dr = tid >> 6, s = tid & 63; const float* ga = w.gab + (size_t)(base + t0 + s) * 16;
        gt[dr * 64 + s] = -__expf(p.gdn_a_log[(layer * 2 + dr) * 4 + h]) * softplusf_(ga[dr * 4 + h] + p.gdn_dt_bias[(layer * 2 + dr) * 4 + h]);
        gt[128 + dr * 64 + s] = sigmoidf_(ga[8 + dr * 4 + h]); }
    __syncthreads();
    if (tid < 384) {
        const int ch = tid % 192, half = tid / 192, part = ch >> 6, d = ch & 63, chg = part * 256 + h * 64 + d; const float* cw = p.gdn_conv + (size_t)layer * 3 * 768 + chg;
        const float w0 = cw[0], w1 = cw[768], w2 = cw[1536]; float* dst = (part == 0 ? Qs : (part == 1 ? Ks : Vs)) + d;
        float x0 = Raw[(half * 32) * 192 + ch], x1 = Raw[(half * 32 + 1) * 192 + ch];
#pragma unroll 8
        for (int s = half * 32; s < half * 32 + 32; ++s) { const float x2 = Raw[(s + 2) * 192 + ch]; dst[s * GS] = siluf(w0 * x0 + w1 * x1 + w2 * x2); x0 = x1; x1 = x2; }
    } else if (tid >= 384 && tid < 512) {
        const int dr = (tid - 384) >> 6, sl = tid & 63; float a = gt[dr * 64 + (dr ? 63 - sl : sl)];
#pragma unroll
        for (int dd = 1; dd < 64; dd <<= 1) { const float o = lane_shfl_f(a, sl >= dd ? sl - dd : sl); if (sl >= dd) a += o; }
        gt[256 + dr * 64 + sl] = a; }
    __syncthreads();
#pragma unroll
    for (int pass = 0; pass < 2; ++pass) {
        float* rowp = (pass == 0 ? Qs : Ks) + (tid >> 3) * GS + (tid & 7) * 8; f32x4 x0 = *(const f32x4*)rowp, x1 = *(const f32x4*)(rowp + 4);
        float ss = x0[0] * x0[0] + x0[1] * x0[1] + x0[2] * x0[2] + x0[3] * x0[3] + x1[0] * x1[0] + x1[1] * x1[1] + x1[2] * x1[2] + x1[3] * x1[3];
        ss = sum8(ss); const float rs = (1.0f / sqrtf(ss + 1e-6f)) * (pass == 0 ? 0.125f : 1.0f);
        *(f32x4*)rowp = x0 * rs; *(f32x4*)(rowp + 4) = x1 * rs; }
    __syncthreads();
#pragma unroll
    for (int tt = 0; tt < 4; ++tt) { const int t = wv * 4 + tt, which = t >> 4, mt = (t >> 2) & 3, nt = t & 3; const float* Am = which ? Qs : Ks;
        f32x4 d = (f32x4){0.f, 0.f, 0.f, 0.f};
#pragma unroll
        for (int ks = 0; ks < 2; ++ks) d = MFMA16(pack8f(Am + (mt * 16 + fr) * GS + ks * 32 + fq * 8), pack8f(Ks + (nt * 16 + fr) * GS + ks * 32 + fq * 8), d);
        float* G = which ? QK : KK;
#pragma unroll
        for (int jj = 0; jj < 4; ++jj) G[(mt * 16 + fq * 4 + jj) * GS + nt * 16 + fr] = d[jj]; }
    __syncthreads();
    for (int i = tid; i < 2 * 4096; i += NT) { const int dr = i >> 12, s = (i >> 6) & 63, s2 = i & 63; float v = 0.f;
        if (s > s2) { const int ts = dr ? 63 - s : s, ts2 = dr ? 63 - s2 : s2; v = -gt[128 + dr * 64 + ts] * KK[ts * GS + ts2] * __expf(gt[256 + dr * 64 + s] - gt[256 + dr * 64 + s2]); }
        NA[(dr * 64 + s) * GNA + s2] = f2bf(v); }
    __syncthreads();
    if (tid < 128) {
        const int dr = tid >> 6, blk = (tid >> 4) & 3, c = tid & 15; const bf16_t* Ab = NA + (dr * 64 + blk * 16) * GNA + blk * 16; float x[16];
#pragma unroll
        for (int r = 0; r < 16; ++r) { float a = (r == c) ? 1.0f : 0.0f;
            const u32x4 lo = *(const u32x4*)(Ab + r * GNA), hi = *(const u32x4*)(Ab + r * GNA + 8);
#pragma unroll
            for (int r2 = 0; r2 < r; ++r2) { const unsigned wd = r2 < 8 ? lo[r2 >> 1] : hi[(r2 - 8) >> 1]; a += __uint_as_float((r2 & 1) ? (wd & 0xffff0000u) : (wd << 16)) * x[r2]; }
            x[r] = a; DIm[((dr * 4 + blk) * 16 + r) * GDI + c] = f2bf(a); }
    }
    __syncthreads();
    const size_t cbase = (size_t)((b * 4 + h) * 2) * NCHG;
#pragma unroll 1
    for (int tk = 0; tk < 2; ++tk) {
        const int task = wv + tk * 8, dr = task >> 3, ntile = task & 7, col = ntile * 16 + fr; const bool isw = ntile >= 4;
        const int sc = dr == 0 ? cg : (cg < NCG ? NCG - 1 - cg : NCG + (NLG - 1 - (cg - NCG))); const size_t ch = cbase + (size_t)dr * NCHG + sc;
        const float* gg = gt + 256 + dr * 64; const float* bt = gt + 128 + dr * 64; const float* Rm = isw ? Ks + (col - 64) : Vs + col;
        u32x2 xb[4];
#pragma unroll
        for (int i = 0; i < 4; ++i) {
            f32x4 acc;
#pragma unroll
            for (int jj = 0; jj < 4; ++jj) { const int sidx = 16 * i + fq * 4 + jj, ts = dr ? 63 - sidx : sidx; float r = bt[ts] * Rm[ts * GS]; if (isw) r *= __expf(gg[sidx]); acc[jj] = r; }
#pragma unroll
            for (int j0 = 0; j0 < i; j0 += 2) {
                const u32x2 a0 = *(const u32x2*)(NA + (dr * 64 + 16 * i + fr) * GNA + 16 * j0 + fq * 4);
                u32x2 a1 = (u32x2){0u, 0u}, b1 = (u32x2){0u, 0u};
                if (j0 + 1 < i) { a1 = *(const u32x2*)(NA + (dr * 64 + 16 * i + fr) * GNA + 16 * (j0 + 1) + fq * 4); b1 = xb[j0 + 1]; }
                u32x4 av; av[0] = a0[0]; av[1] = a0[1]; av[2] = a1[0]; av[3] = a1[1]; u32x4 bv; bv[0] = xb[j0][0]; bv[1] = xb[j0][1]; bv[2] = b1[0]; bv[3] = b1[1];
                acc = MFMA16(__builtin_bit_cast(bf16x8, av), __builtin_bit_cast(bf16x8, bv), acc);
            }
            const u32x2 dd = *(const u32x2*)(DIm + ((dr * 4 + i) * 16 + fr) * GDI + fq * 4);
            u32x4 av; av[0] = dd[0]; av[1] = dd[1]; av[2] = 0u; av[3] = 0u; u32x4 bv; bv[0] = pk2(acc[0], acc[1]); bv[1] = pk2(acc[2], acc[3]); bv[2] = 0u; bv[3] = 0u;
            const f32x4 x = MFMA16(__builtin_bit_cast(bf16x8, av), __builtin_bit_cast(bf16x8, bv), (f32x4){0.f, 0.f, 0.f, 0.f});
            xb[i][0] = pk2(x[0], x[1]); xb[i][1] = pk2(x[2], x[3]);
            if (!isw) *(u32x2*)(w.gub + ch * 4096 + (size_t)col * 64 + 16 * i + fq * 4) = xb[i];
            else { bf16_t* wp = w.gw + ch * 4096 + (size_t)(16 * i + fq * 4) * 64 + (col - 64);
#pragma unroll
                for (int jj = 0; jj < 4; ++jj) wp[jj * 64] = f2bf(x[jj]); }
        }
    }
    for (int i = tid; i < 2 * 4096; i += NT) { const int dr = i >> 12, s = (i >> 6) & 63, c = i & 63, ts = dr ? 63 - s : s; const float* gg = gt + 256 + dr * 64;
        const int sc = dr == 0 ? cg : (cg < NCG ? NCG - 1 - cg : NCG + (NLG - 1 - (cg - NCG))); const size_t ch = cbase + (size_t)dr * NCHG + sc;
        w.gqg[ch * 4096 + s * 64 + c] = f2bf(Qs[ts * GS + c] * __expf(gg[s]));
        const int tc = dr ? 63 - c : c; w.gqk[ch * 4096 + s * 64 + c] = f2bf(s >= c ? QK[ts * GS + tc] * __expf(gg[s] - gg[c]) : 0.f);
        w.gkt[ch * 4096 + s * 64 + c] = f2bf(Ks[tc * GS + s] * __expf(gg[63] - gg[c]));
        if (s == 0 && c == 0) w.gcd[ch] = __expf(gg[63]); }
}
struct GdnOps { bf16x8 aw[2], aqg[2], aqk[2], akt[2]; u32x2 ub; float cd; };
DI void gdn_load_ops(GdnOps& g, const WS& w, size_t ch, int wv, int fr, int fq, int vs) {
#pragma unroll
    for (int ks = 0; ks < 2; ++ks) { const size_t o = ch * 4096 + (size_t)(wv * 16 + fr) * 64 + ks * 32 + fq * 8;
        g.aw[ks] = *(const bf16x8*)(w.gw + o); g.aqg[ks] = *(const bf16x8*)(w.gqg + o); g.aqk[ks] = *(const bf16x8*)(w.gqk + o); g.akt[ks] = *(const bf16x8*)(w.gkt + o); }
    g.ub = *(const u32x2*)(w.gub + ch * 4096 + (size_t)(vs * 16 + fr) * 64 + wv * 16 + fq * 4); g.cd = w.gcd[ch];
}
DI void gdn_scan_step(const GdnOps& g, f32x4& sacc, bf16_t* Sp, bf16_t* Up, const WS& w, int rbase, int dr, int h, int vs, int wv, int fr, int fq) {
    { u32x2 sv; sv[0] = pk2(sacc[0], sacc[1]); sv[1] = pk2(sacc[2], sacc[3]); *(u32x2*)(Sp + fr * 72 + wv * 16 + fq * 4) = sv; }
    LDS_BARRIER();
    bf16x8 sb[2]; f32x4 u = (f32x4){0.f, 0.f, 0.f, 0.f};
#pragma unroll
    for (int ks = 0; ks < 2; ++ks) { sb[ks] = *(const bf16x8*)(Sp + fr * 72 + ks * 32 + fq * 8); u = MFMA16(g.aw[ks], sb[ks], u); }
    u = (f32x4){bf_lo(g.ub[0]), bf_hi(g.ub[0]), bf_lo(g.ub[1]), bf_hi(g.ub[1])} - u;
    { u32x2 uvv; uvv[0] = pk2(u[0], u[1]); uvv[1] = pk2(u[2], u[3]); *(u32x2*)(Up + fr * 72 + wv * 16 + fq * 4) = uvv; }
    LDS_BARRIER();
    f32x4 oo = (f32x4){0.f, 0.f, 0.f, 0.f}, sn = sacc * g.cd;
#pragma unroll
    for (int ks = 0; ks < 2; ++ks) { const bf16x8 ubf = *(const bf16x8*)(Up + fr * 72 + ks * 32 + fq * 8);
        oo = MFMA16(g.aqg[ks], sb[ks], oo); oo = MFMA16(g.aqk[ks], ubf, oo); sn = MFMA16(g.akt[ks], ubf, sn); }
    sacc = sn;
    {
        const bool ev = (fr & 1) == 0;
        const float r0 = lane_xor1_f(ev ? oo[2] : oo[0]), r1 = lane_xor1_f(ev ? oo[3] : oo[1]);
        const unsigned p0 = ev ? pk2(oo[0], r0) : pk2(r0, oo[2]), p1 = ev ? pk2(oo[1], r1) : pk2(r1, oo[3]);
#pragma unroll
        for (int q = 0; q < 2; ++q) { const int s = wv * 16 + fq * 4 + (ev ? 0 : 2) + q, tok = dr ? 63 - s : s;
            *(unsigned*)(w.og + ((size_t)dr * R + rbase + tok) * 256 + h * 64 + vs * 16 + (fr & 14)) = q ? p1 : p0; }
    }
}
DI void gdn_scan_unit(const Params& p, const WS& w, int layer, int b, int h, int dr, int vs, char* smem) {
    static_assert(NCHG % 4 == 0, "scan ring assumes a multiple of 4 chunks");
    bf16_t* Sb = (bf16_t*)smem; bf16_t* Ub = Sb + 2 * 16 * 72;
    const int tid = tidx(), lane = tid & 63, wv = tid >> 6, fr = lane & 15, fq = lane >> 4;
    const size_t cb = (size_t)((b * 4 + h) * 2 + dr) * NCHG;
    __syncthreads();
    if (wv < 4) {
        f32x4 sacc = (f32x4){0.f, 0.f, 0.f, 0.f};
        GdnOps r0, r1, r2, r3;
        gdn_load_ops(r0, w, cb, wv, fr, fq, vs); gdn_load_ops(r1, w, cb + 1, wv, fr, fq, vs); gdn_load_ops(r2, w, cb + 2, wv, fr, fq, vs); gdn_load_ops(r3, w, cb + 3, wv, fr, fq, vs);
#define GDN_STEP(RG, K) do { const int sc_ = sc + (K); const int cgi = dr == 0 ? sc_ : (sc_ < NCG ? NCG - 1 - sc_ : NCG + (NLG - 1 - (sc_ - NCG))); \
        gdn_scan_step(RG, sacc, Sb + (K & 1) * 16 * 72, Ub + (K & 1) * 16 * 72, w, cgi < NCG ? RL + b * CTX + cgi * 64 : b * SEQ + (cgi - NCG) * 64, dr, h, vs, wv, fr, fq); \
        gdn_load_ops(RG, w, cb + (sc_ + 4 < NCHG ? sc_ + 4 : NCHG - 1), wv, fr, fq, vs); } while (0)
#pragma unroll 1
        for (int sc = 0; sc < NCHG; sc += 4) { GDN_STEP(r0, 0); GDN_STEP(r1, 1); GDN_STEP(r2, 2); GDN_STEP(r3, 3); }
#undef GDN_STEP
    } else {
#pragma unroll 1
        for (int sc = 0; sc < NCHG; ++sc) { LDS_BARRIER(); LDS_BARRIER(); }
    }
    __syncthreads();
}
DI void gdn_finish(const Params& p, const WS& w, int layer, int skip) {
    const int lane = tidx() & 63, wv = tidx() >> 6; const int nrows = layer == DEPTH - 1 ? RL : R;
    if (bidx() < skip) return;
    for (int row = (bidx() - skip) * 8 + wv; row < nrows; row += (gridDim.x - skip) * 8) {
        const u32x2 av = *(const u32x2*)(w.og + (size_t)row * 256 + lane * 4), cv = *(const u32x2*)(w.og + ((size_t)R + row) * 256 + lane * 4);
        const f32x4 o = (f32x4){bf_lo(av[0]) + bf_lo(cv[0]), bf_hi(av[0]) + bf_hi(cv[0]), bf_lo(av[1]) + bf_lo(cv[1]), bf_hi(av[1]) + bf_hi(cv[1])};
        float ss = o[0] * o[0] + o[1] * o[1] + o[2] * o[2] + o[3] * o[3];
        ss = sum16(ss);
        const float rs = 1.0f / sqrtf(ss * (1.0f / 64.0f) + 1e-6f); const f32x4 ng = *(const f32x4*)(p.gdn_norm + layer * 64 + (lane & 15) * 4);
        const u32x2 gv = *(const u32x2*)(w.p + (size_t)row * PW + C_GG + lane * 4);
        const float g0 = __uint_as_float(gv[0] << 16), g1 = __uint_as_float(gv[0] & 0xffff0000u), g2 = __uint_as_float(gv[1] << 16), g3 = __uint_as_float(gv[1] & 0xffff0000u);
        u32x2 ov; ov[0] = pk2(o[0] * rs * ng[0] * siluf(g0), o[1] * rs * ng[1] * siluf(g1)); ov[1] = pk2(o[2] * rs * ng[2] * siluf(g2), o[3] * rs * ng[3] * siluf(g3));
        *(u32x2*)(w.mix + (size_t)row * 1024 + 512 + lane * 4) = ov;
    }
}

DI void phase_diff(const Params& p, int layer, char* smem) {
    const WS w = ws_of(p.ws); const bool full_ctx = layer < DEPTH - 1;
    constexpr int QB = SEQ / 256, QC = CTX / 256;
    const int n_diff = NB * 4 * QB, n_diffc = full_ctx ? NB * 4 * QC : 0;
    int lyr = layer;
#ifndef EMU
    asm volatile("" : "+s"(lyr));
#endif
    const float lam_init = 0.8f - 0.6f * __expf(-0.3f * (float)lyr);
    float lam; { const float* lp = p.diff_lambda + layer * 128; const int ln = tidx() & 63; float s1 = 0.f, s2 = 0.f; if (ln < 32) { s1 = lp[ln] * lp[32 + ln]; s2 = lp[64 + ln] * lp[96 + ln]; }
        s1 = wsum(s1); s2 = wsum(s2); lam = __expf(s1) - __expf(s2) + lam_init; }
    for (int r0 = bidx(); r0 < n_diff + n_diffc; r0 += gridDim.x) {
        int r = r0; if (r0 < n_diff && (NB * 4) % 8 == 0) { const int x = r0 & 7, y = r0 >> 3, bh = x + 8 * (y / QB), qb_ = y % QB; r = bh * QB + qb_; }
        const bool isc = r >= n_diff; const int rr = isc ? r - n_diff : r, nq = isc ? QC : QB, qb = rr % nq, h = (rr / nq) & 3, b = rr / (nq * 4);
        const int qrow = (isc ? RL + b * CTX : b * SEQ) + qb * 256;
        attn_unit<2>(w.p, qrow, C_DQ + h * 64, C_DK + h * 64, C_DV + h * 64, isc ? RL + b * CTX : b * SEQ, isc ? CTX / 64 : SEQ / 64, 0, false, RL + b * CTX, isc ? 0 : CTX / 64, 0,
                     -1e30f, 0.f, lam, 1.0f - lam_init, p.diff_norm + layer * 64, w.mix + (size_t)qrow * 1024 + 256 + h * 64, smem);
    }
}
DI void phase_swa(const Params& p, int layer, char* smem) {
    const WS w = ws_of(p.ws); const bool full_ctx = layer < DEPTH - 1;
    constexpr int QB = SEQ / 256, QC = CTX / 256;
    const int n_swa = NB * 4 * QB, n_swac = full_ctx ? NB * 4 * QC : 0;
    for (int r0 = bidx(); r0 < n_swa + n_swac; r0 += gridDim.x) {
        int r = r0; if (r0 < n_swa && (NB * 4) % 8 == 0) { const int x = r0 & 7, y = r0 >> 3, bh = x + 8 * (y / QB), qb_ = y % QB; r = bh * QB + qb_; }
        const bool isc = r >= n_swa; const int rr = isc ? r - n_swa : r, nq = isc ? QC : QB, qb = rr % nq, hh = (rr / nq) & 3, b = rr / (nq * 4), hk = hh >> 1;
        const int qrow = (isc ? RL + b * CTX : b * SEQ) + qb * 256;
        const int ks = qb * 256 - 128 < 0 ? 0 : qb * 256 - 128, ke = qb * 256 + 384 > SEQ ? SEQ : qb * 256 + 384;
        attn_unit<1>(w.p, qrow, C_SQ + hh * 64, C_SK + hk * 64, C_SV + hk * 64, isc ? RL + b * CTX : b * SEQ + ks, isc ? CTX / 64 : (ke - ks) / 64, isc ? 0 : ks, !isc, RL + b * CTX, isc ? 0 : CTX / 64, qb * 256,
                     p.swa_sink[layer * 4 + hh] * LOG2E, 1.0f, 0.f, 1.0f, nullptr, w.mix + (size_t)qrow * 1024 + 768 + hh * 64, smem);
    }
}
DI void phase_gdnp(const Params& p, int layer, char* smem) {
    const WS w = ws_of(p.ws);
    for (int r = bidx(); r < NB * 4 * NCHG; r += gridDim.x) { const int cg = r % NCHG, h = (r / NCHG) & 3, b = r / (NCHG * 4); gdn_prep_unit(p, w, layer, b, h, cg, smem); }
}
DI void phase_rkv(const Params& p, int layer, char* smem) {
    const WS w = ws_of(p.ws);
    const int G = gridDim.x;
    for (int r = (bidx() + G / 2) % G; r < NB * 4 * NCHR; r += G) { const int ci = r % NCHR, h = (r / NCHR) & 3, b = r / (NCHR * 4); ret_kv_unit(p, w, layer, b, h, ci, smem); }
}
DI void phase_mix2(const Params& p, int layer, char* smem) {
    const WS w = ws_of(p.ws);
    for (int u = bidx(); u < NB * 4 * 2 * 4; u += gridDim.x) {
        const int x = u & 7, y = u >> 3, vs = y & 3, chain = x + 8 * (y >> 2), dr = chain & 1, h = (chain >> 1) & 3, b = chain >> 3;
        gdn_scan_unit(p, w, layer, b, h, dr, vs, smem); }
    ret_scan(p, w, layer);
}
DI void phase_mix3(const Params& p, int layer, char* smem) {
    const WS w = ws_of(p.ws); const bool full_ctx = layer < DEPTH - 1;
    for (int u = bidx(); u < NB * 4 * NCHR; u += gridDim.x) { const int ci = u % NCHR, h = (u / NCHR) & 3, b = u / (NCHR * 4); if (ci < NCC && !full_ctx) continue; ret_out_unit(p, w, layer, b, h, ci, smem); }
    const int G = gridDim.x, nun = NB * 4 * (full_ctx ? NCHR : NLC), rem = nun % G;
    gdn_finish(p, w, layer, (rem > 0 && rem <= G / 2) ? rem : 0);
}

DI int block_sum(int v, int* red) {
    const int lane = tidx() & 63, wv = tidx() >> 6;
    const int s = wsum_i(v);
    __syncthreads(); if (lane == 0) red[wv] = s; __syncthreads();
    int t = 0;
#pragma unroll
    for (int i = 0; i < 8; ++i) t += red[i];
    return t;
}
DI int block_exscan(int v, int* red) {
    const int lane = tidx() & 63, wv = tidx() >> 6;
    int s = v;
#pragma unroll
    for (int d = 1; d < 64; d <<= 1) { const int o = lane_shfl_i(s, lane >= d ? lane - d : lane); if (lane >= d) s += o; }
    __syncthreads(); if (lane == 63) red[wv] = s; __syncthreads();
    int off = 0;
#pragma unroll
    for (int i = 0; i < 8; ++i) if (i < wv) off += red[i];
    return off + s - v;
}
template <int N, int CAP> DI void topk_unit(const WS& w, const float* __restrict__ aff, int rowbase, int slotbase, int e, int* red) {
    constexpr int PT = (N + NT - 1) / NT;
    const int tid = tidx(); unsigned key[PT];
#pragma unroll
    for (int i = 0; i < PT; ++i) { const int n = tid * PT + i; key[i] = n < N ? __float_as_uint(aff[n]) : 0u; }
    unsigned T = 0u;
    for (int bit = 30; bit >= 0; --bit) { const unsigned cand = T | (1u << bit); int c = 0;
#pragma unroll
        for (int i = 0; i < PT; ++i) c += (tid * PT + i < N && key[i] >= cand) ? 1 : 0;
        if (block_sum(c, red) >= CAP) T = cand; }
    int cg = 0, ce = 0;
#pragma unroll
    for (int i = 0; i < PT; ++i) { const bool in = tid * PT + i < N; cg += (in && key[i] > T) ? 1 : 0; ce += (in && key[i] == T) ? 1 : 0; }
    const int need = CAP - block_sum(cg, red); const int eoff = block_exscan(ce, red);
    int sel = 0, er = eoff; bool flag[PT];
#pragma unroll
    for (int i = 0; i < PT; ++i) { const bool in = tid * PT + i < N; bool f = in && key[i] > T; if (in && key[i] == T) { f = er < need; ++er; } flag[i] = f; sel += f ? 1 : 0; }
    int slot = block_exscan(sel, red);
    int* selrow = red + 32;
#pragma unroll
    for (int i = 0; i < PT; ++i) { const int n = tid * PT + i; int iv = -1;
        if (n < N) { if (flag[i]) { iv = slotbase + slot; w.idx[(size_t)e * ROWS_E + iv] = rowbase + n; w.wgt[(size_t)e * ROWS_E + iv] = __uint_as_float(key[i]); selrow[slot] = rowbase + n; ++slot; }
            w.inv[(size_t)(rowbase + n) * 16 + e] = iv; } }
    __syncthreads();
}
DI void phase_topk(const Params& p, int layer, char* smem) {
    const WS w = ws_of(p.ws); int* red = (int*)smem; const bool full_ctx = layer < DEPTH - 1;
    for (int u = bidx(); u < 2 * NB * 16; u += gridDim.x) {
        const bool isc = u >= NB * 16; const int v = isc ? u - NB * 16 : u, b = v >> 4, e = v & 15;
        if (!isc) topk_unit<SEQ, CAPL>(w, w.aff + ((size_t)b * 16 + e) * SEQ, b * SEQ, b * CAPL, e, red);
        else if (full_ctx) topk_unit<CTX, CAPC>(w, w.aff + (size_t)RL * 16 + ((size_t)b * 16 + e) * CTX, RL + b * CTX, NB * CAPL + b * CAPC, e, red);
        else { for (int i = tidx(); i < CAPC; i += NT) { w.idx[(size_t)e * ROWS_E + NB * CAPL + b * CAPC + i] = 0; w.wgt[(size_t)e * ROWS_E + NB * CAPL + b * CAPC + i] = 0.f; } }
    }
    {
        const int G = gridDim.x, c = bidx(), first = G > NB * 16 ? NB * 16 : 0;
        if (c >= first) { __syncthreads(); cvt_stream<4>(p, w, smem, layer, c - first, G - first); }
    }
}

enum { PH_CVT = 0, PH_INIT, PH_INPROJ, PH_PREP, PH_DIFF, PH_MIX2, PH_MIX3, PH_OUTPROJ, PH_LN0, PH_TOPK, PH_MOE1, PH_MOE2, PH_LN1, PH_SWA, PH_GDNP, PH_RKV };
#ifdef EMU
#define SMEM_PTR(s) char* s = emu::B->lds
#else
extern __shared__ __attribute__((aligned(16))) char dyn_smem[];
#define SMEM_PTR(s) char* s = dyn_smem
#endif
template <int PH> DI void run_phase(const Params& p, int layer, char* smem) {
    if (PH == PH_CVT) phase_cvt(p, smem);
    else if (PH == PH_INIT) phase_rows<0>(p, 0, smem);
    else if (PH == PH_INPROJ) phase_inproj(p, layer, smem);
    else if (PH == PH_PREP) phase_prep(p, layer, smem);
    else if (PH == PH_DIFF) phase_diff(p, layer, smem);
    else if (PH == PH_SWA) phase_swa(p, layer, smem);
    else if (PH == PH_GDNP) phase_gdnp(p, layer, smem);
    else if (PH == PH_RKV) phase_rkv(p, layer, smem);
    else if (PH == PH_MIX2) phase_mix2(p, layer, smem);
    else if (PH == PH_MIX3) phase_mix3(p, layer, smem);
    else if (PH == PH_OUTPROJ) phase_outproj(p, layer, smem);
    else if (PH == PH_LN0) phase_rows<1>(p, layer, smem);
    else if (PH == PH_TOPK) phase_topk(p, layer, smem);
    else if (PH == PH_MOE1) phase_moe1(p, layer, smem);
    else if (PH == PH_MOE2) phase_moe2(p, layer, smem);
    else if (PH == PH_LN1) phase_rows<2>(p, layer, smem);
}
constexpr int LDS_BYTES = 8 * G_HT * 2 + 2048;
template <int PH> __global__ void __launch_bounds__(NT, 2) k_phase(Params p, int layer) { SMEM_PTR(smem); run_phase<PH>(p, layer, smem); }

#ifdef EMU
void (*emu_hook)(const char* tag, int layer, char* ws) = nullptr;
#define HOOK(t, l) do { if (emu_hook) emu_hook(t, l, (char*)d_ws); } while (0)
#else
#define HOOK(t, l)
#endif
template <int PH> static void launch_phase1(const Params& p, int layer, int grid, hipStream_t stream);
template <int PH> static void launch_phase(const Params& p, int layer, int grid, hipStream_t stream) { launch_phase1<PH>(p, layer, grid, stream); if ((PROBE_REP >> PH) & 1) launch_phase1<PH>(p, layer, grid, stream); }
template <int PH> static void launch_phase1(const Params& p, int layer, int grid, hipStream_t stream) {
#ifndef EMU
    static bool done = false; if (!done) { hipFuncSetAttribute((const void*)k_phase<PH>, hipFuncAttributeMaxDynamicSharedMemorySize, LDS_BYTES); done = true; }
#endif
    hipLaunchKernelGGL(k_phase<PH>, dim3(grid), dim3(NT), LDS_BYTES, stream, p, layer);
}

#ifndef MK_MULTI
#define MK_MULTI 0
#endif
#ifdef EMU
#define PHASE(PH, l) run_phase<PH>(p, l, emu::B->lds)
#define GRID_BARRIER() do { XcdBarrier bar_; bar_.bar = (unsigned*)(p.ws + OFF_BAR); xcd_barrier(bar_); } while (0)
#else
typedef const __attribute__((address_space(4))) Params* KParams;
DI KParams kparams() { KParams kp = (KParams)__builtin_amdgcn_kernarg_segment_ptr(); asm volatile("" : "+s"(kp)); return kp; }
template <int PH> DI void run_phase_k(int layer) { const Params* gp = (const Params*)kparams(); const Params p = *gp; run_phase<PH>(p, layer, dyn_smem); }
DI void grid_barrier_k() { XcdBarrier b; b.bar = (unsigned*)(kparams()->ws + OFF_BAR); b.x = xb_xcc_id(); b.st = (volatile LAS unsigned*)&dyn_smem[8 * G_HT * 2]; xcd_barrier(b); }
#define PHASE(PH, l) run_phase_k<PH>(l)
#define GRID_BARRIER() grid_barrier_k()
#endif
#if !MK_MULTI
__global__ void __launch_bounds__(NT, 2) k_mega(Params p) {
#ifndef EMU
    {   volatile LAS unsigned* st = (volatile LAS unsigned*)&dyn_smem[8 * G_HT * 2];
        if (threadIdx.x == 0) { st[0] = 0u; st[1] = 0u; st[2] = 0u; st[3] = 0u; }
        __syncthreads();
        (void)xcd_barrier_post((unsigned*)(kparams()->ws + OFF_BAR), st); }
#endif
#define PHASE_R(PH, l) do { PHASE(PH, l); if ((PROBE_REP >> PH) & 1) { GRID_BARRIER(); PHASE(PH, l); } } while (0)
    PHASE_R(PH_CVT, 0); GRID_BARRIER();
    PHASE_R(PH_INIT, 0); GRID_BARRIER();
    for (int l = 0; l < DEPTH; ++l) {
        PHASE_R(PH_INPROJ, l); GRID_BARRIER();
        PHASE_R(PH_DIFF, l); PHASE_R(PH_SWA, l); PHASE_R(PH_GDNP, l); PHASE_R(PH_RKV, l); GRID_BARRIER();
        PHASE_R(PH_MIX2, l); GRID_BARRIER();
        PHASE_R(PH_MIX3, l); GRID_BARRIER();
        PHASE_R(PH_OUTPROJ, l); GRID_BARRIER();
        PHASE(PH_LN0, l); GRID_BARRIER();
        PHASE_R(PH_TOPK, l); GRID_BARRIER();
        PHASE_R(PH_MOE1, l); GRID_BARRIER();
        PHASE_R(PH_MOE2, l); GRID_BARRIER();
        PHASE(PH_LN1, l); if (l + 1 < DEPTH) GRID_BARRIER();
    }
}
#endif

extern "C" void kernel_launch(void* const* d_in, const int* in_sizes, int n_in, void* d_out, int out_size, void* d_ws, size_t ws_size, hipStream_t stream) {
    Params p{};
    const float* const* in = (const float* const*)d_in;
    p.x = in[0]; p.c = in[1]; p.ctx = in[2]; p.c_ctx = in[3]; p.ada_w = in[4]; p.ada_b = in[5]; p.w_in = in[6]; p.w_out = in[7]; p.ret_decay = in[8]; p.diff_lambda = in[9];
    p.diff_norm = in[10]; p.gdn_conv = in[11]; p.gdn_a_log = in[12]; p.gdn_dt_bias = in[13]; p.gdn_norm = in[14]; p.swa_sink = in[15]; p.ln_g = in[16]; p.ln_b = in[17];
    p.router_w = in[18]; p.w_gate = in[19]; p.w_up = in[20]; p.w_down = in[21]; p.out = (float*)d_out; p.ws = (char*)d_ws;
    static int cus = 0;
    if (!cus) { int dev = 0; hipGetDevice(&dev); hipDeviceGetAttribute(&cus, hipDeviceAttributeMultiprocessorCount, dev); if (cus <= 0) cus = 256; }
    const int grid = cus;
#if MK_MULTI
    launch_phase<PH_CVT>(p, 0, grid, stream); HOOK("cvt", 0);
    launch_phase<PH_INIT>(p, 0, grid, stream); HOOK("init", 0);
    for (int l = 0; l < DEPTH; ++l) {
        launch_phase<PH_INPROJ>(p, l, grid, stream); HOOK("inproj", l);
        launch_phase<PH_DIFF>(p, l, grid, stream); launch_phase<PH_SWA>(p, l, grid, stream); launch_phase<PH_GDNP>(p, l, grid, stream); launch_phase<PH_RKV>(p, l, grid, stream);
        launch_phase<PH_MIX2>(p, l, grid, stream);
        launch_phase<PH_MIX3>(p, l, grid, stream); HOOK("mix", l);
        launch_phase<PH_OUTPROJ>(p, l, grid, stream);
        launch_phase<PH_LN0>(p, l, grid, stream); HOOK("ln0", l);
        launch_phase<PH_TOPK>(p, l, grid, stream);
        launch_phase<PH_MOE1>(p, l, grid, stream);
        launch_phase<PH_MOE2>(p, l, grid, stream);
        launch_phase<PH_LN1>(p, l, grid, stream); HOOK("ln1", l);
    }
#else
    hipMemsetAsync((char*)d_ws + OFF_BAR, 0, XCD_BAR_WORDS * sizeof(unsigned), stream);
#ifndef EMU
    static bool attr = false; if (!attr) { hipFuncSetAttribute((const void*)k_mega, hipFuncAttributeMaxDynamicSharedMemorySize, LDS_BYTES); attr = true; }
#endif
    hipLaunchKernelGGL(k_mega, dim3(grid), dim3(NT), LDS_BYTES, stream, p);
#endif
}
```

```cpp
#ifndef EMU
#include <hip/hip_runtime.h>
#endif
#include <stdint.h>
#include <stddef.h>
#include <math.h>

#ifndef CFG_B
#define CFG_B 8
#define CFG_SEQ 4096
#define CFG_CTX 256
#define CFG_DEPTH 4
#define CFG_FF 2048
#endif

#ifndef PROBE_REP
#define PROBE_REP 0
#endif
#define DI __device__ __forceinline__
typedef unsigned short bf16_t;
typedef short bf16x8 __attribute__((ext_vector_type(8)));
typedef short s16x4 __attribute__((ext_vector_type(4)));
typedef float f32x4 __attribute__((ext_vector_type(4)));
typedef unsigned u32x4 __attribute__((ext_vector_type(4)));
typedef unsigned u32x2 __attribute__((ext_vector_type(2)));

constexpr int NB = CFG_B, SEQ = CFG_SEQ, CTX = CFG_CTX, DEPTH = CFG_DEPTH, FF = CFG_FF, DM = 1024, NE = 16;
constexpr int RL = NB * SEQ, RC = NB * CTX, R = RL + RC;
constexpr int CAPL = SEQ / 8, CAPC = CTX / 8, ROWS_E = NB * (CAPL + CAPC);
constexpr int INW = 3344, PW = 3328;
constexpr int NT = 512;
constexpr int NCC = CTX / 128, NLC = SEQ / 128, NCHR = NCC + NLC;
constexpr int NCG = CTX / 64, NLG = SEQ / 64, NCHG = NCG + NLG;
constexpr float ALPHA = 1.681792830507429f;
constexpr float LOG2E = 1.4426950408889634f;
constexpr int C_RQ = 0, C_RK = 256, C_RV = 512, C_RG = 768, C_DQ = 1024, C_DK = 1280, C_DV = 1536, C_GQKV = 1792, C_GG = 2560, C_SQ = 2816, C_SK = 3072, C_SV = 3200;

constexpr size_t al256(size_t x) { return (x + 255) & ~(size_t)255; }
constexpr size_t OFF_BAR = 0;
constexpr size_t OFF_MOD = 16384;
constexpr size_t OFF_TAB = OFF_MOD + al256((size_t)DEPTH * (NB + 1) * 6144 * 4);
constexpr size_t OFF_WIN = OFF_TAB + al256((size_t)SEQ * 160 * 4);
constexpr size_t OFF_WOUT = OFF_WIN + al256((size_t)DEPTH * PW * 1024 * 2);
constexpr size_t OFF_WGU = OFF_WOUT + al256((size_t)DEPTH * 1024 * 1024 * 2);
constexpr size_t OFF_WDN = OFF_WGU + al256((size_t)DEPTH * 16 * 2 * FF * 1024 * 2);
constexpr size_t OFF_H = OFF_WDN + al256((size_t)DEPTH * 16 * 1024 * FF * 2);
constexpr size_t OFF_U = OFF_H + al256((size_t)R * 1024 * 4);
constexpr size_t OFF_GAB = OFF_U + al256((size_t)R * 1024 * 2);
constexpr size_t OFF_MIX = OFF_GAB + al256((size_t)R * 16 * 4);
constexpr size_t OFF_AFF = OFF_MIX + al256((size_t)R * 1024 * 2);
constexpr size_t OFF_IDX = OFF_AFF + al256((size_t)R * 16 * 4);
constexpr size_t OFF_WGT = OFF_IDX + al256((size_t)16 * ROWS_E * 4);
constexpr size_t OFF_INV = OFF_WGT + al256((size_t)16 * ROWS_E * 4);
constexpr size_t OFF_U8 = OFF_INV + al256((size_t)R * 16 * 4);
constexpr size_t OFF_ARA = OFF_U8 + al256((size_t)R * 1024);
constexpr size_t SZ_P = (size_t)R * PW * 2, SZ_HID8 = al256((size_t)16 * ROWS_E * FF), SZ_XIN8 = al256((size_t)16 * ROWS_E * 1024), SZ_HID = SZ_HID8 + SZ_XIN8;
constexpr size_t OFF_ARB = OFF_ARA + al256(SZ_P > SZ_HID ? SZ_P : SZ_HID);
constexpr size_t SZ_RKV = (size_t)NB * 4 * 2 * NCHR * 4096 * 4;
constexpr size_t GCH = (size_t)NB * 4 * 2 * NCHG;
constexpr size_t OB_RKV = 0, OB_RS = OB_RKV + al256(SZ_RKV), OB_GW = OB_RS + al256(SZ_RKV), OB_GQG = OB_GW + GCH * 8192, OB_GQK = OB_GQG + GCH * 8192,
                 OB_GKT = OB_GQK + GCH * 8192, OB_GUB = OB_GKT + GCH * 8192, OB_GCD = OB_GUB + GCH * 16384, OB_OG = OB_GCD + al256(GCH * 4), OB_END = OB_OG + (size_t)2 * R * 256 * 4;
constexpr size_t SZ_MIXO = (size_t)R * 1024 * 4, SZ_Y = (size_t)16 * ROWS_E * 1024 * 2;
constexpr size_t SZ_ARB = OB_END > SZ_MIXO ? (OB_END > SZ_Y ? OB_END : SZ_Y) : (SZ_MIXO > SZ_Y ? SZ_MIXO : SZ_Y);
constexpr size_t WS_TOTAL = OFF_ARB + al256(SZ_ARB);

struct Params {
    const float *x, *c, *ctx, *c_ctx, *ada_w, *ada_b, *w_in, *w_out, *ret_decay, *diff_lambda, *diff_norm, *gdn_conv, *gdn_a_log, *gdn_dt_bias,
        *gdn_norm, *swa_sink, *ln_g, *ln_b, *router_w, *w_gate, *w_up, *w_down;
    float* out; char* ws;
};

#ifdef EMU
#define NT_LOAD(p) (*(p))
#define NT_STORE(v, p) (*(p) = (v))
#else
#define NT_LOAD(p) __builtin_nontemporal_load(p)
#define NT_STORE(v, p) __builtin_nontemporal_store((v), (p))
#endif
DI float bf2f(bf16_t v) { return __uint_as_float(((unsigned)v) << 16); }
DI bf16_t f2bf(float f) { unsigned u = __float_as_uint(f); u += 0x7fffu + ((u >> 16) & 1u); return (bf16_t)(u >> 16); }
DI unsigned pk2(float lo, float hi) {
#ifdef EMU
    return (unsigned)f2bf(lo) | ((unsigned)f2bf(hi) << 16);
#else
    typedef float f32x2_ __attribute__((ext_vector_type(2))); typedef __bf16 bf16x2_ __attribute__((ext_vector_type(2)));
    const f32x2_ v = {lo, hi}; return __builtin_bit_cast(unsigned, __builtin_convertvector(v, bf16x2_));
#endif
}
#ifdef EMU
DI int max(int a, int b) { return a > b ? a : b; }
DI int tidx() { return (int)threadIdx.x; }
DI int bidx() { return (int)blockIdx.x; }
#else
DI int tidx() { int t = threadIdx.x; asm volatile("" : "+v"(t)); return t; }
DI int bidx() { int b = blockIdx.x; asm volatile("" : "+s"(b)); return b; }
#endif
constexpr float SW1 = 32.0f, SW2 = 64.0f, SH = 8.0f, SY = 64.0f;
DI unsigned pk4_fp8(float a, float b, float c, float d) {
    a = fminf(fmaxf(a, -448.f), 448.f); b = fminf(fmaxf(b, -448.f), 448.f); c = fminf(fmaxf(c, -448.f), 448.f); d = fminf(fmaxf(d, -448.f), 448.f);
    int r = __builtin_amdgcn_cvt_pk_fp8_f32(a, b, 0, false); r = __builtin_amdgcn_cvt_pk_fp8_f32(c, d, r, true); return (unsigned)r; }
#ifdef EMU
DI float sum8(float v) { for (int m = 4; m >= 1; m >>= 1) v += __shfl_xor(v, m); return v; }
DI float sum16(float v) { for (int m = 8; m >= 1; m >>= 1) v += __shfl_xor(v, m); return v; }
DI float wsum(float v) { for (int m = 32; m >= 1; m >>= 1) v += __shfl_xor(v, m); return v; }
DI int wsum_i(int v) { for (int m = 32; m >= 1; m >>= 1) v += __shfl_xor(v, m); return v; }
DI int lane_bcast(int v, int src) { return __shfl(v, src); }
DI int lane_shfl_i(int v, int src) { return __shfl(v, src); }
DI float lane_shfl_f(float v, int src) { return __shfl(v, src); }
#else
template <int CTRL> DI float dpp_f(float x) { return __int_as_float(__builtin_amdgcn_update_dpp(0, __float_as_int(x), CTRL, 0xF, 0xF, true)); }
template <int CTRL> DI int dpp_i(int x) { return __builtin_amdgcn_update_dpp(0, x, CTRL, 0xF, 0xF, true); }
DI float sum8(float x) { x += dpp_f<0xB1>(x); x += dpp_f<0x4E>(x); x += dpp_f<0x141>(x); return x; }
DI float sum16(float x) { x += dpp_f<0xB1>(x); x += dpp_f<0x4E>(x); x += dpp_f<0x141>(x); x += dpp_f<0x140>(x); return x; }
DI float wsum(float x) { x = sum16(x);
    auto a = __builtin_amdgcn_permlane16_swap(__float_as_uint(x), __float_as_uint(x), false, false); x = __uint_as_float(a[0]) + __uint_as_float(a[1]);
    auto b = __builtin_amdgcn_permlane32_swap(__float_as_uint(x), __float_as_uint(x), false, false); return __uint_as_float(b[0]) + __uint_as_float(b[1]); }
DI int wsum_i(int x) { x += dpp_i<0xB1>(x); x += dpp_i<0x4E>(x); x += dpp_i<0x141>(x); x += dpp_i<0x140>(x);
    auto a = __builtin_amdgcn_permlane16_swap((unsigned)x, (unsigned)x, false, false); x = (int)a[0] + (int)a[1];
    auto b = __builtin_amdgcn_permlane32_swap((unsigned)x, (unsigned)x, false, false); return (int)b[0] + (int)b[1]; }
DI int lane_bcast(int v, int src) { return __builtin_amdgcn_readlane(v, src); }
DI int lane_shfl_i(int v, int src) { return __builtin_amdgcn_ds_bpermute(src << 2, v); }
DI float lane_shfl_f(float v, int src) { return __int_as_float(__builtin_amdgcn_ds_bpermute(src << 2, __float_as_int(v))); }
#endif
#ifdef EMU
DI float lane_xor1_f(float x) { return __shfl_xor(x, 1); }
#else
DI float lane_xor1_f(float x) { return __int_as_float(__builtin_amdgcn_update_dpp(0, __float_as_int(x), 0xB1, 0xF, 0xF, true)); }
#endif
DI float bf_lo(unsigned v) { return __uint_as_float(v << 16); }
DI float bf_hi(unsigned v) { return __uint_as_float(v & 0xffff0000u); }
DI float siluf(float x) { return x * __builtin_amdgcn_rcpf(1.0f + __builtin_amdgcn_exp2f(-LOG2E * x)); }
DI float sigmoidf_(float x) { return __builtin_amdgcn_rcpf(1.0f + __builtin_amdgcn_exp2f(-LOG2E * x)); }
DI float softplusf_(float x) { return x > 20.0f ? x : 0.6931471805599453f * __builtin_amdgcn_logf(1.0f + __builtin_amdgcn_exp2f(x * LOG2E)); }
DI float ex2(float x) { return __builtin_amdgcn_exp2f(x); }
DI f32x4 MFMA16(bf16x8 a, bf16x8 b, f32x4 c) { return __builtin_amdgcn_mfma_f32_16x16x32_bf16(a, b, c, 0, 0, 0); }
typedef int i32x8 __attribute__((ext_vector_type(8)));
typedef unsigned u32x8 __attribute__((ext_vector_type(8)));
DI f32x4 mfma_fp8(u32x8 a, u32x8 b, f32x4 c) {
    return __builtin_amdgcn_mfma_scale_f32_16x16x128_f8f6f4(__builtin_bit_cast(i32x8, a), __builtin_bit_cast(i32x8, b), c, 0, 0, 0, 0x7F7F7F7F, 0, 0x7F7F7F7F); }
DI bf16x8 frag_lo(u32x8 v) { const u32x4 h = __builtin_shufflevector(v, v, 0, 1, 2, 3); return __builtin_bit_cast(bf16x8, h); }
DI bf16x8 frag_hi(u32x8 v) { const u32x4 h = __builtin_shufflevector(v, v, 4, 5, 6, 7); return __builtin_bit_cast(bf16x8, h); }
#ifdef EMU
#define WAIT_V(n)
#define STAGGER_SLEEP(flag)
#define WAIT_L(n)
#else
#define WAIT_V(n) asm volatile("s_waitcnt vmcnt(" #n ")" ::: "memory")
#ifndef STAG_N
#define STAG_N 6
#endif
#define STAG_STR2(x) #x
#define STAG_STR(x) STAG_STR2(x)
#define STAGGER_SLEEP(flag) asm volatile("s_cmp_eq_u32 %0, 0\n\ts_cbranch_scc1 .Lstg%=\n\ts_sleep " STAG_STR(STAG_N) "\n.Lstg%=:" :: "s"(flag) : "memory", "scc")
#define WAIT_L(n) asm volatile("s_waitcnt lgkmcnt(" #n ")" ::: "memory")
#endif
#define BAR __builtin_amdgcn_s_barrier()
#define SCHED __builtin_amdgcn_sched_barrier(0)

#ifdef EMU
#define LDS_BARRIER() __syncthreads()
#else
#define LDS_BARRIER() do { asm volatile("s_waitcnt lgkmcnt(0)" ::: "memory"); __builtin_amdgcn_s_barrier(); asm volatile("" ::: "memory"); } while (0)
#endif
#ifdef EMU
DI float grp_max(float x) { x = fmaxf(x, __shfl_xor(x, 16)); return fmaxf(x, __shfl_xor(x, 32)); }
DI float grp_sum(float x) { x += __shfl_xor(x, 16); return x + __shfl_xor(x, 32); }
DI int grp_imax(int x) { int y = __shfl_xor(x, 16); x = x > y ? x : y; y = __shfl_xor(x, 32); return x > y ? x : y; }
DI s16x4 lds_tr16(const bf16_t* p) { return emu_lds_tr16(p); }
#else
DI float grp_max(float x) {
    auto a = __builtin_amdgcn_permlane16_swap(__float_as_uint(x), __float_as_uint(x), false, false); x = fmaxf(__uint_as_float(a[0]), __uint_as_float(a[1]));
    auto b = __builtin_amdgcn_permlane32_swap(__float_as_uint(x), __float_as_uint(x), false, false); return fmaxf(__uint_as_float(b[0]), __uint_as_float(b[1])); }
DI float grp_sum(float x) {
    auto a = __builtin_amdgcn_permlane16_swap(__float_as_uint(x), __float_as_uint(x), false, false); x = __uint_as_float(a[0]) + __uint_as_float(a[1]);
    auto b = __builtin_amdgcn_permlane32_swap(__float_as_uint(x), __float_as_uint(x), false, false); return __uint_as_float(b[0]) + __uint_as_float(b[1]); }
DI int grp_imax(int x) {
    auto a = __builtin_amdgcn_permlane16_swap((unsigned)x, (unsigned)x, false, false); x = max((int)a[0], (int)a[1]);
    auto b = __builtin_amdgcn_permlane32_swap((unsigned)x, (unsigned)x, false, false); return max((int)b[0], (int)b[1]); }
typedef short v4i16_t_ __attribute__((ext_vector_type(4)));
DI s16x4 lds_tr16(const bf16_t* p) { return __builtin_bit_cast(s16x4, __builtin_amdgcn_ds_read_tr16_b64_v4i16((__attribute__((address_space(3))) v4i16_t_*)p)); }
#endif
#ifdef EMU
struct XcdBarrier { unsigned* bar; };
DI XcdBarrier xcd_barrier_post(unsigned* bar, void*) { XcdBarrier b; b.bar = bar; return b; }
DI void xcd_barrier(const XcdBarrier& b) {
    __syncthreads();
    if (threadIdx.x == 0) { unsigned g = __atomic_load_n(&b.bar[64], __ATOMIC_SEQ_CST);
        if (__atomic_fetch_add(&b.bar[0], 1u, __ATOMIC_SEQ_CST) == gridDim.x - 1) { __atomic_store_n(&b.bar[0], 0u, __ATOMIC_SEQ_CST); __atomic_fetch_add(&b.bar[64], 1u, __ATOMIC_SEQ_CST); }
        else while (__atomic_load_n(&b.bar[64], __ATOMIC_SEQ_CST) == g) sched_yield(); }
    __syncthreads();
}
#define XCD_BAR_WORDS 3456
#else
#define XB_TMO      128
#define XB_XCNT(j)  (256  + 64 * (j))
#define XB_XSUB(j)  (1280 + 64 * (j))
#define XB_XGEN(j)  (2304 + 64 * (j))
#define XB_TOP      3328
#define XB_TOPGEN   3392
#define XCD_BAR_WORDS 3456
#define XB_SPIN_CAP (1u << 22)
#define LAS __attribute__((address_space(3)))
DI unsigned xb_ld(unsigned* p)              { return __hip_atomic_load(p, __ATOMIC_RELAXED, __HIP_MEMORY_SCOPE_AGENT); }
DI unsigned xb_add(unsigned* p, unsigned v) { return __hip_atomic_fetch_add(p, v, __ATOMIC_RELAXED, __HIP_MEMORY_SCOPE_AGENT); }
DI unsigned xb_xcc_id() { return (unsigned)__builtin_amdgcn_s_getreg((3 << 11) | 20) & 0xFu; }
#define XB_SPIN(cond, bar) do { unsigned _sp = 0; while (cond) { __builtin_amdgcn_s_sleep(1); \
    if ((++_sp & 255u) == 0u) { if (xb_ld(&(bar)[XB_TMO])) break; if (_sp > XB_SPIN_CAP) { atomicAdd(&(bar)[XB_TMO], 1u); break; } } } } while (0)
struct XcdBarrier { unsigned* bar; unsigned x; volatile LAS unsigned* st; };
DI XcdBarrier xcd_barrier_post(unsigned* bar, volatile LAS unsigned* st) {
    XcdBarrier b; b.bar = bar; b.x = xb_xcc_id(); b.st = st;
    if (threadIdx.x == 0) (void)xb_add(&bar[XB_XCNT(b.x)], 1u);
    return b;
}
DI void xcd_barrier_complete(unsigned* bar, unsigned x, unsigned& nloc, unsigned& nx) {
    const unsigned G = gridDim.x * gridDim.y * gridDim.z;
    unsigned sum, cnt, mine, sp = 0u;
    for (;;) {
        sum = 0u; cnt = 0u; mine = 0u;
#pragma unroll
        for (unsigned j = 0; j < 16; ++j) { const unsigned c = xb_ld(&bar[XB_XCNT(j)]); sum += c; cnt += (c > 0u) ? 1u : 0u; mine = (j == x) ? c : mine; }
        if (sum == G) break;
        __builtin_amdgcn_s_sleep(1);
        if ((++sp & 255u) == 0u) { if (xb_ld(&bar[XB_TMO])) break; if (sp > XB_SPIN_CAP) { atomicAdd(&bar[XB_TMO], 1u); break; } }
    }
    nloc = mine > 0u ? mine : 1u; nx = cnt > 0u ? cnt : 1u;
}
DI void xcd_barrier(const XcdBarrier& b) {
    asm volatile("s_waitcnt vmcnt(0)" ::: "memory");
    __syncthreads();
    if (threadIdx.x == 0) {
        unsigned* bar = b.bar;
        __builtin_amdgcn_s_waitcnt(0);
        unsigned nloc = b.st[0], nx = b.st[1];
        if (nloc == 0u) { xcd_barrier_complete(bar, b.x, nloc, nx); b.st[0] = nloc; b.st[1] = nx; }
        const unsigned old = xb_add(&bar[XB_XSUB(b.x)], 1u);
        const unsigned gen = old / nloc;
        if (old + 1u == (gen + 1u) * nloc) {
            __builtin_amdgcn_fence(__ATOMIC_RELEASE, "agent");
            asm volatile("s_waitcnt vmcnt(0)" ::: "memory");
            const unsigned og = xb_add(&bar[XB_TOP], 1u);
            const unsigned tg = og / nx;
            if (og + 1u == (tg + 1u) * nx) xb_add(&bar[XB_TOPGEN], 1u);
            else XB_SPIN(xb_ld(&bar[XB_TOPGEN]) == tg, bar);
            __builtin_amdgcn_fence(__ATOMIC_ACQUIRE, "agent");
            xb_add(&bar[XB_XGEN(b.x)], 1u);
            asm volatile("s_waitcnt vmcnt(0)" ::: "memory");
        } else {
            XB_SPIN(xb_ld(&bar[XB_XGEN(b.x)]) == gen, bar);
            __builtin_amdgcn_fence(__ATOMIC_ACQUIRE, "agent");
            asm volatile("s_waitcnt vmcnt(0)" ::: "memory");
        }
    }
    __syncthreads();
}
#endif

struct WS {
    unsigned* bar; float* mod; float* tab; bf16_t* win; bf16_t* wout; unsigned char* wgu; unsigned char* wdn; float* h; bf16_t* u; unsigned char* u8; float* gab; bf16_t* mix; float* aff;
    int* idx; float* wgt; int* inv; bf16_t* p; unsigned char* hid; unsigned char* xin; bf16_t* rkv; bf16_t* rs; bf16_t* gw; bf16_t* gqg; bf16_t* gqk; bf16_t* gkt; bf16_t* gub; float* gcd; bf16_t* og; bf16_t* mixo; unsigned char* y;
};
DI WS ws_of(char* w) {
    WS s; s.bar = (unsigned*)(w + OFF_BAR); s.mod = (float*)(w + OFF_MOD); s.tab = (float*)(w + OFF_TAB); s.win = (bf16_t*)(w + OFF_WIN); s.wout = (bf16_t*)(w + OFF_WOUT);
    s.wgu = (unsigned char*)(w + OFF_WGU); s.wdn = (unsigned char*)(w + OFF_WDN); s.u8 = (unsigned char*)(w + OFF_U8); s.h = (float*)(w + OFF_H); s.u = (bf16_t*)(w + OFF_U); s.gab = (float*)(w + OFF_GAB); s.mix = (bf16_t*)(w + OFF_MIX);
    s.aff = (float*)(w + OFF_AFF); s.idx = (int*)(w + OFF_IDX); s.wgt = (float*)(w + OFF_WGT); s.inv = (int*)(w + OFF_INV); s.p = (bf16_t*)(w + OFF_ARA); s.hid = (unsigned char*)(w + OFF_ARA); s.xin = (unsigned char*)(w + OFF_ARA + SZ_HID8);
    char* b = w + OFF_ARB; s.rkv = (bf16_t*)(b + OB_RKV); s.rs = (bf16_t*)(b + OB_RS); s.gw = (bf16_t*)(b + OB_GW); s.gqg = (bf16_t*)(b + OB_GQG); s.gqk = (bf16_t*)(b + OB_GQK);
    s.gkt = (bf16_t*)(b + OB_GKT); s.gub = (bf16_t*)(b + OB_GUB); s.gcd = (float*)(b + OB_GCD); s.og = (bf16_t*)(b + OB_OG); s.mixo = (bf16_t*)b; s.y = (unsigned char*)b;
    return s;
}

struct CvtJob { const float* src; char* dst; int src_ld, dst_ld  , mode  ; float scale; };
DI CvtJob cvt_job(const Params& p, const WS& w, int u) {
    constexpr int FT = FF / 128, n_in = 8 * 52, n_out = 8 * 16, n_g = 16 * 8 * (FF / 64), n_d = 16 * FT * 16, tot_l = n_in + n_out + 2 * n_g + n_d;
    const int l = u / tot_l; int r = u % tot_l; CvtJob j; j.scale = 1.0f;
    if (r < n_in) { const int kt = r & 7, ct = r >> 3, c0 = ct < 44 ? ct * 64 : 2832 + (ct - 44) * 64;
        j.src = p.w_in + (size_t)l * 1024 * INW + (size_t)(kt * 128) * INW + c0; j.src_ld = INW; j.dst = (char*)(w.win + (size_t)l * PW * 1024 + (size_t)(ct < 44 ? c0 : c0 - 16) * 1024 + kt * 128); j.dst_ld = 2048;
        j.mode = (ct < 8 || (ct >= 44 && ct < 50)) ? 1 : ((ct >= 16 && ct < 24) ? 3 : 0);
    } else if (r < n_in + n_out) { r -= n_in; const int kt = r & 7, ct = r >> 3;
        j.src = p.w_out + (size_t)l * 1024 * 1024 + (size_t)(kt * 128) * 1024 + ct * 64; j.src_ld = 1024; j.dst = (char*)(w.wout + (size_t)l * 1024 * 1024 + (size_t)(ct * 64) * 1024 + kt * 128); j.dst_ld = 2048; j.mode = 0;
    } else if (r < n_in + n_out + 2 * n_g) { r -= n_in + n_out; const int which = r / n_g, rr = r % n_g, e = rr / (8 * (FF / 64)), r2 = rr % (8 * (FF / 64)), kt = r2 & 7, ct = r2 >> 3, c0 = ct * 64;
        j.src = (which ? p.w_up : p.w_gate) + (size_t)(l * 16 + e) * 1024 * FF + (size_t)(kt * 128) * FF + c0; j.src_ld = FF;
        j.dst = (char*)(w.wgu + (size_t)(l * 16 + e) * 2 * FF * 1024 + (size_t)((c0 >> 7) * 256 + which * 128 + (c0 & 127)) * 1024 + kt * 128); j.dst_ld = 1024; j.mode = 2; j.scale = SW1;
    } else { r -= n_in + n_out + 2 * n_g; const int e = r / (16 * FT), r2 = r % (16 * FT), kt = r2 % FT, ct = r2 / FT;
        j.src = p.w_down + (size_t)(l * 16 + e) * FF * 1024 + (size_t)(kt * 128) * 1024 + ct * 64; j.src_ld = 1024; j.dst = (char*)(w.wdn + (size_t)(l * 16 + e) * 1024 * FF + (size_t)(ct * 64) * FF + kt * 128); j.dst_ld = FF; j.mode = 2; j.scale = SW2;
    }
    return j;
}
#define CVT_LOAD(j, v) _Pragma("unroll") for (int i = 0; i < 16; ++i) { const int idx = tid + NT * i, kk = idx >> 6, cc = idx & 63; v[i] = NT_LOAD((j).src + (size_t)kk * (j).src_ld + cc); }
constexpr int CVT_TOT_L = 8 * 52 + 8 * 16 + 2 * 16 * 8 * (FF / 64) + 16 * (FF / 128) * 16;
#ifndef CVT_PER_B
#define CVT_PER_B 16
#endif
#ifndef CVT_PER_D
#define CVT_PER_D 16
#endif
#ifndef CVT_PER_A
#define CVT_PER_A 16
#endif
#ifndef CVT_PER_T
#define CVT_PER_T 0
#endif
constexpr int cvt_share(int pct, int n) { return (CVT_TOT_L * pct / 100) < n ? (CVT_TOT_L * pct / 100) : n; }
constexpr int CVT_TAIL_B = cvt_share(30, 224 * CVT_PER_B), CVT_TAIL_D = cvt_share(25, 192 * CVT_PER_D), CVT_TAIL_A = cvt_share(3, 24 * CVT_PER_A), CVT_TAIL_T = cvt_share(12, 128 * CVT_PER_T);
constexpr int CVT_AHEAD = CVT_TAIL_B + CVT_TAIL_D + CVT_TAIL_A + CVT_TAIL_T, CVT_P0 = DEPTH * (CVT_TOT_L - CVT_AHEAD) + CVT_TAIL_D;
static_assert(CVT_TOT_L - CVT_AHEAD + CVT_TAIL_D >= 8 * 52 + 8 * 16, "a layer's in-proj / out-proj tiles must be converted before its own windows");
template <int KIND> DI int cvt_tile_id(int q, int layer) {
    if (KIND == 0) return q;
    return CVT_P0 + layer * CVT_AHEAD + (KIND == 3 ? 0 : (KIND == 1 ? CVT_TAIL_A : (KIND == 4 ? CVT_TAIL_A + CVT_TAIL_B : CVT_TAIL_A + CVT_TAIL_B + CVT_TAIL_T))) + q;
}
template <int KIND> DI void cvt_stream(const Params& p, const WS& w, char* smem, int layer, int rank, int nranks) {
    float* tile = (float*)smem;
    constexpr int total = KIND == 0 ? CVT_P0 : (KIND == 1 ? CVT_TAIL_B : (KIND == 2 ? CVT_TAIL_D : (KIND == 3 ? CVT_TAIL_A : CVT_TAIL_T)));
    const int tid = tidx(); int q = rank;
    if (q < total) {
        CvtJob j = cvt_job(p, w, cvt_tile_id<KIND>(q, layer)); float v[16];
        CVT_LOAD(j, v);
        for (;;) {
#pragma unroll
            for (int i = 0; i < 16; ++i) { const int idx = tid + NT * i, kk = idx >> 6, cc = idx & 63; tile[kk * 65 + cc] = v[i] * j.scale; }
            const int qn = q + nranks; CvtJob jn = j;
            if (qn < total) { jn = cvt_job(p, w, cvt_tile_id<KIND>(qn, layer)); CVT_LOAD(jn, v); }
            LDS_BARRIER();
            if (j.mode == 2) {
#pragma unroll
                for (int i = 0; i < 4; ++i) { const int idx = tid + NT * i, cc = idx >> 5, kq = idx & 31;
                    *(unsigned*)(j.dst + (size_t)cc * j.dst_ld + 4 * kq) = pk4_fp8(tile[(4 * kq) * 65 + cc], tile[(4 * kq + 1) * 65 + cc], tile[(4 * kq + 2) * 65 + cc], tile[(4 * kq + 3) * 65 + cc]); }
            } else {
#pragma unroll
                for (int i = 0; i < 8; ++i) { const int idx = tid + NT * i, cc = idx >> 6, kp = idx & 63;
                    const int pc = j.mode == 1 ? 32 * ((cc >> 4) & 1) + 8 * ((cc >> 2) & 3) + 4 * (cc >> 5) + (cc & 3) : (j.mode == 3 ? 32 * (cc >> 5) + 8 * ((cc >> 2) & 3) + 4 * ((cc >> 4) & 1) + (cc & 3) : cc);
                    *(unsigned*)(j.dst + (size_t)pc * j.dst_ld + 4 * kp) = pk2(tile[(2 * kp) * 65 + cc], tile[(2 * kp + 1) * 65 + cc]); }
            }
            LDS_BARRIER();
            if (qn >= total) break;
            q = qn; j = jn;
        }
    }
    __syncthreads();
}
DI void phase_cvt(const Params& p, char* smem) {
    const WS w = ws_of(p.ws);
    cvt_stream<0>(p, w, smem, 0, bidx(), gridDim.x);
    for (int i = bidx() * NT + tidx(); i < SEQ * 80; i += gridDim.x * NT) {
        const int n = i / 80, a = i % 80, row = n / 64, col = n % 64; float ang;
        if (a < 32) ang = (float)n * (1.0f / powf(10000.0f, (float)a / 31.0f));
        else if (a < 48) { const int ii = a - 32; ang = (float)(ii < 8 ? row : col) * powf(10000.0f, -(float)(ii & 7) / 8.0f); }
        else { const int ii = a - 48; ang = (float)(ii < 16 ? row : col) * powf(10000.0f, -(float)(ii & 15) / 16.0f); }
        w.tab[2 * i] = cosf(ang); w.tab[2 * i + 1] = sinf(ang);
    }
    float* cond = (float*)smem; float* red = cond + (NB + 1) * 1024;
    __syncthreads();
    for (int i = tidx(); i < (NB + 1) * 1024; i += NT) { const int r = i >> 10, k = i & 1023; const float v = r < NB ? p.c[r * 1024 + k] : p.c_ctx[k]; cond[i] = siluf(v); }
    __syncthreads();
    for (int u = bidx(); u < DEPTH * 96; u += gridDim.x) {
        const int l = u / 96, cg = u % 96, col = tidx() & 63, kg = tidx() >> 6;
        float acc[NB + 1];
#pragma unroll
        for (int r = 0; r <= NB; ++r) acc[r] = 0.f;
        const float* wp = p.ada_w + ((size_t)l * 1024 + kg * 128) * 6144 + cg * 64 + col;
        for (int k = 0; k < 128; ++k) { const float wv = wp[(size_t)k * 6144];
#pragma unroll
            for (int r = 0; r <= NB; ++r) acc[r] += cond[r * 1024 + kg * 128 + k] * wv; }
#pragma unroll
        for (int r = 0; r <= NB; ++r) red[(kg * (NB + 1) + r) * 64 + col] = acc[r];
        __syncthreads();
        for (int i = tidx(); i < (NB + 1) * 64; i += NT) { const int r = i >> 6, cc = i & 63; float s = p.ada_b[l * 6144 + cg * 64 + cc];
#pragma unroll
            for (int g = 0; g < 8; ++g) s += red[(g * (NB + 1) + r) * 64 + cc];
            w.mod[((size_t)l * (NB + 1) + r) * 6144 + cg * 64 + cc] = s; }
        __syncthreads();
    }
}

template <int MODE> DI void phase_rows(const Params& p, int layer, char* smem) {
    const WS w = ws_of(p.ws); float* Wl = (float*)smem;
    const int tid = tidx(), lane = tid & 63, wv = tid >> 6;
    const bool last = (layer == DEPTH - 1);
    __syncthreads();
    if (MODE == 0 || (MODE == 2 && !last)) { const int l2 = MODE == 0 ? 0 : layer + 1;
        for (int i = tid; i < 16 * 1024; i += NT) { const int o = i & 15, k = i >> 4; Wl[o * 1024 + k] = p.w_in[((size_t)l2 * 1024 + k) * INW + 2816 + o]; } }
    if (MODE == 1) for (int i = tid; i < 16 * 1024; i += NT) { const int o = i & 15, k = i >> 4; Wl[o * 1024 + k] = p.router_w[((size_t)layer * 1024 + k) * 16 + o]; }
    __syncthreads();
    const int nrows = (MODE != 0 && last) ? RL : R;
    const int nwaves = gridDim.x * 8, chunk = (nrows + nwaves - 1) / nwaves, row_beg = (bidx() * 8 + wv) * chunk, row_end = row_beg + chunk < nrows ? row_beg + chunk : nrows;
    if (row_beg >= row_end) return;
    f32x4 lg4[4], lb4[4], mg4[4], m04[4], m14[4];
    if (MODE != 0) { const float* lg = p.ln_g + ((size_t)layer * 2 + (MODE == 1 ? 0 : 1)) * 1024; const float* lb = p.ln_b + ((size_t)layer * 2 + (MODE == 1 ? 0 : 1)) * 1024;
#pragma unroll
        for (int j = 0; j < 4; ++j) { lg4[j] = *(const f32x4*)(lg + 256 * j + 4 * lane); lb4[j] = *(const f32x4*)(lb + 256 * j + 4 * lane); } }
    int bcur = -1;
    const int lm = MODE == 2 ? layer + 1 : (MODE == 0 ? 0 : layer);
    const bool write_u = !(MODE == 2 && last);
    auto batch_of = [&](int r) { return r >= RL ? NB : r / SEQ; };
    unsigned short* h_hi = (unsigned short*)w.h; unsigned char* h_lo = (unsigned char*)w.h + (size_t)R * 2048;
    f32x4 hn[2][4]; u32x2 hh[2][4]; unsigned hl[2][4]; u32x2 bn[2][4]; int invn[2] = {-1, -1};
#define ROW_FETCH(Q, ROW) do { const int r_ = (ROW); const bool isc_ = r_ >= RL; \
        const float* src_ = MODE == 0 ? (isc_ ? p.ctx + (size_t)(r_ - RL) * 1024 : p.x + (size_t)r_ * 1024) : w.h + (size_t)r_ * 1024; \
        if (MODE == 0) { _Pragma("unroll") for (int j = 0; j < 4; ++j) hn[Q][j] = NT_LOAD((const f32x4*)(src_ + 256 * j + 4 * lane)); } \
        else { _Pragma("unroll") for (int j = 0; j < 4; ++j) { hh[Q][j] = NT_LOAD((const u32x2*)(h_hi + (size_t)r_ * 1024 + 256 * j + 4 * lane)); hl[Q][j] = NT_LOAD((const unsigned*)(h_lo + (size_t)r_ * 1024 + 256 * j + 4 * lane)); } } \
        if (MODE == 1) { _Pragma("unroll") for (int j = 0; j < 4; ++j) bn[Q][j] = NT_LOAD((const u32x2*)(w.mixo + (size_t)r_ * 1024 + 256 * j + 4 * lane)); } \
        if (MODE == 2) invn[Q] = lane < 16 ? w.inv[(size_t)r_ * 16 + lane] : -1; } while (0)
    int row = row_beg, nr = (row + 1 < row_end && batch_of(row + 1) == batch_of(row)) ? 2 : 1;
    ROW_FETCH(0, row); ROW_FETCH(1, nr == 2 ? row + 1 : row);
    while (row < row_end) {
        const bool isc = row >= RL; const int b = isc ? NB : row / SEQ;
        if (b != bcur) { bcur = b;
            if (MODE != 0) { const float* mg = w.mod + ((size_t)layer * (NB + 1) + b) * 6144 + (MODE == 1 ? 2 : 5) * 1024;
#pragma unroll
                for (int j = 0; j < 4; ++j) mg4[j] = *(const f32x4*)(mg + 256 * j + 4 * lane); }
            if (write_u) { const float* m0 = w.mod + ((size_t)lm * (NB + 1) + b) * 6144 + (MODE == 1 ? 3 : 0) * 1024;
#pragma unroll
                for (int j = 0; j < 4; ++j) { m04[j] = *(const f32x4*)(m0 + 256 * j + 4 * lane); m14[j] = *(const f32x4*)(m0 + 1024 + 256 * j + 4 * lane); } } }
        f32x4 hv[2][4]; u32x2 bc[2][4]; int myinv[2];
#pragma unroll
        for (int q = 0; q < 2; ++q) { myinv[q] = invn[q];
#pragma unroll
            for (int j = 0; j < 4; ++j) { bc[q][j] = bn[q][j];
                if (MODE == 0) hv[q][j] = hn[q][j];
                else { const u32x2 a_ = hh[q][j]; const unsigned b_ = hl[q][j];
                    hv[q][j] = (f32x4){__uint_as_float((a_[0] << 16) | ((b_ & 0xffu) << 8)), __uint_as_float((a_[0] & 0xffff0000u) | (b_ & 0xff00u)),
                                       __uint_as_float((a_[1] << 16) | ((b_ >> 8) & 0xff00u)), __uint_as_float((a_[1] & 0xffff0000u) | ((b_ >> 16) & 0xff00u))}; } } }
        const int row_cur = row, nr_cur = nr;
        row += nr;
        if (row < row_end) { nr = (row + 1 < row_end && batch_of(row + 1) == batch_of(row)) ? 2 : 1; ROW_FETCH(0, row); ROW_FETCH(1, nr == 2 ? row + 1 : row); }
        f32x4 uv[2][4];
#pragma unroll
        for (int q = 0; q < 2; ++q) {
            const int rw_ = row_cur + (q < nr_cur ? q : 0);
            if (MODE != 0) {
                f32x4 br[4];
                if (MODE == 1) {
#pragma unroll
                    for (int j = 0; j < 4; ++j) br[j] = (f32x4){__uint_as_float(bc[q][j][0] << 16), __uint_as_float(bc[q][j][0] & 0xffff0000u), __uint_as_float(bc[q][j][1] << 16), __uint_as_float(bc[q][j][1] & 0xffff0000u)};
                } else {
#pragma unroll
                    for (int j = 0; j < 4; ++j) br[j] = (f32x4){0.f, 0.f, 0.f, 0.f};
                    for (int e = 0; e < 16; ++e) { const int sl = lane_bcast(myinv[q], e);
                        if (sl >= 0) { const unsigned char* yr = w.y + ((size_t)e * ROWS_E + sl) * 1024;
#pragma unroll
                            for (int j = 0; j < 4; ++j) { const int v = (int)NT_LOAD((const unsigned*)(yr + 256 * j + 4 * lane));
                                const auto lo_ = __builtin_amdgcn_cvt_pk_f32_fp8(v, false), hi_ = __builtin_amdgcn_cvt_pk_f32_fp8(v, true);
                                br[j][0] += lo_[0]; br[j][1] += lo_[1]; br[j][2] += hi_[0]; br[j][3] += hi_[1]; } } }
#pragma unroll
                    for (int j = 0; j < 4; ++j) br[j] = br[j] * (1.0f / SY);
                }
                float sm_ = 0.f;
#pragma unroll
                for (int j = 0; j < 4; ++j) { hv[q][j] = ALPHA * hv[q][j] + mg4[j] * br[j]; sm_ += hv[q][j][0] + hv[q][j][1] + hv[q][j][2] + hv[q][j][3]; }
                const float mean = wsum(sm_) * (1.0f / 1024.0f); float qq = 0.f;
#pragma unroll
                for (int j = 0; j < 4; ++j) { hv[q][j] = hv[q][j] - mean; qq += hv[q][j][0] * hv[q][j][0] + hv[q][j][1] * hv[q][j][1] + hv[q][j][2] * hv[q][j][2] + hv[q][j][3] * hv[q][j][3]; }
                const float rstd = 1.0f / sqrtf(wsum(qq) * (1.0f / 1024.0f) + 1e-5f);
#pragma unroll
                for (int j = 0; j < 4; ++j) hv[q][j] = hv[q][j] * rstd * lg4[j] + lb4[j];
            }
            if (q < nr_cur) {
                if (MODE == 2 && last) {
#pragma unroll
                    for (int j = 0; j < 4; ++j) *(f32x4*)(p.out + (size_t)rw_ * 1024 + 256 * j + 4 * lane) = hv[q][j];
                } else {
#pragma unroll
                    for (int j = 0; j < 4; ++j) { const unsigned u0 = __float_as_uint(hv[q][j][0]) + 0x80u, u1 = __float_as_uint(hv[q][j][1]) + 0x80u, u2 = __float_as_uint(hv[q][j][2]) + 0x80u, u3 = __float_as_uint(hv[q][j][3]) + 0x80u;
                        u32x2 a_; a_[0] = (u0 >> 16) | (u1 & 0xffff0000u); a_[1] = (u2 >> 16) | (u3 & 0xffff0000u);
                        const unsigned b_ = ((u0 >> 8) & 0xffu) | (u1 & 0xff00u) | ((u2 << 8) & 0xff0000u) | ((u3 << 16) & 0xff000000u);
                        NT_STORE(a_, (u32x2*)(h_hi + (size_t)rw_ * 1024 + 256 * j + 4 * lane)); NT_STORE(b_, (unsigned*)(h_lo + (size_t)rw_ * 1024 + 256 * j + 4 * lane)); }
                }
            }
#pragma unroll
            for (int j = 0; j < 4; ++j) { uv[q][j] = hv[q][j] * (1.0f + m14[j]) + m04[j];
                if (write_u && q < nr_cur) { if (MODE == 1) *(unsigned*)(w.u8 + (size_t)rw_ * 1024 + 256 * j + 4 * lane) = pk4_fp8(uv[q][j][0], uv[q][j][1], uv[q][j][2], uv[q][j][3]);
                    else { u32x2 o; o[0] = pk2(uv[q][j][0], uv[q][j][1]); o[1] = pk2(uv[q][j][2], uv[q][j][3]); *(u32x2*)(w.u + (size_t)rw_ * 1024 + 256 * j + 4 * lane) = o; } } }
        }
        if (!write_u) continue;
        float lgt[2][16];
#pragma unroll
        for (int o = 0; o < 16; ++o) { float a0 = 0.f, a1 = 0.f;
#pragma unroll
            for (int j = 0; j < 4; ++j) { const f32x4 wv4 = *(const f32x4*)(Wl + o * 1024 + 256 * j + 4 * lane);
                a0 += uv[0][j][0] * wv4[0] + uv[0][j][1] * wv4[1] + uv[0][j][2] * wv4[2] + uv[0][j][3] * wv4[3]; a1 += uv[1][j][0] * wv4[0] + uv[1][j][1] * wv4[1] + uv[1][j][2] * wv4[2] + uv[1][j][3] * wv4[3]; }
            lgt[0][o] = wsum(a0); lgt[1][o] = wsum(a1); SCHED; }
#pragma unroll
        for (int q = 0; q < 2; ++q) {
            if (q >= nr_cur) continue;
            const int rw_ = row_cur + q; float mine = 0.f;
            if (MODE == 1) { float mx = lgt[q][0];
#pragma unroll
                for (int o = 1; o < 16; ++o) mx = fmaxf(mx, lgt[q][o]);
                float sm = 0.f;
#pragma unroll
                for (int o = 0; o < 16; ++o) { lgt[q][o] = __expf(lgt[q][o] - mx); sm += lgt[q][o]; }
                const float inv = 1.0f / sm;
#pragma unroll
                for (int o = 0; o < 16; ++o) if (lane == o) mine = lgt[q][o] * inv;
                if (lane < 16) { if (rw_ < RL) { const int bb = rw_ / SEQ, n = rw_ % SEQ; w.aff[((size_t)bb * 16 + lane) * SEQ + n] = mine; }
                                 else { const int rr = rw_ - RL, bb = rr / CTX, n = rr % CTX; w.aff[(size_t)RL * 16 + ((size_t)bb * 16 + lane) * CTX + n] = mine; } }
            } else {
#pragma unroll
                for (int o = 0; o < 16; ++o) if (lane == o) mine = lgt[q][o];
                if (lane < 16) w.gab[(size_t)rw_ * 16 + lane] = mine;
            }
        }
    }
#undef ROW_FETCH
}

constexpr int G_HT = 128 * 64;
DI int lds_byte(int r, int c) { const int st = (r >> 4) * 2 + (c >> 5), rr = r & 15, cc = c & 31, ob = rr * 64 + cc * 2; return st * 1024 + (ob ^ (((ob >> 9) & 1) << 5)); }
DI void stage_rc(int b, int& Rr, int& Cc) { const int st = b / 1024, sb = b % 1024, swz = sb ^ (((sb >> 9) & 1) << 5); Rr = (st >> 1) * 16 + swz / 64; Cc = (st & 1) * 32 + (swz % 64) / 2; }
#define GLDS16(g, l) __builtin_amdgcn_global_load_lds((const unsigned*)(g), (unsigned*)(l), 16, 0, 0)

struct EpiArgs { void* out; int ld; long orow0; const float* wgt; const float* tab; int kind0, kind1; float sc0, sc1; };
template <int EPI, bool GATHER>
DI void gemm_unit(const bf16_t* __restrict__ A, const bf16_t* __restrict__ Bt, const int K, const int brow, const int bcol, const int* __restrict__ gidx, const EpiArgs ea, char* smem) {
    bf16_t* shm = (bf16_t*)smem;
#define SA(b, h) (shm + ((b) * 2 + (h)) * G_HT)
#define SB(b, h) (shm + (4 + (b) * 2 + (h)) * G_HT)
#define STAGE_B(T, P, h, kt) do { _Pragma("unroll") for (int _i = 0; _i < 2; ++_i) { const int _b = (T) * 16 + _i * 8192; int _r, _c; stage_rc(_b, _r, _c); \
        GLDS16(Bt + (unsigned)((bcol + (h) * 128 + _r) * K + (kt) * 64 + _c), (char*)(P) + _b); } } while (0)
#define STAGE_A(T, P, h, kt) do { _Pragma("unroll") for (int _i = 0; _i < 2; ++_i) { const int _b = (T) * 16 + _i * 8192; int _r, _c; stage_rc(_b, _r, _c); \
        const int _ro = GATHER ? rid[h][_i] : (brow + (h) * 128 + _r); GLDS16(A + (unsigned)(_ro * K + (kt) * 64 + _c), (char*)(P) + _b); } } while (0)
#define LDA(dst, b, h) _Pragma("unroll") for (int m = 0; m < 4; ++m) _Pragma("unroll") for (int k = 0; k < 2; ++k) \
        dst[m][k] = *reinterpret_cast<const bf16x8*>((char*)SA(b, h) + lds_byte(wr * 64 + m * 16 + fr, k * 32 + fq * 8))
#define LDB(dst, b, h) _Pragma("unroll") for (int n = 0; n < 2; ++n) _Pragma("unroll") for (int k = 0; k < 2; ++k) \
        dst[n][k] = *reinterpret_cast<const bf16x8*>((char*)SB(b, h) + lds_byte(wc * 32 + n * 16 + fr, k * 32 + fq * 8))
#define MMA(ai, bj, At_, Bt_) do { __builtin_amdgcn_s_setprio(1); \
        _Pragma("unroll") for (int m = 0; m < 4; ++m) _Pragma("unroll") for (int n = 0; n < 2; ++n) _Pragma("unroll") for (int k = 0; k < 2; ++k) \
            acc[ai][bj][m][n] = MFMA16(Bt_[n][k], At_[m][k], acc[ai][bj][m][n]); \
        __builtin_amdgcn_s_setprio(0); } while (0)
    int tid = tidx();
#ifndef EMU
    asm volatile("" : "+v"(tid));
#endif
    int wid = tid >> 6, lane = tid & 63, wr = wid >> 2, wc = wid & 3, fr = lane & 15, fq = lane >> 4;
    int rid[2][2];
    if (GATHER) {
#pragma unroll
        for (int h = 0; h < 2; ++h)
#pragma unroll
            for (int i = 0; i < 2; ++i) { int r_, c_; stage_rc(tid * 16 + i * 8192, r_, c_); rid[h][i] = gidx[h * 128 + r_]; }
    }
    f32x4 acc[2][2][4][2];
#pragma unroll
    for (int a = 0; a < 2; ++a)
#pragma unroll
        for (int b = 0; b < 2; ++b)
#pragma unroll
            for (int m = 0; m < 4; ++m)
#pragma unroll
                for (int n = 0; n < 2; ++n) acc[a][b][m][n] = (f32x4){0.f, 0.f, 0.f, 0.f};
    bf16x8 At[4][2], B0[2][2], B1[2][2];
    const int nt = K / 64;
    STAGE_B(tid, SB(0, 0), 0, 0); STAGE_A(tid, SA(0, 0), 0, 0);
    STAGE_B(tid, SB(0, 1), 1, 0); STAGE_A(tid, SA(0, 1), 1, 0);
    if (wr == 1) BAR;
    WAIT_V(4); BAR;
    STAGE_B(tid, SB(1, 0), 0, 1); STAGE_A(tid, SA(1, 0), 0, 1); STAGE_B(tid, SB(1, 1), 1, 1);
    WAIT_V(6); BAR;
    for (int t = 0; t < nt - 2; t += 2) {
        LDB(B0, 0, 0); SCHED; LDA(At, 0, 0); STAGE_A(tid, SA(1, 1), 1, t + 1);
        WAIT_L(8); BAR; WAIT_L(0); MMA(0, 0, At, B0); BAR; SCHED;
        LDB(B1, 0, 1); STAGE_B(tid, SB(0, 0), 0, t + 2);
        BAR; WAIT_L(0); MMA(0, 1, At, B1); BAR;
        LDA(At, 0, 1); STAGE_A(tid, SA(0, 0), 0, t + 2);
        BAR; WAIT_L(0); MMA(1, 0, At, B0); BAR; SCHED;
        STAGE_B(tid, SB(0, 1), 1, t + 2);
        WAIT_V(6); BAR; MMA(1, 1, At, B1); BAR;
        LDB(B0, 1, 0); SCHED; LDA(At, 1, 0); STAGE_A(tid, SA(0, 1), 1, t + 2);
        WAIT_L(8); BAR; WAIT_L(0); MMA(0, 0, At, B0); BAR; SCHED;
        LDB(B1, 1, 1); STAGE_B(tid, SB(1, 0), 0, t + 3);
        BAR; WAIT_L(0); MMA(0, 1, At, B1); BAR;
        LDA(At, 1, 1); STAGE_A(tid, SA(1, 0), 0, t + 3);
        BAR; WAIT_L(0); MMA(1, 0, At, B0); BAR; SCHED;
        STAGE_B(tid, SB(1, 1), 1, t + 3);
        WAIT_V(6); BAR; MMA(1, 1, At, B1); BAR;
    }
    int tz = tidx();
#ifndef EMU
    asm volatile("" : "+v"(tz));
#endif
    wid = tz >> 6; lane = tz & 63; wr = wid >> 2; wc = wid & 3; fr = lane & 15; fq = lane >> 4;
    { LDB(B0, 0, 0); WAIT_V(0); LDA(At, 0, 0); STAGE_A(tz, SA(1, 1), 1, nt - 1);
      BAR; WAIT_L(0); MMA(0, 0, At, B0); BAR;
      LDB(B1, 0, 1); BAR; WAIT_L(0); MMA(0, 1, At, B1); BAR;
      LDA(At, 0, 1); WAIT_V(4); BAR; WAIT_L(0); MMA(1, 0, At, B0); MMA(1, 1, At, B1); BAR; }
    { LDB(B0, 1, 0); LDA(At, 1, 0); WAIT_V(2); BAR; WAIT_L(0); MMA(0, 0, At, B0); BAR;
      LDB(B1, 1, 1); WAIT_V(0); BAR; WAIT_L(0); MMA(0, 1, At, B1); BAR;
      LDA(At, 1, 1); BAR; WAIT_L(0); MMA(1, 0, At, B0); MMA(1, 1, At, B1); BAR; }
    if (wr == 0) BAR;
#pragma unroll
    for (int ai = 0; ai < 2; ++ai)
#pragma unroll
        for (int m = 0; m < 4; ++m) {
            const int lrow = ai * 128 + wr * 64 + m * 16 + fr; const long orow = ea.orow0 + lrow;
            float wg = 1.0f; if (EPI == 3) wg = ea.wgt[lrow];
            if (EPI == 4) {
                const bool isc = orow >= RL; const int tokn = isc ? 0 : (int)(orow % SEQ);
#pragma unroll
                for (int bj = 0; bj < 2; ++bj) { const int kind = bj ? ea.kind1 : ea.kind0; const float sc = bj ? ea.sc1 : ea.sc0;
                    f32x4 x1 = acc[ai][bj][m][0], x2 = acc[ai][bj][m][1];
                    if (kind != 0) {
                        f32x4 t0 = (f32x4){1.f, 0.f, 1.f, 0.f}, t1 = t0;
                        if (!isc) { const int a0 = (kind == 1 ? 0 : (kind == 2 ? 32 : 48)) + (kind != 2 ? (wc & 1) * 16 : 0) + fq * 4; const float* tp = ea.tab + ((size_t)tokn * 80 + a0) * 2; t0 = *(const f32x4*)tp; t1 = *(const f32x4*)(tp + 4); }
                        const f32x4 cs = (f32x4){t0[0], t0[2], t1[0], t1[2]} * sc, sn = (f32x4){t0[1], t0[3], t1[1], t1[3]} * sc;
                        const f32x4 y1 = x1 * cs - x2 * sn, y2 = x1 * sn + x2 * cs; x1 = y1; x2 = y2;
                    }
                    const int col = bcol + bj * 128 + wc * 32 + fq * 4; bf16_t* op = (bf16_t*)ea.out + (size_t)orow * ea.ld + col;
                    u32x2 o; o[0] = pk2(x1[0], x1[1]); o[1] = pk2(x1[2], x1[3]); *(u32x2*)op = o; o[0] = pk2(x2[0], x2[1]); o[1] = pk2(x2[2], x2[3]); *(u32x2*)(op + 16) = o; }
                continue;
            }
#pragma unroll
            for (int n = 0; n < 2; ++n) {
                if (EPI == 2) { const f32x4 g = acc[ai][0][m][n], u = acc[ai][1][m][n]; const int col = (bcol >> 1) + wc * 32 + n * 16 + fq * 4;
                    u32x2 o; o[0] = pk2(siluf(g[0]) * u[0], siluf(g[1]) * u[1]); o[1] = pk2(siluf(g[2]) * u[2], siluf(g[3]) * u[3]);
                    *(u32x2*)((bf16_t*)ea.out + (size_t)orow * ea.ld + col) = o;
                } else {
#pragma unroll
                    for (int bj = 0; bj < 2; ++bj) { const f32x4 v = acc[ai][bj][m][n]; const int col = bcol + bj * 128 + wc * 32 + n * 16 + fq * 4;
                        if (EPI == 1) *(f32x4*)((float*)ea.out + (size_t)orow * ea.ld + col) = v;
                        else { u32x2 o; o[0] = pk2(v[0] * wg, v[1] * wg); o[1] = pk2(v[2] * wg, v[3] * wg); *(u32x2*)((bf16_t*)ea.out + (size_t)orow * ea.ld + col) = o; } }
                }
            }
        }
    __syncthreads();
#undef SA
#undef SB
#undef STAGE_A
#undef STAGE_B
#undef LDA
#undef LDB
#undef MMA
}

struct GUnit { const char* B; const int* gidx; const float* wgt; long orow0; int brow, bcol, pn; };
DI bool tile_order(int i, int G, int c, int nM, int nN, int& pm, int& pn) {
    const int nwg = nM * nN; const long L = (long)i * G + c; if (L >= nwg) return false;
    int wgid = (int)L; { const int q = nwg / 8, r = nwg % 8, xcd = wgid % 8, off = wgid / 8; wgid = (xcd < r ? xcd * (q + 1) : r * (q + 1) + (xcd - r) * q) + off; }
    const int nig = 8 * nN, gid = wgid / nig, fm = gid * 8, gsz = (nM - fm) < 8 ? (nM - fm) : 8;
    pm = fm + ((wgid % nig) % gsz); pn = (wgid % nig) / gsz; return true;
}
DI int moe_tiles(int layer) { return layer == DEPTH - 1 ? (NB * CAPL + 255) / 256 : ROWS_E / 256; }
template <int PHK> DI bool gemm_next(const WS& w, int layer, int i, int G, int c, GUnit& u) {
    int pm, pn; u.gidx = nullptr; u.wgt = nullptr;
    if (PHK == 0) { if (!tile_order(i, G, c, R / 256, PW / 256, pm, pn)) return false; u.B = (const char*)(w.win + (size_t)layer * PW * 1024 + (size_t)pn * 256 * 1024); u.brow = pm * 256; u.orow0 = (long)pm * 256; }
    else if (PHK == 1) { if (!tile_order(i, G, c, (layer == DEPTH - 1 ? RL : R) / 256, 4, pm, pn)) return false; u.B = (const char*)(w.wout + (size_t)layer * 1024 * 1024 + (size_t)pn * 256 * 1024); u.brow = pm * 256; u.orow0 = (long)pm * 256; }
    else { const int tm = moe_tiles(layer); constexpr int nN = PHK == 2 ? 2 * FF / 256 : 4;
        if (!tile_order(i, G, c, 16 * tm, nN, pm, pn)) return false;
        constexpr int TM_FULL = ROWS_E / 256, TM_LAST = (NB * CAPL + 255) / 256;
        int e, pme; if (layer == DEPTH - 1) { e = pm / TM_LAST; pme = pm % TM_LAST; } else { e = pm / TM_FULL; pme = pm % TM_FULL; }
        u.orow0 = (long)e * ROWS_E + pme * 256; u.brow = e * ROWS_E + pme * 256;
        if (PHK == 2) { u.B = (const char*)(w.wgu + (size_t)(layer * 16 + e) * 2 * FF * 1024 + (size_t)pn * 256 * 1024); u.gidx = w.idx + (size_t)e * ROWS_E + pme * 256; }
        else { u.B = (const char*)(w.wdn + (size_t)(layer * 16 + e) * 1024 * FF + (size_t)pn * 256 * FF); u.wgt = w.wgt + (size_t)e * ROWS_E + pme * 256; } }
    u.bcol = pn * 256; u.pn = pn; return true;
}
template <int PHK> DI void gemm_stream(const Params& p, int layer, char* smem) {
    constexpr bool GATHER = PHK == 2, FP8 = PHK >= 2;       constexpr int K = PHK == 2 ? 1024 : (PHK == 3 ? FF : 2048)  , nt = K / 128;
    const WS w = ws_of(p.ws); bf16_t* shm = (bf16_t*)smem;
    const char* Abase = PHK == 0 ? (const char*)w.u : (PHK == 1 ? (const char*)w.mix : (PHK == 2 ? (const char*)w.u8 : (const char*)w.hid));
    const int G = gridDim.x, c = bidx();
    int tid = tidx();
    int wid = tid >> 6, lane = tid & 63, wr = wid >> 2, wc = wid & 3, fr = lane & 15, fq = lane >> 4;
    GUnit cur, nxt;
    if (!gemm_next<PHK>(w, layer, 0, G, c, cur)) return;
    unsigned voff[2];
#pragma unroll
    for (int i = 0; i < 2; ++i) { int R_, C_; stage_rc(tid * 16 + i * 8192, R_, C_); voff[i] = (unsigned)(R_ * K + C_ * 2); }
    u32x4 ga = (u32x4){0u, 0u, 0u, 0u};
    unsigned gc2[2];
#pragma unroll
    for (int i = 0; i < 2; ++i) { int R_, C_; stage_rc(tid * 16 + i * 8192, R_, C_); gc2[i] = (unsigned)C_ * 2u; }
#define G_GOFF(dst, U) do { _Pragma("unroll") for (int h_ = 0; h_ < 2; ++h_) _Pragma("unroll") for (int i_ = 0; i_ < 2; ++i_) { int R_, C_; stage_rc(tid * 16 + i_ * 8192, R_, C_); \
        dst[h_ * 2 + i_] = (unsigned)(U).gidx[h_ * 128 + R_]; } } while (0)
    if (GATHER) G_GOFF(ga, cur);
    const int* idbuf = (const int*)(smem + 8 * G_HT * 2 + 1024);
#ifdef EMU
#define UBASE(p)
#else
#define UBASE(p) asm volatile("" : "+s"(p))
#endif
#define SA(b, h) (shm + ((b) * 2 + (h)) * G_HT)
#define SB(b, h) (shm + (4 + (b) * 2 + (h)) * G_HT)
#define STG_A(P, U, GAo, h, koff) do { _Pragma("unroll") for (int _i = 0; _i < 2; ++_i) { \
        const char* ub_ = GATHER ? Abase + (size_t)(koff) : Abase + ((size_t)((U).brow + (h) * 128) * K + (koff)); UBASE(ub_); GLDS16(ub_ + (GATHER ? (GAo)[(h) * 2 + _i] * (unsigned)K + gc2[_i] : voff[_i]), (char*)(P) + tid * 16 + _i * 8192); } } while (0)
#define STG_B(P, BP, h, koff) do { _Pragma("unroll") for (int _i = 0; _i < 2; ++_i) { const char* ub_ = (BP) + ((size_t)(h) * 128 * K + (koff)); UBASE(ub_); GLDS16(ub_ + voff[_i], (char*)(P) + tid * 16 + _i * 8192); } } while (0)
#define LDA(dst, b, h) _Pragma("unroll") for (int m = 0; m < 4; ++m) { \
        const u32x4 lo_ = *reinterpret_cast<const u32x4*>((char*)SA(b, h) + lds_byte(wr * 64 + m * 16 + fr, fq * 8)), hi_ = *reinterpret_cast<const u32x4*>((char*)SA(b, h) + lds_byte(wr * 64 + m * 16 + fr, 32 + fq * 8)); \
        dst[m] = __builtin_shufflevector(lo_, hi_, 0, 1, 2, 3, 4, 5, 6, 7); }
#define LDB_ROW(n) (wc * 32 + 8 * (fr >> 2) + 4 * (n) + (fr & 3))
#define LDB(dst, b, h) _Pragma("unroll") for (int n = 0; n < 2; ++n) { \
        const u32x4 lo_ = *reinterpret_cast<const u32x4*>((char*)SB(b, h) + lds_byte(LDB_ROW(n), fq * 8)), hi_ = *reinterpret_cast<const u32x4*>((char*)SB(b, h) + lds_byte(LDB_ROW(n), 32 + fq * 8)); \
        dst[n] = __builtin_shufflevector(lo_, hi_, 0, 1, 2, 3, 4, 5, 6, 7); }
#define MMA(ai, bj, At_, Bt_) do { __builtin_amdgcn_s_setprio(1); \
        _Pragma("unroll") for (int m = 0; m < 4; ++m) _Pragma("unroll") for (int n = 0; n < 2; ++n) { \
            if (FP8) acc[ai][bj][m][n] = mfma_fp8(Bt_[n], At_[m], acc[ai][bj][m][n]);     \
            else { acc[ai][bj][m][n] = MFMA16(frag_lo(Bt_[n]), frag_lo(At_[m]), acc[ai][bj][m][n]); acc[ai][bj][m][n] = MFMA16(frag_hi(Bt_[n]), frag_hi(At_[m]), acc[ai][bj][m][n]); } } \
        __builtin_amdgcn_s_setprio(0); } while (0)
#define K_TILE_PAIR(UA2, GA2, B2, k1, k2, k3) do { \
            LDB(B0, 0, 0); SCHED; LDA(At, 0, 0); STG_A(SA(1, 1), cur, ga, 1, k1); \
            WAIT_L(8); BAR; WAIT_L(0); MMA(0, 0, At, B0); BAR; SCHED; \
            LDB(B1, 0, 1); STG_B(SB(0, 0), B2, 0, k2); \
            BAR; WAIT_L(0); MMA(0, 1, At, B1); BAR; \
            LDA(At, 0, 1); STG_A(SA(0, 0), UA2, GA2, 0, k2); \
            BAR; WAIT_L(0); MMA(1, 0, At, B0); BAR; SCHED; \
            STG_B(SB(0, 1), B2, 1, k2); \
            WAIT_V(6); BAR; MMA(1, 1, At, B1); BAR; \
            LDB(B0, 1, 0); SCHED; LDA(At, 1, 0); STG_A(SA(0, 1), UA2, GA2, 1, k2); \
            WAIT_L(8); BAR; WAIT_L(0); MMA(0, 0, At, B0); BAR; SCHED; \
            LDB(B1, 1, 1); STG_B(SB(1, 0), B2, 0, k3); \
            BAR; WAIT_L(0); MMA(0, 1, At, B1); BAR; \
            LDA(At, 1, 1); STG_A(SA(1, 0), UA2, GA2, 0, k3); \
            BAR; WAIT_L(0); MMA(1, 0, At, B0); BAR; SCHED; \
            STG_B(SB(1, 1), B2, 1, k3); \
            WAIT_V(6); BAR; MMA(1, 1, At, B1); BAR; } while (0)
    f32x4 acc[2][2][4][2];
#pragma unroll
    for (int a = 0; a < 2; ++a)
#pragma unroll
        for (int b = 0; b < 2; ++b)
#pragma unroll
            for (int m = 0; m < 4; ++m)
#pragma unroll
                for (int n = 0; n < 2; ++n) acc[a][b][m][n] = (f32x4){0.f, 0.f, 0.f, 0.f};
    u32x8 At[4], B0[2], B1[2];
    __syncthreads();
    STG_B(SB(0, 0), cur.B, 0, 0); STG_A(SA(0, 0), cur, ga, 0, 0); STG_B(SB(0, 1), cur.B, 1, 0); STG_A(SA(0, 1), cur, ga, 1, 0);
    if (wr == 1) BAR;
    WAIT_V(4); BAR;
    STG_B(SB(1, 0), cur.B, 0, 128); STG_A(SA(1, 0), cur, ga, 0, 128); STG_B(SB(1, 1), cur.B, 1, 128);
    WAIT_V(6); BAR;
    for (int ui = 0;; ++ui) {
#pragma unroll
        for (int i = 0; i < 2; ++i) { int R_, C_; stage_rc(tid * 16 + i * 8192, R_, C_); voff[i] = (unsigned)(R_ * K + C_ * 2); gc2[i] = (unsigned)C_ * 2u; }
        const bool has_next = gemm_next<PHK>(w, layer, ui + 1, G, c, nxt);
        if (!has_next) nxt = cur;
        u32x4 gn = ga;
#pragma unroll 1
        for (int t = 0; t < nt; t += 2) {
            const bool lastp = (t == nt - 2);
            if (GATHER && t == 0 && wid == 0) GLDS16((const char*)nxt.gidx + lane * 16, (char*)idbuf + lane * 16);
            if (GATHER && t == nt - 4) { _Pragma("unroll") for (int h_ = 0; h_ < 2; ++h_) _Pragma("unroll") for (int i_ = 0; i_ < 2; ++i_) { int R_, C_; stage_rc(tid * 16 + i_ * 8192, R_, C_); gn[h_ * 2 + i_] = (unsigned)idbuf[h_ * 128 + R_]; } }
#ifndef EMU
#endif
            GUnit u2 = cur; u32x4 g2 = ga; if (lastp) { u2 = nxt; g2 = gn; }
            const int k2 = lastp ? 0 : (t + 2) * 128;
            K_TILE_PAIR(u2, g2, u2.B, (t + 1) * 128, k2, k2 + 128);
        }
#ifndef EMU
        asm volatile("" : "+v"(tid));
#endif
        wid = tid >> 6; lane = tid & 63; wr = wid >> 2; wc = wid & 3; fr = lane & 15; fq = lane >> 4;
        const int kd = PHK == 0 ? (cur.pn <= 1 ? 1 : ((cur.pn == 4 || cur.pn == 5) ? 2 : ((cur.pn == 11 || cur.pn == 12) ? 3 : 0))) : 0;
        const float qsc = PHK == 0 ? (cur.pn == 0 ? 0.125f : (cur.pn == 4 ? 0.17677669529663687f * LOG2E : (cur.pn == 11 ? 0.125f * LOG2E : 1.0f))) : 1.0f;
#pragma unroll
        for (int ai = 0; ai < 2; ++ai) {
            f32x4 rt0[4], rt1[4];
            if (PHK == 0 && kd != 0) {
#pragma unroll
                for (int m = 0; m < 4; ++m) { const long orow = cur.orow0 + ai * 128 + wr * 64 + m * 16 + fr; const bool isc = orow >= RL; const int tokn = isc ? 0 : (int)(orow % SEQ);
                    const int a0 = (kd == 1 ? 0 : (kd == 2 ? 32 : 48)) + (kd != 2 ? (wc & 1) * 16 : 0) + fq * 4; const float* tp = w.tab + ((size_t)tokn * 80 + a0) * 2;
                    rt0[m] = *(const f32x4*)tp; rt1[m] = *(const f32x4*)(tp + 4); }
            }
#pragma unroll
            for (int m = 0; m < 4; ++m) {
                const int lrow = ai * 128 + wr * 64 + m * 16 + fr; const long orow = cur.orow0 + lrow;
                if (PHK == 0) {
                    const bool isc = orow >= RL; const int tokn = isc ? 0 : (int)(orow % SEQ);
                    f32x4 cs = (f32x4){qsc, qsc, qsc, qsc}, sn = (f32x4){0.f, 0.f, 0.f, 0.f};
                    if (kd != 0 && !isc) {
                        const f32x4 t0 = rt0[m], t1 = rt1[m]; cs = (f32x4){t0[0], t0[2], t1[0], t1[2]} * qsc; sn = (f32x4){t0[1], t0[3], t1[1], t1[3]} * qsc; }
#pragma unroll
                    for (int bj = 0; bj < 2; ++bj) { const int kind = (cur.pn == 12 && bj == 1) ? 0 : kd;
                        f32x4 x1 = acc[ai][bj][m][0], x2 = acc[ai][bj][m][1];
                        if (kind != 0) { const f32x4 y1 = x1 * cs - x2 * sn, y2 = x1 * sn + x2 * cs; x1 = y1; x2 = y2; }
                        u32x4 o; o[0] = pk2(x1[0], x1[1]); o[1] = pk2(x1[2], x1[3]); o[2] = pk2(x2[0], x2[1]); o[3] = pk2(x2[2], x2[3]);
                        *(u32x4*)(w.p + (size_t)orow * PW + cur.bcol + bj * 128 + wc * 32 + fq * 8) = o; }
                } else if (PHK == 2) {
                    const f32x4 g0 = acc[ai][0][m][0] * (1.0f / SW1), u0 = acc[ai][1][m][0] * (SH / SW1), g1 = acc[ai][0][m][1] * (1.0f / SW1), u1 = acc[ai][1][m][1] * (SH / SW1);
                    u32x2 o; o[0] = pk4_fp8(siluf(g0[0]) * u0[0], siluf(g0[1]) * u0[1], siluf(g0[2]) * u0[2], siluf(g0[3]) * u0[3]); o[1] = pk4_fp8(siluf(g1[0]) * u1[0], siluf(g1[1]) * u1[1], siluf(g1[2]) * u1[2], siluf(g1[3]) * u1[3]);
                    *(u32x2*)(w.hid + (size_t)orow * FF + (cur.bcol >> 1) + wc * 32 + fq * 8) = o;
                } else {
                    float wg = 1.0f; if (PHK == 3) wg = cur.wgt[lrow] * (SY / (SH * SW2));
#pragma unroll
                    for (int bj = 0; bj < 2; ++bj) { const f32x4 v0 = acc[ai][bj][m][0], v1 = acc[ai][bj][m][1];
                        if (PHK == 3) { u32x2 o; o[0] = pk4_fp8(v0[0] * wg, v0[1] * wg, v0[2] * wg, v0[3] * wg); o[1] = pk4_fp8(v1[0] * wg, v1[1] * wg, v1[2] * wg, v1[3] * wg);
                            *(u32x2*)(w.y + (size_t)orow * 1024 + cur.bcol + bj * 128 + wc * 32 + fq * 8) = o;
                        } else { u32x4 o; o[0] = pk2(v0[0] * wg, v0[1] * wg); o[1] = pk2(v0[2] * wg, v0[3] * wg); o[2] = pk2(v1[0] * wg, v1[1] * wg); o[3] = pk2(v1[2] * wg, v1[3] * wg);
                            *(u32x4*)(w.mixo + (size_t)orow * 1024 + cur.bcol + bj * 128 + wc * 32 + fq * 8) = o; } }
                }
            }
        }
        if (!has_next) break;
#pragma unroll
        for (int a = 0; a < 2; ++a)
#pragma unroll
            for (int b = 0; b < 2; ++b)
#pragma unroll
                for (int m = 0; m < 4; ++m)
#pragma unroll
                    for (int n = 0; n < 2; ++n) acc[a][b][m][n] = (f32x4){0.f, 0.f, 0.f, 0.f};
        cur = nxt;
        ga = gn;
#ifndef EMU
        asm volatile("" : "+v"(tid));
#endif
        wid = tid >> 6; lane = tid & 63; wr = wid >> 2; wc = wid & 3; fr = lane & 15; fq = lane >> 4;
    }
    WAIT_V(0);
    if (wr == 0) BAR;
    BAR;
    __syncthreads();
#undef G_GOFF
#undef K_TILE_PAIR
#undef UBASE
#undef SA
#undef SB
#undef STG_A
#undef STG_B
#undef LDA
#undef LDB
#undef LDB_ROW
#undef MMA
}
DI void cvt_tail_a(const Params& p, int layer, char* smem);
DI void phase_inproj(const Params& p, int layer, char* smem) { gemm_stream<0>(p, layer, smem); cvt_tail_a(p, layer, smem); }
DI void cvt_tail_b(const Params& p, int layer, char* smem) {
    const int G = gridDim.x, rem = (((layer == DEPTH - 1 ? RL : R) / 256) * 4) % G, c = bidx(); if (c < rem) return;
    cvt_stream<1>(p, ws_of(p.ws), smem, layer, c - rem, G - rem);
}
DI void cvt_tail_a(const Params& p, int layer, char* smem) {
    const int G = gridDim.x, rem = ((R / 256) * (PW / 256)) % G, c = bidx(); if (c < rem) return;
    cvt_stream<3>(p, ws_of(p.ws), smem, layer, c - rem, G - rem);
}
DI void cvt_tail_d(const Params& p, int layer, char* smem) {
    if (layer + 1 >= DEPTH) return;
    const int G = gridDim.x, rem = (16 * (ROWS_E / 256) * 4) % G, c = bidx(); if (c < rem) return;
    cvt_stream<2>(p, ws_of(p.ws), smem, layer, c - rem, G - rem);
}
DI void phase_outproj(const Params& p, int layer, char* smem) { gemm_stream<1>(p, layer, smem); cvt_tail_b(p, layer, smem); }
DI void phase_moe1(const Params& p, int layer, char* smem) { gemm_stream<2>(p, layer, smem); }
DI void phase_moe2(const Params& p, int layer, char* smem) { gemm_stream<3>(p, layer, smem); cvt_tail_d(p, layer, smem); }

DI void phase_prep(const Params& p, int layer, char* smem) {
    const WS w = ws_of(p.ws); const int lane = tidx() & 63, wv = tidx() >> 6;
    for (int row = bidx() * 8 + wv; row < R; row += gridDim.x * 8) {
        const bool isc = row >= RL; const int n = isc ? 0 : row % SEQ; bf16_t* pr = w.p + (size_t)row * PW;
        for (int idx = lane; idx < 704; idx += 64) {
            int c1, dd, a; float sc;
            if (idx < 128) { const int h = idx >> 5, i = idx & 31; c1 = C_RQ + h * 64 + i; dd = 32; a = i; sc = 0.125f; }
            else if (idx < 256) { const int j = idx - 128, h = j >> 5, i = j & 31; c1 = C_RK + h * 64 + i; dd = 32; a = i; sc = 1.0f; }
            else if (idx < 384) { const int j = idx - 256, hc = j >> 4, i = j & 15; c1 = C_DQ + hc * 32 + i; dd = 16; a = 32 + i; sc = 0.17677669529663687f * LOG2E; }
            else if (idx < 512) { const int j = idx - 384, hc = j >> 4, i = j & 15; c1 = C_DK + hc * 32 + i; dd = 16; a = 32 + i; sc = 1.0f; }
            else if (idx < 640) { const int j = idx - 512, h = j >> 5, i = j & 31; c1 = C_SQ + h * 64 + i; dd = 32; a = 48 + i; sc = 0.125f * LOG2E; }
            else { const int j = idx - 640, h = j >> 5, i = j & 31; c1 = C_SK + h * 64 + i; dd = 32; a = 48 + i; sc = 1.0f; }
            float cs = 1.0f, sn = 0.0f; if (!isc) { cs = w.tab[((size_t)n * 80 + a) * 2]; sn = w.tab[((size_t)n * 80 + a) * 2 + 1]; }
            const float x1 = bf2f(pr[c1]), x2 = bf2f(pr[c1 + dd]);
            pr[c1] = f2bf((x1 * cs - x2 * sn) * sc); pr[c1 + dd] = f2bf((x1 * sn + x2 * cs) * sc);
        }
    }
}

constexpr int A_KS = 72;
constexpr int A_TILE = 64 * A_KS;
constexpr float A_THR = 6.0f;
template <int NC>
DI void attn_unit(const bf16_t* __restrict__ P, const int qrow0, const int qcol, const int kcol, const int vcol,
                  const int r1, const int n1, const int kp1, const bool mask1, const int r2, const int n2, const int qpos0,
                  const float m_init, const float l_init, const float lam, const float fin_scale, const float* __restrict__ norm_g,
                  bf16_t* __restrict__ outp  , char* smem) {
    bf16_t* Kb = (bf16_t*)smem; bf16_t* Vb = Kb + 2 * A_TILE;
    const int tid = tidx(), lane = tid & 63, wv = tid >> 6, fr = lane & 15, fq = lane >> 4;
    bf16x8 qf[2][2];
#pragma unroll
    for (int g = 0; g < 2; ++g)
#pragma unroll
        for (int i = 0; i < 2; ++i) qf[g][i] = *(const bf16x8*)(P + (size_t)(qrow0 + g * 128 + wv * 16 + fr) * PW + qcol + i * 32 + fq * 8);
    f32x4 o[2][NC][4], ol[2][NC], negm[2][NC]; float mrun[2][NC];
    const int T = n1 + n2, skey = tid >> 3, sc8 = tid & 7;
    const int soff = skey * A_KS + sc8 * 8;
    const int voff = (fq * 4 + (fr >> 2)) * A_KS + (fr & 3) * 4;
    u32x4 kr0, vr0, kr1, vr1;
#define A_LOAD(TN, KR, VR) do { const int tn_ = (TN); const int krow_ = (tn_ < n1) ? r1 + tn_ * 64 : r2 + (tn_ - n1) * 64; const bf16_t* src_ = P + (size_t)(krow_ + skey) * PW; \
        KR = *(const u32x4*)(src_ + kcol + sc8 * 8); VR = *(const u32x4*)(src_ + vcol + sc8 * 8); } while (0)
    A_LOAD(0, kr0, vr0);
    *(u32x4*)(Kb + soff) = kr0; *(u32x4*)(Vb + soff) = vr0;
    if (1 < T) A_LOAD(1, kr1, vr1);
    const int qposb = qpos0 + wv * 16 + fr;
    LDS_BARRIER();
    {
#pragma unroll
        for (int g = 0; g < 2; ++g)
#pragma unroll
            for (int c = 0; c < NC; ++c) { float mx = -INFINITY;
#pragma unroll
                for (int kt = 0; kt < 4; ++kt) {
                    const bf16x8 k0 = *(const bf16x8*)(Kb + (kt * 16 + fr) * A_KS + fq * 8), k1 = *(const bf16x8*)(Kb + (kt * 16 + fr) * A_KS + 32 + fq * 8);
                    const f32x4 z = (f32x4){0.f, 0.f, 0.f, 0.f};
                    f32x4 sv; if (NC == 2) sv = c == 0 ? MFMA16(k0, qf[g][0], z) : MFMA16(k1, qf[g][1], z); else sv = MFMA16(k1, qf[g][1], MFMA16(k0, qf[g][0], z));
#pragma unroll
                    for (int j = 0; j < 4; ++j) { const int dlt = qposb + g * 128 - (kp1 + kt * 16 + fq * 4 + j); if (!(mask1 && n1 > 0 && (dlt > 128 || dlt < -128))) mx = fmaxf(mx, sv[j]); } }
                mx = grp_max(mx); mrun[g][c] = fmaxf(m_init, mx); const float l0 = l_init * ex2(m_init - mrun[g][c]);
                negm[g][c] = (f32x4){-mrun[g][c], -mrun[g][c], -mrun[g][c], -mrun[g][c]}; ol[g][c] = (f32x4){l0, l0, l0, l0};
#pragma unroll
                for (int d = 0; d < 4; ++d) o[g][c][d] = (f32x4){0.f, 0.f, 0.f, 0.f}; }
    }
    bf16x8 onesf; { const u32x4 ov = (u32x4){0x3F803F80u, 0x3F803F80u, 0x3F803F80u, 0x3F803F80u}; onesf = __builtin_bit_cast(bf16x8, ov); }
    const int stag = __builtin_amdgcn_readfirstlane(tid >> 8);
    auto tile_step = [&](const int t, u32x4& kl, u32x4& vl, const u32x4& kw, const u32x4& vw) {
        LDS_BARRIER();
        STAGGER_SLEEP(stag);
        const bf16_t* Kt = Kb + (t & 1) * A_TILE; const bf16_t* Vt = Vb + (t & 1) * A_TILE;
        A_LOAD((t + 2 < T ? t + 2 : T - 1), kl, vl);
        const bool msk = mask1 && (t < n1); const int kpos_t = kp1 + t * 64;
        bf16x8 kf[4][2], vf[2][4];
#pragma unroll
        for (int kt = 0; kt < 4; ++kt) { kf[kt][0] = *(const bf16x8*)(Kt + (kt * 16 + fr) * A_KS + fq * 8); kf[kt][1] = *(const bf16x8*)(Kt + (kt * 16 + fr) * A_KS + 32 + fq * 8); }
#pragma unroll
        for (int k2 = 0; k2 < 2; ++k2)
#pragma unroll
            for (int d = 0; d < 4; ++d) { const s16x4 a = lds_tr16(Vt + voff + (2 * k2) * 16 * A_KS + d * 16), b = lds_tr16(Vt + voff + (2 * k2 + 1) * 16 * A_KS + d * 16);
                vf[k2][d] = __builtin_shufflevector(a, b, 0, 1, 2, 3, 4, 5, 6, 7); }
#pragma unroll
        for (int g = 0; g < 2; ++g)
#pragma unroll
            for (int c = 0; c < NC; ++c) {
                f32x4 s[4];
#pragma unroll
                for (int kt = 0; kt < 4; ++kt) { if (NC == 2) s[kt] = MFMA16(kf[kt][c], qf[g][c], negm[g][c]); else s[kt] = MFMA16(kf[kt][1], qf[g][1], MFMA16(kf[kt][0], qf[g][0], negm[g][0])); }
                if (msk) { const int qpos = qposb + g * 128;
#pragma unroll
                    for (int kt = 0; kt < 4; ++kt)
#pragma unroll
                        for (int j = 0; j < 4; ++j) { const int dlt = qpos - (kpos_t + kt * 16 + fq * 4 + j); if (dlt > 128 || dlt < -128) s[kt][j] = -INFINITY; } }
                int im = max(max(__float_as_int(s[0][0]), __float_as_int(s[0][1])), max(__float_as_int(s[0][2]), __float_as_int(s[0][3])));
#pragma unroll
                for (int kt = 1; kt < 4; ++kt) im = max(max(im, __float_as_int(s[kt][0])), max(max(__float_as_int(s[kt][1]), __float_as_int(s[kt][2])), __float_as_int(s[kt][3])));
                const float tm = __int_as_float(grp_imax(im));
                if (__any(tm > A_THR)) {
                    const float delta = fmaxf(tm, 0.f), alpha = ex2(-delta); mrun[g][c] += delta; negm[g][c] = (f32x4){-mrun[g][c], -mrun[g][c], -mrun[g][c], -mrun[g][c]}; ol[g][c] *= alpha;
#pragma unroll
                    for (int d = 0; d < 4; ++d) o[g][c][d] *= alpha;
#pragma unroll
                    for (int kt = 0; kt < 4; ++kt) s[kt] = s[kt] - delta;
                }
#pragma unroll
                for (int kt = 0; kt < 4; ++kt)
#pragma unroll
                    for (int j = 0; j < 4; ++j) s[kt][j] = ex2(s[kt][j]);
#pragma unroll
                for (int k2 = 0; k2 < 2; ++k2) {
                    u32x4 pp; pp[0] = pk2(s[2 * k2][0], s[2 * k2][1]); pp[1] = pk2(s[2 * k2][2], s[2 * k2][3]); pp[2] = pk2(s[2 * k2 + 1][0], s[2 * k2 + 1][1]); pp[3] = pk2(s[2 * k2 + 1][2], s[2 * k2 + 1][3]);
                    const bf16x8 pb = __builtin_bit_cast(bf16x8, pp);
#pragma unroll
                    for (int d = 0; d < 4; ++d) o[g][c][d] = MFMA16(vf[k2][d], pb, o[g][c][d]);
                    ol[g][c] = MFMA16(onesf, pb, ol[g][c]);
                }
            }
        { bf16_t* Kn = Kb + ((t + 1) & 1) * A_TILE + soff; bf16_t* Vn = Vb + ((t + 1) & 1) * A_TILE + soff;
            *(u32x4*)Kn = kw; *(u32x4*)Vn = vw; }
    };
#ifndef EMU
    __builtin_amdgcn_s_waitcnt(0x0F70);
#endif
    for (int t = 0; t < T; t += 2) { tile_step(t, kr0, vr0, kr1, vr1); if (t + 1 < T) tile_step(t + 1, kr1, vr1, kr0, vr0); }
#undef A_LOAD
#pragma unroll
    for (int g = 0; g < 2; ++g) {
        float linv[NC];
#pragma unroll
        for (int c = 0; c < NC; ++c) linv[c] = 1.0f / ol[g][c][0];
        f32x4 val[4]; float ss = 0.f;
#pragma unroll
        for (int d = 0; d < 4; ++d) {
            if (NC == 2) val[d] = o[g][0][d] * linv[0] - lam * (o[g][NC - 1][d] * linv[NC - 1]); else val[d] = o[g][0][d] * linv[0];
            ss += val[d][0] * val[d][0] + val[d][1] * val[d][1] + val[d][2] * val[d][2] + val[d][3] * val[d][3];
        }
        float rs = 1.0f;
        if (NC == 2) { ss = grp_sum(ss); rs = fin_scale / sqrtf(ss * (1.0f / 64.0f) + 1e-6f); }
        bf16_t* orow = outp + (size_t)(g * 128 + wv * 16 + fr) * 1024;
#pragma unroll
        for (int d = 0; d < 4; ++d) { f32x4 v = val[d] * rs; if (NC == 2) v = v * *(const f32x4*)(norm_g + d * 16 + fq * 4);
            u32x2 ov; ov[0] = pk2(v[0], v[1]); ov[1] = pk2(v[2], v[3]); *(u32x2*)(orow + d * 16 + fq * 4) = ov; }
    }
    __syncthreads();
}

DI void ret_kv_unit(const Params& p, const WS& w, int layer, int b, int h, int ci, char* smem) {
    bf16_t* Kr = (bf16_t*)smem; bf16_t* V0 = Kr + 128 * 72; bf16_t* V1 = V0 + 128 * 72;
    const int tid = tidx(), lane = tid & 63, wv = tid >> 6, fr = lane & 15, fq = lane >> 4; const bool isc = ci < NCC; const int row0 = isc ? RL + b * CTX + ci * 128 : b * SEQ + (ci - NCC) * 128;
    const float lg0 = -softplusf_(-p.ret_decay[(layer * 2 + 0) * 4 + h]) * LOG2E, lg1 = -softplusf_(-p.ret_decay[(layer * 2 + 1) * 4 + h]) * LOG2E;
    __syncthreads();
    for (int i = tid; i < 128 * 8; i += NT) { const int j = i >> 3, c8 = i & 7; const bf16_t* src = w.p + (size_t)(row0 + j) * PW + h * 64 + c8 * 8;
        *(u32x4*)(Kr + j * 72 + c8 * 8) = *(const u32x4*)(src + C_RK); const u32x4 vv = *(const u32x4*)(src + C_RV);
        const float d0 = ex2(lg0 * (float)(127 - j)), d1 = ex2(lg1 * (float)j); u32x4 a, c;
#pragma unroll
        for (int q = 0; q < 4; ++q) { const float lo = __uint_as_float(vv[q] << 16), hi = __uint_as_float(vv[q] & 0xffff0000u); a[q] = pk2(lo * d0, hi * d0); c[q] = pk2(lo * d1, hi * d1); }
        *(u32x4*)(V0 + j * 72 + c8 * 8) = a; *(u32x4*)(V1 + j * 72 + c8 * 8) = c; }
    __syncthreads();
    const int dir = wv >> 2, et = wv & 3; const bf16_t* Vd = dir ? V1 : V0; const int toff = (fq * 8 + (fr >> 2)) * 72 + (fr & 3) * 4;
    f32x4 acc[4];
#pragma unroll
    for (int n = 0; n < 4; ++n) acc[n] = (f32x4){0.f, 0.f, 0.f, 0.f};
#pragma unroll
    for (int ks = 0; ks < 4; ++ks) {
        const s16x4 va = lds_tr16(Vd + toff + (ks * 32) * 72 + et * 16), vb = lds_tr16(Vd + toff + (ks * 32 + 4) * 72 + et * 16); const bf16x8 vfr = __builtin_shufflevector(va, vb, 0, 1, 2, 3, 4, 5, 6, 7);
#pragma unroll
        for (int n = 0; n < 4; ++n) { const s16x4 ka = lds_tr16(Kr + toff + (ks * 32) * 72 + n * 16), kb = lds_tr16(Kr + toff + (ks * 32 + 4) * 72 + n * 16);
            acc[n] = MFMA16(vfr, __builtin_shufflevector(ka, kb, 0, 1, 2, 3, 4, 5, 6, 7), acc[n]); }
    }
    bf16_t* ob = w.rkv + ((size_t)((b * 4 + h) * 2 + dir) * NCHR + ci) * 4096;
#pragma unroll
    for (int n = 0; n < 4; ++n) { u32x2 o; o[0] = pk2(acc[n][0], acc[n][1]); o[1] = pk2(acc[n][2], acc[n][3]); *(u32x2*)(ob + (n * 16 + fr) * 64 + et * 16 + fq * 4) = o; }
}
DI void ret_scan(const Params& p, const WS& w, int layer) {
    for (int i = bidx() * NT + tidx(); i < NB * 4 * 2 * 4096; i += gridDim.x * NT) {
        const int chain = i >> 12, el = i & 4095, d = chain & 1, h = (chain >> 1) & 3;
        const float x = p.ret_decay[(layer * 2 + d) * 4 + h]; const float cd = ex2(-softplusf_(-x) * LOG2E * 128.0f);
        float kv[NCHR];
#pragma unroll
        for (int st = 0; st < NCHR; ++st) { const int ci = d == 0 ? st : (st < NCC ? NCC - 1 - st : NCC + (NLC - 1 - (st - NCC))); kv[st] = __uint_as_float((unsigned)w.rkv[((size_t)chain * NCHR + ci) * 4096 + el] << 16); }
        float s = 0.f;
#pragma unroll
        for (int st = 0; st < NCHR; ++st) { const int ci = d == 0 ? st : (st < NCC ? NCC - 1 - st : NCC + (NLC - 1 - (st - NCC))); w.rs[((size_t)chain * NCHR + ci) * 4096 + el] = f2bf(s); s = s * cd + kv[st]; }
    }
}
constexpr int RO_KS = 72, RO_VS = 136;
DI void ret_out_unit(const Params& p, const WS& w, int layer, int b, int h, int ci, char* smem) {
    bf16_t* Ks = (bf16_t*)smem; bf16_t* Vr = Ks + 128 * RO_KS; bf16_t* Sr = Vr + 128 * RO_KS;
    const int tid = tidx(), lane = tid & 63, wv = tid >> 6, fr = lane & 15, fq = lane >> 4;
    const bool isc = ci < NCC; const int row0 = isc ? RL + b * CTX + ci * 128 : b * SEQ + (ci - NCC) * 128;
    __syncthreads();
    for (int i = tid; i < 128 * 8; i += NT) { const int j = i >> 3, c8 = i & 7; const bf16_t* src = w.p + (size_t)(row0 + j) * PW + h * 64 + c8 * 8;
        *(u32x4*)(Ks + j * RO_KS + c8 * 8) = *(const u32x4*)(src + C_RK); *(u32x4*)(Vr + j * RO_KS + c8 * 8) = *(const u32x4*)(src + C_RV); }
    for (int i = tid; i < 2 * 64 * 8; i += NT) { const int d = i >> 9, dk = (i >> 3) & 63, e8 = i & 7; const bf16_t* src = w.rs + ((size_t)((b * 4 + h) * 2 + d) * NCHR + ci) * 4096 + dk * 64 + e8 * 8;
        *(u32x4*)(Sr + (d * 64 + dk) * RO_KS + e8 * 8) = *(const u32x4*)src; }
    __syncthreads();
    const float lg0 = -softplusf_(-p.ret_decay[(layer * 2 + 0) * 4 + h]) * LOG2E, lg1 = -softplusf_(-p.ret_decay[(layer * 2 + 1) * 4 + h]) * LOG2E;
    const int qi = wv * 16 + fr;
    const int voff = (fq * 4 + (fr >> 2)) * RO_KS + (fr & 3) * 4;
    const int soffs = (fq * 8 + (fr >> 2)) * RO_KS + (fr & 3) * 4;
    bf16x8 qf[2];
#pragma unroll
    for (int i = 0; i < 2; ++i) qf[i] = *(const bf16x8*)(w.p + (size_t)(row0 + qi) * PW + C_RQ + h * 64 + i * 32 + fq * 8);
    f32x4 o[4], t0[4], t1[4];
#pragma unroll
    for (int d = 0; d < 4; ++d) { o[d] = (f32x4){0.f, 0.f, 0.f, 0.f}; t0[d] = o[d]; t1[d] = o[d]; }
#pragma unroll
    for (int k2 = 0; k2 < 4; ++k2) {
        f32x4 s[2];
#pragma unroll
        for (int q = 0; q < 2; ++q) { const int kt = 2 * k2 + q;
            const bf16x8 k0 = *(const bf16x8*)(Ks + (kt * 16 + fr) * RO_KS + fq * 8), k1 = *(const bf16x8*)(Ks + (kt * 16 + fr) * RO_KS + 32 + fq * 8);
            s[q] = MFMA16(k1, qf[1], MFMA16(k0, qf[0], (f32x4){0.f, 0.f, 0.f, 0.f}));
#pragma unroll
            for (int j = 0; j < 4; ++j) { const int kj = kt * 16 + fq * 4 + j, dl = qi - kj; const float dm = dl > 0 ? ex2(lg0 * (float)dl) : (dl < 0 ? ex2(lg1 * (float)(-dl)) : 2.0f); s[q][j] *= dm; } }
        u32x4 pp; pp[0] = pk2(s[0][0], s[0][1]); pp[1] = pk2(s[0][2], s[0][3]); pp[2] = pk2(s[1][0], s[1][1]); pp[3] = pk2(s[1][2], s[1][3]);
        const bf16x8 pb = __builtin_bit_cast(bf16x8, pp);
#pragma unroll
        for (int d = 0; d < 4; ++d) { const s16x4 v0 = lds_tr16(Vr + voff + (2 * k2) * 16 * RO_KS + d * 16), v1 = lds_tr16(Vr + voff + (2 * k2 + 1) * 16 * RO_KS + d * 16);
            o[d] = MFMA16(__builtin_shufflevector(v0, v1, 0, 1, 2, 3, 4, 5, 6, 7), pb, o[d]); }
    }
#pragma unroll
    for (int d = 0; d < 4; ++d)
#pragma unroll
        for (int ks = 0; ks < 2; ++ks) {
            const s16x4 a0 = lds_tr16(Sr + soffs + (ks * 32) * RO_KS + d * 16), a1 = lds_tr16(Sr + soffs + (ks * 32 + 4) * RO_KS + d * 16);
            const s16x4 b0 = lds_tr16(Sr + soffs + (64 + ks * 32) * RO_KS + d * 16), b1 = lds_tr16(Sr + soffs + (64 + ks * 32 + 4) * RO_KS + d * 16);
            t0[d] = MFMA16(__builtin_shufflevector(a0, a1, 0, 1, 2, 3, 4, 5, 6, 7), qf[ks], t0[d]); t1[d] = MFMA16(__builtin_shufflevector(b0, b1, 0, 1, 2, 3, 4, 5, 6, 7), qf[ks], t1[d]); }
    const float qd0 = ex2(lg0 * (float)(qi + 1)), qd1 = ex2(lg1 * (float)(128 - qi));
    float ss = 0.f;
#pragma unroll
    for (int d = 0; d < 4; ++d) { o[d] = o[d] + qd0 * t0[d] + qd1 * t1[d]; ss += o[d][0] * o[d][0] + o[d][1] * o[d][1] + o[d][2] * o[d][2] + o[d][3] * o[d][3]; }
    ss = grp_sum(ss);
    const float rs = 1.0f / sqrtf(ss * (1.0f / 64.0f) + 1e-6f);
    const bf16_t* gp = w.p + (size_t)(row0 + qi) * PW + C_RG + h * 64; bf16_t* op = w.mix + (size_t)(row0 + qi) * 1024 + h * 64;
#pragma unroll
    for (int d = 0; d < 4; ++d) { const u32x2 gv = *(const u32x2*)(gp + d * 16 + fq * 4);
        const float g0 = __uint_as_float(gv[0] << 16), g1 = __uint_as_float(gv[0] & 0xffff0000u), g2 = __uint_as_float(gv[1] << 16), g3 = __uint_as_float(gv[1] & 0xffff0000u);
        u32x2 ov; ov[0] = pk2(o[d][0] * rs * siluf(g0), o[d][1] * rs * siluf(g1)); ov[1] = pk2(o[d][2] * rs * siluf(g2), o[d][3] * rs * siluf(g3)); *(u32x2*)(op + d * 16 + fq * 4) = ov; }
}

constexpr int GS = 68, GNA = 72, GDI = 24;
DI bf16x8 pack8f(const float* p) {
    const f32x4 a = *(const f32x4*)p, b = *(const f32x4*)(p + 4); u32x4 r; r[0] = pk2(a[0], a[1]); r[1] = pk2(a[2], a[3]); r[2] = pk2(b[0], b[1]); r[3] = pk2(b[2], b[3]); return __builtin_bit_cast(bf16x8, r);
}
DI void gdn_prep_unit(const Params& p, const WS& w, int layer, int b, int h, int cg, char* smem) {
    float* Qs = (float*)smem; float* Ks = Qs + 64 * GS; float* Vs = Ks + 64 * GS; float* Raw = Vs + 64 * GS;
    float* KK = Raw; float* QK = KK + 64 * GS; float* gt = Raw + 66 * 192;
    bf16_t* NA = (bf16_t*)(gt + 384); bf16_t* DIm = NA + 2 * 64 * GNA;
    const int tid = tidx(), lane = tid & 63, wv = tid >> 6, fr = lane & 15, fq = lane >> 4;
    const bool isc = cg < NCG; const int nseq = isc ? CTX : SEQ, t0 = (isc ? cg : cg - NCG) * 64, base = isc ? RL + b * CTX : b * SEQ;
    __syncthreads();
    for (int i = tid; i < 66 * 24; i += NT) { const int tt = i / 24, c8 = i % 24, part = c8 >> 3, tok = t0 - 1 + tt; u32x4 v = (u32x4){0u, 0u, 0u, 0u};
        if (tok >= 0 && tok < nseq) v = *(const u32x4*)(w.p + (size_t)(base + tok) * PW + C_GQKV + part * 256 + h * 64 + (c8 & 7) * 8);
#pragma unroll
        for (int q = 0; q < 4; ++q) { Raw[tt * 192 + c8 * 8 + 2 * q] = __uint_as_float(v[q] << 16); Raw[tt * 192 + c8 * 8 + 2 * q + 1] = __uint_as_float(v[q] & 0xffff0000u); } }
    if (tid < 128) { const int dr = tid >> 6, s = tid & 63; const float* ga = w.gab + (size_t)(base + t0 + s) * 16;
        gt[dr * 64 + s] = -__expf(p.gdn_a_log[(layer * 2 + dr) * 4 + h]) * softplusf_(ga[dr * 4 + h] + p.gdn_dt_bias[(layer * 2 + dr) * 4 + h]);
        gt[128 + dr * 64 + s] = sigmoidf_(ga[8 + dr * 4 + h]); }
    __syncthreads();
    if (tid < 384) {
        const int ch = tid % 192, half = tid / 192, part = ch >> 6, d = ch & 63, chg = part * 256 + h * 64 + d; const float* cw = p.gdn_conv + (size_t)layer * 3 * 768 + chg;
        const float w0 = cw[0], w1 = cw[768], w2 = cw[1536]; float* dst = (part == 0 ? Qs : (part == 1 ? Ks : Vs)) + d;
        float x0 = Raw[(half * 32) * 192 + ch], x1 = Raw[(half * 32 + 1) * 192 + ch];
#pragma unroll 8
        for (int s = half * 32; s < half * 32 + 32; ++s) { const float x2 = Raw[(s + 2) * 192 + ch]; dst[s * GS] = siluf(w0 * x0 + w1 * x1 + w2 * x2); x0 = x1; x1 = x2; }
    } else if (tid >= 384 && tid < 512) {
        const int dr = (tid - 384) >> 6, sl = tid & 63; float a = gt[dr * 64 + (dr ? 63 - sl : sl)];
#pragma unroll
        for (int dd = 1; dd < 64; dd <<= 1) { const float o = lane_shfl_f(a, sl >= dd ? sl - dd : sl); if (sl >= dd) a += o; }
        gt[256 + dr * 64 + sl] = a; }
    __syncthreads();
#pragma unroll
    for (int pass = 0; pass < 2; ++pass) {
        float* rowp = (pass == 0 ? Qs : Ks) + (tid >> 3) * GS + (tid & 7) * 8; f32x4 x0 = *(const f32x4*)rowp, x1 = *(const f32x4*)(rowp + 4);
        float ss = x0[0] * x0[0] + x0[1] * x0[1] + x0[2] * x0[2] + x0[3] * x0[3] + x1[0] * x1[0] + x1[1] * x1[1] + x1[2] * x1[2] + x1[3] * x1[3];
        ss = sum8(ss); const float rs = (1.0f / sqrtf(ss + 1e-6f)) * (pass == 0 ? 0.125f : 1.0f);
        *(f32x4*)rowp = x0 * rs; *(f32x4*)(rowp + 4) = x1 * rs; }
    __syncthreads();
#pragma unroll
    for (int tt = 0; tt < 4; ++tt) { const int t = wv * 4 + tt, which = t >> 4, mt = (t >> 2) & 3, nt = t & 3; const float* Am = which ? Qs : Ks;
        f32x4 d = (f32x4){0.f, 0.f, 0.f, 0.f};
#pragma unroll
        for (int ks = 0; ks < 2; ++ks) d = MFMA16(pack8f(Am + (mt * 16 + fr) * GS + ks * 32 + fq * 8), pack8f(Ks + (nt * 16 + fr) * GS + ks * 32 + fq * 8), d);
        float* G = which ? QK : KK;
#pragma unroll
        for (int jj = 0; jj < 4; ++jj) G[(mt * 16 + fq * 4 + jj) * GS + nt * 16 + fr] = d[jj]; }
    __syncthreads();
    for (int i = tid; i < 2 * 4096; i += NT) { const int dr = i >> 12, s = (i >> 6) & 63, s2 = i & 63; float v = 0.f;
        if (s > s2) { const int ts = dr ? 63 - s : s, ts2 = dr ? 63 - s2 : s2; v = -gt[128 + dr * 64 + ts] * KK[ts * GS + ts2] * __expf(gt[256 + dr * 64 + s] - gt[256 + dr * 64 + s2]); }
        NA[(dr * 64 + s) * GNA + s2] = f2bf(v); }
    __syncthreads();
    if (tid < 128) {
        const int dr = tid >> 6, blk = (tid >> 4) & 3, c = tid & 15; const bf16_t* Ab = NA + (dr * 64 + blk * 16) * GNA + blk * 16; float x[16];
#pragma unroll
        for (int r = 0; r < 16; ++r) { float a = (r == c) ? 1.0f : 0.0f;
            const u32x4 lo = *(const u32x4*)(Ab + r * GNA), hi = *(const u32x4*)(Ab + r * GNA + 8);
#pragma unroll
            for (int r2 = 0; r2 < r; ++r2) { const unsigned wd = r2 < 8 ? lo[r2 >> 1] : hi[(r2 - 8) >> 1]; a += __uint_as_float((r2 & 1) ? (wd & 0xffff0000u) : (wd << 16)) * x[r2]; }
            x[r] = a; DIm[((dr * 4 + blk) * 16 + r) * GDI + c] = f2bf(a); }
    }
    __syncthreads();
    const size_t cbase = (size_t)((b * 4 + h) * 2) * NCHG;
#pragma unroll 1
    for (int tk = 0; tk < 2; ++tk) {
        const int task = wv + tk * 8, dr = task >> 3, ntile = task & 7, col = ntile * 16 + fr; const bool isw = ntile >= 4;
        const int sc = dr == 0 ? cg : (cg < NCG ? NCG - 1 - cg : NCG + (NLG - 1 - (cg - NCG))); const size_t ch = cbase + (size_t)dr * NCHG + sc;
        const float* gg = gt + 256 + dr * 64; const float* bt = gt + 128 + dr * 64; const float* Rm = isw ? Ks + (col - 64) : Vs + col;
        u32x2 xb[4];
#pragma unroll
        for (int i = 0; i < 4; ++i) {
            f32x4 acc;
#pragma unroll
            for (int jj = 0; jj < 4; ++jj) { const int sidx = 16 * i + fq * 4 + jj, ts = dr ? 63 - sidx : sidx; float r = bt[ts] * Rm[ts * GS]; if (isw) r *= __expf(gg[sidx]); acc[jj] = r; }
#pragma unroll
            for (int j0 = 0; j0 < i; j0 += 2) {
                const u32x2 a0 = *(const u32x2*)(NA + (dr * 64 + 16 * i + fr) * GNA + 16 * j0 + fq * 4);
                u32x2 a1 = (u32x2){0u, 0u}, b1 = (u32x2){0u, 0u};
                if (j0 + 1 < i) { a1 = *(const u32x2*)(NA + (dr * 64 + 16 * i + fr) * GNA + 16 * (j0 + 1) + fq * 4); b1 = xb[j0 + 1]; }
                u32x4 av; av[0] = a0[0]; av[1] = a0[1]; av[2] = a1[0]; av[3] = a1[1]; u32x4 bv; bv[0] = xb[j0][0]; bv[1] = xb[j0][1]; bv[2] = b1[0]; bv[3] = b1[1];
                acc = MFMA16(__builtin_bit_cast(bf16x8, av), __builtin_bit_cast(bf16x8, bv), acc);
            }
            const u32x2 dd = *(const u32x2*)(DIm + ((dr * 4 + i) * 16 + fr) * GDI + fq * 4);
            u32x4 av; av[0] = dd[0]; av[1] = dd[1]; av[2] = 0u; av[3] = 0u; u32x4 bv; bv[0] = pk2(acc[0], acc[1]); bv[1] = pk2(acc[2], acc[3]); bv[2] = 0u; bv[3] = 0u;
            const f32x4 x = MFMA16(__builtin_bit_cast(bf16x8, av), __builtin_bit_cast(bf16x8, bv), (f32x4){0.f, 0.f, 0.f, 0.f});
            xb[i][0] = pk2(x[0], x[1]); xb[i][1] = pk2(x[2], x[3]);
            if (!isw) *(u32x2*)(w.gub + ch * 4096 + (size_t)col * 64 + 16 * i + fq * 4) = xb[i];
            else { bf16_t* wp = w.gw + ch * 4096 + (size_t)(16 * i + fq * 4) * 64 + (col - 64);
#pragma unroll
                for (int jj = 0; jj < 4; ++jj) wp[jj * 64] = f2bf(x[jj]); }
        }
    }
    for (int i = tid; i < 2 * 2048; i += NT) {
        const int dr = i >> 11, s = (i >> 5) & 63, c = (i & 31) * 2, ts = dr ? 63 - s : s; const float* gg = gt + 256 + dr * 64;
        const int sc = dr == 0 ? cg : (cg < NCG ? NCG - 1 - cg : NCG + (NLG - 1 - (cg - NCG))); const size_t ch = cbase + (size_t)dr * NCHG + sc;
        const float es = __expf(gg[s]), g0 = gg[c], g1 = gg[c + 1], g63 = gg[63];
        *(unsigned*)(w.gqg + ch * 4096 + s * 64 + c) = pk2(Qs[ts * GS + c] * es, Qs[ts * GS + c + 1] * es);
        const int tc0 = dr ? 63 - c : c, tc1 = dr ? 62 - c : c + 1;
        *(unsigned*)(w.gqk + ch * 4096 + s * 64 + c) = pk2(s >= c ? QK[ts * GS + tc0] * __expf(gg[s] - g0) : 0.f, s >= c + 1 ? QK[ts * GS + tc1] * __expf(gg[s] - g1) : 0.f);
        *(unsigned*)(w.gkt + ch * 4096 + s * 64 + c) = pk2(Ks[tc0 * GS + s] * __expf(g63 - g0), Ks[tc1 * GS + s] * __expf(g63 - g1));
        if (s == 0 && c == 0) w.gcd[ch] = __expf(g63); }
}
struct GdnOps { bf16x8 aw[2], aqg[2], aqk[2], akt[2]; u32x2 ub; float cd; };
DI void gdn_load_ops(GdnOps& g, const WS& w, size_t ch, int wv, int fr, int fq, int vs) {
#pragma unroll
    for (int ks = 0; ks < 2; ++ks) { const size_t o = ch * 4096 + (size_t)(wv * 16 + fr) * 64 + ks * 32 + fq * 8;
        g.aw[ks] = *(const bf16x8*)(w.gw + o); g.aqg[ks] = *(const bf16x8*)(w.gqg + o); g.aqk[ks] = *(const bf16x8*)(w.gqk + o); g.akt[ks] = *(const bf16x8*)(w.gkt + o); }
    g.ub = *(const u32x2*)(w.gub + ch * 4096 + (size_t)(vs * 16 + fr) * 64 + wv * 16 + fq * 4); g.cd = w.gcd[ch];
}
DI void gdn_scan_step(const GdnOps& g, f32x4& sacc, bf16_t* Sp, bf16_t* Up, const WS& w, int rbase, int dr, int h, int vs, int wv, int fr, int fq) {
    { u32x2 sv; sv[0] = pk2(sacc[0], sacc[1]); sv[1] = pk2(sacc[2], sacc[3]); *(u32x2*)(Sp + fr * 72 + wv * 16 + fq * 4) = sv; }
    LDS_BARRIER();
    bf16x8 sb[2]; f32x4 u = (f32x4){0.f, 0.f, 0.f, 0.f};
#pragma unroll
    for (int ks = 0; ks < 2; ++ks) { sb[ks] = *(const bf16x8*)(Sp + fr * 72 + ks * 32 + fq * 8); u = MFMA16(g.aw[ks], sb[ks], u); }
    u = (f32x4){bf_lo(g.ub[0]), bf_hi(g.ub[0]), bf_lo(g.ub[1]), bf_hi(g.ub[1])} - u;
    { u32x2 uvv; uvv[0] = pk2(u[0], u[1]); uvv[1] = pk2(u[2], u[3]); *(u32x2*)(Up + fr * 72 + wv * 16 + fq * 4) = uvv; }
    LDS_BARRIER();
    f32x4 oo = (f32x4){0.f, 0.f, 0.f, 0.f}, sn = sacc * g.cd;
#pragma unroll
    for (int ks = 0; ks < 2; ++ks) { const bf16x8 ubf = *(const bf16x8*)(Up + fr * 72 + ks * 32 + fq * 8);
        oo = MFMA16(g.aqg[ks], sb[ks], oo); oo = MFMA16(g.aqk[ks], ubf, oo); sn = MFMA16(g.akt[ks], ubf, sn); }
    sacc = sn;
    {
        const bool ev = (fr & 1) == 0;
        const float r0 = lane_xor1_f(ev ? oo[2] : oo[0]), r1 = lane_xor1_f(ev ? oo[3] : oo[1]);
        const unsigned p0 = ev ? pk2(oo[0], r0) : pk2(r0, oo[2]), p1 = ev ? pk2(oo[1], r1) : pk2(r1, oo[3]);
#pragma unroll
        for (int q = 0; q < 2; ++q) { const int s = wv * 16 + fq * 4 + (ev ? 0 : 2) + q, tok = dr ? 63 - s : s;
            *(unsigned*)(w.og + ((size_t)dr * R + rbase + tok) * 256 + h * 64 + vs * 16 + (fr & 14)) = q ? p1 : p0; }
    }
}
DI void gdn_scan_unit(const Params& p, const WS& w, int layer, int b, int h, int dr, int vs, char* smem) {
    static_assert(NCHG % 4 == 0, "scan ring assumes a multiple of 4 chunks");
    bf16_t* Sb = (bf16_t*)smem; bf16_t* Ub = Sb + 2 * 16 * 72;
    const int tid = tidx(), lane = tid & 63, wv = tid >> 6, fr = lane & 15, fq = lane >> 4;
    const size_t cb = (size_t)((b * 4 + h) * 2 + dr) * NCHG;
    __syncthreads();
    if (wv < 4) {
        f32x4 sacc = (f32x4){0.f, 0.f, 0.f, 0.f};
        GdnOps r0, r1, r2, r3;
        gdn_load_ops(r0, w, cb, wv, fr, fq, vs); gdn_load_ops(r1, w, cb + 1, wv, fr, fq, vs); gdn_load_ops(r2, w, cb + 2, wv, fr, fq, vs); gdn_load_ops(r3, w, cb + 3, wv, fr, fq, vs);
#define GDN_STEP(RG, K) do { const int sc_ = sc + (K); const int cgi = dr == 0 ? sc_ : (sc_ < NCG ? NCG - 1 - sc_ : NCG + (NLG - 1 - (sc_ - NCG))); \
        gdn_scan_step(RG, sacc, Sb + (K & 1) * 16 * 72, Ub + (K & 1) * 16 * 72, w, cgi < NCG ? RL + b * CTX + cgi * 64 : b * SEQ + (cgi - NCG) * 64, dr, h, vs, wv, fr, fq); \
        gdn_load_ops(RG, w, cb + (sc_ + 4 < NCHG ? sc_ + 4 : NCHG - 1), wv, fr, fq, vs); } while (0)
#pragma unroll 1
        for (int sc = 0; sc < NCHG; sc += 4) { GDN_STEP(r0, 0); GDN_STEP(r1, 1); GDN_STEP(r2, 2); GDN_STEP(r3, 3); }
#undef GDN_STEP
    } else {
#pragma unroll 1
        for (int sc = 0; sc < NCHG; ++sc) { LDS_BARRIER(); LDS_BARRIER(); }
    }
    __syncthreads();
}
DI void gdn_finish(const Params& p, const WS& w, int layer, int skip) {
    const int lane = tidx() & 63, wv = tidx() >> 6; const int nrows = layer == DEPTH - 1 ? RL : R;
    if (bidx() < skip) return;
    for (int row = (bidx() - skip) * 8 + wv; row < nrows; row += (gridDim.x - skip) * 8) {
        const u32x2 av = *(const u32x2*)(w.og + (size_t)row * 256 + lane * 4), cv = *(const u32x2*)(w.og + ((size_t)R + row) * 256 + lane * 4);
        const f32x4 o = (f32x4){bf_lo(av[0]) + bf_lo(cv[0]), bf_hi(av[0]) + bf_hi(cv[0]), bf_lo(av[1]) + bf_lo(cv[1]), bf_hi(av[1]) + bf_hi(cv[1])};
        float ss = o[0] * o[0] + o[1] * o[1] + o[2] * o[2] + o[3] * o[3];
        ss = sum16(ss);
        const float rs = 1.0f / sqrtf(ss * (1.0f / 64.0f) + 1e-6f); const f32x4 ng = *(const f32x4*)(p.gdn_norm + layer * 64 + (lane & 15) * 4);
        const u32x2 gv = *(const u32x2*)(w.p + (size_t)row * PW + C_GG + lane * 4);
        const float g0 = __uint_as_float(gv[0] << 16), g1 = __uint_as_float(gv[0] & 0xffff0000u), g2 = __uint_as_float(gv[1] << 16), g3 = __uint_as_float(gv[1] & 0xffff0000u);
        u32x2 ov; ov[0] = pk2(o[0] * rs * ng[0] * siluf(g0), o[1] * rs * ng[1] * siluf(g1)); ov[1] = pk2(o[2] * rs * ng[2] * siluf(g2), o[3] * rs * ng[3] * siluf(g3));
        *(u32x2*)(w.mix + (size_t)row * 1024 + 512 + lane * 4) = ov;
    }
}

DI void phase_diff(const Params& p, int layer, char* smem) {
    const WS w = ws_of(p.ws); const bool full_ctx = layer < DEPTH - 1;
    constexpr int QB = SEQ / 256, QC = CTX / 256;
    const int n_diff = NB * 4 * QB, n_diffc = full_ctx ? NB * 4 * QC : 0;
    int lyr = layer;
#ifndef EMU
    asm volatile("" : "+s"(lyr));
#endif
    const float lam_init = 0.8f - 0.6f * __expf(-0.3f * (float)lyr);
    float lam; { const float* lp = p.diff_lambda + layer * 128; const int ln = tidx() & 63; float s1 = 0.f, s2 = 0.f; if (ln < 32) { s1 = lp[ln] * lp[32 + ln]; s2 = lp[64 + ln] * lp[96 + ln]; }
        s1 = wsum(s1); s2 = wsum(s2); lam = __expf(s1) - __expf(s2) + lam_init; }
    for (int r0 = bidx(); r0 < n_diff + n_diffc; r0 += gridDim.x) {
        int r = r0; if (r0 < n_diff && (NB * 4) % 8 == 0) { const int x = r0 & 7, y = r0 >> 3, bh = x + 8 * (y / QB), qb_ = y % QB; r = bh * QB + qb_; }
        const bool isc = r >= n_diff; const int rr = isc ? r - n_diff : r, nq = isc ? QC : QB, qb = rr % nq, h = (rr / nq) & 3, b = rr / (nq * 4);
        const int qrow = (isc ? RL + b * CTX : b * SEQ) + qb * 256;
        attn_unit<2>(w.p, qrow, C_DQ + h * 64, C_DK + h * 64, C_DV + h * 64, isc ? RL + b * CTX : b * SEQ, isc ? CTX / 64 : SEQ / 64, 0, false, RL + b * CTX, isc ? 0 : CTX / 64, 0,
                     -1e30f, 0.f, lam, 1.0f - lam_init, p.diff_norm + layer * 64, w.mix + (size_t)qrow * 1024 + 256 + h * 64, smem);
    }
}
DI void phase_swa(const Params& p, int layer, char* smem) {
    const WS w = ws_of(p.ws); const bool full_ctx = layer < DEPTH - 1;
    constexpr int QB = SEQ / 256, QC = CTX / 256;
    const int n_swa = NB * 4 * QB, n_swac = full_ctx ? NB * 4 * QC : 0;
    for (int r0 = bidx(); r0 < n_swa + n_swac; r0 += gridDim.x) {
        int r = r0; if (r0 < n_swa && (NB * 4) % 8 == 0) { const int x = r0 & 7, y = r0 >> 3, bh = x + 8 * (y / QB), qb_ = y % QB; r = bh * QB + qb_; }
        const bool isc = r >= n_swa; const int rr = isc ? r - n_swa : r, nq = isc ? QC : QB, qb = rr % nq, hh = (rr / nq) & 3, b = rr / (nq * 4), hk = hh >> 1;
        const int qrow = (isc ? RL + b * CTX : b * SEQ) + qb * 256;
        const int ks = qb * 256 - 128 < 0 ? 0 : qb * 256 - 128, ke = qb * 256 + 384 > SEQ ? SEQ : qb * 256 + 384;
        attn_unit<1>(w.p, qrow, C_SQ + hh * 64, C_SK + hk * 64, C_SV + hk * 64, isc ? RL + b * CTX : b * SEQ + ks, isc ? CTX / 64 : (ke - ks) / 64, isc ? 0 : ks, !isc, RL + b * CTX, isc ? 0 : CTX / 64, qb * 256,
                     p.swa_sink[layer * 4 + hh] * LOG2E, 1.0f, 0.f, 1.0f, nullptr, w.mix + (size_t)qrow * 1024 + 768 + hh * 64, smem);
    }
}
DI void phase_gdnp(const Params& p, int layer, char* smem) {
    const WS w = ws_of(p.ws);
    for (int r = bidx(); r < NB * 4 * NCHG; r += gridDim.x) { const int cg = r % NCHG, h = (r / NCHG) & 3, b = r / (NCHG * 4); gdn_prep_unit(p, w, layer, b, h, cg, smem); }
}
DI void phase_rkv(const Params& p, int layer, char* smem) {
    const WS w = ws_of(p.ws);
    const int G = gridDim.x;
    for (int r = (bidx() + G / 2) % G; r < NB * 4 * NCHR; r += G) { const int ci = r % NCHR, h = (r / NCHR) & 3, b = r / (NCHR * 4); ret_kv_unit(p, w, layer, b, h, ci, smem); }
}
DI void phase_mix2(const Params& p, int layer, char* smem) {
    const WS w = ws_of(p.ws);
    for (int u = bidx(); u < NB * 4 * 2 * 4; u += gridDim.x) {
        const int x = u & 7, y = u >> 3, vs = y & 3, chain = x + 8 * (y >> 2), dr = chain & 1, h = (chain >> 1) & 3, b = chain >> 3;
        gdn_scan_unit(p, w, layer, b, h, dr, vs, smem); }
    ret_scan(p, w, layer);
}
DI void phase_mix3(const Params& p, int layer, char* smem) {
    const WS w = ws_of(p.ws); const bool full_ctx = layer < DEPTH - 1;
    for (int u = bidx(); u < NB * 4 * NCHR; u += gridDim.x) { const int ci = u % NCHR, h = (u / NCHR) & 3, b = u / (NCHR * 4); if (ci < NCC && !full_ctx) continue; ret_out_unit(p, w, layer, b, h, ci, smem); }
    const int G = gridDim.x, nun = NB * 4 * (full_ctx ? NCHR : NLC), rem = nun % G;
    gdn_finish(p, w, layer, (rem > 0 && rem <= G / 2) ? rem : 0);
}

DI int block_sum(int v, int* red) {
    const int lane = tidx() & 63, wv = tidx() >> 6;
    const int s = wsum_i(v);
    __syncthreads(); if (lane == 0) red[wv] = s; __syncthreads();
    int t = 0;
#pragma unroll
    for (int i = 0; i < 8; ++i) t += red[i];
    return t;
}
DI int block_exscan(int v, int* red) {
    const int lane = tidx() & 63, wv = tidx() >> 6;
    int s = v;
#pragma unroll
    for (int d = 1; d < 64; d <<= 1) { const int o = lane_shfl_i(s, lane >= d ? lane - d : lane); if (lane >= d) s += o; }
    __syncthreads(); if (lane == 63) red[wv] = s; __syncthreads();
    int off = 0;
#pragma unroll
    for (int i = 0; i < 8; ++i) if (i < wv) off += red[i];
    return off + s - v;
}
template <int N, int CAP> DI void topk_unit(const WS& w, const float* __restrict__ aff, int rowbase, int slotbase, int e, int* red) {
    constexpr int PT = (N + NT - 1) / NT;
    const int tid = tidx(); unsigned key[PT];
#pragma unroll
    for (int i = 0; i < PT; ++i) { const int n = tid * PT + i; key[i] = n < N ? __float_as_uint(aff[n]) : 0u; }
    unsigned T = 0u;
    for (int bit = 30; bit >= 0; --bit) { const unsigned cand = T | (1u << bit); int c = 0;
#pragma unroll
        for (int i = 0; i < PT; ++i) c += (tid * PT + i < N && key[i] >= cand) ? 1 : 0;
        if (block_sum(c, red) >= CAP) T = cand; }
    int cg = 0, ce = 0;
#pragma unroll
    for (int i = 0; i < PT; ++i) { const bool in = tid * PT + i < N; cg += (in && key[i] > T) ? 1 : 0; ce += (in && key[i] == T) ? 1 : 0; }
    const int need = CAP - block_sum(cg, red); const int eoff = block_exscan(ce, red);
    int sel = 0, er = eoff; bool flag[PT];
#pragma unroll
    for (int i = 0; i < PT; ++i) { const bool in = tid * PT + i < N; bool f = in && key[i] > T; if (in && key[i] == T) { f = er < need; ++er; } flag[i] = f; sel += f ? 1 : 0; }
    int slot = block_exscan(sel, red);
    int* selrow = red + 32;
#pragma unroll
    for (int i = 0; i < PT; ++i) { const int n = tid * PT + i; int iv = -1;
        if (n < N) { if (flag[i]) { iv = slotbase + slot; w.idx[(size_t)e * ROWS_E + iv] = rowbase + n; w.wgt[(size_t)e * ROWS_E + iv] = __uint_as_float(key[i]); selrow[slot] = rowbase + n; ++slot; }
            w.inv[(size_t)(rowbase + n) * 16 + e] = iv; } }
    __syncthreads();
}
DI void phase_topk(const Params& p, int layer, char* smem) {
    const WS w = ws_of(p.ws); int* red = (int*)smem; const bool full_ctx = layer < DEPTH - 1;
    for (int u = bidx(); u < 2 * NB * 16; u += gridDim.x) {
        const bool isc = u >= NB * 16; const int v = isc ? u - NB * 16 : u, b = v >> 4, e = v & 15;
        if (!isc) topk_unit<SEQ, CAPL>(w, w.aff + ((size_t)b * 16 + e) * SEQ, b * SEQ, b * CAPL, e, red);
        else if (full_ctx) topk_unit<CTX, CAPC>(w, w.aff + (size_t)RL * 16 + ((size_t)b * 16 + e) * CTX, RL + b * CTX, NB * CAPL + b * CAPC, e, red);
        else { for (int i = tidx(); i < CAPC; i += NT) { w.idx[(size_t)e * ROWS_E + NB * CAPL + b * CAPC + i] = 0; w.wgt[(size_t)e * ROWS_E + NB * CAPL + b * CAPC + i] = 0.f; } }
    }
    {
        const int G = gridDim.x, c = bidx(), first = G > NB * 16 ? NB * 16 : 0;
        if (c >= first) { __syncthreads(); cvt_stream<4>(p, w, smem, layer, c - first, G - first); }
    }
}

enum { PH_CVT = 0, PH_INIT, PH_INPROJ, PH_PREP, PH_DIFF, PH_MIX2, PH_MIX3, PH_OUTPROJ, PH_LN0, PH_TOPK, PH_MOE1, PH_MOE2, PH_LN1, PH_SWA, PH_GDNP, PH_RKV };
#ifdef EMU
#define SMEM_PTR(s) char* s = emu::B->lds
#else
extern __shared__ __attribute__((aligned(16))) char dyn_smem[];
#define SMEM_PTR(s) char* s = dyn_smem
#endif
template <int PH> DI void run_phase(const Params& p, int layer, char* smem) {
    if (PH == PH_CVT) phase_cvt(p, smem);
    else if (PH == PH_INIT) phase_rows<0>(p, 0, smem);
    else if (PH == PH_INPROJ) phase_inproj(p, layer, smem);
    else if (PH == PH_PREP) phase_prep(p, layer, smem);
    else if (PH == PH_DIFF) phase_diff(p, layer, smem);
    else if (PH == PH_SWA) phase_swa(p, layer, smem);
    else if (PH == PH_GDNP) phase_gdnp(p, layer, smem);
    else if (PH == PH_RKV) phase_rkv(p, layer, smem);
    else if (PH == PH_MIX2) phase_mix2(p, layer, smem);
    else if (PH == PH_MIX3) phase_mix3(p, layer, smem);
    else if (PH == PH_OUTPROJ) phase_outproj(p, layer, smem);
    else if (PH == PH_LN0) phase_rows<1>(p, layer, smem);
    else if (PH == PH_TOPK) phase_topk(p, layer, smem);
    else if (PH == PH_MOE1) phase_moe1(p, layer, smem);
    else if (PH == PH_MOE2) phase_moe2(p, layer, smem);
    else if (PH == PH_LN1) phase_rows<2>(p, layer, smem);
}
constexpr int LDS_BYTES = 8 * G_HT * 2 + 2048;
template <int PH> __global__ void __launch_bounds__(NT, 2) k_phase(Params p, int layer) { SMEM_PTR(smem); run_phase<PH>(p, layer, smem); }

#ifdef EMU
void (*emu_hook)(const char* tag, int layer, char* ws) = nullptr;
#define HOOK(t, l) do { if (emu_hook) emu_hook(t, l, (char*)d_ws); } while (0)
#else
#define HOOK(t, l)
#endif
template <int PH> static void launch_phase1(const Params& p, int layer, int grid, hipStream_t stream);
template <int PH> static void launch_phase(const Params& p, int layer, int grid, hipStream_t stream) { launch_phase1<PH>(p, layer, grid, stream); if ((PROBE_REP >> PH) & 1) launch_phase1<PH>(p, layer, grid, stream); }
template <int PH> static void launch_phase1(const Params& p, int layer, int grid, hipStream_t stream) {
#ifndef EMU
    static bool done = false; if (!done) { hipFuncSetAttribute((const void*)k_phase<PH>, hipFuncAttributeMaxDynamicSharedMemorySize, LDS_BYTES); done = true; }
#endif
    hipLaunchKernelGGL(k_phase<PH>, dim3(grid), dim3(NT), LDS_BYTES, stream, p, layer);
}

#ifndef MK_MULTI
#define MK_MULTI 0
#endif
#ifdef EMU
#define PHASE(PH, l) run_phase<PH>(p, l, emu::B->lds)
#define GRID_BARRIER() do { XcdBarrier bar_; bar_.bar = (unsigned*)(p.ws + OFF_BAR); xcd_barrier(bar_); } while (0)
#else
typedef const __attribute__((address_space(4))) Params* KParams;
DI KParams kparams() { KParams kp = (KParams)__builtin_amdgcn_kernarg_segment_ptr(); asm volatile("" : "+s"(kp)); return kp; }
template <int PH> DI void run_phase_k(int layer) { const Params* gp = (const Params*)kparams(); const Params p = *gp; run_phase<PH>(p, layer, dyn_smem); }
DI void grid_barrier_k() { XcdBarrier b; b.bar = (unsigned*)(kparams()->ws + OFF_BAR); b.x = xb_xcc_id(); b.st = (volatile LAS unsigned*)&dyn_smem[8 * G_HT * 2]; xcd_barrier(b); }
#define PHASE(PH, l) run_phase_k<PH>(l)
#define GRID_BARRIER() grid_barrier_k()
#endif
#if !MK_MULTI
__global__ void __launch_bounds__(NT, 2) k_mega(Params p) {
#ifndef EMU
    {   volatile LAS unsigned* st = (volatile LAS unsigned*)&dyn_smem[8 * G_HT * 2];
        if (threadIdx.x == 0) { st[0] = 0u; st[1] = 0u; st[2] = 0u; st[3] = 0u; }
        __syncthreads();
        (void)xcd_barrier_post((unsigned*)(kparams()->ws + OFF_BAR), st); }
#endif
#define PHASE_R(PH, l) do { PHASE(PH, l); if ((PROBE_REP >> PH) & 1) { GRID_BARRIER(); PHASE(PH, l); } } while (0)
    PHASE_R(PH_CVT, 0); GRID_BARRIER();
    PHASE_R(PH_INIT, 0); GRID_BARRIER();
    for (int l = 0; l < DEPTH; ++l) {
        PHASE_R(PH_INPROJ, l); GRID_BARRIER();
        PHASE_R(PH_DIFF, l); PHASE_R(PH_SWA, l); PHASE_R(PH_GDNP, l); PHASE_R(PH_RKV, l); GRID_BARRIER();
        PHASE_R(PH_MIX2, l); GRID_BARRIER();
        PHASE_R(PH_MIX3, l); GRID_BARRIER();
        PHASE_R(PH_OUTPROJ, l); GRID_BARRIER();
        PHASE(PH_LN0, l); GRID_BARRIER();
        PHASE_R(PH_TOPK, l); GRID_BARRIER();
        PHASE_R(PH_MOE1, l); GRID_BARRIER();
        PHASE_R(PH_MOE2, l); GRID_BARRIER();
        PHASE(PH_LN1, l); if (l + 1 < DEPTH) GRID_BARRIER();
    }
}
#endif

extern "C" void kernel_launch(void* const* d_in, const int* in_sizes, int n_in, void* d_out, int out_size, void* d_ws, size_t ws_size, hipStream_t stream) {
    Params p{};
    const float* const* in = (const float* const*)d_in;
    p.x = in[0]; p.c = in[1]; p.ctx = in[2]; p.c_ctx = in[3]; p.ada_w = in[4]; p.ada_b = in[5]; p.w_in = in[6]; p.w_out = in[7]; p.ret_decay = in[8]; p.diff_lambda = in[9];
    p.diff_norm = in[10]; p.gdn_conv = in[11]; p.gdn_a_log = in[12]; p.gdn_dt_bias = in[13]; p.gdn_norm = in[14]; p.swa_sink = in[15]; p.ln_g = in[16]; p.ln_b = in[17];
    p.router_w = in[18]; p.w_gate = in[19]; p.w_up = in[20]; p.w_down = in[21]; p.out = (float*)d_out; p.ws = (char*)d_ws;
    static int cus = 0;
    if (!cus) { int dev = 0; hipGetDevice(&dev); hipDeviceGetAttribute(&cus, hipDeviceAttributeMultiprocessorCount, dev); if (cus <= 0) cus = 256; }
    const int grid = cus;
#if MK_MULTI
    launch_phase<PH_CVT>(p, 0, grid, stream); HOOK("cvt", 0);
    launch_phase<PH_INIT>(p, 0, grid, stream); HOOK("init", 0);
    for (int l = 0; l < DEPTH; ++l) {
        launch_phase<PH_INPROJ>(p, l, grid, stream); HOOK("inproj", l);
        launch_phase<PH_DIFF>(p, l, grid, stream); launch_phase<PH_SWA>(p, l, grid, stream); launch_phase<PH_GDNP>(p, l, grid, stream); launch_phase<PH_RKV>(p, l, grid, stream);
        launch_phase<PH_MIX2>(p, l, grid, stream);
        launch_phase<PH_MIX3>(p, l, grid, stream); HOOK("mix", l);
        launch_phase<PH_OUTPROJ>(p, l, grid, stream);
        launch_phase<PH_LN0>(p, l, grid, stream); HOOK("ln0", l);
        launch_phase<PH_TOPK>(p, l, grid, stream);
        launch_phase<PH_MOE1>(p, l, grid, stream);
        launch_phase<PH_MOE2>(p, l, grid, stream);
        launch_phase<PH_LN1>(p, l, grid, stream); HOOK("ln1", l);
    }
#else
    hipMemsetAsync((char*)d_ws + OFF_BAR, 0, XCD_BAR_WORDS * sizeof(unsigned), stream);
#ifndef EMU
    static bool attr = false; if (!attr) { hipFuncSetAttribute((const void*)k_mega, hipFuncAttributeMaxDynamicSharedMemorySize, LDS_BYTES); attr = true; }
#endif
    hipLaunchKernelGGL(k_mega, dim3(grid), dim3(NT), LDS_BYTES, stream, p);
#endif
}
```

```cpp
#ifndef EMU
#include <hip/hip_runtime.h>
#endif
#include <stdint.h>
#include <stddef.h>
#include <math.h>

#ifndef CFG_B
#define CFG_B 8
#define CFG_SEQ 4096
#define CFG_CTX 256
#define CFG_DEPTH 4
#define CFG_FF 2048
#endif

#ifndef PROBE_REP
#define PROBE_REP 0
#endif
#define DI __device__ __forceinline__
typedef unsigned short bf16_t;
typedef short bf16x8 __attribute__((ext_vector_type(8)));
typedef short s16x4 __attribute__((ext_vector_type(4)));
typedef float f32x4 __attribute__((ext_vector_type(4)));
typedef unsigned u32x4 __attribute__((ext_vector_type(4)));
typedef unsigned u32x2 __attribute__((ext_vector_type(2)));

constexpr int NB = CFG_B, SEQ = CFG_SEQ, CTX = CFG_CTX, DEPTH = CFG_DEPTH, FF = CFG_FF, DM = 1024, NE = 16;
constexpr int RL = NB * SEQ, RC = NB * CTX, R = RL + RC;
constexpr int CAPL = SEQ / 8, CAPC = CTX / 8, ROWS_E = NB * (CAPL + CAPC);
constexpr int INW = 3344, PW = 3328;
constexpr int NT = 512;
constexpr int NCC = CTX / 128, NLC = SEQ / 128, NCHR = NCC + NLC;
constexpr int NCG = CTX / 64, NLG = SEQ / 64, NCHG = NCG + NLG;
constexpr float ALPHA = 1.681792830507429f;
constexpr float LOG2E = 1.4426950408889634f;
constexpr int C_RQ = 0, C_RK = 256, C_RV = 512, C_RG = 768, C_DQ = 1024, C_DK = 1280, C_DV = 1536, C_GQKV = 1792, C_GG = 2560, C_SQ = 2816, C_SK = 3072, C_SV = 3200;

constexpr size_t al256(size_t x) { return (x + 255) & ~(size_t)255; }
constexpr size_t OFF_BAR = 0;
constexpr size_t OFF_MOD = 16384;
constexpr size_t OFF_TAB = OFF_MOD + al256((size_t)DEPTH * (NB + 1) * 6144 * 4);
constexpr size_t OFF_WIN = OFF_TAB + al256((size_t)SEQ * 160 * 4);
constexpr size_t OFF_WOUT = OFF_WIN + al256((size_t)DEPTH * PW * 1024 * 2);
constexpr size_t OFF_WGU = OFF_WOUT + al256((size_t)DEPTH * 1024 * 1024 * 2);
constexpr size_t OFF_WDN = OFF_WGU + al256((size_t)DEPTH * 16 * 2 * FF * 1024 * 2);
constexpr size_t OFF_H = OFF_WDN + al256((size_t)DEPTH * 16 * 1024 * FF * 2);
constexpr size_t OFF_U = OFF_H + al256((size_t)R * 1024 * 4);
constexpr size_t OFF_GAB = OFF_U + al256((size_t)R * 1024 * 2);
constexpr size_t OFF_MIX = OFF_GAB + al256((size_t)R * 16 * 4);
constexpr size_t OFF_AFF = OFF_MIX + al256((size_t)R * 1024 * 2);
constexpr size_t OFF_IDX = OFF_AFF + al256((size_t)R * 16 * 4);
constexpr size_t OFF_WGT = OFF_IDX + al256((size_t)16 * ROWS_E * 4);
constexpr size_t OFF_INV = OFF_WGT + al256((size_t)16 * ROWS_E * 4);
constexpr size_t OFF_U8 = OFF_INV + al256((size_t)R * 16 * 4);
constexpr size_t OFF_ARA = OFF_U8 + al256((size_t)R * 1024);
constexpr size_t SZ_P = (size_t)R * PW * 2, SZ_HID8 = al256((size_t)16 * ROWS_E * FF), SZ_XIN8 = al256((size_t)16 * ROWS_E * 1024), SZ_HID = SZ_HID8 + SZ_XIN8;
constexpr size_t OFF_ARB = OFF_ARA + al256(SZ_P > SZ_HID ? SZ_P : SZ_HID);
constexpr size_t SZ_RKV = (size_t)NB * 4 * 2 * NCHR * 4096 * 4;
constexpr size_t GCH = (size_t)NB * 4 * 2 * NCHG;
constexpr size_t OB_RKV = 0, OB_RS = OB_RKV + al256(SZ_RKV), OB_GW = OB_RS + al256(SZ_RKV), OB_GQG = OB_GW + GCH * 8192, OB_GQK = OB_GQG + GCH * 8192,
                 OB_GKT = OB_GQK + GCH * 8192, OB_GUB = OB_GKT + GCH * 8192, OB_GCD = OB_GUB + GCH * 16384, OB_OG = OB_GCD + al256(GCH * 4), OB_END = OB_OG + (size_t)2 * R * 256 * 4;
constexpr size_t SZ_MIXO = (size_t)R * 1024 * 4, SZ_Y = (size_t)16 * ROWS_E * 1024 * 2;
constexpr size_t SZ_ARB = OB_END > SZ_MIXO ? (OB_END > SZ_Y ? OB_END : SZ_Y) : (SZ_MIXO > SZ_Y ? SZ_MIXO : SZ_Y);
constexpr size_t WS_TOTAL = OFF_ARB + al256(SZ_ARB);

struct Params {
    const float *x, *c, *ctx, *c_ctx, *ada_w, *ada_b, *w_in, *w_out, *ret_decay, *diff_lambda, *diff_norm, *gdn_conv, *gdn_a_log, *gdn_dt_bias,
        *gdn_norm, *swa_sink, *ln_g, *ln_b, *router_w, *w_gate, *w_up, *w_down;
    float* out; char* ws;
};

#ifdef EMU
#define NT_LOAD(p) (*(p))
#define NT_STORE(v, p) (*(p) = (v))
#else
#define NT_LOAD(p) __builtin_nontemporal_load(p)
#define NT_STORE(v, p) __builtin_nontemporal_store((v), (p))
#endif
DI float bf2f(bf16_t v) { return __uint_as_float(((unsigned)v) << 16); }
DI bf16_t f2bf(float f) { unsigned u = __float_as_uint(f); u += 0x7fffu + ((u >> 16) & 1u); return (bf16_t)(u >> 16); }
DI unsigned pk2(float lo, float hi) {
#ifdef EMU
    return (unsigned)f2bf(lo) | ((unsigned)f2bf(hi) << 16);
#else
    typedef float f32x2_ __attribute__((ext_vector_type(2))); typedef __bf16 bf16x2_ __attribute__((ext_vector_type(2)));
    const f32x2_ v = {lo, hi}; return __builtin_bit_cast(unsigned, __builtin_convertvector(v, bf16x2_));
#endif
}
#ifdef EMU
DI int max(int a, int b) { return a > b ? a : b; }
DI int tidx() { return (int)threadIdx.x; }
DI int bidx() { return (int)blockIdx.x; }
#else
DI int tidx() { int t = threadIdx.x; asm volatile("" : "+v"(t)); return t; }
DI int bidx() { int b = blockIdx.x; asm volatile("" : "+s"(b)); return b; }
#endif
constexpr float SW1 = 32.0f, SW2 = 64.0f, SH = 8.0f, SY = 64.0f;
DI unsigned pk4_fp8(float a, float b, float c, float d) {
    a = fminf(fmaxf(a, -448.f), 448.f); b = fminf(fmaxf(b, -448.f), 448.f); c = fminf(fmaxf(c, -448.f), 448.f); d = fminf(fmaxf(d, -448.f), 448.f);
    int r = __builtin_amdgcn_cvt_pk_fp8_f32(a, b, 0, false); r = __builtin_amdgcn_cvt_pk_fp8_f32(c, d, r, true); return (unsigned)r; }
#ifdef EMU
DI float sum8(float v) { for (int m = 4; m >= 1; m >>= 1) v += __shfl_xor(v, m); return v; }
DI float sum16(float v) { for (int m = 8; m >= 1; m >>= 1) v += __shfl_xor(v, m); return v; }
DI float wsum(float v) { for (int m = 32; m >= 1; m >>= 1) v += __shfl_xor(v, m); return v; }
DI int wsum_i(int v) { for (int m = 32; m >= 1; m >>= 1) v += __shfl_xor(v, m); return v; }
DI int lane_bcast(int v, int src) { return __shfl(v, src); }
DI int lane_shfl_i(int v, int src) { return __shfl(v, src); }
DI float lane_shfl_f(float v, int src) { return __shfl(v, src); }
#else
template <int CTRL> DI float dpp_f(float x) { return __int_as_float(__builtin_amdgcn_update_dpp(0, __float_as_int(x), CTRL, 0xF, 0xF, true)); }
template <int CTRL> DI int dpp_i(int x) { return __builtin_amdgcn_update_dpp(0, x, CTRL, 0xF, 0xF, true); }
DI float sum8(float x) { x += dpp_f<0xB1>(x); x += dpp_f<0x4E>(x); x += dpp_f<0x141>(x); return x; }
DI float sum16(float x) { x += dpp_f<0xB1>(x); x += dpp_f<0x4E>(x); x += dpp_f<0x141>(x); x += dpp_f<0x140>(x); return x; }
DI float wsum(float x) { x = sum16(x);
    auto a = __builtin_amdgcn_permlane16_swap(__float_as_uint(x), __float_as_uint(x), false, false); x = __uint_as_float(a[0]) + __uint_as_float(a[1]);
    auto b = __builtin_amdgcn_permlane32_swap(__float_as_uint(x), __float_as_uint(x), false, false); return __uint_as_float(b[0]) + __uint_as_float(b[1]); }
DI int wsum_i(int x) { x += dpp_i<0xB1>(x); x += dpp_i<0x4E>(x); x += dpp_i<0x141>(x); x += dpp_i<0x140>(x);
    auto a = __builtin_amdgcn_permlane16_swap((unsigned)x, (unsigned)x, false, false); x = (int)a[0] + (int)a[1];
    auto b = __builtin_amdgcn_permlane32_swap((unsigned)x, (unsigned)x, false, false); return (int)b[0] + (int)b[1]; }
DI int lane_bcast(int v, int src) { return __builtin_amdgcn_readlane(v, src); }
DI int lane_shfl_i(int v, int src) { return __builtin_amdgcn_ds_bpermute(src << 2, v); }
DI float lane_shfl_f(float v, int src) { return __int_as_float(__builtin_amdgcn_ds_bpermute(src << 2, __float_as_int(v))); }
#endif
#ifdef EMU
DI float lane_xor1_f(float x) { return __shfl_xor(x, 1); }
#else
DI float lane_xor1_f(float x) { return __int_as_float(__builtin_amdgcn_update_dpp(0, __float_as_int(x), 0xB1, 0xF, 0xF, true)); }
#endif
DI float bf_lo(unsigned v) { return __uint_as_float(v << 16); }
DI float bf_hi(unsigned v) { return __uint_as_float(v & 0xffff0000u); }
DI float siluf(float x) { return x * __builtin_amdgcn_rcpf(1.0f + __builtin_amdgcn_exp2f(-LOG2E * x)); }
DI float sigmoidf_(float x) { return __builtin_amdgcn_rcpf(1.0f + __builtin_amdgcn_exp2f(-LOG2E * x)); }
DI float softplusf_(float x) { return x > 20.0f ? x : 0.6931471805599453f * __builtin_amdgcn_logf(1.0f + __builtin_amdgcn_exp2f(x * LOG2E)); }
DI float ex2(float x) { return __builtin_amdgcn_exp2f(x); }
DI f32x4 MFMA16(bf16x8 a, bf16x8 b, f32x4 c) { return __builtin_amdgcn_mfma_f32_16x16x32_bf16(a, b, c, 0, 0, 0); }
typedef int i32x8 __attribute__((ext_vector_type(8)));
typedef unsigned u32x8 __attribute__((ext_vector_type(8)));
DI f32x4 mfma_fp8(u32x8 a, u32x8 b, f32x4 c) {
    return __builtin_amdgcn_mfma_scale_f32_16x16x128_f8f6f4(__builtin_bit_cast(i32x8, a), __builtin_bit_cast(i32x8, b), c, 0, 0, 0, 0x7F7F7F7F, 0, 0x7F7F7F7F); }
DI bf16x8 frag_lo(u32x8 v) { const u32x4 h = __builtin_shufflevector(v, v, 0, 1, 2, 3); return __builtin_bit_cast(bf16x8, h); }
DI bf16x8 frag_hi(u32x8 v) { const u32x4 h = __builtin_shufflevector(v, v, 4, 5, 6, 7); return __builtin_bit_cast(bf16x8, h); }
#ifdef EMU
#define WAIT_V(n)
#define STAGGER_SLEEP(flag)
#define WAIT_L(n)
#else
#define WAIT_V(n) asm volatile("s_waitcnt vmcnt(" #n ")" ::: "memory")
#ifndef STAG_N
#define STAG_N 6
#endif
#define STAG_STR2(x) #x
#define STAG_STR(x) STAG_STR2(x)
#define STAGGER_SLEEP(flag) asm volatile("s_cmp_eq_u32 %0, 0\n\ts_cbranch_scc1 .Lstg%=\n\ts_sleep " STAG_STR(STAG_N) "\n.Lstg%=:" :: "s"(flag) : "memory", "scc")
#define WAIT_L(n) asm volatile("s_waitcnt lgkmcnt(" #n ")" ::: "memory")
#endif
#define BAR __builtin_amdgcn_s_barrier()
#define SCHED __builtin_amdgcn_sched_barrier(0)

#ifdef EMU
#define LDS_BARRIER() __syncthreads()
#else
#define LDS_BARRIER() do { asm volatile("s_waitcnt lgkmcnt(0)" ::: "memory"); __builtin_amdgcn_s_barrier(); asm volatile("" ::: "memory"); } while (0)
#endif
#ifdef EMU
DI float grp_max(float x) { x = fmaxf(x, __shfl_xor(x, 16)); return fmaxf(x, __shfl_xor(x, 32)); }
DI float grp_sum(float x) { x += __shfl_xor(x, 16); return x + __shfl_xor(x, 32); }
DI int grp_imax(int x) { int y = __shfl_xor(x, 16); x = x > y ? x : y; y = __shfl_xor(x, 32); return x > y ? x : y; }
DI s16x4 lds_tr16(const bf16_t* p) { return emu_lds_tr16(p); }
#else
DI float grp_max(float x) {
    auto a = __builtin_amdgcn_permlane16_swap(__float_as_uint(x), __float_as_uint(x), false, false); x = fmaxf(__uint_as_float(a[0]), __uint_as_float(a[1]));
    auto b = __builtin_amdgcn_permlane32_swap(__float_as_uint(x), __float_as_uint(x), false, false); return fmaxf(__uint_as_float(b[0]), __uint_as_float(b[1])); }
DI float grp_sum(float x) {
    auto a = __builtin_amdgcn_permlane16_swap(__float_as_uint(x), __float_as_uint(x), false, false); x = __uint_as_float(a[0]) + __uint_as_float(a[1]);
    auto b = __builtin_amdgcn_permlane32_swap(__float_as_uint(x), __float_as_uint(x), false, false); return __uint_as_float(b[0]) + __uint_as_float(b[1]); }
DI int grp_imax(int x) {
    auto a = __builtin_amdgcn_permlane16_swap((unsigned)x, (unsigned)x, false, false); x = max((int)a[0], (int)a[1]);
    auto b = __builtin_amdgcn_permlane32_swap((unsigned)x, (unsigned)x, false, false); return max((int)b[0], (int)b[1]); }
typedef short v4i16_t_ __attribute__((ext_vector_type(4)));
DI s16x4 lds_tr16(const bf16_t* p) { return __builtin_bit_cast(s16x4, __builtin_amdgcn_ds_read_tr16_b64_v4i16((__attribute__((address_space(3))) v4i16_t_*)p)); }
#endif
#ifdef EMU
struct XcdBarrier { unsigned* bar; };
DI XcdBarrier xcd_barrier_post(unsigned* bar, void*) { XcdBarrier b; b.bar = bar; return b; }
DI void xcd_barrier(const XcdBarrier& b) {
    __syncthreads();
    if (threadIdx.x == 0) { unsigned g = __atomic_load_n(&b.bar[64], __ATOMIC_SEQ_CST);
        if (__atomic_fetch_add(&b.bar[0], 1u, __ATOMIC_SEQ_CST) == gridDim.x - 1) { __atomic_store_n(&b.bar[0], 0u, __ATOMIC_SEQ_CST); __atomic_fetch_add(&b.bar[64], 1u, __ATOMIC_SEQ_CST); }
        else while (__atomic_load_n(&b.bar[64], __ATOMIC_SEQ_CST) == g) sched_yield(); }
    __syncthreads();
}
#define XCD_BAR_WORDS 3456
#else
#define XB_TMO      128
#define XB_XCNT(j)  (256  + 64 * (j))
#define XB_XSUB(j)  (1280 + 64 * (j))
#define XB_XGEN(j)  (2304 + 64 * (j))
#define XB_TOP      3328
#define XB_TOPGEN   3392
#define XCD_BAR_WORDS 3456
#define XB_SPIN_CAP (1u << 22)
#define LAS __attribute__((address_space(3)))
DI unsigned xb_ld(unsigned* p)              { return __hip_atomic_load(p, __ATOMIC_RELAXED, __HIP_MEMORY_SCOPE_AGENT); }
DI unsigned xb_add(unsigned* p, unsigned v) { return __hip_atomic_fetch_add(p, v, __ATOMIC_RELAXED, __HIP_MEMORY_SCOPE_AGENT); }
DI unsigned xb_xcc_id() { return (unsigned)__builtin_amdgcn_s_getreg((3 << 11) | 20) & 0xFu; }
#define XB_SPIN(cond, bar) do { unsigned _sp = 0; while (cond) { __builtin_amdgcn_s_sleep(1); \
    if ((++_sp & 255u) == 0u) { if (xb_ld(&(bar)[XB_TMO])) break; if (_sp > XB_SPIN_CAP) { atomicAdd(&(bar)[XB_TMO], 1u); break; } } } } while (0)
struct XcdBarrier { unsigned* bar; unsigned x; volatile LAS unsigned* st; };
DI XcdBarrier xcd_barrier_post(unsigned* bar, volatile LAS unsigned* st) {
    XcdBarrier b; b.bar = bar; b.x = xb_xcc_id(); b.st = st;
    if (threadIdx.x == 0) (void)xb_add(&bar[XB_XCNT(b.x)], 1u);
    return b;
}
DI void xcd_barrier_complete(unsigned* bar, unsigned x, unsigned& nloc, unsigned& nx) {
    const unsigned G = gridDim.x * gridDim.y * gridDim.z;
    unsigned sum, cnt, mine, sp = 0u;
    for (;;) {
        sum = 0u; cnt = 0u; mine = 0u;
#pragma unroll
        for (unsigned j = 0; j < 16; ++j) { const unsigned c = xb_ld(&bar[XB_XCNT(j)]); sum += c; cnt += (c > 0u) ? 1u : 0u; mine = (j == x) ? c : mine; }
        if (sum == G) break;
        __builtin_amdgcn_s_sleep(1);
        if ((++sp & 255u) == 0u) { if (xb_ld(&bar[XB_TMO])) break; if (sp > XB_SPIN_CAP) { atomicAdd(&bar[XB_TMO], 1u); break; } }
    }
    nloc = mine > 0u ? mine : 1u; nx = cnt > 0u ? cnt : 1u;
}
DI void xcd_barrier(const XcdBarrier& b) {
    asm volatile("s_waitcnt vmcnt(0)" ::: "memory");
    __syncthreads();
    if (threadIdx.x == 0) {
        unsigned* bar = b.bar;
        __builtin_amdgcn_s_waitcnt(0);
        unsigned nloc = b.st[0], nx = b.st[1];
        if (nloc == 0u) { xcd_barrier_complete(bar, b.x, nloc, nx); b.st[0] = nloc; b.st[1] = nx; }
        const unsigned old = xb_add(&bar[XB_XSUB(b.x)], 1u);
        const unsigned gen = old / nloc;
        if (old + 1u == (gen + 1u) * nloc) {
            __builtin_amdgcn_fence(__ATOMIC_RELEASE, "agent");
            asm volatile("s_waitcnt vmcnt(0)" ::: "memory");
            const unsigned og = xb_add(&bar[XB_TOP], 1u);
            const unsigned tg = og / nx;
            if (og + 1u == (tg + 1u) * nx) xb_add(&bar[XB_TOPGEN], 1u);
            else XB_SPIN(xb_ld(&bar[XB_TOPGEN]) == tg, bar);
            __builtin_amdgcn_fence(__ATOMIC_ACQUIRE, "agent");
            xb_add(&bar[XB_XGEN(b.x)], 1u);
            asm volatile("s_waitcnt vmcnt(0)" ::: "memory");
        } else {
            XB_SPIN(xb_ld(&bar[XB_XGEN(b.x)]) == gen, bar);
            __builtin_amdgcn_fence(__ATOMIC_ACQUIRE, "agent");
            asm volatile("s_waitcnt vmcnt(0)" ::: "memory");
        }
    }
    __syncthreads();
}
#endif

struct WS {
    unsigned* bar; float* mod; float* tab; bf16_t* win; bf16_t* wout; unsigned char* wgu; unsigned char* wdn; float* h; bf16_t* u; unsigned char* u8; float* gab; bf16_t* mix; float* aff;
    int* idx; float* wgt; int* inv; bf16_t* p; unsigned char* hid; unsigned char* xin; bf16_t* rkv; bf16_t* rs; bf16_t* gw; bf16_t* gqg; bf16_t* gqk; bf16_t* gkt; bf16_t* gub; float* gcd; bf16_t* og; bf16_t* mixo; unsigned char* y;
};
DI WS ws_of(char* w) {
    WS s; s.bar = (unsigned*)(w + OFF_BAR); s.mod = (float*)(w + OFF_MOD); s.tab = (float*)(w + OFF_TAB); s.win = (bf16_t*)(w + OFF_WIN); s.wout = (bf16_t*)(w + OFF_WOUT);
    s.wgu = (unsigned char*)(w + OFF_WGU); s.wdn = (unsigned char*)(w + OFF_WDN); s.u8 = (unsigned char*)(w + OFF_U8); s.h = (float*)(w + OFF_H); s.u = (bf16_t*)(w + OFF_U); s.gab = (float*)(w + OFF_GAB); s.mix = (bf16_t*)(w + OFF_MIX);
    s.aff = (float*)(w + OFF_AFF); s.idx = (int*)(w + OFF_IDX); s.wgt = (float*)(w + OFF_WGT); s.inv = (int*)(w + OFF_INV); s.p = (bf16_t*)(w + OFF_ARA); s.hid = (unsigned char*)(w + OFF_ARA); s.xin = (unsigned char*)(w + OFF_ARA + SZ_HID8);
    char* b = w + OFF_ARB; s.rkv = (bf16_t*)(b + OB_RKV); s.rs = (bf16_t*)(b + OB_RS); s.gw = (bf16_t*)(b + OB_GW); s.gqg = (bf16_t*)(b + OB_GQG); s.gqk = (bf16_t*)(b + OB_GQK);
    s.gkt = (bf16_t*)(b + OB_GKT); s.gub = (bf16_t*)(b + OB_GUB); s.gcd = (float*)(b + OB_GCD); s.og = (bf16_t*)(b + OB_OG); s.mixo = (bf16_t*)b; s.y = (unsigned char*)b;
    return s;
}

struct CvtJob { const float* src; char* dst; int src_ld, dst_ld  , mode  ; float scale; };
DI CvtJob cvt_job(const Params& p, const WS& w, int u) {
    constexpr int FT = FF / 128, n_in = 8 * 52, n_out = 8 * 16, n_g = 16 * 8 * (FF / 64), n_d = 16 * FT * 16, tot_l = n_in + n_out + 2 * n_g + n_d;
    const int l = u / tot_l; int r = u % tot_l; CvtJob j; j.scale = 1.0f;
    if (r < n_in) { const int kt = r & 7, ct = r >> 3, c0 = ct < 44 ? ct * 64 : 2832 + (ct - 44) * 64;
        j.src = p.w_in + (size_t)l * 1024 * INW + (size_t)(kt * 128) * INW + c0; j.src_ld = INW; j.dst = (char*)(w.win + (size_t)l * PW * 1024 + (size_t)(ct < 44 ? c0 : c0 - 16) * 1024 + kt * 128); j.dst_ld = 2048;
        j.mode = (ct < 8 || (ct >= 44 && ct < 50)) ? 1 : ((ct >= 16 && ct < 24) ? 3 : 0);
    } else if (r < n_in + n_out) { r -= n_in; const int kt = r & 7, ct = r >> 3;
        j.src = p.w_out + (size_t)l * 1024 * 1024 + (size_t)(kt * 128) * 1024 + ct * 64; j.src_ld = 1024; j.dst = (char*)(w.wout + (size_t)l * 1024 * 1024 + (size_t)(ct * 64) * 1024 + kt * 128); j.dst_ld = 2048; j.mode = 0;
    } else if (r < n_in + n_out + 2 * n_g) { r -= n_in + n_out; const int which = r / n_g, rr = r % n_g, e = rr / (8 * (FF / 64)), r2 = rr % (8 * (FF / 64)), kt = r2 & 7, ct = r2 >> 3, c0 = ct * 64;
        j.src = (which ? p.w_up : p.w_gate) + (size_t)(l * 16 + e) * 1024 * FF + (size_t)(kt * 128) * FF + c0; j.src_ld = FF;
        j.dst = (char*)(w.wgu + (size_t)(l * 16 + e) * 2 * FF * 1024 + (size_t)((c0 >> 7) * 256 + which * 128 + (c0 & 127)) * 1024 + kt * 128); j.dst_ld = 1024; j.mode = 2; j.scale = SW1;
    } else { r -= n_in + n_out + 2 * n_g; const int e = r / (16 * FT), r2 = r % (16 * FT), kt = r2 % FT, ct = r2 / FT;
        j.src = p.w_down + (size_t)(l * 16 + e) * FF * 1024 + (size_t)(kt * 128) * 1024 + ct * 64; j.src_ld = 1024; j.dst = (char*)(w.wdn + (size_t)(l * 16 + e) * 1024 * FF + (size_t)(ct * 64) * FF + kt * 128); j.dst_ld = FF; j.mode = 2; j.scale = SW2;
    }
    return j;
}
#define CVT_LOAD(j, v) _Pragma("unroll") for (int i = 0; i < 16; ++i) { const int idx = tid + NT * i, kk = idx >> 6, cc = idx & 63; v[i] = NT_LOAD((j).src + (size_t)kk * (j).src_ld + cc); }
constexpr int CVT_TOT_L = 8 * 52 + 8 * 16 + 2 * 16 * 8 * (FF / 64) + 16 * (FF / 128) * 16;
#ifndef CVT_PER_B
#define CVT_PER_B 16
#endif
#ifndef CVT_PER_D
#define CVT_PER_D 16
#endif
#ifndef CVT_PER_A
#define CVT_PER_A 16
#endif
#ifndef CVT_PER_T
#define CVT_PER_T 0
#endif
constexpr int cvt_share(int pct, int n) { return (CVT_TOT_L * pct / 100) < n ? (CVT_TOT_L * pct / 100) : n; }
constexpr int CVT_TAIL_B = cvt_share(30, 224 * CVT_PER_B), CVT_TAIL_D = cvt_share(25, 192 * CVT_PER_D), CVT_TAIL_A = cvt_share(3, 24 * CVT_PER_A), CVT_TAIL_T = cvt_share(12, 128 * CVT_PER_T);
constexpr int CVT_AHEAD = CVT_TAIL_B + CVT_TAIL_D + CVT_TAIL_A + CVT_TAIL_T, CVT_P0 = DEPTH * (CVT_TOT_L - CVT_AHEAD) + CVT_TAIL_D;
static_assert(CVT_TOT_L - CVT_AHEAD + CVT_TAIL_D >= 8 * 52 + 8 * 16, "a layer's in-proj / out-proj tiles must be converted before its own windows");
template <int KIND> DI int cvt_tile_id(int q, int layer) {
    if (KIND == 0) return q;
    return CVT_P0 + layer * CVT_AHEAD + (KIND == 3 ? 0 : (KIND == 1 ? CVT_TAIL_A : (KIND == 4 ? CVT_TAIL_A + CVT_TAIL_B : CVT_TAIL_A + CVT_TAIL_B + CVT_TAIL_T))) + q;
}
template <int KIND> DI void cvt_stream(const Params& p, const WS& w, char* smem, int layer, int rank, int nranks) {
    float* tile = (float*)smem;
    constexpr int total = KIND == 0 ? CVT_P0 : (KIND == 1 ? CVT_TAIL_B : (KIND == 2 ? CVT_TAIL_D : (KIND == 3 ? CVT_TAIL_A : CVT_TAIL_T)));
    const int tid = tidx(); int q = rank;
    if (q < total) {
        CvtJob j = cvt_job(p, w, cvt_tile_id<KIND>(q, layer)); float v[16];
        CVT_LOAD(j, v);
        for (;;) {
#pragma unroll
            for (int i = 0; i < 16; ++i) { const int idx = tid + NT * i, kk = idx >> 6, cc = idx & 63; tile[kk * 65 + cc] = v[i] * j.scale; }
            const int qn = q + nranks; CvtJob jn = j;
            if (qn < total) { jn = cvt_job(p, w, cvt_tile_id<KIND>(qn, layer)); CVT_LOAD(jn, v); }
            LDS_BARRIER();
            if (j.mode == 2) {
#pragma unroll
                for (int i = 0; i < 4; ++i) { const int idx = tid + NT * i, cc = idx >> 5, kq = idx & 31;
                    *(unsigned*)(j.dst + (size_t)cc * j.dst_ld + 4 * kq) = pk4_fp8(tile[(4 * kq) * 65 + cc], tile[(4 * kq + 1) * 65 + cc], tile[(4 * kq + 2) * 65 + cc], tile[(4 * kq + 3) * 65 + cc]); }
            } else {
#pragma unroll
                for (int i = 0; i < 8; ++i) { const int idx = tid + NT * i, cc = idx >> 6, kp = idx & 63;
                    const int pc = j.mode == 1 ? 32 * ((cc >> 4) & 1) + 8 * ((cc >> 2) & 3) + 4 * (cc >> 5) + (cc & 3) : (j.mode == 3 ? 32 * (cc >> 5) + 8 * ((cc >> 2) & 3) + 4 * ((cc >> 4) & 1) + (cc & 3) : cc);
                    *(unsigned*)(j.dst + (size_t)pc * j.dst_ld + 4 * kp) = pk2(tile[(2 * kp) * 65 + cc], tile[(2 * kp + 1) * 65 + cc]); }
            }
            LDS_BARRIER();
            if (qn >= total) break;
            q = qn; j = jn;
        }
    }
    __syncthreads();
}
DI void phase_cvt(const Params& p, char* smem) {
    const WS w = ws_of(p.ws);
    cvt_stream<0>(p, w, smem, 0, bidx(), gridDim.x);
    for (int i = bidx() * NT + tidx(); i < SEQ * 80; i += gridDim.x * NT) {
        const int n = i / 80, a = i % 80, row = n / 64, col = n % 64; float ang;
        if (a < 32) ang = (float)n * (1.0f / powf(10000.0f, (float)a / 31.0f));
        else if (a < 48) { const int ii = a - 32; ang = (float)(ii < 8 ? row : col) * powf(10000.0f, -(float)(ii & 7) / 8.0f); }
        else { const int ii = a - 48; ang = (float)(ii < 16 ? row : col) * powf(10000.0f, -(float)(ii & 15) / 16.0f); }
        w.tab[2 * i] = cosf(ang); w.tab[2 * i + 1] = sinf(ang);
    }
    float* cond = (float*)smem; float* red = cond + (NB + 1) * 1024;
    __syncthreads();
    for (int i = tidx(); i < (NB + 1) * 1024; i += NT) { const int r = i >> 10, k = i & 1023; const float v = r < NB ? p.c[r * 1024 + k] : p.c_ctx[k]; cond[i] = siluf(v); }
    __syncthreads();
    for (int u = bidx(); u < DEPTH * 96; u += gridDim.x) {
        const int l = u / 96, cg = u % 96, col = tidx() & 63, kg = tidx() >> 6;
        float acc[NB + 1];
#pragma unroll
        for (int r = 0; r <= NB; ++r) acc[r] = 0.f;
        const float* wp = p.ada_w + ((size_t)l * 1024 + kg * 128) * 6144 + cg * 64 + col;
        for (int k = 0; k < 128; ++k) { const float wv = wp[(size_t)k * 6144];
#pragma unroll
            for (int r = 0; r <= NB; ++r) acc[r] += cond[r * 1024 + kg * 128 + k] * wv; }
#pragma unroll
        for (int r = 0; r <= NB; ++r) red[(kg * (NB + 1) + r) * 64 + col] = acc[r];
        __syncthreads();
        for (int i = tidx(); i < (NB + 1) * 64; i += NT) { const int r = i >> 6, cc = i & 63; float s = p.ada_b[l * 6144 + cg * 64 + cc];
#pragma unroll
            for (int g = 0; g < 8; ++g) s += red[(g * (NB + 1) + r) * 64 + cc];
            w.mod[((size_t)l * (NB + 1) + r) * 6144 + cg * 64 + cc] = s; }
        __syncthreads();
    }
}

template <int MODE> DI void phase_rows(const Params& p, int layer, char* smem) {
    const WS w = ws_of(p.ws); float* Wl = (float*)smem;
    const int tid = tidx(), lane = tid & 63, wv = tid >> 6;
    const bool last = (layer == DEPTH - 1);
    __syncthreads();
    if (MODE == 0 || (MODE == 2 && !last)) { const int l2 = MODE == 0 ? 0 : layer + 1;
        for (int i = tid; i < 16 * 1024; i += NT) { const int o = i & 15, k = i >> 4; Wl[o * 1024 + k] = p.w_in[((size_t)l2 * 1024 + k) * INW + 2816 + o]; } }
    if (MODE == 1) for (int i = tid; i < 16 * 1024; i += NT) { const int o = i & 15, k = i >> 4; Wl[o * 1024 + k] = p.router_w[((size_t)layer * 1024 + k) * 16 + o]; }
    __syncthreads();
    const int nrows = (MODE != 0 && last) ? RL : R;
    const int nwaves = gridDim.x * 8, chunk = (nrows + nwaves - 1) / nwaves, row_beg = (bidx() * 8 + wv) * chunk, row_end = row_beg + chunk < nrows ? row_beg + chunk : nrows;
    if (row_beg >= row_end) return;
    f32x4 lg4[4], lb4[4], mg4[4], m04[4], m14[4];
    if (MODE != 0) { const float* lg = p.ln_g + ((size_t)layer * 2 + (MODE == 1 ? 0 : 1)) * 1024; const float* lb = p.ln_b + ((size_t)layer * 2 + (MODE == 1 ? 0 : 1)) * 1024;
#pragma unroll
        for (int j = 0; j < 4; ++j) { lg4[j] = *(const f32x4*)(lg + 256 * j + 4 * lane); lb4[j] = *(const f32x4*)(lb + 256 * j + 4 * lane); } }
    int bcur = -1;
    const int lm = MODE == 2 ? layer + 1 : (MODE == 0 ? 0 : layer);
    const bool write_u = !(MODE == 2 && last);
    auto batch_of = [&](int r) { return r >= RL ? NB : r / SEQ; };
    unsigned short* h_hi = (unsigned short*)w.h; unsigned char* h_lo = (unsigned char*)w.h + (size_t)R * 2048;
    f32x4 hn[2][4]; u32x2 hh[2][4]; unsigned hl[2][4]; u32x2 bn[2][4]; int invn[2] = {-1, -1};
#define ROW_FETCH(Q, ROW) do { const int r_ = (ROW); const bool isc_ = r_ >= RL; \
        const float* src_ = MODE == 0 ? (isc_ ? p.ctx + (size_t)(r_ - RL) * 1024 : p.x + (size_t)r_ * 1024) : w.h + (size_t)r_ * 1024; \
        if (MODE == 0) { _Pragma("unroll") for (int j = 0; j < 4; ++j) hn[Q][j] = NT_LOAD((const f32x4*)(src_ + 256 * j + 4 * lane)); } \
        else { _Pragma("unroll") for (int j = 0; j < 4; ++j) { hh[Q][j] = NT_LOAD((const u32x2*)(h_hi + (size_t)r_ * 1024 + 256 * j + 4 * lane)); hl[Q][j] = NT_LOAD((const unsigned*)(h_lo + (size_t)r_ * 1024 + 256 * j + 4 * lane)); } } \
        if (MODE == 1) { _Pragma("unroll") for (int j = 0; j < 4; ++j) bn[Q][j] = NT_LOAD((const u32x2*)(w.mixo + (size_t)r_ * 1024 + 256 * j + 4 * lane)); } \
        if (MODE == 2) invn[Q] = lane < 16 ? w.inv[(size_t)r_ * 16 + lane] : -1; } while (0)
    int row = row_beg, nr = (row + 1 < row_end && batch_of(row + 1) == batch_of(row)) ? 2 : 1;
    ROW_FETCH(0, row); ROW_FETCH(1, nr == 2 ? row + 1 : row);
    while (row < row_end) {
        const bool isc = row >= RL; const int b = isc ? NB : row / SEQ;
        if (b != bcur) { bcur = b;
            if (MODE != 0) { const float* mg = w.mod + ((size_t)layer * (NB + 1) + b) * 6144 + (MODE == 1 ? 2 : 5) * 1024;
#pragma unroll
                for (int j = 0; j < 4; ++j) mg4[j] = *(const f32x4*)(mg + 256 * j + 4 * lane); }
            if (write_u) { const float* m0 = w.mod + ((size_t)lm * (NB + 1) + b) * 6144 + (MODE == 1 ? 3 : 0) * 1024;
#pragma unroll
                for (int j = 0; j < 4; ++j) { m04[j] = *(const f32x4*)(m0 + 256 * j + 4 * lane); m14[j] = *(const f32x4*)(m0 + 1024 + 256 * j + 4 * lane); } } }
        f32x4 hv[2][4]; u32x2 bc[2][4]; int myinv[2];
#pragma unroll
        for (int q = 0; q < 2; ++q) { myinv[q] = invn[q];
#pragma unroll
            for (int j = 0; j < 4; ++j) { bc[q][j] = bn[q][j];
                if (MODE == 0) hv[q][j] = hn[q][j];
                else { const u32x2 a_ = hh[q][j]; const unsigned b_ = hl[q][j];
                    hv[q][j] = (f32x4){__uint_as_float((a_[0] << 16) | ((b_ & 0xffu) << 8)), __uint_as_float((a_[0] & 0xffff0000u) | (b_ & 0xff00u)),
                                       __uint_as_float((a_[1] << 16) | ((b_ >> 8) & 0xff00u)), __uint_as_float((a_[1] & 0xffff0000u) | ((b_ >> 16) & 0xff00u))}; } } }
        const int row_cur = row, nr_cur = nr;
        row += nr;
        if (row < row_end) { nr = (row + 1 < row_end && batch_of(row + 1) == batch_of(row)) ? 2 : 1; ROW_FETCH(0, row); ROW_FETCH(1, nr == 2 ? row + 1 : row); }
        f32x4 uv[2][4];
#pragma unroll
        for (int q = 0; q < 2; ++q) {
            const int rw_ = row_cur + (q < nr_cur ? q : 0);
            if (MODE != 0) {
                f32x4 br[4];
                if (MODE == 1) {
#pragma unroll
                    for (int j = 0; j < 4; ++j) br[j] = (f32x4){__uint_as_float(bc[q][j][0] << 16), __uint_as_float(bc[q][j][0] & 0xffff0000u), __uint_as_float(bc[q][j][1] << 16), __uint_as_float(bc[q][j][1] & 0xffff0000u)};
                } else {
#pragma unroll
                    for (int j = 0; j < 4; ++j) br[j] = (f32x4){0.f, 0.f, 0.f, 0.f};
                    for (int e = 0; e < 16; ++e) { const int sl = lane_bcast(myinv[q], e);
                        if (sl >= 0) { const unsigned char* yr = w.y + ((size_t)e * ROWS_E + sl) * 1024;
#pragma unroll
                            for (int j = 0; j < 4; ++j) { const int v = (int)NT_LOAD((const unsigned*)(yr + 256 * j + 4 * lane));
                                const auto lo_ = __builtin_amdgcn_cvt_pk_f32_fp8(v, false), hi_ = __builtin_amdgcn_cvt_pk_f32_fp8(v, true);
                                br[j][0] += lo_[0]; br[j][1] += lo_[1]; br[j][2] += hi_[0]; br[j][3] += hi_[1]; } } }
#pragma unroll
                    for (int j = 0; j < 4; ++j) br[j] = br[j] * (1.0f / SY);
                }
                float sm_ = 0.f;
#pragma unroll
                for (int j = 0; j < 4; ++j) { hv[q][j] = ALPHA * hv[q][j] + mg4[j] * br[j]; sm_ += hv[q][j][0] + hv[q][j][1] + hv[q][j][2] + hv[q][j][3]; }
                const float mean = wsum(sm_) * (1.0f / 1024.0f); float qq = 0.f;
#pragma unroll
                for (int j = 0; j < 4; ++j) { hv[q][j] = hv[q][j] - mean; qq += hv[q][j][0] * hv[q][j][0] + hv[q][j][1] * hv[q][j][1] + hv[q][j][2] * hv[q][j][2] + hv[q][j][3] * hv[q][j][3]; }
                const float rstd = 1.0f / sqrtf(wsum(qq) * (1.0f / 1024.0f) + 1e-5f);
#pragma unroll
                for (int j = 0; j < 4; ++j) hv[q][j] = hv[q][j] * rstd * lg4[j] + lb4[j];
            }
            if (q < nr_cur) {
                if (MODE == 2 && last) {
#pragma unroll
                    for (int j = 0; j < 4; ++j) *(f32x4*)(p.out + (size_t)rw_ * 1024 + 256 * j + 4 * lane) = hv[q][j];
                } else {
#pragma unroll
                    for (int j = 0; j < 4; ++j) { const unsigned u0 = __float_as_uint(hv[q][j][0]) + 0x80u, u1 = __float_as_uint(hv[q][j][1]) + 0x80u, u2 = __float_as_uint(hv[q][j][2]) + 0x80u, u3 = __float_as_uint(hv[q][j][3]) + 0x80u;
                        u32x2 a_; a_[0] = (u0 >> 16) | (u1 & 0xffff0000u); a_[1] = (u2 >> 16) | (u3 & 0xffff0000u);
                        const unsigned b_ = ((u0 >> 8) & 0xffu) | (u1 & 0xff00u) | ((u2 << 8) & 0xff0000u) | ((u3 << 16) & 0xff000000u);
                        NT_STORE(a_, (u32x2*)(h_hi + (size_t)rw_ * 1024 + 256 * j + 4 * lane)); NT_STORE(b_, (unsigned*)(h_lo + (size_t)rw_ * 1024 + 256 * j + 4 * lane)); }
                }
            }
#pragma unroll
            for (int j = 0; j < 4; ++j) { uv[q][j] = hv[q][j] * (1.0f + m14[j]) + m04[j];
                if (write_u && q < nr_cur) { if (MODE == 1) *(unsigned*)(w.u8 + (size_t)rw_ * 1024 + 256 * j + 4 * lane) = pk4_fp8(uv[q][j][0], uv[q][j][1], uv[q][j][2], uv[q][j][3]);
                    else { u32x2 o; o[0] = pk2(uv[q][j][0], uv[q][j][1]); o[1] = pk2(uv[q][j][2], uv[q][j][3]); *(u32x2*)(w.u + (size_t)rw_ * 1024 + 256 * j + 4 * lane) = o; } } }
        }
        if (!write_u) continue;
        float lgt[2][16];
#pragma unroll
        for (int o = 0; o < 16; ++o) { float a0 = 0.f, a1 = 0.f;
#pragma unroll
            for (int j = 0; j < 4; ++j) { const f32x4 wv4 = *(const f32x4*)(Wl + o * 1024 + 256 * j + 4 * lane);
                a0 += uv[0][j][0] * wv4[0] + uv[0][j][1] * wv4[1] + uv[0][j][2] * wv4[2] + uv[0][j][3] * wv4[3]; a1 += uv[1][j][0] * wv4[0] + uv[1][j][1] * wv4[1] + uv[1][j][2] * wv4[2] + uv[1][j][3] * wv4[3]; }
            lgt[0][o] = wsum(a0); lgt[1][o] = wsum(a1); SCHED; }
#pragma unroll
        for (int q = 0; q < 2; ++q) {
            if (q >= nr_cur) continue;
            const int rw_ = row_cur + q; float mine = 0.f;
            if (MODE == 1) { float mx = lgt[q][0];
#pragma unroll
                for (int o = 1; o < 16; ++o) mx = fmaxf(mx, lgt[q][o]);
                float sm = 0.f;
#pragma unroll
                for (int o = 0; o < 16; ++o) { lgt[q][o] = __expf(lgt[q][o] - mx); sm += lgt[q][o]; }
                const float inv = 1.0f / sm;
#pragma unroll
                for (int o = 0; o < 16; ++o) if (lane == o) mine = lgt[q][o] * inv;
                if (lane < 16) { if (rw_ < RL) { const int bb = rw_ / SEQ, n = rw_ % SEQ; w.aff[((size_t)bb * 16 + lane) * SEQ + n] = mine; }
                                 else { const int rr = rw_ - RL, bb = rr / CTX, n = rr % CTX; w.aff[(size_t)RL * 16 + ((size_t)bb * 16 + lane) * CTX + n] = mine; } }
            } else {
#pragma unroll
                for (int o = 0; o < 16; ++o) if (lane == o) mine = lgt[q][o];
                if (lane < 16) w.gab[(size_t)rw_ * 16 + lane] = mine;
            }
        }
    }
#undef ROW_FETCH
}

constexpr int G_HT = 128 * 64;
DI int lds_byte(int r, int c) { const int st = (r >> 4) * 2 + (c >> 5), rr = r & 15, cc = c & 31, ob = rr * 64 + cc * 2; return st * 1024 + (ob ^ (((ob >> 9) & 1) << 5)); }
DI void stage_rc(int b, int& Rr, int& Cc) { const int st = b / 1024, sb = b % 1024, swz = sb ^ (((sb >> 9) & 1) << 5); Rr = (st >> 1) * 16 + swz / 64; Cc = (st & 1) * 32 + (swz % 64) / 2; }
#define GLDS16(g, l) __builtin_amdgcn_global_load_lds((const unsigned*)(g), (unsigned*)(l), 16, 0, 0)

struct EpiArgs { void* out; int ld; long orow0; const float* wgt; const float* tab; int kind0, kind1; float sc0, sc1; };
template <int EPI, bool GATHER>
DI void gemm_unit(const bf16_t* __restrict__ A, const bf16_t* __restrict__ Bt, const int K, const int brow, const int bcol, const int* __restrict__ gidx, const EpiArgs ea, char* smem) {
    bf16_t* shm = (bf16_t*)smem;
#define SA(b, h) (shm + ((b) * 2 + (h)) * G_HT)
#define SB(b, h) (shm + (4 + (b) * 2 + (h)) * G_HT)
#define STAGE_B(T, P, h, kt) do { _Pragma("unroll") for (int _i = 0; _i < 2; ++_i) { const int _b = (T) * 16 + _i * 8192; int _r, _c; stage_rc(_b, _r, _c); \
        GLDS16(Bt + (unsigned)((bcol + (h) * 128 + _r) * K + (kt) * 64 + _c), (char*)(P) + _b); } } while (0)
#define STAGE_A(T, P, h, kt) do { _Pragma("unroll") for (int _i = 0; _i < 2; ++_i) { const int _b = (T) * 16 + _i * 8192; int _r, _c; stage_rc(_b, _r, _c); \
        const int _ro = GATHER ? rid[h][_i] : (brow + (h) * 128 + _r); GLDS16(A + (unsigned)(_ro * K + (kt) * 64 + _c), (char*)(P) + _b); } } while (0)
#define LDA(dst, b, h) _Pragma("unroll") for (int m = 0; m < 4; ++m) _Pragma("unroll") for (int k = 0; k < 2; ++k) \
        dst[m][k] = *reinterpret_cast<const bf16x8*>((char*)SA(b, h) + lds_byte(wr * 64 + m * 16 + fr, k * 32 + fq * 8))
#define LDB(dst, b, h) _Pragma("unroll") for (int n = 0; n < 2; ++n) _Pragma("unroll") for (int k = 0; k < 2; ++k) \
        dst[n][k] = *reinterpret_cast<const bf16x8*>((char*)SB(b, h) + lds_byte(wc * 32 + n * 16 + fr, k * 32 + fq * 8))
#define MMA(ai, bj, At_, Bt_) do { __builtin_amdgcn_s_setprio(1); \
        _Pragma("unroll") for (int m = 0; m < 4; ++m) _Pragma("unroll") for (int n = 0; n < 2; ++n) _Pragma("unroll") for (int k = 0; k < 2; ++k) \
            acc[ai][bj][m][n] = MFMA16(Bt_[n][k], At_[m][k], acc[ai][bj][m][n]); \
        __builtin_amdgcn_s_setprio(0); } while (0)
    int tid = tidx();
#ifndef EMU
    asm volatile("" : "+v"(tid));
#endif
    int wid = tid >> 6, lane = tid & 63, wr = wid >> 2, wc = wid & 3, fr = lane & 15, fq = lane >> 4;
    int rid[2][2];
    if (GATHER) {
#pragma unroll
        for (int h = 0; h < 2; ++h)
#pragma unroll
            for (int i = 0; i < 2; ++i) { int r_, c_; stage_rc(tid * 16 + i * 8192, r_, c_); rid[h][i] = gidx[h * 128 + r_]; }
    }
    f32x4 acc[2][2][4][2];
#pragma unroll
    for (int a = 0; a < 2; ++a)
#pragma unroll
        for (int b = 0; b < 2; ++b)
#pragma unroll
            for (int m = 0; m < 4; ++m)
#pragma unroll
                for (int n = 0; n < 2; ++n) acc[a][b][m][n] = (f32x4){0.f, 0.f, 0.f, 0.f};
    bf16x8 At[4][2], B0[2][2], B1[2][2];
    const int nt = K / 64;
    STAGE_B(tid, SB(0, 0), 0, 0); STAGE_A(tid, SA(0, 0), 0, 0);
    STAGE_B(tid, SB(0, 1), 1, 0); STAGE_A(tid, SA(0, 1), 1, 0);
    if (wr == 1) BAR;
    WAIT_V(4); BAR;
    STAGE_B(tid, SB(1, 0), 0, 1); STAGE_A(tid, SA(1, 0), 0, 1); STAGE_B(tid, SB(1, 1), 1, 1);
    WAIT_V(6); BAR;
    for (int t = 0; t < nt - 2; t += 2) {
        LDB(B0, 0, 0); SCHED; LDA(At, 0, 0); STAGE_A(tid, SA(1, 1), 1, t + 1);
        WAIT_L(8); BAR; WAIT_L(0); MMA(0, 0, At, B0); BAR; SCHED;
        LDB(B1, 0, 1); STAGE_B(tid, SB(0, 0), 0, t + 2);
        BAR; WAIT_L(0); MMA(0, 1, At, B1); BAR;
        LDA(At, 0, 1); STAGE_A(tid, SA(0, 0), 0, t + 2);
        BAR; WAIT_L(0); MMA(1, 0, At, B0); BAR; SCHED;
        STAGE_B(tid, SB(0, 1), 1, t + 2);
        WAIT_V(6); BAR; MMA(1, 1, At, B1); BAR;
        LDB(B0, 1, 0); SCHED; LDA(At, 1, 0); STAGE_A(tid, SA(0, 1), 1, t + 2);
        WAIT_L(8); BAR; WAIT_L(0); MMA(0, 0, At, B0); BAR; SCHED;
        LDB(B1, 1, 1); STAGE_B(tid, SB(1, 0), 0, t + 3);
        BAR; WAIT_L(0); MMA(0, 1, At, B1); BAR;
        LDA(At, 1, 1); STAGE_A(tid, SA(1, 0), 0, t + 3);
        BAR; WAIT_L(0); MMA(1, 0, At, B0); BAR; SCHED;
        STAGE_B(tid, SB(1, 1), 1, t + 3);
        WAIT_V(6); BAR; MMA(1, 1, At, B1); BAR;
    }
    int tz = tidx();
#ifndef EMU
    asm volatile("" : "+v"(tz));
#endif
    wid = tz >> 6; lane = tz & 63; wr = wid >> 2; wc = wid & 3; fr = lane & 15; fq = lane >> 4;
    { LDB(B0, 0, 0); WAIT_V(0); LDA(At, 0, 0); STAGE_A(tz, SA(1, 1), 1, nt - 1);
      BAR; WAIT_L(0); MMA(0, 0, At, B0); BAR;
      LDB(B1, 0, 1); BAR; WAIT_L(0); MMA(0, 1, At, B1); BAR;
      LDA(At, 0, 1); WAIT_V(4); BAR; WAIT_L(0); MMA(1, 0, At, B0); MMA(1, 1, At, B1); BAR; }
    { LDB(B0, 1, 0); LDA(At, 1, 0); WAIT_V(2); BAR; WAIT_L(0); MMA(0, 0, At, B0); BAR;
      LDB(B1, 1, 1); WAIT_V(0); BAR; WAIT_L(0); MMA(0, 1, At, B1); BAR;
      LDA(At, 1, 1); BAR; WAIT_L(0); MMA(1, 0, At, B0); MMA(1, 1, At, B1); BAR; }
    if (wr == 0) BAR;
#pragma unroll
    for (int ai = 0; ai < 2; ++ai)
#pragma unroll
        for (int m = 0; m < 4; ++m) {
            const int lrow = ai * 128 + wr * 64 + m * 16 + fr; const long orow = ea.orow0 + lrow;
            float wg = 1.0f; if (EPI == 3) wg = ea.wgt[lrow];
            if (EPI == 4) {
                const bool isc = orow >= RL; const int tokn = isc ? 0 : (int)(orow % SEQ);
#pragma unroll
                for (int bj = 0; bj < 2; ++bj) { const int kind = bj ? ea.kind1 : ea.kind0; const float sc = bj ? ea.sc1 : ea.sc0;
                    f32x4 x1 = acc[ai][bj][m][0], x2 = acc[ai][bj][m][1];
                    if (kind != 0) {
                        f32x4 t0 = (f32x4){1.f, 0.f, 1.f, 0.f}, t1 = t0;
                        if (!isc) { const int a0 = (kind == 1 ? 0 : (kind == 2 ? 32 : 48)) + (kind != 2 ? (wc & 1) * 16 : 0) + fq * 4; const float* tp = ea.tab + ((size_t)tokn * 80 + a0) * 2; t0 = *(const f32x4*)tp; t1 = *(const f32x4*)(tp + 4); }
                        const f32x4 cs = (f32x4){t0[0], t0[2], t1[0], t1[2]} * sc, sn = (f32x4){t0[1], t0[3], t1[1], t1[3]} * sc;
                        const f32x4 y1 = x1 * cs - x2 * sn, y2 = x1 * sn + x2 * cs; x1 = y1; x2 = y2;
                    }
                    const int col = bcol + bj * 128 + wc * 32 + fq * 4; bf16_t* op = (bf16_t*)ea.out + (size_t)orow * ea.ld + col;
                    u32x2 o; o[0] = pk2(x1[0], x1[1]); o[1] = pk2(x1[2], x1[3]); *(u32x2*)op = o; o[0] = pk2(x2[0], x2[1]); o[1] = pk2(x2[2], x2[3]); *(u32x2*)(op + 16) = o; }
                continue;
            }
#pragma unroll
            for (int n = 0; n < 2; ++n) {
                if (EPI == 2) { const f32x4 g = acc[ai][0][m][n], u = acc[ai][1][m][n]; const int col = (bcol >> 1) + wc * 32 + n * 16 + fq * 4;
                    u32x2 o; o[0] = pk2(siluf(g[0]) * u[0], siluf(g[1]) * u[1]); o[1] = pk2(siluf(g[2]) * u[2], siluf(g[3]) * u[3]);
                    *(u32x2*)((bf16_t*)ea.out + (size_t)orow * ea.ld + col) = o;
                } else {
#pragma unroll
                    for (int bj = 0; bj < 2; ++bj) { const f32x4 v = acc[ai][bj][m][n]; const int col = bcol + bj * 128 + wc * 32 + n * 16 + fq * 4;
                        if (EPI == 1) *(f32x4*)((float*)ea.out + (size_t)orow * ea.ld + col) = v;
                        else { u32x2 o; o[0] = pk2(v[0] * wg, v[1] * wg); o[1] = pk2(v[2] * wg, v[3] * wg); *(u32x2*)((bf16_t*)ea.out + (size_t)orow * ea.ld + col) = o; } }
                }
            }
        }
    __syncthreads();
#undef SA
#undef SB
#undef STAGE_A
#undef STAGE_B
#undef LDA
#undef LDB
#undef MMA
}

struct GUnit { const char* B; const int* gidx; const float* wgt; long orow0; int brow, bcol, pn; };
DI bool tile_order(int i, int G, int c, int nM, int nN, int& pm, int& pn) {
    const int nwg = nM * nN; const long L = (long)i * G + c; if (L >= nwg) return false;
    int wgid = (int)L; { const int q = nwg / 8, r = nwg % 8, xcd = wgid % 8, off = wgid / 8; wgid = (xcd < r ? xcd * (q + 1) : r * (q + 1) + (xcd - r) * q) + off; }
    const int nig = 8 * nN, gid = wgid / nig, fm = gid * 8, gsz = (nM - fm) < 8 ? (nM - fm) : 8;
    pm = fm + ((wgid % nig) % gsz); pn = (wgid % nig) / gsz; return true;
}
DI int moe_tiles(int layer) { return layer == DEPTH - 1 ? (NB * CAPL + 255) / 256 : ROWS_E / 256; }
template <int PHK> DI bool gemm_next(const WS& w, int layer, int i, int G, int c, GUnit& u) {
    int pm, pn; u.gidx = nullptr; u.wgt = nullptr;
    if (PHK == 0) { if (!tile_order(i, G, c, R / 256, PW / 256, pm, pn)) return false; u.B = (const char*)(w.win + (size_t)layer * PW * 1024 + (size_t)pn * 256 * 1024); u.brow = pm * 256; u.orow0 = (long)pm * 256; }
    else if (PHK == 1) { if (!tile_order(i, G, c, (layer == DEPTH - 1 ? RL : R) / 256, 4, pm, pn)) return false; u.B = (const char*)(w.wout + (size_t)layer * 1024 * 1024 + (size_t)pn * 256 * 1024); u.brow = pm * 256; u.orow0 = (long)pm * 256; }
    else { const int tm = moe_tiles(layer); constexpr int nN = PHK == 2 ? 2 * FF / 256 : 4;
        if (!tile_order(i, G, c, 16 * tm, nN, pm, pn)) return false;
        constexpr int TM_FULL = ROWS_E / 256, TM_LAST = (NB * CAPL + 255) / 256;
        int e, pme; if (layer == DEPTH - 1) { e = pm / TM_LAST; pme = pm % TM_LAST; } else { e = pm / TM_FULL; pme = pm % TM_FULL; }
        u.orow0 = (long)e * ROWS_E + pme * 256; u.brow = e * ROWS_E + pme * 256;
        if (PHK == 2) { u.B = (const char*)(w.wgu + (size_t)(layer * 16 + e) * 2 * FF * 1024 + (size_t)pn * 256 * 1024); u.gidx = w.idx + (size_t)e * ROWS_E + pme * 256; }
        else { u.B = (const char*)(w.wdn + (size_t)(layer * 16 + e) * 1024 * FF + (size_t)pn * 256 * FF); u.wgt = w.wgt + (size_t)e * ROWS_E + pme * 256; } }
    u.bcol = pn * 256; u.pn = pn; return true;
}
template <int PHK> DI void gemm_stream(const Params& p, int layer, char* smem) {
    constexpr bool GATHER = PHK == 2, FP8 = PHK >= 2;       constexpr int K = PHK == 2 ? 1024 : (PHK == 3 ? FF : 2048)  , nt = K / 128;
    const WS w = ws_of(p.ws); bf16_t* shm = (bf16_t*)smem;
    const char* Abase = PHK == 0 ? (const char*)w.u : (PHK == 1 ? (const char*)w.mix : (PHK == 2 ? (const char*)w.u8 : (const char*)w.hid));
    const int G = gridDim.x, c = bidx();
    int tid = tidx();
    int wid = tid >> 6, lane = tid & 63, wr = wid >> 2, wc = wid & 3, fr = lane & 15, fq = lane >> 4;
    GUnit cur, nxt;
    if (!gemm_next<PHK>(w, layer, 0, G, c, cur)) return;
    unsigned voff[2];
#pragma unroll
    for (int i = 0; i < 2; ++i) { int R_, C_; stage_rc(tid * 16 + i * 8192, R_, C_); voff[i] = (unsigned)(R_ * K + C_ * 2); }
    u32x4 ga = (u32x4){0u, 0u, 0u, 0u};
    unsigned gc2[2];
#pragma unroll
    for (int i = 0; i < 2; ++i) { int R_, C_; stage_rc(tid * 16 + i * 8192, R_, C_); gc2[i] = (unsigned)C_ * 2u; }
#define G_GOFF(dst, U) do { _Pragma("unroll") for (int h_ = 0; h_ < 2; ++h_) _Pragma("unroll") for (int i_ = 0; i_ < 2; ++i_) { int R_, C_; stage_rc(tid * 16 + i_ * 8192, R_, C_); \
        dst[h_ * 2 + i_] = (unsigned)(U).gidx[h_ * 128 + R_]; } } while (0)
    if (GATHER) G_GOFF(ga, cur);
    const int* idbuf = (const int*)(smem + 8 * G_HT * 2 + 1024);
#ifdef EMU
#define UBASE(p)
#else
#define UBASE(p) asm volatile("" : "+s"(p))
#endif
#define SA(b, h) (shm + ((b) * 2 + (h)) * G_HT)
#define SB(b, h) (shm + (4 + (b) * 2 + (h)) * G_HT)
#define STG_A(P, U, GAo, h, koff) do { _Pragma("unroll") for (int _i = 0; _i < 2; ++_i) { \
        const char* ub_ = GATHER ? Abase + (size_t)(koff) : Abase + ((size_t)((U).brow + (h) * 128) * K + (koff)); UBASE(ub_); GLDS16(ub_ + (GATHER ? (GAo)[(h) * 2 + _i] * (unsigned)K + gc2[_i] : voff[_i]), (char*)(P) + tid * 16 + _i * 8192); } } while (0)
#define STG_B(P, BP, h, koff) do { _Pragma("unroll") for (int _i = 0; _i < 2; ++_i) { const char* ub_ = (BP) + ((size_t)(h) * 128 * K + (koff)); UBASE(ub_); GLDS16(ub_ + voff[_i], (char*)(P) + tid * 16 + _i * 8192); } } while (0)
#define LDA(dst, b, h) _Pragma("unroll") for (int m = 0; m < 4; ++m) { \
        const u32x4 lo_ = *reinterpret_cast<const u32x4*>((char*)SA(b, h) + lds_byte(wr * 64 + m * 16 + fr, fq * 8)), hi_ = *reinterpret_cast<const u32x4*>((char*)SA(b, h) + lds_byte(wr * 64 + m * 16 + fr, 32 + fq * 8)); \
        dst[m] = __builtin_shufflevector(lo_, hi_, 0, 1, 2, 3, 4, 5, 6, 7); }
#define LDB_ROW(n) (wc * 32 + 8 * (fr >> 2) + 4 * (n) + (fr & 3))
#define LDB(dst, b, h) _Pragma("unroll") for (int n = 0; n < 2; ++n) { \
        const u32x4 lo_ = *reinterpret_cast<const u32x4*>((char*)SB(b, h) + lds_byte(LDB_ROW(n), fq * 8)), hi_ = *reinterpret_cast<const u32x4*>((char*)SB(b, h) + lds_byte(LDB_ROW(n), 32 + fq * 8)); \
        dst[n] = __builtin_shufflevector(lo_, hi_, 0, 1, 2, 3, 4, 5, 6, 7); }
#define MMA(ai, bj, At_, Bt_) do { __builtin_amdgcn_s_setprio(1); \
        _Pragma("unroll") for (int m = 0; m < 4; ++m) _Pragma("unroll") for (int n = 0; n < 2; ++n) { \
            if (FP8) acc[ai][bj][m][n] = mfma_fp8(Bt_[n], At_[m], acc[ai][bj][m][n]);     \
            else { acc[ai][bj][m][n] = MFMA16(frag_lo(Bt_[n]), frag_lo(At_[m]), acc[ai][bj][m][n]); acc[ai][bj][m][n] = MFMA16(frag_hi(Bt_[n]), frag_hi(At_[m]), acc[ai][bj][m][n]); } } \
        __builtin_amdgcn_s_setprio(0); } while (0)
#define K_TILE_PAIR(UA2, GA2, B2, k1, k2, k3) do { \
            LDB(B0, 0, 0); SCHED; LDA(At, 0, 0); STG_A(SA(1, 1), cur, ga, 1, k1); \
            WAIT_L(8); BAR; WAIT_L(0); MMA(0, 0, At, B0); BAR; SCHED; \
            LDB(B1, 0, 1); STG_B(SB(0, 0), B2, 0, k2); \
            BAR; WAIT_L(0); MMA(0, 1, At, B1); BAR; \
            LDA(At, 0, 1); STG_A(SA(0, 0), UA2, GA2, 0, k2); \
            BAR; WAIT_L(0); MMA(1, 0, At, B0); BAR; SCHED; \
            STG_B(SB(0, 1), B2, 1, k2); \
            WAIT_V(6); BAR; MMA(1, 1, At, B1); BAR; \
            LDB(B0, 1, 0); SCHED; LDA(At, 1, 0); STG_A(SA(0, 1), UA2, GA2, 1, k2); \
            WAIT_L(8); BAR; WAIT_L(0); MMA(0, 0, At, B0); BAR; SCHED; \
            LDB(B1, 1, 1); STG_B(SB(1, 0), B2, 0, k3); \
            BAR; WAIT_L(0); MMA(0, 1, At, B1); BAR; \
            LDA(At, 1, 1); STG_A(SA(1, 0), UA2, GA2, 0, k3); \
            BAR; WAIT_L(0); MMA(1, 0, At, B0); BAR; SCHED; \
            STG_B(SB(1, 1), B2, 1, k3); \
            WAIT_V(6); BAR; MMA(1, 1, At, B1); BAR; } while (0)
    f32x4 acc[2][2][4][2];
#pragma unroll
    for (int a = 0; a < 2; ++a)
#pragma unroll
        for (int b = 0; b < 2; ++b)
#pragma unroll
            for (int m = 0; m < 4; ++m)
#pragma unroll
                for (int n = 0; n < 2; ++n) acc[a][b][m][n] = (f32x4){0.f, 0.f, 0.f, 0.f};
    u32x8 At[4], B0[2], B1[2];
    __syncthreads();
    STG_B(SB(0, 0), cur.B, 0, 0); STG_A(SA(0, 0), cur, ga, 0, 0); STG_B(SB(0, 1), cur.B, 1, 0); STG_A(SA(0, 1), cur, ga, 1, 0);
    if (wr == 1) BAR;
    WAIT_V(4); BAR;
    STG_B(SB(1, 0), cur.B, 0, 128); STG_A(SA(1, 0), cur, ga, 0, 128); STG_B(SB(1, 1), cur.B, 1, 128);
    WAIT_V(6); BAR;
    for (int ui = 0;; ++ui) {
#pragma unroll
        for (int i = 0; i < 2; ++i) { int R_, C_; stage_rc(tid * 16 + i * 8192, R_, C_); voff[i] = (unsigned)(R_ * K + C_ * 2); gc2[i] = (unsigned)C_ * 2u; }
        const bool has_next = gemm_next<PHK>(w, layer, ui + 1, G, c, nxt);
        if (!has_next) nxt = cur;
        u32x4 gn = ga;
#pragma unroll 1
        for (int t = 0; t < nt; t += 2) {
            const bool lastp = (t == nt - 2);
            if (GATHER && t == 0 && wid == 0) GLDS16((const char*)nxt.gidx + lane * 16, (char*)idbuf + lane * 16);
            if (GATHER && t == nt - 4) { _Pragma("unroll") for (int h_ = 0; h_ < 2; ++h_) _Pragma("unroll") for (int i_ = 0; i_ < 2; ++i_) { int R_, C_; stage_rc(tid * 16 + i_ * 8192, R_, C_); gn[h_ * 2 + i_] = (unsigned)idbuf[h_ * 128 + R_]; } }
#ifndef EMU
#endif
            GUnit u2 = cur; u32x4 g2 = ga; if (lastp) { u2 = nxt; g2 = gn; }
            const int k2 = lastp ? 0 : (t + 2) * 128;
            K_TILE_PAIR(u2, g2, u2.B, (t + 1) * 128, k2, k2 + 128);
        }
#ifndef EMU
        asm volatile("" : "+v"(tid));
#endif
        wid = tid >> 6; lane = tid & 63; wr = wid >> 2; wc = wid & 3; fr = lane & 15; fq = lane >> 4;
        const int kd = PHK == 0 ? (cur.pn <= 1 ? 1 : ((cur.pn == 4 || cur.pn == 5) ? 2 : ((cur.pn == 11 || cur.pn == 12) ? 3 : 0))) : 0;
        const float qsc = PHK == 0 ? (cur.pn == 0 ? 0.125f : (cur.pn == 4 ? 0.17677669529663687f * LOG2E : (cur.pn == 11 ? 0.125f * LOG2E : 1.0f))) : 1.0f;
#pragma unroll
        for (int ai = 0; ai < 2; ++ai) {
            f32x4 rt0[4], rt1[4];
            if (PHK == 0 && kd != 0) {
#pragma unroll
                for (int m = 0; m < 4; ++m) { const long orow = cur.orow0 + ai * 128 + wr * 64 + m * 16 + fr; const bool isc = orow >= RL; const int tokn = isc ? 0 : (int)(orow % SEQ);
                    const int a0 = (kd == 1 ? 0 : (kd == 2 ? 32 : 48)) + (kd != 2 ? (wc & 1) * 16 : 0) + fq * 4; const float* tp = w.tab + ((size_t)tokn * 80 + a0) * 2;
                    rt0[m] = *(const f32x4*)tp; rt1[m] = *(const f32x4*)(tp + 4); }
            }
#pragma unroll
            for (int m = 0; m < 4; ++m) {
                const int lrow = ai * 128 + wr * 64 + m * 16 + fr; const long orow = cur.orow0 + lrow;
                if (PHK == 0) {
                    const bool isc = orow >= RL; const int tokn = isc ? 0 : (int)(orow % SEQ);
                    f32x4 cs = (f32x4){qsc, qsc, qsc, qsc}, sn = (f32x4){0.f, 0.f, 0.f, 0.f};
                    if (kd != 0 && !isc) {
                        const f32x4 t0 = rt0[m], t1 = rt1[m]; cs = (f32x4){t0[0], t0[2], t1[0], t1[2]} * qsc; sn = (f32x4){t0[1], t0[3], t1[1], t1[3]} * qsc; }
#pragma unroll
                    for (int bj = 0; bj < 2; ++bj) { const int kind = (cur.pn == 12 && bj == 1) ? 0 : kd;
                        f32x4 x1 = acc[ai][bj][m][0], x2 = acc[ai][bj][m][1];
                        if (kind != 0) { const f32x4 y1 = x1 * cs - x2 * sn, y2 = x1 * sn + x2 * cs; x1 = y1; x2 = y2; }
                        u32x4 o; o[0] = pk2(x1[0], x1[1]); o[1] = pk2(x1[2], x1[3]); o[2] = pk2(x2[0], x2[1]); o[3] = pk2(x2[2], x2[3]);
                        *(u32x4*)(w.p + (size_t)orow * PW + cur.bcol + bj * 128 + wc * 32 + fq * 8) = o; }
                } else if (PHK == 2) {
                    const f32x4 g0 = acc[ai][0][m][0] * (1.0f / SW1), u0 = acc[ai][1][m][0] * (SH / SW1), g1 = acc[ai][0][m][1] * (1.0f / SW1), u1 = acc[ai][1][m][1] * (SH / SW1);
                    u32x2 o; o[0] = pk4_fp8(siluf(g0[0]) * u0[0], siluf(g0[1]) * u0[1], siluf(g0[2]) * u0[2], siluf(g0[3]) * u0[3]); o[1] = pk4_fp8(siluf(g1[0]) * u1[0], siluf(g1[1]) * u1[1], siluf(g1[2]) * u1[2], siluf(g1[3]) * u1[3]);
                    *(u32x2*)(w.hid + (size_t)orow * FF + (cur.bcol >> 1) + wc * 32 + fq * 8) = o;
                } else {
                    float wg = 1.0f; if (PHK == 3) wg = cur.wgt[lrow] * (SY / (SH * SW2));
#pragma unroll
                    for (int bj = 0; bj < 2; ++bj) { const f32x4 v0 = acc[ai][bj][m][0], v1 = acc[ai][bj][m][1];
                        if (PHK == 3) { u32x2 o; o[0] = pk4_fp8(v0[0] * wg, v0[1] * wg, v0[2] * wg, v0[3] * wg); o[1] = pk4_fp8(v1[0] * wg, v1[1] * wg, v1[2] * wg, v1[3] * wg);
                            *(u32x2*)(w.y + (size_t)orow * 1024 + cur.bcol + bj * 128 + wc * 32 + fq * 8) = o;
                        } else { u32x4 o; o[0] = pk2(v0[0] * wg, v0[1] * wg); o[1] = pk2(v0[2] * wg, v0[3] * wg); o[2] = pk2(v1[0] * wg, v1[1] * wg); o[3] = pk2(v1[2] * wg, v1[3] * wg);
                            *(u32x4*)(w.mixo + (size_t)orow * 1024 + cur.bcol + bj * 128 + wc * 32 + fq * 8) = o; } }
                }
            }
        }
        if (!has_next) break;
#pragma unroll
        for (int a = 0; a < 2; ++a)
#pragma unroll
            for (int b = 0; b < 2; ++b)
#pragma unroll
                for (int m = 0; m < 4; ++m)
#pragma unroll
                    for (int n = 0; n < 2; ++n) acc[a][b][m][n] = (f32x4){0.f, 0.f, 0.f, 0.f};
        cur = nxt;
        ga = gn;
#ifndef EMU
        asm volatile("" : "+v"(tid));
#endif
        wid = tid >> 6; lane = tid & 63; wr = wid >> 2; wc = wid & 3; fr = lane & 15; fq = lane >> 4;
    }
    WAIT_V(0);
    if (wr == 0) BAR;
    BAR;
    __syncthreads();
#undef G_GOFF
#undef K_TILE_PAIR
#undef UBASE
#undef SA
#undef SB
#undef STG_A
#undef STG_B
#undef LDA
#undef LDB
#undef LDB_ROW
#undef MMA
}
DI void cvt_tail_a(const Params& p, int layer, char* smem);
DI void phase_inproj(const Params& p, int layer, char* smem) { gemm_stream<0>(p, layer, smem); cvt_tail_a(p, layer, smem); }
DI void cvt_tail_b(const Params& p, int layer, char* smem) {
    const int G = gridDim.x, rem = (((layer == DEPTH - 1 ? RL : R) / 256) * 4) % G, c = bidx(); if (c < rem) return;
    cvt_stream<1>(p, ws_of(p.ws), smem, layer, c - rem, G - rem);
}
DI void cvt_tail_a(const Params& p, int layer, char* smem) {
    const int G = gridDim.x, rem = ((R / 256) * (PW / 256)) % G, c = bidx(); if (c < rem) return;
    cvt_stream<3>(p, ws_of(p.ws), smem, layer, c - rem, G - rem);
}
DI void cvt_tail_d(const Params& p, int layer, char* smem) {
    if (layer + 1 >= DEPTH) return;
    const int G = gridDim.x, rem = (16 * (ROWS_E / 256) * 4) % G, c = bidx(); if (c < rem) return;
    cvt_stream<2>(p, ws_of(p.ws), smem, layer, c - rem, G - rem);
}
DI void phase_outproj(const Params& p, int layer, char* smem) { gemm_stream<1>(p, layer, smem); cvt_tail_b(p, layer, smem); }
DI void phase_moe1(const Params& p, int layer, char* smem) { gemm_stream<2>(p, layer, smem); }
DI void phase_moe2(const Params& p, int layer, char* smem) { gemm_stream<3>(p, layer, smem); cvt_tail_d(p, layer, smem); }

DI void phase_prep(const Params& p, int layer, char* smem) {
    const WS w = ws_of(p.ws); const int lane = tidx() & 63, wv = tidx() >> 6;
    for (int row = bidx() * 8 + wv; row < R; row += gridDim.x * 8) {
        const bool isc = row >= RL; const int n = isc ? 0 : row % SEQ; bf16_t* pr = w.p + (size_t)row * PW;
        for (int idx = lane; idx < 704; idx += 64) {
            int c1, dd, a; float sc;
            if (idx < 128) { const int h = idx >> 5, i = idx & 31; c1 = C_RQ + h * 64 + i; dd = 32; a = i; sc = 0.125f; }
            else if (idx < 256) { const int j = idx - 128, h = j >> 5, i = j & 31; c1 = C_RK + h * 64 + i; dd = 32; a = i; sc = 1.0f; }
            else if (idx < 384) { const int j = idx - 256, hc = j >> 4, i = j & 15; c1 = C_DQ + hc * 32 + i; dd = 16; a = 32 + i; sc = 0.17677669529663687f * LOG2E; }
            else if (idx < 512) { const int j = idx - 384, hc = j >> 4, i = j & 15; c1 = C_DK + hc * 32 + i; dd = 16; a = 32 + i; sc = 1.0f; }
            else if (idx < 640) { const int j = idx - 512, h = j >> 5, i = j & 31; c1 = C_SQ + h * 64 + i; dd = 32; a = 48 + i; sc = 0.125f * LOG2E; }
            else { const int j = idx - 640, h = j >> 5, i = j & 31; c1 = C_SK + h * 64 + i; dd = 32; a = 48 + i; sc = 1.0f; }
            float cs = 1.0f, sn = 0.0f; if (!isc) { cs = w.tab[((size_t)n * 80 + a) * 2]; sn = w.tab[((size_t)n * 80 + a) * 2 + 1]; }
            const float x1 = bf2f(pr[c1]), x2 = bf2f(pr[c1 + dd]);
            pr[c1] = f2bf((x1 * cs - x2 * sn) * sc); pr[c1 + dd] = f2bf((x1 * sn + x2 * cs) * sc);
        }
    }
}

constexpr int A_KS = 72;
constexpr int A_TILE = 64 * A_KS;
constexpr float A_THR = 6.0f;
template <int NC>
DI void attn_unit(const bf16_t* __restrict__ P, const int qrow0, const int qcol, const int kcol, const int vcol,
                  const int r1, const int n1, const int kp1, const bool mask1, const int r2, const int n2, const int qpos0,
                  const float m_init, const float l_init, const float lam, const float fin_scale, const float* __restrict__ norm_g,
                  bf16_t* __restrict__ outp  , char* smem) {
    bf16_t* Kb = (bf16_t*)smem; bf16_t* Vb = Kb + 2 * A_TILE;
    const int tid = tidx(), lane = tid & 63, wv = tid >> 6, fr = lane & 15, fq = lane >> 4;
    bf16x8 qf[2][2];
#pragma unroll
    for (int g = 0; g < 2; ++g)
#pragma unroll
        for (int i = 0; i < 2; ++i) qf[g][i] = *(const bf16x8*)(P + (size_t)(qrow0 + g * 128 + wv * 16 + fr) * PW + qcol + i * 32 + fq * 8);
    f32x4 o[2][NC][4], ol[2][NC], negm[2][NC]; float mrun[2][NC];
    const int T = n1 + n2, skey = tid >> 3, sc8 = tid & 7;
    const int soff = skey * A_KS + sc8 * 8;
    const int voff = (fq * 4 + (fr >> 2)) * A_KS + (fr & 3) * 4;
    u32x4 kr0, vr0, kr1, vr1;
#define A_LOAD(TN, KR, VR) do { const int tn_ = (TN); const int krow_ = (tn_ < n1) ? r1 + tn_ * 64 : r2 + (tn_ - n1) * 64; const bf16_t* src_ = P + (size_t)(krow_ + skey) * PW; \
        KR = *(const u32x4*)(src_ + kcol + sc8 * 8); VR = *(const u32x4*)(src_ + vcol + sc8 * 8); } while (0)
    A_LOAD(0, kr0, vr0);
    *(u32x4*)(Kb + soff) = kr0; *(u32x4*)(Vb + soff) = vr0;
    if (1 < T) A_LOAD(1, kr1, vr1);
    const int qposb = qpos0 + wv * 16 + fr;
    LDS_BARRIER();
    {
#pragma unroll
        for (int g = 0; g < 2; ++g)
#pragma unroll
            for (int c = 0; c < NC; ++c) { float mx = -INFINITY;
#pragma unroll
                for (int kt = 0; kt < 4; ++kt) {
                    const bf16x8 k0 = *(const bf16x8*)(Kb + (kt * 16 + fr) * A_KS + fq * 8), k1 = *(const bf16x8*)(Kb + (kt * 16 + fr) * A_KS + 32 + fq * 8);
                    const f32x4 z = (f32x4){0.f, 0.f, 0.f, 0.f};
                    f32x4 sv; if (NC == 2) sv = c == 0 ? MFMA16(k0, qf[g][0], z) : MFMA16(k1, qf[g][1], z); else sv = MFMA16(k1, qf[g][1], MFMA16(k0, qf[g][0], z));
#pragma unroll
                    for (int j = 0; j < 4; ++j) { const int dlt = qposb + g * 128 - (kp1 + kt * 16 + fq * 4 + j); if (!(mask1 && n1 > 0 && (dlt > 128 || dlt < -128))) mx = fmaxf(mx, sv[j]); } }
                mx = grp_max(mx); mrun[g][c] = fmaxf(m_init, mx); const float l0 = l_init * ex2(m_init - mrun[g][c]);
                negm[g][c] = (f32x4){-mrun[g][c], -mrun[g][c], -mrun[g][c], -mrun[g][c]}; ol[g][c] = (f32x4){l0, l0, l0, l0};
#pragma unroll
                for (int d = 0; d < 4; ++d) o[g][c][d] = (f32x4){0.f, 0.f, 0.f, 0.f}; }
    }
    bf16x8 onesf; { const u32x4 ov = (u32x4){0x3F803F80u, 0x3F803F80u, 0x3F803F80u, 0x3F803F80u}; onesf = __builtin_bit_cast(bf16x8, ov); }
    const int stag = __builtin_amdgcn_readfirstlane(tid >> 8);
    auto tile_step = [&](const int t, u32x4& kl, u32x4& vl, const u32x4& kw, const u32x4& vw) {
        LDS_BARRIER();
        STAGGER_SLEEP(stag);
        const bf16_t* Kt = Kb + (t & 1) * A_TILE; const bf16_t* Vt = Vb + (t & 1) * A_TILE;
        A_LOAD((t + 2 < T ? t + 2 : T - 1), kl, vl);
        const bool msk = mask1 && (t < n1); const int kpos_t = kp1 + t * 64;
        bf16x8 kf[4][2], vf[2][4];
#pragma unroll
        for (int kt = 0; kt < 4; ++kt) { kf[kt][0] = *(const bf16x8*)(Kt + (kt * 16 + fr) * A_KS + fq * 8); kf[kt][1] = *(const bf16x8*)(Kt + (kt * 16 + fr) * A_KS + 32 + fq * 8); }
#pragma unroll
        for (int k2 = 0; k2 < 2; ++k2)
#pragma unroll
            for (int d = 0; d < 4; ++d) { const s16x4 a = lds_tr16(Vt + voff + (2 * k2) * 16 * A_KS + d * 16), b = lds_tr16(Vt + voff + (2 * k2 + 1) * 16 * A_KS + d * 16);
                vf[k2][d] = __builtin_shufflevector(a, b, 0, 1, 2, 3, 4, 5, 6, 7); }
#pragma unroll
        for (int g = 0; g < 2; ++g)
#pragma unroll
            for (int c = 0; c < NC; ++c) {
                f32x4 s[4];
#pragma unroll
                for (int kt = 0; kt < 4; ++kt) { if (NC == 2) s[kt] = MFMA16(kf[kt][c], qf[g][c], negm[g][c]); else s[kt] = MFMA16(kf[kt][1], qf[g][1], MFMA16(kf[kt][0], qf[g][0], negm[g][0])); }
                if (msk) { const int qpos = qposb + g * 128;
#pragma unroll
                    for (int kt = 0; kt < 4; ++kt)
#pragma unroll
                        for (int j = 0; j < 4; ++j) { const int dlt = qpos - (kpos_t + kt * 16 + fq * 4 + j); if (dlt > 128 || dlt < -128) s[kt][j] = -INFINITY; } }
                int im = max(max(__float_as_int(s[0][0]), __float_as_int(s[0][1])), max(__float_as_int(s[0][2]), __float_as_int(s[0][3])));
#pragma unroll
                for (int kt = 1; kt < 4; ++kt) im = max(max(im, __float_as_int(s[kt][0])), max(max(__float_as_int(s[kt][1]), __float_as_int(s[kt][2])), __float_as_int(s[kt][3])));
                const float tm = __int_as_float(grp_imax(im));
                if (__any(tm > A_THR)) {
                    const float delta = fmaxf(tm, 0.f), alpha = ex2(-delta); mrun[g][c] += delta; negm[g][c] = (f32x4){-mrun[g][c], -mrun[g][c], -mrun[g][c], -mrun[g][c]}; ol[g][c] *= alpha;
#pragma unroll
                    for (int d = 0; d < 4; ++d) o[g][c][d] *= alpha;
#pragma unroll
                    for (int kt = 0; kt < 4; ++kt) s[kt] = s[kt] - delta;
                }
#pragma unroll
                for (int kt = 0; kt < 4; ++kt)
#pragma unroll
                    for (int j = 0; j < 4; ++j) s[kt][j] = ex2(s[kt][j]);
#pragma unroll
                for (int k2 = 0; k2 < 2; ++k2) {
                    u32x4 pp; pp[0] = pk2(s[2 * k2][0], s[2 * k2][1]); pp[1] = pk2(s[2 * k2][2], s[2 * k2][3]); pp[2] = pk2(s[2 * k2 + 1][0], s[2 * k2 + 1][1]); pp[3] = pk2(s[2 * k2 + 1][2], s[2 * k2 + 1][3]);
                    const bf16x8 pb = __builtin_bit_cast(bf16x8, pp);
#pragma unroll
                    for (int d = 0; d < 4; ++d) o[g][c][d] = MFMA16(vf[k2][d], pb, o[g][c][d]);
                    ol[g][c] = MFMA16(onesf, pb, ol[g][c]);
                }
            }
        { bf16_t* Kn = Kb + ((t + 1) & 1) * A_TILE + soff; bf16_t* Vn = Vb + ((t + 1) & 1) * A_TILE + soff;
            *(u32x4*)Kn = kw; *(u32x4*)Vn = vw; }
    };
#ifndef EMU
    __builtin_amdgcn_s_waitcnt(0x0F70);
#endif
    for (int t = 0; t < T; t += 2) { tile_step(t, kr0, vr0, kr1, vr1); if (t + 1 < T) tile_step(t + 1, kr1, vr1, kr0, vr0); }
#undef A_LOAD
#pragma unroll
    for (int g = 0; g < 2; ++g) {
        float linv[NC];
#pragma unroll
        for (int c = 0; c < NC; ++c) linv[c] = 1.0f / ol[g][c][0];
        f32x4 val[4]; float ss = 0.f;
#pragma unroll
        for (int d = 0; d < 4; ++d) {
            if (NC == 2) val[d] = o[g][0][d] * linv[0] - lam * (o[g][NC - 1][d] * linv[NC - 1]); else val[d] = o[g][0][d] * linv[0];
            ss += val[d][0] * val[d][0] + val[d][1] * val[d][1] + val[d][2] * val[d][2] + val[d][3] * val[d][3];
        }
        float rs = 1.0f;
        if (NC == 2) { ss = grp_sum(ss); rs = fin_scale / sqrtf(ss * (1.0f / 64.0f) + 1e-6f); }
        bf16_t* orow = outp + (size_t)(g * 128 + wv * 16 + fr) * 1024;
#pragma unroll
        for (int d = 0; d < 4; ++d) { f32x4 v = val[d] * rs; if (NC == 2) v = v * *(const f32x4*)(norm_g + d * 16 + fq * 4);
            u32x2 ov; ov[0] = pk2(v[0], v[1]); ov[1] = pk2(v[2], v[3]); *(u32x2*)(orow + d * 16 + fq * 4) = ov; }
    }
    __syncthreads();
}

DI void ret_kv_unit(const Params& p, const WS& w, int layer, int b, int h, int ci, char* smem) {
    bf16_t* Kr = (bf16_t*)smem; bf16_t* V0 = Kr + 128 * 72; bf16_t* V1 = V0 + 128 * 72;
    const int tid = tidx(), lane = tid & 63, wv = tid >> 6, fr = lane & 15, fq = lane >> 4; const bool isc = ci < NCC; const int row0 = isc ? RL + b * CTX + ci * 128 : b * SEQ + (ci - NCC) * 128;
    const float lg0 = -softplusf_(-p.ret_decay[(layer * 2 + 0) * 4 + h]) * LOG2E, lg1 = -softplusf_(-p.ret_decay[(layer * 2 + 1) * 4 + h]) * LOG2E;
    __syncthreads();
    for (int i = tid; i < 128 * 8; i += NT) { const int j = i >> 3, c8 = i & 7; const bf16_t* src = w.p + (size_t)(row0 + j) * PW + h * 64 + c8 * 8;
        *(u32x4*)(Kr + j * 72 + c8 * 8) = *(const u32x4*)(src + C_RK); const u32x4 vv = *(const u32x4*)(src + C_RV);
        const float d0 = ex2(lg0 * (float)(127 - j)), d1 = ex2(lg1 * (float)j); u32x4 a, c;
#pragma unroll
        for (int q = 0; q < 4; ++q) { const float lo = __uint_as_float(vv[q] << 16), hi = __uint_as_float(vv[q] & 0xffff0000u); a[q] = pk2(lo * d0, hi * d0); c[q] = pk2(lo * d1, hi * d1); }
        *(u32x4*)(V0 + j * 72 + c8 * 8) = a; *(u32x4*)(V1 + j * 72 + c8 * 8) = c; }
    __syncthreads();
    const int dir = wv >> 2, et = wv & 3; const bf16_t* Vd = dir ? V1 : V0; const int toff = (fq * 8 + (fr >> 2)) * 72 + (fr & 3) * 4;
    f32x4 acc[4];
#pragma unroll
    for (int n = 0; n < 4; ++n) acc[n] = (f32x4){0.f, 0.f, 0.f, 0.f};
#pragma unroll
    for (int ks = 0; ks < 4; ++ks) {
        const s16x4 va = lds_tr16(Vd + toff + (ks * 32) * 72 + et * 16), vb = lds_tr16(Vd + toff + (ks * 32 + 4) * 72 + et * 16); const bf16x8 vfr = __builtin_shufflevector(va, vb, 0, 1, 2, 3, 4, 5, 6, 7);
#pragma unroll
        for (int n = 0; n < 4; ++n) { const s16x4 ka = lds_tr16(Kr + toff + (ks * 32) * 72 + n * 16), kb = lds_tr16(Kr + toff + (ks * 32 + 4) * 72 + n * 16);
            acc[n] = MFMA16(vfr, __builtin_shufflevector(ka, kb, 0, 1, 2, 3, 4, 5, 6, 7), acc[n]); }
    }
    bf16_t* ob = w.rkv + ((size_t)((b * 4 + h) * 2 + dir) * NCHR + ci) * 4096;
#pragma unroll
    for (int n = 0; n < 4; ++n) { u32x2 o; o[0] = pk2(acc[n][0], acc[n][1]); o[1] = pk2(acc[n][2], acc[n][3]); *(u32x2*)(ob + (n * 16 + fr) * 64 + et * 16 + fq * 4) = o; }
}
DI void ret_scan(const Params& p, const WS& w, int layer) {
    for (int i = bidx() * NT + tidx(); i < NB * 4 * 2 * 4096; i += gridDim.x * NT) {
        const int chain = i >> 12, el = i & 4095, d = chain & 1, h = (chain >> 1) & 3;
        const float x = p.ret_decay[(layer * 2 + d) * 4 + h]; const float cd = ex2(-softplusf_(-x) * LOG2E * 128.0f);
        float kv[NCHR];
#pragma unroll
        for (int st = 0; st < NCHR; ++st) { const int ci = d == 0 ? st : (st < NCC ? NCC - 1 - st : NCC + (NLC - 1 - (st - NCC))); kv[st] = __uint_as_float((unsigned)w.rkv[((size_t)chain * NCHR + ci) * 4096 + el] << 16); }
        float s = 0.f;
#pragma unroll
        for (int st = 0; st < NCHR; ++st) { const int ci = d == 0 ? st : (st < NCC ? NCC - 1 - st : NCC + (NLC - 1 - (st - NCC))); w.rs[((size_t)chain * NCHR + ci) * 4096 + el] = f2bf(s); s = s * cd + kv[st]; }
    }
}
constexpr int RO_KS = 72, RO_VS = 136;
DI void ret_out_unit(const Params& p, const WS& w, int layer, int b, int h, int ci, char* smem) {
    bf16_t* Ks = (bf16_t*)smem; bf16_t* Vr = Ks + 128 * RO_KS; bf16_t* Sr = Vr + 128 * RO_KS;
    const int tid = tidx(), lane = tid & 63, wv = tid >> 6, fr = lane & 15, fq = lane >> 4;
    const bool isc = ci < NCC; const int row0 = isc ? RL + b * CTX + ci * 128 : b * SEQ + (ci - NCC) * 128;
    __syncthreads();
    for (int i = tid; i < 128 * 8; i += NT) { const int j = i >> 3, c8 = i & 7; const bf16_t* src = w.p + (size_t)(row0 + j) * PW + h * 64 + c8 * 8;
        *(u32x4*)(Ks + j * RO_KS + c8 * 8) = *(const u32x4*)(src + C_RK); *(u32x4*)(Vr + j * RO_KS + c8 * 8) = *(const u32x4*)(src + C_RV); }
    for (int i = tid; i < 2 * 64 * 8; i += NT) { const int d = i >> 9, dk = (i >> 3) & 63, e8 = i & 7; const bf16_t* src = w.rs + ((size_t)((b * 4 + h) * 2 + d) * NCHR + ci) * 4096 + dk * 64 + e8 * 8;
        *(u32x4*)(Sr + (d * 64 + dk) * RO_KS + e8 * 8) = *(const u32x4*)src; }
    __syncthreads();
    const float lg0 = -softplusf_(-p.ret_decay[(layer * 2 + 0) * 4 + h]) * LOG2E, lg1 = -softplusf_(-p.ret_decay[(layer * 2 + 1) * 4 + h]) * LOG2E;
    const int qi = wv * 16 + fr;
    const int voff = (fq * 4 + (fr >> 2)) * RO_KS + (fr & 3) * 4;
    const int soffs = (fq * 8 + (fr >> 2)) * RO_KS + (fr & 3) * 4;
    bf16x8 qf[2];
#pragma unroll
    for (int i = 0; i < 2; ++i) qf[i] = *(const bf16x8*)(w.p + (size_t)(row0 + qi) * PW + C_RQ + h * 64 + i * 32 + fq * 8);
    f32x4 o[4], t0[4], t1[4];
#pragma unroll
    for (int d = 0; d < 4; ++d) { o[d] = (f32x4){0.f, 0.f, 0.f, 0.f}; t0[d] = o[d]; t1[d] = o[d]; }
#pragma unroll
    for (int k2 = 0; k2 < 4; ++k2) {
        f32x4 s[2];
#pragma unroll
        for (int q = 0; q < 2; ++q) { const int kt = 2 * k2 + q;
            const bf16x8 k0 = *(const bf16x8*)(Ks + (kt * 16 + fr) * RO_KS + fq * 8), k1 = *(const bf16x8*)(Ks + (kt * 16 + fr) * RO_KS + 32 + fq * 8);
            s[q] = MFMA16(k1, qf[1], MFMA16(k0, qf[0], (f32x4){0.f, 0.f, 0.f, 0.f}));
#pragma unroll
            for (int j = 0; j < 4; ++j) { const int kj = kt * 16 + fq * 4 + j, dl = qi - kj; const float dm = dl > 0 ? ex2(lg0 * (float)dl) : (dl < 0 ? ex2(lg1 * (float)(-dl)) : 2.0f); s[q][j] *= dm; } }
        u32x4 pp; pp[0] = pk2(s[0][0], s[0][1]); pp[1] = pk2(s[0][2], s[0][3]); pp[2] = pk2(s[1][0], s[1][1]); pp[3] = pk2(s[1][2], s[1][3]);
        const bf16x8 pb = __builtin_bit_cast(bf16x8, pp);
#pragma unroll
        for (int d = 0; d < 4; ++d) { const s16x4 v0 = lds_tr16(Vr + voff + (2 * k2) * 16 * RO_KS + d * 16), v1 = lds_tr16(Vr + voff + (2 * k2 + 1) * 16 * RO_KS + d * 16);
            o[d] = MFMA16(__builtin_shufflevector(v0, v1, 0, 1, 2, 3, 4, 5, 6, 7), pb, o[d]); }
    }
#pragma unroll
    for (int d = 0; d < 4; ++d)
#pragma unroll
        for (int ks = 0; ks < 2; ++ks) {
            const s16x4 a0 = lds_tr16(Sr + soffs + (ks * 32) * RO_KS + d * 16), a1 = lds_tr16(Sr + soffs + (ks * 32 + 4) * RO_KS + d * 16);
            const s16x4 b0 = lds_tr16(Sr + soffs + (64 + ks * 32) * RO_KS + d * 16), b1 = lds_tr16(Sr + soffs + (64 + ks * 32 + 4) * RO_KS + d * 16);
            t0[d] = MFMA16(__builtin_shufflevector(a0, a1, 0, 1, 2, 3, 4, 5, 6, 7), qf[ks], t0[d]); t1[d] = MFMA16(__builtin_shufflevector(b0, b1, 0, 1, 2, 3, 4, 5, 6, 7), qf[ks], t1[d]); }
    const float qd0 = ex2(lg0 * (float)(qi + 1)), qd1 = ex2(lg1 * (float)(128 - qi));
    float ss = 0.f;
#pragma unroll
    for (int d = 0; d < 4; ++d) { o[d] = o[d] + qd0 * t0[d] + qd1 * t1[d]; ss += o[d][0] * o[d][0] + o[d][1] * o[d][1] + o[d][2] * o[d][2] + o[d][3] * o[d][3]; }
    ss = grp_sum(ss);
    const float rs = 1.0f / sqrtf(ss * (1.0f / 64.0f) + 1e-6f);
    const bf16_t* gp = w.p + (size_t)(row0 + qi) * PW + C_RG + h * 64; bf16_t* op = w.mix + (size_t)(row0 + qi) * 1024 + h * 64;
#pragma unroll
    for (int d = 0; d < 4; ++d) { const u32x2 gv = *(const u32x2*)(gp + d * 16 + fq * 4);
        const float g0 = __uint_as_float(gv[0] << 16), g1 = __uint_as_float(gv[0] & 0xffff0000u), g2 = __uint_as_float(gv[1] << 16), g3 = __uint_as_float(gv[1] & 0xffff0000u);
        u32x2 ov; ov[0] = pk2(o[d][0] * rs * siluf(g0), o[d][1] * rs * siluf(g1)); ov[1] = pk2(o[d][2] * rs * siluf(g2), o[d][3] * rs * siluf(g3)); *(u32x2*)(op + d * 16 + fq * 4) = ov; }
}

constexpr int GS = 68, GNA = 72, GDI = 24;
DI bf16x8 pack8f(const float* p) {
    const f32x4 a = *(const f32x4*)p, b = *(const f32x4*)(p + 4); u32x4 r; r[0] = pk2(a[0], a[1]); r[1] = pk2(a[2], a[3]); r[2] = pk2(b[0], b[1]); r[3] = pk2(b[2], b[3]); return __builtin_bit_cast(bf16x8, r);
}
DI void gdn_prep_unit(const Params& p, const WS& w, int layer, int b, int h, int cg, char* smem) {
    float* Qs = (float*)smem; float* Ks = Qs + 64 * GS; float* Vs = Ks + 64 * GS; float* Raw = Vs + 64 * GS;
    float* KK = Raw; float* QK = KK + 64 * GS; float* gt = Raw + 66 * 192;
    bf16_t* NA = (bf16_t*)(gt + 384); bf16_t* DIm = NA + 2 * 64 * GNA;
    const int tid = tidx(), lane = tid & 63, wv = tid >> 6, fr = lane & 15, fq = lane >> 4;
    const bool isc = cg < NCG; const int nseq = isc ? CTX : SEQ, t0 = (isc ? cg : cg - NCG) * 64, base = isc ? RL + b * CTX : b * SEQ;
    __syncthreads();
    for (int i = tid; i < 66 * 24; i += NT) { const int tt = i / 24, c8 = i % 24, part = c8 >> 3, tok = t0 - 1 + tt; u32x4 v = (u32x4){0u, 0u, 0u, 0u};
        if (tok >= 0 && tok < nseq) v = *(const u32x4*)(w.p + (size_t)(base + tok) * PW + C_GQKV + part * 256 + h * 64 + (c8 & 7) * 8);
#pragma unroll
        for (int q = 0; q < 4; ++q) { Raw[tt * 192 + c8 * 8 + 2 * q] = __uint_as_float(v[q] << 16); Raw[tt * 192 + c8 * 8 + 2 * q + 1] = __uint_as_float(v[q] & 0xffff0000u); } }
    if (tid < 128) { const int dr = tid >> 6, s = tid & 63; const float* ga = w.gab + (size_t)(base + t0 + s) * 16;
        gt[dr * 64 + s] = -__expf(p.gdn_a_log[(layer * 2 + dr) * 4 + h]) * softplusf_(ga[dr * 4 + h] + p.gdn_dt_bias[(layer * 2 + dr) * 4 + h]);
        gt[128 + dr * 64 + s] = sigmoidf_(ga[8 + dr * 4 + h]); }
    __syncthreads();
    if (tid < 384) {
        const int ch = tid % 192, half = tid / 192, part = ch >> 6, d = ch & 63, chg = part * 256 + h * 64 + d; const float* cw = p.gdn_conv + (size_t)layer * 3 * 768 + chg;
        const float w0 = cw[0], w1 = cw[768], w2 = cw[1536]; float* dst = (part == 0 ? Qs : (part == 1 ? Ks : Vs)) + d;
        float x0 = Raw[(half * 32) * 192 + ch], x1 = Raw[(half * 32 + 1) * 192 + ch];
#pragma unroll 8
        for (int s = half * 32; s < half * 32 + 32; ++s) { const float x2 = Raw[(s + 2) * 192 + ch]; dst[s * GS] = siluf(w0 * x0 + w1 * x1 + w2 * x2); x0 = x1; x1 = x2; }
    } else if (tid >= 384 && tid < 512) {
        const int dr = (tid - 384) >> 6, sl = tid & 63; float a = gt[dr * 64 + (dr ? 63 - sl : sl)];
#pragma unroll
        for (int dd = 1; dd < 64; dd <<= 1) { const float o = lane_shfl_f(a, sl >= dd ? sl - dd : sl); if (sl >= dd) a += o; }
        gt[256 + dr * 64 + sl] = a; }
    __syncthreads();
#pragma unroll
    for (int pass = 0; pass < 2; ++pass) {
        float* rowp = (pass == 0 ? Qs : Ks) + (tid >> 3) * GS + (tid & 7) * 8; f32x4 x0 = *(const f32x4*)rowp, x1 = *(const f32x4*)(rowp + 4);
        float ss = x0[0] * x0[0] + x0[1] * x0[1] + x0[2] * x0[2] + x0[3] * x0[3] + x1[0] * x1[0] + x1[1] * x1[1] + x1[2] * x1[2] + x1[3] * x1[3];
        ss = sum8(ss); const float rs = (1.0f / sqrtf(ss + 1e-6f)) * (pass == 0 ? 0.125f : 1.0f);
        *(f32x4*)rowp = x0 * rs; *(f32x4*)(rowp + 4) = x1 * rs; }
    __syncthreads();
#pragma unroll
    for (int tt = 0; tt < 4; ++tt) { const int t = wv * 4 + tt, which = t >> 4, mt = (t >> 2) & 3, nt = t & 3; const float* Am = which ? Qs : Ks;
        f32x4 d = (f32x4){0.f, 0.f, 0.f, 0.f};
#pragma unroll
        for (int ks = 0; ks < 2; ++ks) d = MFMA16(pack8f(Am + (mt * 16 + fr) * GS + ks * 32 + fq * 8), pack8f(Ks + (nt * 16 + fr) * GS + ks * 32 + fq * 8), d);
        float* G = which ? QK : KK;
#pragma unroll
        for (int jj = 0; jj < 4; ++jj) G[(mt * 16 + fq * 4 + jj) * GS + nt * 16 + fr] = d[jj]; }
    __syncthreads();
    for (int i = tid; i < 2 * 2048; i += NT) { const int dr = i >> 11, s = (i >> 5) & 63, s2 = (i & 31) * 2, ts = dr ? 63 - s : s; float v0 = 0.f, v1 = 0.f;
        const float nb = -gt[128 + dr * 64 + ts], gs = gt[256 + dr * 64 + s];
        if (s > s2) v0 = nb * KK[ts * GS + (dr ? 63 - s2 : s2)] * __expf(gs - gt[256 + dr * 64 + s2]);
        if (s > s2 + 1) v1 = nb * KK[ts * GS + (dr ? 62 - s2 : s2 + 1)] * __expf(gs - gt[256 + dr * 64 + s2 + 1]);
        *(unsigned*)(NA + (dr * 64 + s) * GNA + s2) = pk2(v0, v1); }
    __syncthreads();
    if (tid < 128) {
        const int dr = tid >> 6, blk = (tid >> 4) & 3, c = tid & 15; const bf16_t* Ab = NA + (dr * 64 + blk * 16) * GNA + blk * 16; float x[16];
#pragma unroll
        for (int r = 0; r < 16; ++r) { float a = (r == c) ? 1.0f : 0.0f;
            const u32x4 lo = *(const u32x4*)(Ab + r * GNA), hi = *(const u32x4*)(Ab + r * GNA + 8);
#pragma unroll
            for (int r2 = 0; r2 < r; ++r2) { const unsigned wd = r2 < 8 ? lo[r2 >> 1] : hi[(r2 - 8) >> 1]; a += __uint_as_float((r2 & 1) ? (wd & 0xffff0000u) : (wd << 16)) * x[r2]; }
            x[r] = a; DIm[((dr * 4 + blk) * 16 + r) * GDI + c] = f2bf(a); }
    }
    __syncthreads();
    const size_t cbase = (size_t)((b * 4 + h) * 2) * NCHG;
#pragma unroll 1
    for (int tk = 0; tk < 2; ++tk) {
        const int task = wv + tk * 8, dr = task >> 3, ntile = task & 7, col = ntile * 16 + fr; const bool isw = ntile >= 4;
        const int sc = dr == 0 ? cg : (cg < NCG ? NCG - 1 - cg : NCG + (NLG - 1 - (cg - NCG))); const size_t ch = cbase + (size_t)dr * NCHG + sc;
        const float* gg = gt + 256 + dr * 64; const float* bt = gt + 128 + dr * 64; const float* Rm = isw ? Ks + (col - 64) : Vs + col;
        u32x2 xb[4];
#pragma unroll
        for (int i = 0; i < 4; ++i) {
            f32x4 acc;
#pragma unroll
            for (int jj = 0; jj < 4; ++jj) { const int sidx = 16 * i + fq * 4 + jj, ts = dr ? 63 - sidx : sidx; float r = bt[ts] * Rm[ts * GS]; if (isw) r *= __expf(gg[sidx]); acc[jj] = r; }
#pragma unroll
            for (int j0 = 0; j0 < i; j0 += 2) {
                const u32x2 a0 = *(const u32x2*)(NA + (dr * 64 + 16 * i + fr) * GNA + 16 * j0 + fq * 4);
                u32x2 a1 = (u32x2){0u, 0u}, b1 = (u32x2){0u, 0u};
                if (j0 + 1 < i) { a1 = *(const u32x2*)(NA + (dr * 64 + 16 * i + fr) * GNA + 16 * (j0 + 1) + fq * 4); b1 = xb[j0 + 1]; }
                u32x4 av; av[0] = a0[0]; av[1] = a0[1]; av[2] = a1[0]; av[3] = a1[1]; u32x4 bv; bv[0] = xb[j0][0]; bv[1] = xb[j0][1]; bv[2] = b1[0]; bv[3] = b1[1];
                acc = MFMA16(__builtin_bit_cast(bf16x8, av), __builtin_bit_cast(bf16x8, bv), acc);
            }
            const u32x2 dd = *(const u32x2*)(DIm + ((dr * 4 + i) * 16 + fr) * GDI + fq * 4);
            u32x4 av; av[0] = dd[0]; av[1] = dd[1]; av[2] = 0u; av[3] = 0u; u32x4 bv; bv[0] = pk2(acc[0], acc[1]); bv[1] = pk2(acc[2], acc[3]); bv[2] = 0u; bv[3] = 0u;
            const f32x4 x = MFMA16(__builtin_bit_cast(bf16x8, av), __builtin_bit_cast(bf16x8, bv), (f32x4){0.f, 0.f, 0.f, 0.f});
            xb[i][0] = pk2(x[0], x[1]); xb[i][1] = pk2(x[2], x[3]);
            if (!isw) *(u32x2*)(w.gub + ch * 4096 + (size_t)col * 64 + 16 * i + fq * 4) = xb[i];
            else { bf16_t* wp = w.gw + ch * 4096 + (size_t)(16 * i + fq * 4) * 64 + (col - 64);
#pragma unroll
                for (int jj = 0; jj < 4; ++jj) wp[jj * 64] = f2bf(x[jj]); }
        }
    }
    for (int i = tid; i < 2 * 1024; i += NT) {
        const int dr = i >> 10, s = (i >> 4) & 63, c = (i & 15) * 4, ts = dr ? 63 - s : s; const float* gg = gt + 256 + dr * 64;
        const int sc = dr == 0 ? cg : (cg < NCG ? NCG - 1 - cg : NCG + (NLG - 1 - (cg - NCG))); const size_t ch = cbase + (size_t)dr * NCHG + sc;
        const float gs = gg[s], es = __expf(gs), g63 = gg[63];
        float qg[4], qk[4], kt[4];
#pragma unroll
        for (int k = 0; k < 4; ++k) { const int cc = c + k, tc = dr ? 63 - cc : cc; const float gc = gg[cc];
            qg[k] = Qs[ts * GS + cc] * es; qk[k] = s >= cc ? QK[ts * GS + tc] * __expf(gs - gc) : 0.f; kt[k] = Ks[tc * GS + s] * __expf(g63 - gc); }
        u32x2 o; o[0] = pk2(qg[0], qg[1]); o[1] = pk2(qg[2], qg[3]); *(u32x2*)(w.gqg + ch * 4096 + s * 64 + c) = o;
        o[0] = pk2(qk[0], qk[1]); o[1] = pk2(qk[2], qk[3]); *(u32x2*)(w.gqk + ch * 4096 + s * 64 + c) = o;
        o[0] = pk2(kt[0], kt[1]); o[1] = pk2(kt[2], kt[3]); *(u32x2*)(w.gkt + ch * 4096 + s * 64 + c) = o;
        if (s == 0 && c == 0) w.gcd[ch] = __expf(g63); }
}
struct GdnOps { bf16x8 aw[2], aqg[2], aqk[2], akt[2]; u32x2 ub; float cd; };
DI void gdn_load_ops(GdnOps& g, const WS& w, size_t ch, int wv, int fr, int fq, int vs) {
#pragma unroll
    for (int ks = 0; ks < 2; ++ks) { const size_t o = ch * 4096 + (size_t)(wv * 16 + fr) * 64 + ks * 32 + fq * 8;
        g.aw[ks] = *(const bf16x8*)(w.gw + o); g.aqg[ks] = *(const bf16x8*)(w.gqg + o); g.aqk[ks] = *(const bf16x8*)(w.gqk + o); g.akt[ks] = *(const bf16x8*)(w.gkt + o); }
    g.ub = *(const u32x2*)(w.gub + ch * 4096 + (size_t)(vs * 16 + fr) * 64 + wv * 16 + fq * 4); g.cd = w.gcd[ch];
}
DI void gdn_scan_step(const GdnOps& g, f32x4& sacc, bf16_t* Sp, bf16_t* Up, const WS& w, int rbase, int dr, int h, int vs, int wv, int fr, int fq) {
    { u32x2 sv; sv[0] = pk2(sacc[0], sacc[1]); sv[1] = pk2(sacc[2], sacc[3]); *(u32x2*)(Sp + fr * 72 + wv * 16 + fq * 4) = sv; }
    LDS_BARRIER();
    bf16x8 sb[2]; f32x4 u = (f32x4){0.f, 0.f, 0.f, 0.f};
#pragma unroll
    for (int ks = 0; ks < 2; ++ks) { sb[ks] = *(const bf16x8*)(Sp + fr * 72 + ks * 32 + fq * 8); u = MFMA16(g.aw[ks], sb[ks], u); }
    u = (f32x4){bf_lo(g.ub[0]), bf_hi(g.ub[0]), bf_lo(g.ub[1]), bf_hi(g.ub[1])} - u;
    { u32x2 uvv; uvv[0] = pk2(u[0], u[1]); uvv[1] = pk2(u[2], u[3]); *(u32x2*)(Up + fr * 72 + wv * 16 + fq * 4) = uvv; }
    LDS_BARRIER();
    f32x4 oo = (f32x4){0.f, 0.f, 0.f, 0.f}, sn = sacc * g.cd;
#pragma unroll
    for (int ks = 0; ks < 2; ++ks) { const bf16x8 ubf = *(const bf16x8*)(Up + fr * 72 + ks * 32 + fq * 8);
        oo = MFMA16(g.aqg[ks], sb[ks], oo); oo = MFMA16(g.aqk[ks], ubf, oo); sn = MFMA16(g.akt[ks], ubf, sn); }
    sacc = sn;
    {
        const bool ev = (fr & 1) == 0;
        const float r0 = lane_xor1_f(ev ? oo[2] : oo[0]), r1 = lane_xor1_f(ev ? oo[3] : oo[1]);
        const unsigned p0 = ev ? pk2(oo[0], r0) : pk2(r0, oo[2]), p1 = ev ? pk2(oo[1], r1) : pk2(r1, oo[3]);
#pragma unroll
        for (int q = 0; q < 2; ++q) { const int s = wv * 16 + fq * 4 + (ev ? 0 : 2) + q, tok = dr ? 63 - s : s;
            *(unsigned*)(w.og + ((size_t)dr * R + rbase + tok) * 256 + h * 64 + vs * 16 + (fr & 14)) = q ? p1 : p0; }
    }
}
DI void gdn_scan_unit(const Params& p, const WS& w, int layer, int b, int h, int dr, int vs, char* smem) {
    static_assert(NCHG % 4 == 0, "scan ring assumes a multiple of 4 chunks");
    bf16_t* Sb = (bf16_t*)smem; bf16_t* Ub = Sb + 2 * 16 * 72;
    const int tid = tidx(), lane = tid & 63, wv = tid >> 6, fr = lane & 15, fq = lane >> 4;
    const size_t cb = (size_t)((b * 4 + h) * 2 + dr) * NCHG;
    __syncthreads();
    if (wv < 4) {
        f32x4 sacc = (f32x4){0.f, 0.f, 0.f, 0.f};
        GdnOps r0, r1, r2, r3;
        gdn_load_ops(r0, w, cb, wv, fr, fq, vs); gdn_load_ops(r1, w, cb + 1, wv, fr, fq, vs); gdn_load_ops(r2, w, cb + 2, wv, fr, fq, vs); gdn_load_ops(r3, w, cb + 3, wv, fr, fq, vs);
#define GDN_STEP(RG, K) do { const int sc_ = sc + (K); const int cgi = dr == 0 ? sc_ : (sc_ < NCG ? NCG - 1 - sc_ : NCG + (NLG - 1 - (sc_ - NCG))); \
        gdn_scan_step(RG, sacc, Sb + (K & 1) * 16 * 72, Ub + (K & 1) * 16 * 72, w, cgi < NCG ? RL + b * CTX + cgi * 64 : b * SEQ + (cgi - NCG) * 64, dr, h, vs, wv, fr, fq); \
        gdn_load_ops(RG, w, cb + (sc_ + 4 < NCHG ? sc_ + 4 : NCHG - 1), wv, fr, fq, vs); } while (0)
#pragma unroll 1
        for (int sc = 0; sc < NCHG; sc += 4) { GDN_STEP(r0, 0); GDN_STEP(r1, 1); GDN_STEP(r2, 2); GDN_STEP(r3, 3); }
#undef GDN_STEP
    } else {
#pragma unroll 1
        for (int sc = 0; sc < NCHG; ++sc) { LDS_BARRIER(); LDS_BARRIER(); }
    }
    __syncthreads();
}
DI void gdn_finish(const Params& p, const WS& w, int layer, int skip) {
    const int lane = tidx() & 63, wv = tidx() >> 6; const int nrows = layer == DEPTH - 1 ? RL : R;
    if (bidx() < skip) return;
    for (int row = (bidx() - skip) * 8 + wv; row < nrows; row += (gridDim.x - skip) * 8) {
        const u32x2 av = *(const u32x2*)(w.og + (size_t)row * 256 + lane * 4), cv = *(const u32x2*)(w.og + ((size_t)R + row) * 256 + lane * 4);
        const f32x4 o = (f32x4){bf_lo(av[0]) + bf_lo(cv[0]), bf_hi(av[0]) + bf_hi(cv[0]), bf_lo(av[1]) + bf_lo(cv[1]), bf_hi(av[1]) + bf_hi(cv[1])};
        float ss = o[0] * o[0] + o[1] * o[1] + o[2] * o[2] + o[3] * o[3];
        ss = sum16(ss);
        const float rs = 1.0f / sqrtf(ss * (1.0f / 64.0f) + 1e-6f); const f32x4 ng = *(const f32x4*)(p.gdn_norm + layer * 64 + (lane & 15) * 4);
        const u32x2 gv = *(const u32x2*)(w.p + (size_t)row * PW + C_GG + lane * 4);
        const float g0 = __uint_as_float(gv[0] << 16), g1 = __uint_as_float(gv[0] & 0xffff0000u), g2 = __uint_as_float(gv[1] << 16), g3 = __uint_as_float(gv[1] & 0xffff0000u);
        u32x2 ov; ov[0] = pk2(o[0] * rs * ng[0] * siluf(g0), o[1] * rs * ng[1] * siluf(g1)); ov[1] = pk2(o[2] * rs * ng[2] * siluf(g2), o[3] * rs * ng[3] * siluf(g3));
        *(u32x2*)(w.mix + (size_t)row * 1024 + 512 + lane * 4) = ov;
    }
}

DI void phase_diff(const Params& p, int layer, char* smem) {
    const WS w = ws_of(p.ws); const bool full_ctx = layer < DEPTH - 1;
    constexpr int QB = SEQ / 256, QC = CTX / 256;
    const int n_diff = NB * 4 * QB, n_diffc = full_ctx ? NB * 4 * QC : 0;
    int lyr = layer;
#ifndef EMU
    asm volatile("" : "+s"(lyr));
#endif
    const float lam_init = 0.8f - 0.6f * __expf(-0.3f * (float)lyr);
    float lam; { const float* lp = p.diff_lambda + layer * 128; const int ln = tidx() & 63; float s1 = 0.f, s2 = 0.f; if (ln < 32) { s1 = lp[ln] * lp[32 + ln]; s2 = lp[64 + ln] * lp[96 + ln]; }
        s1 = wsum(s1); s2 = wsum(s2); lam = __expf(s1) - __expf(s2) + lam_init; }
    for (int r0 = bidx(); r0 < n_diff + n_diffc; r0 += gridDim.x) {
        int r = r0; if (r0 < n_diff && (NB * 4) % 8 == 0) { const int x = r0 & 7, y = r0 >> 3, bh = x + 8 * (y / QB), qb_ = y % QB; r = bh * QB + qb_; }
        const bool isc = r >= n_diff; const int rr = isc ? r - n_diff : r, nq = isc ? QC : QB, qb = rr % nq, h = (rr / nq) & 3, b = rr / (nq * 4);
        const int qrow = (isc ? RL + b * CTX : b * SEQ) + qb * 256;
        attn_unit<2>(w.p, qrow, C_DQ + h * 64, C_DK + h * 64, C_DV + h * 64, isc ? RL + b * CTX : b * SEQ, isc ? CTX / 64 : SEQ / 64, 0, false, RL + b * CTX, isc ? 0 : CTX / 64, 0,
                     -1e30f, 0.f, lam, 1.0f - lam_init, p.diff_norm + layer * 64, w.mix + (size_t)qrow * 1024 + 256 + h * 64, smem);
    }
}
DI void phase_swa(const Params& p, int layer, char* smem) {
    const WS w = ws_of(p.ws); const bool full_ctx = layer < DEPTH - 1;
    constexpr int QB = SEQ / 256, QC = CTX / 256;
    const int n_swa = NB * 4 * QB, n_swac = full_ctx ? NB * 4 * QC : 0;
    for (int r0 = bidx(); r0 < n_swa + n_swac; r0 += gridDim.x) {
        int r = r0; if (r0 < n_swa && (NB * 4) % 8 == 0) { const int x = r0 & 7, y = r0 >> 3, bh = x + 8 * (y / QB), qb_ = y % QB; r = bh * QB + qb_; }
        const bool isc = r >= n_swa; const int rr = isc ? r - n_swa : r, nq = isc ? QC : QB, qb = rr % nq, hh = (rr / nq) & 3, b = rr / (nq * 4), hk = hh >> 1;
        const int qrow = (isc ? RL + b * CTX : b * SEQ) + qb * 256;
        const int ks = qb * 256 - 128 < 0 ? 0 : qb * 256 - 128, ke = qb * 256 + 384 > SEQ ? SEQ : qb * 256 + 384;
        attn_unit<1>(w.p, qrow, C_SQ + hh * 64, C_SK + hk * 64, C_SV + hk * 64, isc ? RL + b * CTX : b * SEQ + ks, isc ? CTX / 64 : (ke - ks) / 64, isc ? 0 : ks, !isc, RL + b * CTX, isc ? 0 : CTX / 64, qb * 256,
                     p.swa_sink[layer * 4 + hh] * LOG2E, 1.0f, 0.f, 1.0f, nullptr, w.mix + (size_t)qrow * 1024 + 768 + hh * 64, smem);
    }
}
DI void phase_gdnp(const Params& p, int layer, char* smem) {
    const WS w = ws_of(p.ws);
    for (int r = bidx(); r < NB * 4 * NCHG; r += gridDim.x) { const int cg = r % NCHG, h = (r / NCHG) & 3, b = r / (NCHG * 4); gdn_prep_unit(p, w, layer, b, h, cg, smem); }
}
DI void phase_rkv(const Params& p, int layer, char* smem) {
    const WS w = ws_of(p.ws);
    const int G = gridDim.x;
    for (int r = (bidx() + G / 2) % G; r < NB * 4 * NCHR; r += G) { const int ci = r % NCHR, h = (r / NCHR) & 3, b = r / (NCHR * 4); ret_kv_unit(p, w, layer, b, h, ci, smem); }
}
DI void phase_mix2(const Params& p, int layer, char* smem) {
    const WS w = ws_of(p.ws);
    for (int u = bidx(); u < NB * 4 * 2 * 4; u += gridDim.x) {
        const int x = u & 7, y = u >> 3, vs = y & 3, chain = x + 8 * (y >> 2), dr = chain & 1, h = (chain >> 1) & 3, b = chain >> 3;
        gdn_scan_unit(p, w, layer, b, h, dr, vs, smem); }
    ret_scan(p, w, layer);
}
DI void phase_mix3(const Params& p, int layer, char* smem) {
    const WS w = ws_of(p.ws); const bool full_ctx = layer < DEPTH - 1;
    for (int u = bidx(); u < NB * 4 * NCHR; u += gridDim.x) { const int ci = u % NCHR, h = (u / NCHR) & 3, b = u / (NCHR * 4); if (ci < NCC && !full_ctx) continue; ret_out_unit(p, w, layer, b, h, ci, smem); }
    const int G = gridDim.x, nun = NB * 4 * (full_ctx ? NCHR : NLC), rem = nun % G;
    gdn_finish(p, w, layer, (rem > 0 && rem <= G / 2) ? rem : 0);
}

DI int block_sum(int v, int* red) {
    const int lane = tidx() & 63, wv = tidx() >> 6;
    const int s = wsum_i(v);
    __syncthreads(); if (lane == 0) red[wv] = s; __syncthreads();
    int t = 0;
#pragma unroll
    for (int i = 0; i < 8; ++i) t += red[i];
    return t;
}
DI int block_exscan(int v, int* red) {
    const int lane = tidx() & 63, wv = tidx() >> 6;
    int s = v;
#pragma unroll
    for (int d = 1; d < 64; d <<= 1) { const int o = lane_shfl_i(s, lane >= d ? lane - d : lane); if (lane >= d) s += o; }
    __syncthreads(); if (lane == 63) red[wv] = s; __syncthreads();
    int off = 0;
#pragma unroll
    for (int i = 0; i < 8; ++i) if (i < wv) off += red[i];
    return off + s - v;
}
template <int N, int CAP> DI void topk_unit(const WS& w, const float* __restrict__ aff, int rowbase, int slotbase, int e, int* red) {
    constexpr int PT = (N + NT - 1) / NT;
    const int tid = tidx(); unsigned key[PT];
#pragma unroll
    for (int i = 0; i < PT; ++i) { const int n = tid * PT + i; key[i] = n < N ? __float_as_uint(aff[n]) : 0u; }
    unsigned T = 0u;
    for (int bit = 30; bit >= 0; --bit) { const unsigned cand = T | (1u << bit); int c = 0;
#pragma unroll
        for (int i = 0; i < PT; ++i) c += (tid * PT + i < N && key[i] >= cand) ? 1 : 0;
        if (block_sum(c, red) >= CAP) T = cand; }
    int cg = 0, ce = 0;
#pragma unroll
    for (int i = 0; i < PT; ++i) { const bool in = tid * PT + i < N; cg += (in && key[i] > T) ? 1 : 0; ce += (in && key[i] == T) ? 1 : 0; }
    const int need = CAP - block_sum(cg, red); const int eoff = block_exscan(ce, red);
    int sel = 0, er = eoff; bool flag[PT];
#pragma unroll
    for (int i = 0; i < PT; ++i) { const bool in = tid * PT + i < N; bool f = in && key[i] > T; if (in && key[i] == T) { f = er < need; ++er; } flag[i] = f; sel += f ? 1 : 0; }
    int slot = block_exscan(sel, red);
    int* selrow = red + 32;
#pragma unroll
    for (int i = 0; i < PT; ++i) { const int n = tid * PT + i; int iv = -1;
        if (n < N) { if (flag[i]) { iv = slotbase + slot; w.idx[(size_t)e * ROWS_E + iv] = rowbase + n; w.wgt[(size_t)e * ROWS_E + iv] = __uint_as_float(key[i]); selrow[slot] = rowbase + n; ++slot; }
            w.inv[(size_t)(rowbase + n) * 16 + e] = iv; } }
    __syncthreads();
}
DI void phase_topk(const Params& p, int layer, char* smem) {
    const WS w = ws_of(p.ws); int* red = (int*)smem; const bool full_ctx = layer < DEPTH - 1;
    for (int u = bidx(); u < 2 * NB * 16; u += gridDim.x) {
        const bool isc = u >= NB * 16; const int v = isc ? u - NB * 16 : u, b = v >> 4, e = v & 15;
        if (!isc) topk_unit<SEQ, CAPL>(w, w.aff + ((size_t)b * 16 + e) * SEQ, b * SEQ, b * CAPL, e, red);
        else if (full_ctx) topk_unit<CTX, CAPC>(w, w.aff + (size_t)RL * 16 + ((size_t)b * 16 + e) * CTX, RL + b * CTX, NB * CAPL + b * CAPC, e, red);
        else { for (int i = tidx(); i < CAPC; i += NT) { w.idx[(size_t)e * ROWS_E + NB * CAPL + b * CAPC + i] = 0; w.wgt[(size_t)e * ROWS_E + NB * CAPL + b * CAPC + i] = 0.f; } }
    }
    {
        const int G = gridDim.x, c = bidx(), first = G > NB * 16 ? NB * 16 : 0;
        if (c >= first) { __syncthreads(); cvt_stream<4>(p, w, smem, layer, c - first, G - first); }
    }
}

enum { PH_CVT = 0, PH_INIT, PH_INPROJ, PH_PREP, PH_DIFF, PH_MIX2, PH_MIX3, PH_OUTPROJ, PH_LN0, PH_TOPK, PH_MOE1, PH_MOE2, PH_LN1, PH_SWA, PH_GDNP, PH_RKV };
#ifdef EMU
#define SMEM_PTR(s) char* s = emu::B->lds
#else
extern __shared__ __attribute__((aligned(16))) char dyn_smem[];
#define SMEM_PTR(s) char* s = dyn_smem
#endif
template <int PH> DI void run_phase(const Params& p, int layer, char* smem) {
    if (PH == PH_CVT) phase_cvt(p, smem);
    else if (PH == PH_INIT) phase_rows<0>(p, 0, smem);
    else if (PH == PH_INPROJ) phase_inproj(p, layer, smem);
    else if (PH == PH_PREP) phase_prep(p, layer, smem);
    else if (PH == PH_DIFF) phase_diff(p, layer, smem);
    else if (PH == PH_SWA) phase_swa(p, layer, smem);
    else if (PH == PH_GDNP) phase_gdnp(p, layer, smem);
    else if (PH == PH_RKV) phase_rkv(p, layer, smem);
    else if (PH == PH_MIX2) phase_mix2(p, layer, smem);
    else if (PH == PH_MIX3) phase_mix3(p, layer, smem);
    else if (PH == PH_OUTPROJ) phase_outproj(p, layer, smem);
    else if (PH == PH_LN0) phase_rows<1>(p, layer, smem);
    else if (PH == PH_TOPK) phase_topk(p, layer, smem);
    else if (PH == PH_MOE1) phase_moe1(p, layer, smem);
    else if (PH == PH_MOE2) phase_moe2(p, layer, smem);
    else if (PH == PH_LN1) phase_rows<2>(p, layer, smem);
}
constexpr int LDS_BYTES = 8 * G_HT * 2 + 2048;
template <int PH> __global__ void __launch_bounds__(NT, 2) k_phase(Params p, int layer) { SMEM_PTR(smem); run_phase<PH>(p, layer, smem); }

#ifdef EMU
void (*emu_hook)(const char* tag, int layer, char* ws) = nullptr;
#define HOOK(t, l) do { if (emu_hook) emu_hook(t, l, (char*)d_ws); } while (0)
#else
#define HOOK(t, l)
#endif
template <int PH> static void launch_phase1(const Params& p, int layer, int grid, hipStream_t stream);
template <int PH> static void launch_phase(const Params& p, int layer, int grid, hipStream_t stream) { launch_phase1<PH>(p, layer, grid, stream); if ((PROBE_REP >> PH) & 1) launch_phase1<PH>(p, layer, grid, stream); }
template <int PH> static void launch_phase1(const Params& p, int layer, int grid, hipStream_t stream) {
#ifndef EMU
    static bool done = false; if (!done) { hipFuncSetAttribute((const void*)k_phase<PH>, hipFuncAttributeMaxDynamicSharedMemorySize, LDS_BYTES); done = true; }
#endif
    hipLaunchKernelGGL(k_phase<PH>, dim3(grid), dim3(NT), LDS_BYTES, stream, p, layer);
}

#ifndef MK_MULTI
#define MK_MULTI 0
#endif
#ifdef EMU
#define PHASE(PH, l) run_phase<PH>(p, l, emu::B->lds)
#define GRID_BARRIER() do { XcdBarrier bar_; bar_.bar = (unsigned*)(p.ws + OFF_BAR); xcd_barrier(bar_); } while (0)
#else
typedef const __attribute__((address_space(4))) Params* KParams;
DI KParams kparams() { KParams kp = (KParams)__builtin_amdgcn_kernarg_segment_ptr(); asm volatile("" : "+s"(kp)); return kp; }
template <int PH> DI void run_phase_k(int layer) { const Params* gp = (const Params*)kparams(); const Params p = *gp; run_phase<PH>(p, layer, dyn_smem); }
DI void grid_barrier_k() { XcdBarrier b; b.bar = (unsigned*)(kparams()->ws + OFF_BAR); b.x = xb_xcc_id(); b.st = (volatile LAS unsigned*)&dyn_smem[8 * G_HT * 2]; xcd_barrier(b); }
#define PHASE(PH, l) run_phase_k<PH>(l)
#define GRID_BARRIER() grid_barrier_k()
#endif
#if !MK_MULTI
__global__ void __launch_bounds__(NT, 2) k_mega(Params p) {
#ifndef EMU
    {   volatile LAS unsigned* st = (volatile LAS unsigned*)&dyn_smem[8 * G_HT * 2];
        if (threadIdx.x == 0) { st[0] = 0u; st[1] = 0u; st[2] = 0u; st[3] = 0u; }
        __syncthreads();
        (void)xcd_barrier_post((unsigned*)(kparams()->ws + OFF_BAR), st); }
#endif
#define PHASE_R(PH, l) do { PHASE(PH, l); if ((PROBE_REP >> PH) & 1) { GRID_BARRIER(); PHASE(PH, l); } } while (0)
    PHASE_R(PH_CVT, 0); GRID_BARRIER();
    PHASE_R(PH_INIT, 0); GRID_BARRIER();
    for (int l = 0; l < DEPTH; ++l) {
        PHASE_R(PH_INPROJ, l); GRID_BARRIER();
        PHASE_R(PH_DIFF, l); PHASE_R(PH_SWA, l); PHASE_R(PH_GDNP, l); PHASE_R(PH_RKV, l); GRID_BARRIER();
        PHASE_R(PH_MIX2, l); GRID_BARRIER();
        PHASE_R(PH_MIX3, l); GRID_BARRIER();
        PHASE_R(PH_OUTPROJ, l); GRID_BARRIER();
        PHASE(PH_LN0, l); GRID_BARRIER();
        PHASE_R(PH_TOPK, l); GRID_BARRIER();
        PHASE_R(PH_MOE1, l); GRID_BARRIER();
        PHASE_R(PH_MOE2, l); GRID_BARRIER();
        PHASE(PH_LN1, l); if (l + 1 < DEPTH) GRID_BARRIER();
    }
}
#endif

extern "C" void kernel_launch(void* const* d_in, const int* in_sizes, int n_in, void* d_out, int out_size, void* d_ws, size_t ws_size, hipStream_t stream) {
    Params p{};
    const float* const* in = (const float* const*)d_in;
    p.x = in[0]; p.c = in[1]; p.ctx = in[2]; p.c_ctx = in[3]; p.ada_w = in[4]; p.ada_b = in[5]; p.w_in = in[6]; p.w_out = in[7]; p.ret_decay = in[8]; p.diff_lambda = in[9];
    p.diff_norm = in[10]; p.gdn_conv = in[11]; p.gdn_a_log = in[12]; p.gdn_dt_bias = in[13]; p.gdn_norm = in[14]; p.swa_sink = in[15]; p.ln_g = in[16]; p.ln_b = in[17];
    p.router_w = in[18]; p.w_gate = in[19]; p.w_up = in[20]; p.w_down = in[21]; p.out = (float*)d_out; p.ws = (char*)d_ws;
    static int cus = 0;
    if (!cus) { int dev = 0; hipGetDevice(&dev); hipDeviceGetAttribute(&cus, hipDeviceAttributeMultiprocessorCount, dev); if (cus <= 0) cus = 256; }
    const int grid = cus;
#if MK_MULTI
    launch_phase<PH_CVT>(p, 0, grid, stream); HOOK("cvt", 0);
    launch_phase<PH_INIT>(p, 0, grid, stream); HOOK("init", 0);
    for (int l = 0; l < DEPTH; ++l) {
        launch_phase<PH_INPROJ>(p, l, grid, stream); HOOK("inproj", l);
        launch_phase<PH_DIFF>(p, l, grid, stream); launch_phase<PH_SWA>(p, l, grid, stream); launch_phase<PH_GDNP>(p, l, grid, stream); launch_phase<PH_RKV>(p, l, grid, stream);
        launch_phase<PH_MIX2>(p, l, grid, stream);
        launch_phase<PH_MIX3>(p, l, grid, stream); HOOK("mix", l);
        launch_phase<PH_OUTPROJ>(p, l, grid, stream);
        launch_phase<PH_LN0>(p, l, grid, stream); HOOK("ln0", l);
        launch_phase<PH_TOPK>(p, l, grid, stream);
        launch_phase<PH_MOE1>(p, l, grid, stream);
        launch_phase<PH_MOE2>(p, l, grid, stream);
        launch_phase<PH_LN1>(p, l, grid, stream); HOOK("ln1", l);
    }
#else
    hipMemsetAsync((char*)d_ws + OFF_BAR, 0, XCD_BAR_WORDS * sizeof(unsigned), stream);
#ifndef EMU
    static bool attr = false; if (!attr) { hipFuncSetAttribute((const void*)k_mega, hipFuncAttributeMaxDynamicSharedMemorySize, LDS_BYTES); attr = true; }
#endif
    hipLaunchKernelGGL(k_mega, dim3(grid), dim3(NT), LDS_BYTES, stream, p);
#endif
}
```

```cpp
#ifndef EMU
#include <hip/hip_runtime.h>
#endif
#include <stdint.h>
#include <stddef.h>
#include <math.h>

#ifndef CFG_B
#define CFG_B 8
#define CFG_SEQ 4096
#define CFG_CTX 256
#define CFG_DEPTH 4
#define CFG_FF 2048
#endif

#ifndef PROBE_REP
#define PROBE_REP 0
#endif
#define DI __device__ __forceinline__
typedef unsigned short bf16_t;
typedef short bf16x8 __attribute__((ext_vector_type(8)));
typedef short s16x4 __attribute__((ext_vector_type(4)));
typedef float f32x4 __attribute__((ext_vector_type(4)));
typedef unsigned u32x4 __attribute__((ext_vector_type(4)));
typedef unsigned u32x2 __attribute__((ext_vector_type(2)));

constexpr int NB = CFG_B, SEQ = CFG_SEQ, CTX = CFG_CTX, DEPTH = CFG_DEPTH, FF = CFG_FF, DM = 1024, NE = 16;
constexpr int RL = NB * SEQ, RC = NB * CTX, R = RL + RC;
constexpr int CAPL = SEQ / 8, CAPC = CTX / 8, ROWS_E = NB * (CAPL + CAPC);
constexpr int INW = 3344, PW = 3328;
constexpr int NT = 512;
constexpr int NCC = CTX / 128, NLC = SEQ / 128, NCHR = NCC + NLC;
constexpr int NCG = CTX / 64, NLG = SEQ / 64, NCHG = NCG + NLG;
constexpr float ALPHA = 1.681792830507429f;
constexpr float LOG2E = 1.4426950408889634f;
constexpr int C_RQ = 0, C_RK = 256, C_RV = 512, C_RG = 768, C_DQ = 1024, C_DK = 1280, C_DV = 1536, C_GQKV = 1792, C_GG = 2560, C_SQ = 2816, C_SK = 3072, C_SV = 3200;

constexpr size_t al256(size_t x) { return (x + 255) & ~(size_t)255; }
constexpr size_t OFF_BAR = 0;
constexpr size_t OFF_MOD = 16384;
constexpr size_t OFF_TAB = OFF_MOD + al256((size_t)DEPTH * (NB + 1) * 6144 * 4);
constexpr size_t OFF_WIN = OFF_TAB + al256((size_t)SEQ * 160 * 4);
constexpr size_t OFF_WOUT = OFF_WIN + al256((size_t)DEPTH * PW * 1024 * 2);
constexpr size_t OFF_WGU = OFF_WOUT + al256((size_t)DEPTH * 1024 * 1024 * 2);
constexpr size_t OFF_WDN = OFF_WGU + al256((size_t)DEPTH * 16 * 2 * FF * 1024 * 2);
constexpr size_t OFF_H = OFF_WDN + al256((size_t)DEPTH * 16 * 1024 * FF * 2);
constexpr size_t OFF_U = OFF_H + al256((size_t)R * 1024 * 4);
constexpr size_t OFF_GAB = OFF_U + al256((size_t)R * 1024 * 2);
constexpr size_t OFF_MIX = OFF_GAB + al256((size_t)R * 16 * 4);
constexpr size_t OFF_AFF = OFF_MIX + al256((size_t)R * 1024 * 2);
constexpr size_t OFF_IDX = OFF_AFF + al256((size_t)R * 16 * 4);
constexpr size_t OFF_WGT = OFF_IDX + al256((size_t)16 * ROWS_E * 4);
constexpr size_t OFF_INV = OFF_WGT + al256((size_t)16 * ROWS_E * 4);
constexpr size_t OFF_U8 = OFF_INV + al256((size_t)R * 16 * 4);
constexpr size_t OFF_ARA = OFF_U8 + al256((size_t)R * 1024);
constexpr size_t SZ_P = (size_t)R * PW * 2, SZ_HID8 = al256((size_t)16 * ROWS_E * FF), SZ_XIN8 = al256((size_t)16 * ROWS_E * 1024), SZ_HID = SZ_HID8 + SZ_XIN8;
constexpr size_t OFF_ARB = OFF_ARA + al256(SZ_P > SZ_HID ? SZ_P : SZ_HID);
constexpr size_t SZ_RKV = (size_t)NB * 4 * 2 * NCHR * 4096 * 4;
constexpr size_t GCH = (size_t)NB * 4 * 2 * NCHG;
constexpr size_t OB_RKV = 0, OB_RS = OB_RKV + al256(SZ_RKV), OB_GW = OB_RS + al256(SZ_RKV), OB_GQG = OB_GW + GCH * 8192, OB_GQK = OB_GQG + GCH * 8192,
                 OB_GKT = OB_GQK + GCH * 8192, OB_GUB = OB_GKT + GCH * 8192, OB_GCD = OB_GUB + GCH * 16384, OB_OG = OB_GCD + al256(GCH * 4), OB_END = OB_OG + (size_t)2 * R * 256 * 4;
constexpr size_t SZ_MIXO = (size_t)R * 1024 * 4, SZ_Y = (size_t)16 * ROWS_E * 1024 * 2;
constexpr size_t SZ_ARB = OB_END > SZ_MIXO ? (OB_END > SZ_Y ? OB_END : SZ_Y) : (SZ_MIXO > SZ_Y ? SZ_MIXO : SZ_Y);
constexpr size_t WS_TOTAL = OFF_ARB + al256(SZ_ARB);

struct Params {
    const float *x, *c, *ctx, *c_ctx, *ada_w, *ada_b, *w_in, *w_out, *ret_decay, *diff_lambda, *diff_norm, *gdn_conv, *gdn_a_log, *gdn_dt_bias,
        *gdn_norm, *swa_sink, *ln_g, *ln_b, *router_w, *w_gate, *w_up, *w_down;
    float* out; char* ws;
};

#ifdef EMU
#define NT_LOAD(p) (*(p))
#define NT_STORE(v, p) (*(p) = (v))
#else
#define NT_LOAD(p) __builtin_nontemporal_load(p)
#define NT_STORE(v, p) __builtin_nontemporal_store((v), (p))
#endif
DI float bf2f(bf16_t v) { return __uint_as_float(((unsigned)v) << 16); }
DI bf16_t f2bf(float f) { unsigned u = __float_as_uint(f); u += 0x7fffu + ((u >> 16) & 1u); return (bf16_t)(u >> 16); }
DI unsigned pk2(float lo, float hi) {
#ifdef EMU
    return (unsigned)f2bf(lo) | ((unsigned)f2bf(hi) << 16);
#else
    typedef float f32x2_ __attribute__((ext_vector_type(2))); typedef __bf16 bf16x2_ __attribute__((ext_vector_type(2)));
    const f32x2_ v = {lo, hi}; return __builtin_bit_cast(unsigned, __builtin_convertvector(v, bf16x2_));
#endif
}
#ifdef EMU
DI int max(int a, int b) { return a > b ? a : b; }
DI int tidx() { return (int)threadIdx.x; }
DI int bidx() { return (int)blockIdx.x; }
#else
DI int tidx() { int t = threadIdx.x; asm volatile("" : "+v"(t)); return t; }
DI int bidx() { int b = blockIdx.x; asm volatile("" : "+s"(b)); return b; }
#endif
constexpr float SW1 = 32.0f, SW2 = 64.0f, SH = 8.0f, SY = 64.0f;
DI unsigned pk4_fp8(float a, float b, float c, float d) {
    a = fminf(fmaxf(a, -448.f), 448.f); b = fminf(fmaxf(b, -448.f), 448.f); c = fminf(fmaxf(c, -448.f), 448.f); d = fminf(fmaxf(d, -448.f), 448.f);
    int r = __builtin_amdgcn_cvt_pk_fp8_f32(a, b, 0, false); r = __builtin_amdgcn_cvt_pk_fp8_f32(c, d, r, true); return (unsigned)r; }
#ifdef EMU
DI float sum8(float v) { for (int m = 4; m >= 1; m >>= 1) v += __shfl_xor(v, m); return v; }
DI float sum16(float v) { for (int m = 8; m >= 1; m >>= 1) v += __shfl_xor(v, m); return v; }
DI float wsum(float v) { for (int m = 32; m >= 1; m >>= 1) v += __shfl_xor(v, m); return v; }
DI int wsum_i(int v) { for (int m = 32; m >= 1; m >>= 1) v += __shfl_xor(v, m); return v; }
DI int lane_bcast(int v, int src) { return __shfl(v, src); }
DI int lane_shfl_i(int v, int src) { return __shfl(v, src); }
DI float lane_shfl_f(float v, int src) { return __shfl(v, src); }
#else
template <int CTRL> DI float dpp_f(float x) { return __int_as_float(__builtin_amdgcn_update_dpp(0, __float_as_int(x), CTRL, 0xF, 0xF, true)); }
template <int CTRL> DI int dpp_i(int x) { return __builtin_amdgcn_update_dpp(0, x, CTRL, 0xF, 0xF, true); }
DI float sum8(float x) { x += dpp_f<0xB1>(x); x += dpp_f<0x4E>(x); x += dpp_f<0x141>(x); return x; }
DI float sum16(float x) { x += dpp_f<0xB1>(x); x += dpp_f<0x4E>(x); x += dpp_f<0x141>(x); x += dpp_f<0x140>(x); return x; }
DI float wsum(float x) { x = sum16(x);
    auto a = __builtin_amdgcn_permlane16_swap(__float_as_uint(x), __float_as_uint(x), false, false); x = __uint_as_float(a[0]) + __uint_as_float(a[1]);
    auto b = __builtin_amdgcn_permlane32_swap(__float_as_uint(x), __float_as_uint(x), false, false); return __uint_as_float(b[0]) + __uint_as_float(b[1]); }
DI int wsum_i(int x) { x += dpp_i<0xB1>(x); x += dpp_i<0x4E>(x); x += dpp_i<0x141>(x); x += dpp_i<0x140>(x);
    auto a = __builtin_amdgcn_permlane16_swap((unsigned)x, (unsigned)x, false, false); x = (int)a[0] + (int)a[1];
    auto b = __builtin_amdgcn_permlane32_swap((unsigned)x, (unsigned)x, false, false); return (int)b[0] + (int)b[1]; }
DI int lane_bcast(int v, int src) { return __builtin_amdgcn_readlane(v, src); }
DI int lane_shfl_i(int v, int src) { return __builtin_amdgcn_ds_bpermute(src << 2, v); }
DI float lane_shfl_f(float v, int src) { return __int_as_float(__builtin_amdgcn_ds_bpermute(src << 2, __float_as_int(v))); }
#endif
#ifdef EMU
DI float lane_xor1_f(float x) { return __shfl_xor(x, 1); }
#else
DI float lane_xor1_f(float x) { return __int_as_float(__builtin_amdgcn_update_dpp(0, __float_as_int(x), 0xB1, 0xF, 0xF, true)); }
#endif
DI float bf_lo(unsigned v) { return __uint_as_float(v << 16); }
DI float bf_hi(unsigned v) { return __uint_as_float(v & 0xffff0000u); }
DI float siluf(float x) { return x * __builtin_amdgcn_rcpf(1.0f + __builtin_amdgcn_exp2f(-LOG2E * x)); }
DI float sigmoidf_(float x) { return __builtin_amdgcn_rcpf(1.0f + __builtin_amdgcn_exp2f(-LOG2E * x)); }
DI float softplusf_(float x) { return x > 20.0f ? x : 0.6931471805599453f * __builtin_amdgcn_logf(1.0f + __builtin_amdgcn_exp2f(x * LOG2E)); }
DI float ex2(float x) { return __builtin_amdgcn_exp2f(x); }
DI f32x4 MFMA16(bf16x8 a, bf16x8 b, f32x4 c) { return __builtin_amdgcn_mfma_f32_16x16x32_bf16(a, b, c, 0, 0, 0); }
typedef int i32x8 __attribute__((ext_vector_type(8)));
typedef unsigned u32x8 __attribute__((ext_vector_type(8)));
DI f32x4 mfma_fp8(u32x8 a, u32x8 b, f32x4 c) {
    return __builtin_amdgcn_mfma_scale_f32_16x16x128_f8f6f4(__builtin_bit_cast(i32x8, a), __builtin_bit_cast(i32x8, b), c, 0, 0, 0, 0x7F7F7F7F, 0, 0x7F7F7F7F); }
DI bf16x8 frag_lo(u32x8 v) { const u32x4 h = __builtin_shufflevector(v, v, 0, 1, 2, 3); return __builtin_bit_cast(bf16x8, h); }
DI bf16x8 frag_hi(u32x8 v) { const u32x4 h = __builtin_shufflevector(v, v, 4, 5, 6, 7); return __builtin_bit_cast(bf16x8, h); }
#ifdef EMU
#define WAIT_V(n)
#define STAGGER_SLEEP(flag)
#define WAIT_L(n)
#else
#define WAIT_V(n) asm volatile("s_waitcnt vmcnt(" #n ")" ::: "memory")
#ifndef STAG_N
#define STAG_N 6
#endif
#define STAG_STR2(x) #x
#define STAG_STR(x) STAG_STR2(x)
#define STAGGER_SLEEP(flag) asm volatile("s_cmp_eq_u32 %0, 0\n\ts_cbranch_scc1 .Lstg%=\n\ts_sleep " STAG_STR(STAG_N) "\n.Lstg%=:" :: "s"(flag) : "memory", "scc")
#define WAIT_L(n) asm volatile("s_waitcnt lgkmcnt(" #n ")" ::: "memory")
#endif
#define BAR __builtin_amdgcn_s_barrier()
#define SCHED __builtin_amdgcn_sched_barrier(0)

#ifdef EMU
#define LDS_BARRIER() __syncthreads()
#else
#define LDS_BARRIER() do { asm volatile("s_waitcnt lgkmcnt(0)" ::: "memory"); __builtin_amdgcn_s_barrier(); asm volatile("" ::: "memory"); } while (0)
#endif
#ifdef EMU
DI float grp_max(float x) { x = fmaxf(x, __shfl_xor(x, 16)); return fmaxf(x, __shfl_xor(x, 32)); }
DI float grp_sum(float x) { x += __shfl_xor(x, 16); return x + __shfl_xor(x, 32); }
DI int grp_imax(int x) { int y = __shfl_xor(x, 16); x = x > y ? x : y; y = __shfl_xor(x, 32); return x > y ? x : y; }
DI s16x4 lds_tr16(const bf16_t* p) { return emu_lds_tr16(p); }
#else
DI float grp_max(float x) {
    auto a = __builtin_amdgcn_permlane16_swap(__float_as_uint(x), __float_as_uint(x), false, false); x = fmaxf(__uint_as_float(a[0]), __uint_as_float(a[1]));
    auto b = __builtin_amdgcn_permlane32_swap(__float_as_uint(x), __float_as_uint(x), false, false); return fmaxf(__uint_as_float(b[0]), __uint_as_float(b[1])); }
DI float grp_sum(float x) {
    auto a = __builtin_amdgcn_permlane16_swap(__float_as_uint(x), __float_as_uint(x), false, false); x = __uint_as_float(a[0]) + __uint_as_float(a[1]);
    auto b = __builtin_amdgcn_permlane32_swap(__float_as_uint(x), __float_as_uint(x), false, false); return __uint_as_float(b[0]) + __uint_as_float(b[1]); }
DI int grp_imax(int x) {
    auto a = __builtin_amdgcn_permlane16_swap((unsigned)x, (unsigned)x, false, false); x = max((int)a[0], (int)a[1]);
    auto b = __builtin_amdgcn_permlane32_swap((unsigned)x, (unsigned)x, false, false); return max((int)b[0], (int)b[1]); }
typedef short v4i16_t_ __attribute__((ext_vector_type(4)));
DI s16x4 lds_tr16(const bf16_t* p) { return __builtin_bit_cast(s16x4, __builtin_amdgcn_ds_read_tr16_b64_v4i16((__attribute__((address_space(3))) v4i16_t_*)p)); }
#endif
#ifdef EMU
struct XcdBarrier { unsigned* bar; };
DI XcdBarrier xcd_barrier_post(unsigned* bar, void*) { XcdBarrier b; b.bar = bar; return b; }
DI void xcd_barrier(const XcdBarrier& b) {
    __syncthreads();
    if (threadIdx.x == 0) { unsigned g = __atomic_load_n(&b.bar[64], __ATOMIC_SEQ_CST);
        if (__atomic_fetch_add(&b.bar[0], 1u, __ATOMIC_SEQ_CST) == gridDim.x - 1) { __atomic_store_n(&b.bar[0], 0u, __ATOMIC_SEQ_CST); __atomic_fetch_add(&b.bar[64], 1u, __ATOMIC_SEQ_CST); }
        else while (__atomic_load_n(&b.bar[64], __ATOMIC_SEQ_CST) == g) sched_yield(); }
    __syncthreads();
}
#define XCD_BAR_WORDS 3456
#else
#define XB_TMO      128
#define XB_XCNT(j)  (256  + 64 * (j))
#define XB_XSUB(j)  (1280 + 64 * (j))
#define XB_XGEN(j)  (2304 + 64 * (j))
#define XB_TOP      3328
#define XB_TOPGEN   3392
#define XCD_BAR_WORDS 3456
#define XB_SPIN_CAP (1u << 22)
#define LAS __attribute__((address_space(3)))
DI unsigned xb_ld(unsigned* p)              { return __hip_atomic_load(p, __ATOMIC_RELAXED, __HIP_MEMORY_SCOPE_AGENT); }
DI unsigned xb_add(unsigned* p, unsigned v) { return __hip_atomic_fetch_add(p, v, __ATOMIC_RELAXED, __HIP_MEMORY_SCOPE_AGENT); }
DI unsigned xb_xcc_id() { return (unsigned)__builtin_amdgcn_s_getreg((3 << 11) | 20) & 0xFu; }
#define XB_SPIN(cond, bar) do { unsigned _sp = 0; while (cond) { __builtin_amdgcn_s_sleep(1); \
    if ((++_sp & 255u) == 0u) { if (xb_ld(&(bar)[XB_TMO])) break; if (_sp > XB_SPIN_CAP) { atomicAdd(&(bar)[XB_TMO], 1u); break; } } } } while (0)
struct XcdBarrier { unsigned* bar; unsigned x; volatile LAS unsigned* st; };
DI XcdBarrier xcd_barrier_post(unsigned* bar, volatile LAS unsigned* st) {
    XcdBarrier b; b.bar = bar; b.x = xb_xcc_id(); b.st = st;
    if (threadIdx.x == 0) (void)xb_add(&bar[XB_XCNT(b.x)], 1u);
    return b;
}
DI void xcd_barrier_complete(unsigned* bar, unsigned x, unsigned& nloc, unsigned& nx) {
    const unsigned G = gridDim.x * gridDim.y * gridDim.z;
    unsigned sum, cnt, mine, sp = 0u;
    for (;;) {
        sum = 0u; cnt = 0u; mine = 0u;
#pragma unroll
        for (unsigned j = 0; j < 16; ++j) { const unsigned c = xb_ld(&bar[XB_XCNT(j)]); sum += c; cnt += (c > 0u) ? 1u : 0u; mine = (j == x) ? c : mine; }
        if (sum == G) break;
        __builtin_amdgcn_s_sleep(1);
        if ((++sp & 255u) == 0u) { if (xb_ld(&bar[XB_TMO])) break; if (sp > XB_SPIN_CAP) { atomicAdd(&bar[XB_TMO], 1u); break; } }
    }
    nloc = mine > 0u ? mine : 1u; nx = cnt > 0u ? cnt : 1u;
}
DI void xcd_barrier(const XcdBarrier& b) {
    asm volatile("s_waitcnt vmcnt(0)" ::: "memory");
    __syncthreads();
    if (threadIdx.x == 0) {
        unsigned* bar = b.bar;
        __builtin_amdgcn_s_waitcnt(0);
        unsigned nloc = b.st[0], nx = b.st[1];
        if (nloc == 0u) { xcd_barrier_complete(bar, b.x, nloc, nx); b.st[0] = nloc; b.st[1] = nx; }
        const unsigned old = xb_add(&bar[XB_XSUB(b.x)], 1u);
        const unsigned gen = old / nloc;
        if (old + 1u == (gen + 1u) * nloc) {
            __builtin_amdgcn_fence(__ATOMIC_RELEASE, "agent");
            asm volatile("s_waitcnt vmcnt(0)" ::: "memory");
            const unsigned og = xb_add(&bar[XB_TOP], 1u);
            const unsigned tg = og / nx;
            if (og + 1u == (tg + 1u) * nx) xb_add(&bar[XB_TOPGEN], 1u);
            else XB_SPIN(xb_ld(&bar[XB_TOPGEN]) == tg, bar);
            __builtin_amdgcn_fence(__ATOMIC_ACQUIRE, "agent");
            xb_add(&bar[XB_XGEN(b.x)], 1u);
            asm volatile("s_waitcnt vmcnt(0)" ::: "memory");
        } else {
            XB_SPIN(xb_ld(&bar[XB_XGEN(b.x)]) == gen, bar);
            __builtin_amdgcn_fence(__ATOMIC_ACQUIRE, "agent");
            asm volatile("s_waitcnt vmcnt(0)" ::: "memory");
        }
    }
    __syncthreads();
}
#endif

struct WS {
    unsigned* bar; float* mod; float* tab; bf16_t* win; bf16_t* wout; unsigned char* wgu; unsigned char* wdn; float* h; bf16_t* u; unsigned char* u8; float* gab; bf16_t* mix; float* aff;
    int* idx; float* wgt; int* inv; bf16_t* p; unsigned char* hid; unsigned char* xin; bf16_t* rkv; bf16_t* rs; bf16_t* gw; bf16_t* gqg; bf16_t* gqk; bf16_t* gkt; bf16_t* gub; float* gcd; bf16_t* og; bf16_t* mixo; unsigned char* y;
};
DI WS ws_of(char* w) {
    WS s; s.bar = (unsigned*)(w + OFF_BAR); s.mod = (float*)(w + OFF_MOD); s.tab = (float*)(w + OFF_TAB); s.win = (bf16_t*)(w + OFF_WIN); s.wout = (bf16_t*)(w + OFF_WOUT);
    s.wgu = (unsigned char*)(w + OFF_WGU); s.wdn = (unsigned char*)(w + OFF_WDN); s.u8 = (unsigned char*)(w + OFF_U8); s.h = (float*)(w + OFF_H); s.u = (bf16_t*)(w + OFF_U); s.gab = (float*)(w + OFF_GAB); s.mix = (bf16_t*)(w + OFF_MIX);
    s.aff = (float*)(w + OFF_AFF); s.idx = (int*)(w + OFF_IDX); s.wgt = (float*)(w + OFF_WGT); s.inv = (int*)(w + OFF_INV); s.p = (bf16_t*)(w + OFF_ARA); s.hid = (unsigned char*)(w + OFF_ARA); s.xin = (unsigned char*)(w + OFF_ARA + SZ_HID8);
    char* b = w + OFF_ARB; s.rkv = (bf16_t*)(b + OB_RKV); s.rs = (bf16_t*)(b + OB_RS); s.gw = (bf16_t*)(b + OB_GW); s.gqg = (bf16_t*)(b + OB_GQG); s.gqk = (bf16_t*)(b + OB_GQK);
    s.gkt = (bf16_t*)(b + OB_GKT); s.gub = (bf16_t*)(b + OB_GUB); s.gcd = (float*)(b + OB_GCD); s.og = (bf16_t*)(b + OB_OG); s.mixo = (bf16_t*)b; s.y = (unsigned char*)b;
    return s;
}

struct CvtJob { const float* src; char* dst; int src_ld, dst_ld  , mode  ; float scale; };
DI CvtJob cvt_job(const Params& p, const WS& w, int u) {
    constexpr int FT = FF / 128, n_in = 8 * 52, n_out = 8 * 16, n_g = 16 * 8 * (FF / 64), n_d = 16 * FT * 16, tot_l = n_in + n_out + 2 * n_g + n_d;
    const int l = u / tot_l; int r = u % tot_l; CvtJob j; j.scale = 1.0f;
    if (r < n_in) { const int kt = r & 7, ct = r >> 3, c0 = ct < 44 ? ct * 64 : 2832 + (ct - 44) * 64;
        j.src = p.w_in + (size_t)l * 1024 * INW + (size_t)(kt * 128) * INW + c0; j.src_ld = INW; j.dst = (char*)(w.win + (size_t)l * PW * 1024 + (size_t)(ct < 44 ? c0 : c0 - 16) * 1024 + kt * 128); j.dst_ld = 2048;
        j.mode = (ct < 8 || (ct >= 44 && ct < 50)) ? 1 : ((ct >= 16 && ct < 24) ? 3 : 0);
    } else if (r < n_in + n_out) { r -= n_in; const int kt = r & 7, ct = r >> 3;
        j.src = p.w_out + (size_t)l * 1024 * 1024 + (size_t)(kt * 128) * 1024 + ct * 64; j.src_ld = 1024; j.dst = (char*)(w.wout + (size_t)l * 1024 * 1024 + (size_t)(ct * 64) * 1024 + kt * 128); j.dst_ld = 2048; j.mode = 0;
    } else if (r < n_in + n_out + 2 * n_g) { r -= n_in + n_out; const int which = r / n_g, rr = r % n_g, e = rr / (8 * (FF / 64)), r2 = rr % (8 * (FF / 64)), kt = r2 & 7, ct = r2 >> 3, c0 = ct * 64;
        j.src = (which ? p.w_up : p.w_gate) + (size_t)(l * 16 + e) * 1024 * FF + (size_t)(kt * 128) * FF + c0; j.src_ld = FF;
        j.dst = (char*)(w.wgu + (size_t)(l * 16 + e) * 2 * FF * 1024 + (size_t)((c0 >> 7) * 256 + which * 128 + (c0 & 127)) * 1024 + kt * 128); j.dst_ld = 1024; j.mode = 2; j.scale = SW1;
    } else { r -= n_in + n_out + 2 * n_g; const int e = r / (16 * FT), r2 = r % (16 * FT), kt = r2 % FT, ct = r2 / FT;
        j.src = p.w_down + (size_t)(l * 16 + e) * FF * 1024 + (size_t)(kt * 128) * 1024 + ct * 64; j.src_ld = 1024; j.dst = (char*)(w.wdn + (size_t)(l * 16 + e) * 1024 * FF + (size_t)(ct * 64) * FF + kt * 128); j.dst_ld = FF; j.mode = 2; j.scale = SW2;
    }
    return j;
}
#define CVT_LOAD(j, v) _Pragma("unroll") for (int i = 0; i < 16; ++i) { const int idx = tid + NT * i, kk = idx >> 6, cc = idx & 63; v[i] = NT_LOAD((j).src + (size_t)kk * (j).src_ld + cc); }
constexpr int CVT_TOT_L = 8 * 52 + 8 * 16 + 2 * 16 * 8 * (FF / 64) + 16 * (FF / 128) * 16;
#ifndef CVT_PER_B
#define CVT_PER_B 16
#endif
#ifndef CVT_PER_D
#define CVT_PER_D 16
#endif
#ifndef CVT_PER_A
#define CVT_PER_A 16
#endif
#ifndef CVT_PER_T
#define CVT_PER_T 0
#endif
constexpr int cvt_share(int pct, int n) { return (CVT_TOT_L * pct / 100) < n ? (CVT_TOT_L * pct / 100) : n; }
constexpr int CVT_TAIL_B = cvt_share(30, 224 * CVT_PER_B), CVT_TAIL_D = cvt_share(25, 192 * CVT_PER_D), CVT_TAIL_A = cvt_share(3, 24 * CVT_PER_A), CVT_TAIL_T = cvt_share(12, 128 * CVT_PER_T);
constexpr int CVT_AHEAD = CVT_TAIL_B + CVT_TAIL_D + CVT_TAIL_A + CVT_TAIL_T, CVT_P0 = DEPTH * (CVT_TOT_L - CVT_AHEAD) + CVT_TAIL_D;
static_assert(CVT_TOT_L - CVT_AHEAD + CVT_TAIL_D >= 8 * 52 + 8 * 16, "a layer's in-proj / out-proj tiles must be converted before its own windows");
template <int KIND> DI int cvt_tile_id(int q, int layer) {
    if (KIND == 0) return q;
    return CVT_P0 + layer * CVT_AHEAD + (KIND == 3 ? 0 : (KIND == 1 ? CVT_TAIL_A : (KIND == 4 ? CVT_TAIL_A + CVT_TAIL_B : CVT_TAIL_A + CVT_TAIL_B + CVT_TAIL_T))) + q;
}
template <int KIND> DI void cvt_stream(const Params& p, const WS& w, char* smem, int layer, int rank, int nranks) {
    float* tile = (float*)smem;
    constexpr int total = KIND == 0 ? CVT_P0 : (KIND == 1 ? CVT_TAIL_B : (KIND == 2 ? CVT_TAIL_D : (KIND == 3 ? CVT_TAIL_A : CVT_TAIL_T)));
    const int tid = tidx(); int q = rank;
    if (q < total) {
        CvtJob j = cvt_job(p, w, cvt_tile_id<KIND>(q, layer)); float v[16];
        CVT_LOAD(j, v);
        for (;;) {
#pragma unroll
            for (int i = 0; i < 16; ++i) { const int idx = tid + NT * i, kk = idx >> 6, cc = idx & 63; tile[kk * 65 + cc] = v[i] * j.scale; }
            const int qn = q + nranks; CvtJob jn = j;
            if (qn < total) { jn = cvt_job(p, w, cvt_tile_id<KIND>(qn, layer)); CVT_LOAD(jn, v); }
            LDS_BARRIER();
            if (j.mode == 2) {
#pragma unroll
                for (int i = 0; i < 4; ++i) { const int idx = tid + NT * i, cc = idx >> 5, kq = idx & 31;
                    *(unsigned*)(j.dst + (size_t)cc * j.dst_ld + 4 * kq) = pk4_fp8(tile[(4 * kq) * 65 + cc], tile[(4 * kq + 1) * 65 + cc], tile[(4 * kq + 2) * 65 + cc], tile[(4 * kq + 3) * 65 + cc]); }
            } else {
#pragma unroll
                for (int i = 0; i < 8; ++i) { const int idx = tid + NT * i, cc = idx >> 6, kp = idx & 63;
                    const int pc = j.mode == 1 ? 32 * ((cc >> 4) & 1) + 8 * ((cc >> 2) & 3) + 4 * (cc >> 5) + (cc & 3) : (j.mode == 3 ? 32 * (cc >> 5) + 8 * ((cc >> 2) & 3) + 4 * ((cc >> 4) & 1) + (cc & 3) : cc);
                    *(unsigned*)(j.dst + (size_t)pc * j.dst_ld + 4 * kp) = pk2(tile[(2 * kp) * 65 + cc], tile[(2 * kp + 1) * 65 + cc]); }
            }
            LDS_BARRIER();
            if (qn >= total) break;
            q = qn; j = jn;
        }
    }
    __syncthreads();
}
DI void phase_cvt(const Params& p, char* smem) {
    const WS w = ws_of(p.ws);
    cvt_stream<0>(p, w, smem, 0, bidx(), gridDim.x);
    for (int i = bidx() * NT + tidx(); i < SEQ * 80; i += gridDim.x * NT) {
        const int n = i / 80, a = i % 80, row = n / 64, col = n % 64; float ang;
        if (a < 32) ang = (float)n * (1.0f / powf(10000.0f, (float)a / 31.0f));
        else if (a < 48) { const int ii = a - 32; ang = (float)(ii < 8 ? row : col) * powf(10000.0f, -(float)(ii & 7) / 8.0f); }
        else { const int ii = a - 48; ang = (float)(ii < 16 ? row : col) * powf(10000.0f, -(float)(ii & 15) / 16.0f); }
        w.tab[2 * i] = cosf(ang); w.tab[2 * i + 1] = sinf(ang);
    }
    float* cond = (float*)smem; float* red = cond + (NB + 1) * 1024;
    __syncthreads();
    for (int i = tidx(); i < (NB + 1) * 1024; i += NT) { const int r = i >> 10, k = i & 1023; const float v = r < NB ? p.c[r * 1024 + k] : p.c_ctx[k]; cond[i] = siluf(v); }
    __syncthreads();
    for (int u = bidx(); u < DEPTH * 96; u += gridDim.x) {
        const int l = u / 96, cg = u % 96, col = tidx() & 63, kg = tidx() >> 6;
        float acc[NB + 1];
#pragma unroll
        for (int r = 0; r <= NB; ++r) acc[r] = 0.f;
        const float* wp = p.ada_w + ((size_t)l * 1024 + kg * 128) * 6144 + cg * 64 + col;
        for (int k = 0; k < 128; ++k) { const float wv = wp[(size_t)k * 6144];
#pragma unroll
            for (int r = 0; r <= NB; ++r) acc[r] += cond[r * 1024 + kg * 128 + k] * wv; }
#pragma unroll
        for (int r = 0; r <= NB; ++r) red[(kg * (NB + 1) + r) * 64 + col] = acc[r];
        __syncthreads();
        for (int i = tidx(); i < (NB + 1) * 64; i += NT) { const int r = i >> 6, cc = i & 63; float s = p.ada_b[l * 6144 + cg * 64 + cc];
#pragma unroll
            for (int g = 0; g < 8; ++g) s += red[(g * (NB + 1) + r) * 64 + cc];
            w.mod[((size_t)l * (NB + 1) + r) * 6144 + cg * 64 + cc] = s; }
        __syncthreads();
    }
}

template <int MODE> DI void phase_rows(const Params& p, int layer, char* smem) {
    const WS w = ws_of(p.ws); float* Wl = (float*)smem;
    const int tid = tidx(), lane = tid & 63, wv = tid >> 6;
    const bool last = (layer == DEPTH - 1);
    __syncthreads();
    if (MODE == 0 || (MODE == 2 && !last)) { const int l2 = MODE == 0 ? 0 : layer + 1;
        for (int i = tid; i < 16 * 1024; i += NT) { const int o = i & 15, k = i >> 4; Wl[o * 1024 + k] = p.w_in[((size_t)l2 * 1024 + k) * INW + 2816 + o]; } }
    if (MODE == 1) for (int i = tid; i < 16 * 1024; i += NT) { const int o = i & 15, k = i >> 4; Wl[o * 1024 + k] = p.router_w[((size_t)layer * 1024 + k) * 16 + o]; }
    __syncthreads();
    const int nrows = (MODE != 0 && last) ? RL : R;
    const int nwaves = gridDim.x * 8, chunk = (nrows + nwaves - 1) / nwaves, row_beg = (bidx() * 8 + wv) * chunk, row_end = row_beg + chunk < nrows ? row_beg + chunk : nrows;
    if (row_beg >= row_end) return;
    f32x4 lg4[4], lb4[4], mg4[4], m04[4], m14[4];
    if (MODE != 0) { const float* lg = p.ln_g + ((size_t)layer * 2 + (MODE == 1 ? 0 : 1)) * 1024; const float* lb = p.ln_b + ((size_t)layer * 2 + (MODE == 1 ? 0 : 1)) * 1024;
#pragma unroll
        for (int j = 0; j < 4; ++j) { lg4[j] = *(const f32x4*)(lg + 256 * j + 4 * lane); lb4[j] = *(const f32x4*)(lb + 256 * j + 4 * lane); } }
    int bcur = -1;
    const int lm = MODE == 2 ? layer + 1 : (MODE == 0 ? 0 : layer);
    const bool write_u = !(MODE == 2 && last);
    auto batch_of = [&](int r) { return r >= RL ? NB : r / SEQ; };
    unsigned short* h_hi = (unsigned short*)w.h; unsigned char* h_lo = (unsigned char*)w.h + (size_t)R * 2048;
    f32x4 hn[2][4]; u32x2 hh[2][4]; unsigned hl[2][4]; u32x2 bn[2][4]; int invn[2] = {-1, -1};
#define ROW_FETCH(Q, ROW) do { const int r_ = (ROW); const bool isc_ = r_ >= RL; \
        const float* src_ = MODE == 0 ? (isc_ ? p.ctx + (size_t)(r_ - RL) * 1024 : p.x + (size_t)r_ * 1024) : w.h + (size_t)r_ * 1024; \
        if (MODE == 0) { _Pragma("unroll") for (int j = 0; j < 4; ++j) hn[Q][j] = NT_LOAD((const f32x4*)(src_ + 256 * j + 4 * lane)); } \
        else { _Pragma("unroll") for (int j = 0; j < 4; ++j) { hh[Q][j] = NT_LOAD((const u32x2*)(h_hi + (size_t)r_ * 1024 + 256 * j + 4 * lane)); hl[Q][j] = NT_LOAD((const unsigned*)(h_lo + (size_t)r_ * 1024 + 256 * j + 4 * lane)); } } \
        if (MODE == 1) { _Pragma("unroll") for (int j = 0; j < 4; ++j) bn[Q][j] = NT_LOAD((const u32x2*)(w.mixo + (size_t)r_ * 1024 + 256 * j + 4 * lane)); } \
        if (MODE == 2) invn[Q] = lane < 16 ? w.inv[(size_t)r_ * 16 + lane] : -1; } while (0)
    int row = row_beg, nr = (row + 1 < row_end && batch_of(row + 1) == batch_of(row)) ? 2 : 1;
    ROW_FETCH(0, row); ROW_FETCH(1, nr == 2 ? row + 1 : row);
    while (row < row_end) {
        const bool isc = row >= RL; const int b = isc ? NB : row / SEQ;
        if (b != bcur) { bcur = b;
            if (MODE != 0) { const float* mg = w.mod + ((size_t)layer * (NB + 1) + b) * 6144 + (MODE == 1 ? 2 : 5) * 1024;
#pragma unroll
                for (int j = 0; j < 4; ++j) mg4[j] = *(const f32x4*)(mg + 256 * j + 4 * lane); }
            if (write_u) { const float* m0 = w.mod + ((size_t)lm * (NB + 1) + b) * 6144 + (MODE == 1 ? 3 : 0) * 1024;
#pragma unroll
                for (int j = 0; j < 4; ++j) { m04[j] = *(const f32x4*)(m0 + 256 * j + 4 * lane); m14[j] = *(const f32x4*)(m0 + 1024 + 256 * j + 4 * lane); } } }
        f32x4 hv[2][4]; u32x2 bc[2][4]; int myinv[2];
#pragma unroll
        for (int q = 0; q < 2; ++q) { myinv[q] = invn[q];
#pragma unroll
            for (int j = 0; j < 4; ++j) { bc[q][j] = bn[q][j];
                if (MODE == 0) hv[q][j] = hn[q][j];
                else { const u32x2 a_ = hh[q][j]; const unsigned b_ = hl[q][j];
                    hv[q][j] = (f32x4){__uint_as_float((a_[0] << 16) | ((b_ & 0xffu) << 8)), __uint_as_float((a_[0] & 0xffff0000u) | (b_ & 0xff00u)),
                                       __uint_as_float((a_[1] << 16) | ((b_ >> 8) & 0xff00u)), __uint_as_float((a_[1] & 0xffff0000u) | ((b_ >> 16) & 0xff00u))}; } } }
        const int row_cur = row, nr_cur = nr;
        row += nr;
        if (row < row_end) { nr = (row + 1 < row_end && batch_of(row + 1) == batch_of(row)) ? 2 : 1; ROW_FETCH(0, row); ROW_FETCH(1, nr == 2 ? row + 1 : row); }
        f32x4 uv[2][4];
#pragma unroll
        for (int q = 0; q < 2; ++q) {
            const int rw_ = row_cur + (q < nr_cur ? q : 0);
            if (MODE != 0) {
                f32x4 br[4];
                if (MODE == 1) {
#pragma unroll
                    for (int j = 0; j < 4; ++j) br[j] = (f32x4){__uint_as_float(bc[q][j][0] << 16), __uint_as_float(bc[q][j][0] & 0xffff0000u), __uint_as_float(bc[q][j][1] << 16), __uint_as_float(bc[q][j][1] & 0xffff0000u)};
                } else {
#pragma unroll
                    for (int j = 0; j < 4; ++j) br[j] = (f32x4){0.f, 0.f, 0.f, 0.f};
                    for (int e = 0; e < 16; ++e) { const int sl = lane_bcast(myinv[q], e);
                        if (sl >= 0) { const unsigned char* yr = w.y + ((size_t)e * ROWS_E + sl) * 1024;
#pragma unroll
                            for (int j = 0; j < 4; ++j) { const int v = (int)NT_LOAD((const unsigned*)(yr + 256 * j + 4 * lane));
                                const auto lo_ = __builtin_amdgcn_cvt_pk_f32_fp8(v, false), hi_ = __builtin_amdgcn_cvt_pk_f32_fp8(v, true);
                                br[j][0] += lo_[0]; br[j][1] += lo_[1]; br[j][2] += hi_[0]; br[j][3] += hi_[1]; } } }
#pragma unroll
                    for (int j = 0; j < 4; ++j) br[j] = br[j] * (1.0f / SY);
                }
                float sm_ = 0.f;
#pragma unroll
                for (int j = 0; j < 4; ++j) { hv[q][j] = ALPHA * hv[q][j] + mg4[j] * br[j]; sm_ += hv[q][j][0] + hv[q][j][1] + hv[q][j][2] + hv[q][j][3]; }
                const float mean = wsum(sm_) * (1.0f / 1024.0f); float qq = 0.f;
#pragma unroll
                for (int j = 0; j < 4; ++j) { hv[q][j] = hv[q][j] - mean; qq += hv[q][j][0] * hv[q][j][0] + hv[q][j][1] * hv[q][j][1] + hv[q][j][2] * hv[q][j][2] + hv[q][j][3] * hv[q][j][3]; }
                const float rstd = 1.0f / sqrtf(wsum(qq) * (1.0f / 1024.0f) + 1e-5f);
#pragma unroll
                for (int j = 0; j < 4; ++j) hv[q][j] = hv[q][j] * rstd * lg4[j] + lb4[j];
            }
            if (q < nr_cur) {
                if (MODE == 2 && last) {
#pragma unroll
                    for (int j = 0; j < 4; ++j) *(f32x4*)(p.out + (size_t)rw_ * 1024 + 256 * j + 4 * lane) = hv[q][j];
                } else {
#pragma unroll
                    for (int j = 0; j < 4; ++j) { const unsigned u0 = __float_as_uint(hv[q][j][0]) + 0x80u, u1 = __float_as_uint(hv[q][j][1]) + 0x80u, u2 = __float_as_uint(hv[q][j][2]) + 0x80u, u3 = __float_as_uint(hv[q][j][3]) + 0x80u;
                        u32x2 a_; a_[0] = (u0 >> 16) | (u1 & 0xffff0000u); a_[1] = (u2 >> 16) | (u3 & 0xffff0000u);
                        const unsigned b_ = ((u0 >> 8) & 0xffu) | (u1 & 0xff00u) | ((u2 << 8) & 0xff0000u) | ((u3 << 16) & 0xff000000u);
                        NT_STORE(a_, (u32x2*)(h_hi + (size_t)rw_ * 1024 + 256 * j + 4 * lane)); NT_STORE(b_, (unsigned*)(h_lo + (size_t)rw_ * 1024 + 256 * j + 4 * lane)); }
                }
            }
#pragma unroll
            for (int j = 0; j < 4; ++j) { uv[q][j] = hv[q][j] * (1.0f + m14[j]) + m04[j];
                if (write_u && q < nr_cur) { if (MODE == 1) *(unsigned*)(w.u8 + (size_t)rw_ * 1024 + 256 * j + 4 * lane) = pk4_fp8(uv[q][j][0], uv[q][j][1], uv[q][j][2], uv[q][j][3]);
                    else { u32x2 o; o[0] = pk2(uv[q][j][0], uv[q][j][1]); o[1] = pk2(uv[q][j][2], uv[q][j][3]); *(u32x2*)(w.u + (size_t)rw_ * 1024 + 256 * j + 4 * lane) = o; } } }
        }
        if (!write_u) continue;
        float lgt[2][16];
#pragma unroll
        for (int o = 0; o < 16; ++o) { float a0 = 0.f, a1 = 0.f;
#pragma unroll
            for (int j = 0; j < 4; ++j) { const f32x4 wv4 = *(const f32x4*)(Wl + o * 1024 + 256 * j + 4 * lane);
                a0 += uv[0][j][0] * wv4[0] + uv[0][j][1] * wv4[1] + uv[0][j][2] * wv4[2] + uv[0][j][3] * wv4[3]; a1 += uv[1][j][0] * wv4[0] + uv[1][j][1] * wv4[1] + uv[1][j][2] * wv4[2] + uv[1][j][3] * wv4[3]; }
            lgt[0][o] = wsum(a0); lgt[1][o] = wsum(a1); SCHED; }
#pragma unroll
        for (int q = 0; q < 2; ++q) {
            if (q >= nr_cur) continue;
            const int rw_ = row_cur + q; float mine = 0.f;
            if (MODE == 1) { float mx = lgt[q][0];
#pragma unroll
                for (int o = 1; o < 16; ++o) mx = fmaxf(mx, lgt[q][o]);
                float sm = 0.f;
#pragma unroll
                for (int o = 0; o < 16; ++o) { lgt[q][o] = __expf(lgt[q][o] - mx); sm += lgt[q][o]; }
                const float inv = 1.0f / sm;
#pragma unroll
                for (int o = 0; o < 16; ++o) if (lane == o) mine = lgt[q][o] * inv;
                if (lane < 16) { if (rw_ < RL) { const int bb = rw_ / SEQ, n = rw_ % SEQ; w.aff[((size_t)bb * 16 + lane) * SEQ + n] = mine; }
                                 else { const int rr = rw_ - RL, bb = rr / CTX, n = rr % CTX; w.aff[(size_t)RL * 16 + ((size_t)bb * 16 + lane) * CTX + n] = mine; } }
            } else {
#pragma unroll
                for (int o = 0; o < 16; ++o) if (lane == o) mine = lgt[q][o];
                if (lane < 16) w.gab[(size_t)rw_ * 16 + lane] = mine;
            }
        }
    }
#undef ROW_FETCH
}

constexpr int G_HT = 128 * 64;
DI int lds_byte(int r, int c) { const int st = (r >> 4) * 2 + (c >> 5), rr = r & 15, cc = c & 31, ob = rr * 64 + cc * 2; return st * 1024 + (ob ^ (((ob >> 9) & 1) << 5)); }
DI void stage_rc(int b, int& Rr, int& Cc) { const int st = b / 1024, sb = b % 1024, swz = sb ^ (((sb >> 9) & 1) << 5); Rr = (st >> 1) * 16 + swz / 64; Cc = (st & 1) * 32 + (swz % 64) / 2; }
#define GLDS16(g, l) __builtin_amdgcn_global_load_lds((const unsigned*)(g), (unsigned*)(l), 16, 0, 0)

struct EpiArgs { void* out; int ld; long orow0; const float* wgt; const float* tab; int kind0, kind1; float sc0, sc1; };
template <int EPI, bool GATHER>
DI void gemm_unit(const bf16_t* __restrict__ A, const bf16_t* __restrict__ Bt, const int K, const int brow, const int bcol, const int* __restrict__ gidx, const EpiArgs ea, char* smem) {
    bf16_t* shm = (bf16_t*)smem;
#define SA(b, h) (shm + ((b) * 2 + (h)) * G_HT)
#define SB(b, h) (shm + (4 + (b) * 2 + (h)) * G_HT)
#define STAGE_B(T, P, h, kt) do { _Pragma("unroll") for (int _i = 0; _i < 2; ++_i) { const int _b = (T) * 16 + _i * 8192; int _r, _c; stage_rc(_b, _r, _c); \
        GLDS16(Bt + (unsigned)((bcol + (h) * 128 + _r) * K + (kt) * 64 + _c), (char*)(P) + _b); } } while (0)
#define STAGE_A(T, P, h, kt) do { _Pragma("unroll") for (int _i = 0; _i < 2; ++_i) { const int _b = (T) * 16 + _i * 8192; int _r, _c; stage_rc(_b, _r, _c); \
        const int _ro = GATHER ? rid[h][_i] : (brow + (h) * 128 + _r); GLDS16(A + (unsigned)(_ro * K + (kt) * 64 + _c), (char*)(P) + _b); } } while (0)
#define LDA(dst, b, h) _Pragma("unroll") for (int m = 0; m < 4; ++m) _Pragma("unroll") for (int k = 0; k < 2; ++k) \
        dst[m][k] = *reinterpret_cast<const bf16x8*>((char*)SA(b, h) + lds_byte(wr * 64 + m * 16 + fr, k * 32 + fq * 8))
#define LDB(dst, b, h) _Pragma("unroll") for (int n = 0; n < 2; ++n) _Pragma("unroll") for (int k = 0; k < 2; ++k) \
        dst[n][k] = *reinterpret_cast<const bf16x8*>((char*)SB(b, h) + lds_byte(wc * 32 + n * 16 + fr, k * 32 + fq * 8))
#define MMA(ai, bj, At_, Bt_) do { __builtin_amdgcn_s_setprio(1); \
        _Pragma("unroll") for (int m = 0; m < 4; ++m) _Pragma("unroll") for (int n = 0; n < 2; ++n) _Pragma("unroll") for (int k = 0; k < 2; ++k) \
            acc[ai][bj][m][n] = MFMA16(Bt_[n][k], At_[m][k], acc[ai][bj][m][n]); \
        __builtin_amdgcn_s_setprio(0); } while (0)
    int tid = tidx();
#ifndef EMU
    asm volatile("" : "+v"(tid));
#endif
    int wid = tid >> 6, lane = tid & 63, wr = wid >> 2, wc = wid & 3, fr = lane & 15, fq = lane >> 4;
    int rid[2][2];
    if (GATHER) {
#pragma unroll
        for (int h = 0; h < 2; ++h)
#pragma unroll
            for (int i = 0; i < 2; ++i) { int r_, c_; stage_rc(tid * 16 + i * 8192, r_, c_); rid[h][i] = gidx[h * 128 + r_]; }
    }
    f32x4 acc[2][2][4][2];
#pragma unroll
    for (int a = 0; a < 2; ++a)
#pragma unroll
        for (int b = 0; b < 2; ++b)
#pragma unroll
            for (int m = 0; m < 4; ++m)
#pragma unroll
                for (int n = 0; n < 2; ++n) acc[a][b][m][n] = (f32x4){0.f, 0.f, 0.f, 0.f};
    bf16x8 At[4][2], B0[2][2], B1[2][2];
    const int nt = K / 64;
    STAGE_B(tid, SB(0, 0), 0, 0); STAGE_A(tid, SA(0, 0), 0, 0);
    STAGE_B(tid, SB(0, 1), 1, 0); STAGE_A(tid, SA(0, 1), 1, 0);
    if (wr == 1) BAR;
    WAIT_V(4); BAR;
    STAGE_B(tid, SB(1, 0), 0, 1); STAGE_A(tid, SA(1, 0), 0, 1); STAGE_B(tid, SB(1, 1), 1, 1);
    WAIT_V(6); BAR;
    for (int t = 0; t < nt - 2; t += 2) {
        LDB(B0, 0, 0); SCHED; LDA(At, 0, 0); STAGE_A(tid, SA(1, 1), 1, t + 1);
        WAIT_L(8); BAR; WAIT_L(0); MMA(0, 0, At, B0); BAR; SCHED;
        LDB(B1, 0, 1); STAGE_B(tid, SB(0, 0), 0, t + 2);
        BAR; WAIT_L(0); MMA(0, 1, At, B1); BAR;
        LDA(At, 0, 1); STAGE_A(tid, SA(0, 0), 0, t + 2);
        BAR; WAIT_L(0); MMA(1, 0, At, B0); BAR; SCHED;
        STAGE_B(tid, SB(0, 1), 1, t + 2);
        WAIT_V(6); BAR; MMA(1, 1, At, B1); BAR;
        LDB(B0, 1, 0); SCHED; LDA(At, 1, 0); STAGE_A(tid, SA(0, 1), 1, t + 2);
        WAIT_L(8); BAR; WAIT_L(0); MMA(0, 0, At, B0); BAR; SCHED;
        LDB(B1, 1, 1); STAGE_B(tid, SB(1, 0), 0, t + 3);
        BAR; WAIT_L(0); MMA(0, 1, At, B1); BAR;
        LDA(At, 1, 1); STAGE_A(tid, SA(1, 0), 0, t + 3);
        BAR; WAIT_L(0); MMA(1, 0, At, B0); BAR; SCHED;
        STAGE_B(tid, SB(1, 1), 1, t + 3);
        WAIT_V(6); BAR; MMA(1, 1, At, B1); BAR;
    }
    int tz = tidx();
#ifndef EMU
    asm volatile("" : "+v"(tz));
#endif
    wid = tz >> 6; lane = tz & 63; wr = wid >> 2; wc = wid & 3; fr = lane & 15; fq = lane >> 4;
    { LDB(B0, 0, 0); WAIT_V(0); LDA(At, 0, 0); STAGE_A(tz, SA(1, 1), 1, nt - 1);
      BAR; WAIT_L(0); MMA(0, 0, At, B0); BAR;
      LDB(B1, 0, 1); BAR; WAIT_L(0); MMA(0, 1, At, B1); BAR;
      LDA(At, 0, 1); WAIT_V(4); BAR; WAIT_L(0); MMA(1, 0, At, B0); MMA(1, 1, At, B1); BAR; }
    { LDB(B0, 1, 0); LDA(At, 1, 0); WAIT_V(2); BAR; WAIT_L(0); MMA(0, 0, At, B0); BAR;
      LDB(B1, 1, 1); WAIT_V(0); BAR; WAIT_L(0); MMA(0, 1, At, B1); BAR;
      LDA(At, 1, 1); BAR; WAIT_L(0); MMA(1, 0, At, B0); MMA(1, 1, At, B1); BAR; }
    if (wr == 0) BAR;
#pragma unroll
    for (int ai = 0; ai < 2; ++ai)
#pragma unroll
        for (int m = 0; m < 4; ++m) {
            const int lrow = ai * 128 + wr * 64 + m * 16 + fr; const long orow = ea.orow0 + lrow;
            float wg = 1.0f; if (EPI == 3) wg = ea.wgt[lrow];
            if (EPI == 4) {
                const bool isc = orow >= RL; const int tokn = isc ? 0 : (int)(orow % SEQ);
#pragma unroll
                for (int bj = 0; bj < 2; ++bj) { const int kind = bj ? ea.kind1 : ea.kind0; const float sc = bj ? ea.sc1 : ea.sc0;
                    f32x4 x1 = acc[ai][bj][m][0], x2 = acc[ai][bj][m][1];
                    if (kind != 0) {
                        f32x4 t0 = (f32x4){1.f, 0.f, 1.f, 0.f}, t1 = t0;
                        if (!isc) { const int a0 = (kind == 1 ? 0 : (kind == 2 ? 32 : 48)) + (kind != 2 ? (wc & 1) * 16 : 0) + fq * 4; const float* tp = ea.tab + ((size_t)tokn * 80 + a0) * 2; t0 = *(const f32x4*)tp; t1 = *(const f32x4*)(tp + 4); }
                        const f32x4 cs = (f32x4){t0[0], t0[2], t1[0], t1[2]} * sc, sn = (f32x4){t0[1], t0[3], t1[1], t1[3]} * sc;
                        const f32x4 y1 = x1 * cs - x2 * sn, y2 = x1 * sn + x2 * cs; x1 = y1; x2 = y2;
                    }
                    const int col = bcol + bj * 128 + wc * 32 + fq * 4; bf16_t* op = (bf16_t*)ea.out + (size_t)orow * ea.ld + col;
                    u32x2 o; o[0] = pk2(x1[0], x1[1]); o[1] = pk2(x1[2], x1[3]); *(u32x2*)op = o; o[0] = pk2(x2[0], x2[1]); o[1] = pk2(x2[2], x2[3]); *(u32x2*)(op + 16) = o; }
                continue;
            }
#pragma unroll
            for (int n = 0; n < 2; ++n) {
                if (EPI == 2) { const f32x4 g = acc[ai][0][m][n], u = acc[ai][1][m][n]; const int col = (bcol >> 1) + wc * 32 + n * 16 + fq * 4;
                    u32x2 o; o[0] = pk2(siluf(g[0]) * u[0], siluf(g[1]) * u[1]); o[1] = pk2(siluf(g[2]) * u[2], siluf(g[3]) * u[3]);
                    *(u32x2*)((bf16_t*)ea.out + (size_t)orow * ea.ld + col) = o;
                } else {
#pragma unroll
                    for (int bj = 0; bj < 2; ++bj) { const f32x4 v = acc[ai][bj][m][n]; const int col = bcol + bj * 128 + wc * 32 + n * 16 + fq * 4;
                        if (EPI == 1) *(f32x4*)((float*)ea.out + (size_t)orow * ea.ld + col) = v;
                        else { u32x2 o; o[0] = pk2(v[0] * wg, v[1] * wg); o[1] = pk2(v[2] * wg, v[3] * wg); *(u32x2*)((bf16_t*)ea.out + (size_t)orow * ea.ld + col) = o; } }
                }
            }
        }
    __syncthreads();
#undef SA
#undef SB
#undef STAGE_A
#undef STAGE_B
#undef LDA
#undef LDB
#undef MMA
}

struct GUnit { const char* B; const int* gidx; const float* wgt; long orow0; int brow, bcol, pn; };
DI bool tile_order(int i, int G, int c, int nM, int nN, int& pm, int& pn) {
    const int nwg = nM * nN; const long L = (long)i * G + c; if (L >= nwg) return false;
    int wgid = (int)L; { const int q = nwg / 8, r = nwg % 8, xcd = wgid % 8, off = wgid / 8; wgid = (xcd < r ? xcd * (q + 1) : r * (q + 1) + (xcd - r) * q) + off; }
    const int nig = 8 * nN, gid = wgid / nig, fm = gid * 8, gsz = (nM - fm) < 8 ? (nM - fm) : 8;
    pm = fm + ((wgid % nig) % gsz); pn = (wgid % nig) / gsz; return true;
}
DI int moe_tiles(int layer) { return layer == DEPTH - 1 ? (NB * CAPL + 255) / 256 : ROWS_E / 256; }
template <int PHK> DI bool gemm_next(const WS& w, int layer, int i, int G, int c, GUnit& u) {
    int pm, pn; u.gidx = nullptr; u.wgt = nullptr;
    if (PHK == 0) { if (!tile_order(i, G, c, R / 256, PW / 256, pm, pn)) return false; u.B = (const char*)(w.win + (size_t)layer * PW * 1024 + (size_t)pn * 256 * 1024); u.brow = pm * 256; u.orow0 = (long)pm * 256; }
    else if (PHK == 1) { if (!tile_order(i, G, c, (layer == DEPTH - 1 ? RL : R) / 256, 4, pm, pn)) return false; u.B = (const char*)(w.wout + (size_t)layer * 1024 * 1024 + (size_t)pn * 256 * 1024); u.brow = pm * 256; u.orow0 = (long)pm * 256; }
    else { const int tm = moe_tiles(layer); constexpr int nN = PHK == 2 ? 2 * FF / 256 : 4;
        if (!tile_order(i, G, c, 16 * tm, nN, pm, pn)) return false;
        constexpr int TM_FULL = ROWS_E / 256, TM_LAST = (NB * CAPL + 255) / 256;
        int e, pme; if (layer == DEPTH - 1) { e = pm / TM_LAST; pme = pm % TM_LAST; } else { e = pm / TM_FULL; pme = pm % TM_FULL; }
        u.orow0 = (long)e * ROWS_E + pme * 256; u.brow = e * ROWS_E + pme * 256;
        if (PHK == 2) { u.B = (const char*)(w.wgu + (size_t)(layer * 16 + e) * 2 * FF * 1024 + (size_t)pn * 256 * 1024); u.gidx = w.idx + (size_t)e * ROWS_E + pme * 256; }
        else { u.B = (const char*)(w.wdn + (size_t)(layer * 16 + e) * 1024 * FF + (size_t)pn * 256 * FF); u.wgt = w.wgt + (size_t)e * ROWS_E + pme * 256; } }
    u.bcol = pn * 256; u.pn = pn; return true;
}
template <int PHK> DI void gemm_stream(const Params& p, int layer, char* smem) {
    constexpr bool GATHER = PHK == 2, FP8 = PHK >= 2;       constexpr int K = PHK == 2 ? 1024 : (PHK == 3 ? FF : 2048)  , nt = K / 128;
    const WS w = ws_of(p.ws); bf16_t* shm = (bf16_t*)smem;
    const char* Abase = PHK == 0 ? (const char*)w.u : (PHK == 1 ? (const char*)w.mix : (PHK == 2 ? (const char*)w.u8 : (const char*)w.hid));
    const int G = gridDim.x, c = bidx();
    int tid = tidx();
    int wid = tid >> 6, lane = tid & 63, wr = wid >> 2, wc = wid & 3, fr = lane & 15, fq = lane >> 4;
    GUnit cur, nxt;
    if (!gemm_next<PHK>(w, layer, 0, G, c, cur)) return;
    unsigned voff[2];
#pragma unroll
    for (int i = 0; i < 2; ++i) { int R_, C_; stage_rc(tid * 16 + i * 8192, R_, C_); voff[i] = (unsigned)(R_ * K + C_ * 2); }
    u32x4 ga = (u32x4){0u, 0u, 0u, 0u};
    unsigned gc2[2];
#pragma unroll
    for (int i = 0; i < 2; ++i) { int R_, C_; stage_rc(tid * 16 + i * 8192, R_, C_); gc2[i] = (unsigned)C_ * 2u; }
#define G_GOFF(dst, U) do { _Pragma("unroll") for (int h_ = 0; h_ < 2; ++h_) _Pragma("unroll") for (int i_ = 0; i_ < 2; ++i_) { int R_, C_; stage_rc(tid * 16 + i_ * 8192, R_, C_); \
        dst[h_ * 2 + i_] = (unsigned)(U).gidx[h_ * 128 + R_]; } } while (0)
    if (GATHER) G_GOFF(ga, cur);
    const int* idbuf = (const int*)(smem + 8 * G_HT * 2 + 1024);
#ifdef EMU
#define UBASE(p)
#else
#define UBASE(p) asm volatile("" : "+s"(p))
#endif
#define SA(b, h) (shm + ((b) * 2 + (h)) * G_HT)
#define SB(b, h) (shm + (4 + (b) * 2 + (h)) * G_HT)
#define STG_A(P, U, GAo, h, koff) do { _Pragma("unroll") for (int _i = 0; _i < 2; ++_i) { \
        const char* ub_ = GATHER ? Abase + (size_t)(koff) : Abase + ((size_t)((U).brow + (h) * 128) * K + (koff)); UBASE(ub_); GLDS16(ub_ + (GATHER ? (GAo)[(h) * 2 + _i] * (unsigned)K + gc2[_i] : voff[_i]), (char*)(P) + tid * 16 + _i * 8192); } } while (0)
#define STG_B(P, BP, h, koff) do { _Pragma("unroll") for (int _i = 0; _i < 2; ++_i) { const char* ub_ = (BP) + ((size_t)(h) * 128 * K + (koff)); UBASE(ub_); GLDS16(ub_ + voff[_i], (char*)(P) + tid * 16 + _i * 8192); } } while (0)
#define LDA(dst, b, h) _Pragma("unroll") for (int m = 0; m < 4; ++m) { \
        const u32x4 lo_ = *reinterpret_cast<const u32x4*>((char*)SA(b, h) + lds_byte(wr * 64 + m * 16 + fr, fq * 8)), hi_ = *reinterpret_cast<const u32x4*>((char*)SA(b, h) + lds_byte(wr * 64 + m * 16 + fr, 32 + fq * 8)); \
        dst[m] = __builtin_shufflevector(lo_, hi_, 0, 1, 2, 3, 4, 5, 6, 7); }
#define LDB_ROW(n) (wc * 32 + 8 * (fr >> 2) + 4 * (n) + (fr & 3))
#define LDB(dst, b, h) _Pragma("unroll") for (int n = 0; n < 2; ++n) { \
        const u32x4 lo_ = *reinterpret_cast<const u32x4*>((char*)SB(b, h) + lds_byte(LDB_ROW(n), fq * 8)), hi_ = *reinterpret_cast<const u32x4*>((char*)SB(b, h) + lds_byte(LDB_ROW(n), 32 + fq * 8)); \
        dst[n] = __builtin_shufflevector(lo_, hi_, 0, 1, 2, 3, 4, 5, 6, 7); }
#define MMA(ai, bj, At_, Bt_) do { __builtin_amdgcn_s_setprio(1); \
        _Pragma("unroll") for (int m = 0; m < 4; ++m) _Pragma("unroll") for (int n = 0; n < 2; ++n) { \
            if (FP8) acc[ai][bj][m][n] = mfma_fp8(Bt_[n], At_[m], acc[ai][bj][m][n]);     \
            else { acc[ai][bj][m][n] = MFMA16(frag_lo(Bt_[n]), frag_lo(At_[m]), acc[ai][bj][m][n]); acc[ai][bj][m][n] = MFMA16(frag_hi(Bt_[n]), frag_hi(At_[m]), acc[ai][bj][m][n]); } } \
        __builtin_amdgcn_s_setprio(0); } while (0)
#define K_TILE_PAIR(UA2, GA2, B2, k1, k2, k3) do { \
            LDB(B0, 0, 0); SCHED; LDA(At, 0, 0); STG_A(SA(1, 1), cur, ga, 1, k1); \
            WAIT_L(8); BAR; WAIT_L(0); MMA(0, 0, At, B0); BAR; SCHED; \
            LDB(B1, 0, 1); STG_B(SB(0, 0), B2, 0, k2); \
            BAR; WAIT_L(0); MMA(0, 1, At, B1); BAR; \
            LDA(At, 0, 1); STG_A(SA(0, 0), UA2, GA2, 0, k2); \
            BAR; WAIT_L(0); MMA(1, 0, At, B0); BAR; SCHED; \
            STG_B(SB(0, 1), B2, 1, k2); \
            WAIT_V(6); BAR; MMA(1, 1, At, B1); BAR; \
            LDB(B0, 1, 0); SCHED; LDA(At, 1, 0); STG_A(SA(0, 1), UA2, GA2, 1, k2); \
            WAIT_L(8); BAR; WAIT_L(0); MMA(0, 0, At, B0); BAR; SCHED; \
            LDB(B1, 1, 1); STG_B(SB(1, 0), B2, 0, k3); \
            BAR; WAIT_L(0); MMA(0, 1, At, B1); BAR; \
            LDA(At, 1, 1); STG_A(SA(1, 0), UA2, GA2, 0, k3); \
            BAR; WAIT_L(0); MMA(1, 0, At, B0); BAR; SCHED; \
            STG_B(SB(1, 1), B2, 1, k3); \
            WAIT_V(6); BAR; MMA(1, 1, At, B1); BAR; } while (0)
    f32x4 acc[2][2][4][2];
#pragma unroll
    for (int a = 0; a < 2; ++a)
#pragma unroll
        for (int b = 0; b < 2; ++b)
#pragma unroll
            for (int m = 0; m < 4; ++m)
#pragma unroll
                for (int n = 0; n < 2; ++n) acc[a][b][m][n] = (f32x4){0.f, 0.f, 0.f, 0.f};
    u32x8 At[4], B0[2], B1[2];
    __syncthreads();
    STG_B(SB(0, 0), cur.B, 0, 0); STG_A(SA(0, 0), cur, ga, 0, 0); STG_B(SB(0, 1), cur.B, 1, 0); STG_A(SA(0, 1), cur, ga, 1, 0);
    if (wr == 1) BAR;
    WAIT_V(4); BAR;
    STG_B(SB(1, 0), cur.B, 0, 128); STG_A(SA(1, 0), cur, ga, 0, 128); STG_B(SB(1, 1), cur.B, 1, 128);
    WAIT_V(6); BAR;
    for (int ui = 0;; ++ui) {
#pragma unroll
        for (int i = 0; i < 2; ++i) { int R_, C_; stage_rc(tid * 16 + i * 8192, R_, C_); voff[i] = (unsigned)(R_ * K + C_ * 2); gc2[i] = (unsigned)C_ * 2u; }
        const bool has_next = gemm_next<PHK>(w, layer, ui + 1, G, c, nxt);
        if (!has_next) nxt = cur;
        u32x4 gn = ga;
#pragma unroll 1
        for (int t = 0; t < nt; t += 2) {
            const bool lastp = (t == nt - 2);
            if (GATHER && t == 0 && wid == 0) GLDS16((const char*)nxt.gidx + lane * 16, (char*)idbuf + lane * 16);
            if (GATHER && t == nt - 4) { _Pragma("unroll") for (int h_ = 0; h_ < 2; ++h_) _Pragma("unroll") for (int i_ = 0; i_ < 2; ++i_) { int R_, C_; stage_rc(tid * 16 + i_ * 8192, R_, C_); gn[h_ * 2 + i_] = (unsigned)idbuf[h_ * 128 + R_]; } }
#ifndef EMU
#endif
            GUnit u2 = cur; u32x4 g2 = ga; if (lastp) { u2 = nxt; g2 = gn; }
            const int k2 = lastp ? 0 : (t + 2) * 128;
            K_TILE_PAIR(u2, g2, u2.B, (t + 1) * 128, k2, k2 + 128);
        }
#ifndef EMU
        asm volatile("" : "+v"(tid));
#endif
        wid = tid >> 6; lane = tid & 63; wr = wid >> 2; wc = wid & 3; fr = lane & 15; fq = lane >> 4;
        const int kd = PHK == 0 ? (cur.pn <= 1 ? 1 : ((cur.pn == 4 || cur.pn == 5) ? 2 : ((cur.pn == 11 || cur.pn == 12) ? 3 : 0))) : 0;
        const float qsc = PHK == 0 ? (cur.pn == 0 ? 0.125f : (cur.pn == 4 ? 0.17677669529663687f * LOG2E : (cur.pn == 11 ? 0.125f * LOG2E : 1.0f))) : 1.0f;
#pragma unroll
        for (int ai = 0; ai < 2; ++ai) {
            f32x4 rt0[4], rt1[4];
            if (PHK == 0 && kd != 0) {
#pragma unroll
                for (int m = 0; m < 4; ++m) { const long orow = cur.orow0 + ai * 128 + wr * 64 + m * 16 + fr; const bool isc = orow >= RL; const int tokn = isc ? 0 : (int)(orow % SEQ);
                    const int a0 = (kd == 1 ? 0 : (kd == 2 ? 32 : 48)) + (kd != 2 ? (wc & 1) * 16 : 0) + fq * 4; const float* tp = w.tab + ((size_t)tokn * 80 + a0) * 2;
                    rt0[m] = *(const f32x4*)tp; rt1[m] = *(const f32x4*)(tp + 4); }
            }
#pragma unroll
            for (int m = 0; m < 4; ++m) {
                const int lrow = ai * 128 + wr * 64 + m * 16 + fr; const long orow = cur.orow0 + lrow;
                if (PHK == 0) {
                    const bool isc = orow >= RL; const int tokn = isc ? 0 : (int)(orow % SEQ);
                    f32x4 cs = (f32x4){qsc, qsc, qsc, qsc}, sn = (f32x4){0.f, 0.f, 0.f, 0.f};
                    if (kd != 0 && !isc) {
                        const f32x4 t0 = rt0[m], t1 = rt1[m]; cs = (f32x4){t0[0], t0[2], t1[0], t1[2]} * qsc; sn = (f32x4){t0[1], t0[3], t1[1], t1[3]} * qsc; }
#pragma unroll
                    for (int bj = 0; bj < 2; ++bj) { const int kind = (cur.pn == 12 && bj == 1) ? 0 : kd;
                        f32x4 x1 = acc[ai][bj][m][0], x2 = acc[ai][bj][m][1];
                        if (kind != 0) { const f32x4 y1 = x1 * cs - x2 * sn, y2 = x1 * sn + x2 * cs; x1 = y1; x2 = y2; }
                        u32x4 o; o[0] = pk2(x1[0], x1[1]); o[1] = pk2(x1[2], x1[3]); o[2] = pk2(x2[0], x2[1]); o[3] = pk2(x2[2], x2[3]);
                        *(u32x4*)(w.p + (size_t)orow * PW + cur.bcol + bj * 128 + wc * 32 + fq * 8) = o; }
                } else if (PHK == 2) {
                    const f32x4 g0 = acc[ai][0][m][0] * (1.0f / SW1), u0 = acc[ai][1][m][0] * (SH / SW1), g1 = acc[ai][0][m][1] * (1.0f / SW1), u1 = acc[ai][1][m][1] * (SH / SW1);
                    u32x2 o; o[0] = pk4_fp8(siluf(g0[0]) * u0[0], siluf(g0[1]) * u0[1], siluf(g0[2]) * u0[2], siluf(g0[3]) * u0[3]); o[1] = pk4_fp8(siluf(g1[0]) * u1[0], siluf(g1[1]) * u1[1], siluf(g1[2]) * u1[2], siluf(g1[3]) * u1[3]);
                    *(u32x2*)(w.hid + (size_t)orow * FF + (cur.bcol >> 1) + wc * 32 + fq * 8) = o;
                } else {
                    float wg = 1.0f; if (PHK == 3) wg = cur.wgt[lrow] * (SY / (SH * SW2));
#pragma unroll
                    for (int bj = 0; bj < 2; ++bj) { const f32x4 v0 = acc[ai][bj][m][0], v1 = acc[ai][bj][m][1];
                        if (PHK == 3) { u32x2 o; o[0] = pk4_fp8(v0[0] * wg, v0[1] * wg, v0[2] * wg, v0[3] * wg); o[1] = pk4_fp8(v1[0] * wg, v1[1] * wg, v1[2] * wg, v1[3] * wg);
                            *(u32x2*)(w.y + (size_t)orow * 1024 + cur.bcol + bj * 128 + wc * 32 + fq * 8) = o;
                        } else { u32x4 o; o[0] = pk2(v0[0] * wg, v0[1] * wg); o[1] = pk2(v0[2] * wg, v0[3] * wg); o[2] = pk2(v1[0] * wg, v1[1] * wg); o[3] = pk2(v1[2] * wg, v1[3] * wg);
                            *(u32x4*)(w.mixo + (size_t)orow * 1024 + cur.bcol + bj * 128 + wc * 32 + fq * 8) = o; } }
                }
            }
        }
        if (!has_next) break;
#pragma unroll
        for (int a = 0; a < 2; ++a)
#pragma unroll
            for (int b = 0; b < 2; ++b)
#pragma unroll
                for (int m = 0; m < 4; ++m)
#pragma unroll
                    for (int n = 0; n < 2; ++n) acc[a][b][m][n] = (f32x4){0.f, 0.f, 0.f, 0.f};
        cur = nxt;
        ga = gn;
#ifndef EMU
        asm volatile("" : "+v"(tid));
#endif
        wid = tid >> 6; lane = tid & 63; wr = wid >> 2; wc = wid & 3; fr = lane & 15; fq = lane >> 4;
    }
    WAIT_V(0);
    if (wr == 0) BAR;
    BAR;
    __syncthreads();
#undef G_GOFF
#undef K_TILE_PAIR
#undef UBASE
#undef SA
#undef SB
#undef STG_A
#undef STG_B
#undef LDA
#undef LDB
#undef LDB_ROW
#undef MMA
}
DI void cvt_tail_a(const Params& p, int layer, char* smem);
DI void phase_inproj(const Params& p, int layer, char* smem) { gemm_stream<0>(p, layer, smem); cvt_tail_a(p, layer, smem); }
DI void cvt_tail_b(const Params& p, int layer, char* smem) {
    const int G = gridDim.x, rem = (((layer == DEPTH - 1 ? RL : R) / 256) * 4) % G, c = bidx(); if (c < rem) return;
    cvt_stream<1>(p, ws_of(p.ws), smem, layer, c - rem, G - rem);
}
DI void cvt_tail_a(const Params& p, int layer, char* smem) {
    const int G = gridDim.x, rem = ((R / 256) * (PW / 256)) % G, c = bidx(); if (c < rem) return;
    cvt_stream<3>(p, ws_of(p.ws), smem, layer, c - rem, G - rem);
}
DI void cvt_tail_d(const Params& p, int layer, char* smem) {
    if (layer + 1 >= DEPTH) return;
    const int G = gridDim.x, rem = (16 * (ROWS_E / 256) * 4) % G, c = bidx(); if (c < rem) return;
    cvt_stream<2>(p, ws_of(p.ws), smem, layer, c - rem, G - rem);
}
DI void phase_outproj(const Params& p, int layer, char* smem) { gemm_stream<1>(p, layer, smem); cvt_tail_b(p, layer, smem); }
DI void phase_moe1(const Params& p, int layer, char* smem) { gemm_stream<2>(p, layer, smem); }
DI void phase_moe2(const Params& p, int layer, char* smem) { gemm_stream<3>(p, layer, smem); cvt_tail_d(p, layer, smem); }

DI void phase_prep(const Params& p, int layer, char* smem) {
    const WS w = ws_of(p.ws); const int lane = tidx() & 63, wv = tidx() >> 6;
    for (int row = bidx() * 8 + wv; row < R; row += gridDim.x * 8) {
        const bool isc = row >= RL; const int n = isc ? 0 : row % SEQ; bf16_t* pr = w.p + (size_t)row * PW;
        for (int idx = lane; idx < 704; idx += 64) {
            int c1, dd, a; float sc;
            if (idx < 128) { const int h = idx >> 5, i = idx & 31; c1 = C_RQ + h * 64 + i; dd = 32; a = i; sc = 0.125f; }
            else if (idx < 256) { const int j = idx - 128, h = j >> 5, i = j & 31; c1 = C_RK + h * 64 + i; dd = 32; a = i; sc = 1.0f; }
            else if (idx < 384) { const int j = idx - 256, hc = j >> 4, i = j & 15; c1 = C_DQ + hc * 32 + i; dd = 16; a = 32 + i; sc = 0.17677669529663687f * LOG2E; }
            else if (idx < 512) { const int j = idx - 384, hc = j >> 4, i = j & 15; c1 = C_DK + hc * 32 + i; dd = 16; a = 32 + i; sc = 1.0f; }
            else if (idx < 640) { const int j = idx - 512, h = j >> 5, i = j & 31; c1 = C_SQ + h * 64 + i; dd = 32; a = 48 + i; sc = 0.125f * LOG2E; }
            else { const int j = idx - 640, h = j >> 5, i = j & 31; c1 = C_SK + h * 64 + i; dd = 32; a = 48 + i; sc = 1.0f; }
            float cs = 1.0f, sn = 0.0f; if (!isc) { cs = w.tab[((size_t)n * 80 + a) * 2]; sn = w.tab[((size_t)n * 80 + a) * 2 + 1]; }
            const float x1 = bf2f(pr[c1]), x2 = bf2f(pr[c1 + dd]);
            pr[c1] = f2bf((x1 * cs - x2 * sn) * sc); pr[c1 + dd] = f2bf((x1 * sn + x2 * cs) * sc);
        }
    }
}

constexpr int A_KS = 72;
constexpr int A_TILE = 64 * A_KS;
constexpr float A_THR = 6.0f;
template <int NC>
DI void attn_unit(const bf16_t* __restrict__ P, const int qrow0, const int qcol, const int kcol, const int vcol,
                  const int r1, const int n1, const int kp1, const bool mask1, const int r2, const int n2, const int qpos0,
                  const float m_init, const float l_init, const float lam, const float fin_scale, const float* __restrict__ norm_g,
                  bf16_t* __restrict__ outp  , char* smem) {
    bf16_t* Kb = (bf16_t*)smem; bf16_t* Vb = Kb + 2 * A_TILE;
    const int tid = tidx(), lane = tid & 63, wv = tid >> 6, fr = lane & 15, fq = lane >> 4;
    bf16x8 qf[2][2];
#pragma unroll
    for (int g = 0; g < 2; ++g)
#pragma unroll
        for (int i = 0; i < 2; ++i) qf[g][i] = *(const bf16x8*)(P + (size_t)(qrow0 + g * 128 + wv * 16 + fr) * PW + qcol + i * 32 + fq * 8);
    f32x4 o[2][NC][4], ol[2][NC], negm[2][NC]; float mrun[2][NC];
    const int T = n1 + n2, skey = tid >> 3, sc8 = tid & 7;
    const int soff = skey * A_KS + sc8 * 8;
    const int voff = (fq * 4 + (fr >> 2)) * A_KS + (fr & 3) * 4;
    u32x4 kr0, vr0, kr1, vr1;
#define A_LOAD(TN, KR, VR) do { const int tn_ = (TN); const int krow_ = (tn_ < n1) ? r1 + tn_ * 64 : r2 + (tn_ - n1) * 64; const bf16_t* src_ = P + (size_t)(krow_ + skey) * PW; \
        KR = *(const u32x4*)(src_ + kcol + sc8 * 8); VR = *(const u32x4*)(src_ + vcol + sc8 * 8); } while (0)
    A_LOAD(0, kr0, vr0);
    *(u32x4*)(Kb + soff) = kr0; *(u32x4*)(Vb + soff) = vr0;
    if (1 < T) A_LOAD(1, kr1, vr1);
    const int qposb = qpos0 + wv * 16 + fr;
    LDS_BARRIER();
    {
#pragma unroll
        for (int g = 0; g < 2; ++g)
#pragma unroll
            for (int c = 0; c < NC; ++c) { float mx = -INFINITY;
#pragma unroll
                for (int kt = 0; kt < 4; ++kt) {
                    const bf16x8 k0 = *(const bf16x8*)(Kb + (kt * 16 + fr) * A_KS + fq * 8), k1 = *(const bf16x8*)(Kb + (kt * 16 + fr) * A_KS + 32 + fq * 8);
                    const f32x4 z = (f32x4){0.f, 0.f, 0.f, 0.f};
                    f32x4 sv; if (NC == 2) sv = c == 0 ? MFMA16(k0, qf[g][0], z) : MFMA16(k1, qf[g][1], z); else sv = MFMA16(k1, qf[g][1], MFMA16(k0, qf[g][0], z));
#pragma unroll
                    for (int j = 0; j < 4; ++j) { const int dlt = qposb + g * 128 - (kp1 + kt * 16 + fq * 4 + j); if (!(mask1 && n1 > 0 && (dlt > 128 || dlt < -128))) mx = fmaxf(mx, sv[j]); } }
                mx = grp_max(mx); mrun[g][c] = fmaxf(m_init, mx); const float l0 = l_init * ex2(m_init - mrun[g][c]);
                negm[g][c] = (f32x4){-mrun[g][c], -mrun[g][c], -mrun[g][c], -mrun[g][c]}; ol[g][c] = (f32x4){l0, l0, l0, l0};
#pragma unroll
                for (int d = 0; d < 4; ++d) o[g][c][d] = (f32x4){0.f, 0.f, 0.f, 0.f}; }
    }
    bf16x8 onesf; { const u32x4 ov = (u32x4){0x3F803F80u, 0x3F803F80u, 0x3F803F80u, 0x3F803F80u}; onesf = __builtin_bit_cast(bf16x8, ov); }
    const int stag = __builtin_amdgcn_readfirstlane(tid >> 8);
    auto tile_step = [&](const int t, u32x4& kl, u32x4& vl, const u32x4& kw, const u32x4& vw) {
        LDS_BARRIER();
        STAGGER_SLEEP(stag);
        const bf16_t* Kt = Kb + (t & 1) * A_TILE; const bf16_t* Vt = Vb + (t & 1) * A_TILE;
        A_LOAD((t + 2 < T ? t + 2 : T - 1), kl, vl);
        const bool msk = mask1 && (t < n1); const int kpos_t = kp1 + t * 64;
        bf16x8 kf[4][2], vf[2][4];
#pragma unroll
        for (int kt = 0; kt < 4; ++kt) { kf[kt][0] = *(const bf16x8*)(Kt + (kt * 16 + fr) * A_KS + fq * 8); kf[kt][1] = *(const bf16x8*)(Kt + (kt * 16 + fr) * A_KS + 32 + fq * 8); }
#pragma unroll
        for (int k2 = 0; k2 < 2; ++k2)
#pragma unroll
            for (int d = 0; d < 4; ++d) { const s16x4 a = lds_tr16(Vt + voff + (2 * k2) * 16 * A_KS + d * 16), b = lds_tr16(Vt + voff + (2 * k2 + 1) * 16 * A_KS + d * 16);
                vf[k2][d] = __builtin_shufflevector(a, b, 0, 1, 2, 3, 4, 5, 6, 7); }
#pragma unroll
        for (int g = 0; g < 2; ++g)
#pragma unroll
            for (int c = 0; c < NC; ++c) {
                f32x4 s[4];
#pragma unroll
                for (int kt = 0; kt < 4; ++kt) { if (NC == 2) s[kt] = MFMA16(kf[kt][c], qf[g][c], negm[g][c]); else s[kt] = MFMA16(kf[kt][1], qf[g][1], MFMA16(kf[kt][0], qf[g][0], negm[g][0])); }
                if (msk) { const int qpos = qposb + g * 128;
#pragma unroll
                    for (int kt = 0; kt < 4; ++kt)
#pragma unroll
                        for (int j = 0; j < 4; ++j) { const int dlt = qpos - (kpos_t + kt * 16 + fq * 4 + j); if (dlt > 128 || dlt < -128) s[kt][j] = -INFINITY; } }
                int im = max(max(__float_as_int(s[0][0]), __float_as_int(s[0][1])), max(__float_as_int(s[0][2]), __float_as_int(s[0][3])));
#pragma unroll
                for (int kt = 1; kt < 4; ++kt) im = max(max(im, __float_as_int(s[kt][0])), max(max(__float_as_int(s[kt][1]), __float_as_int(s[kt][2])), __float_as_int(s[kt][3])));
                const float tm = __int_as_float(grp_imax(im));
                if (__any(tm > A_THR)) {
                    const float delta = fmaxf(tm, 0.f), alpha = ex2(-delta); mrun[g][c] += delta; negm[g][c] = (f32x4){-mrun[g][c], -mrun[g][c], -mrun[g][c], -mrun[g][c]}; ol[g][c] *= alpha;
#pragma unroll
                    for (int d = 0; d < 4; ++d) o[g][c][d] *= alpha;
#pragma unroll
                    for (int kt = 0; kt < 4; ++kt) s[kt] = s[kt] - delta;
                }
#pragma unroll
                for (int kt = 0; kt < 4; ++kt)
#pragma unroll
                    for (int j = 0; j < 4; ++j) s[kt][j] = ex2(s[kt][j]);
#pragma unroll
                for (int k2 = 0; k2 < 2; ++k2) {
                    u32x4 pp; pp[0] = pk2(s[2 * k2][0], s[2 * k2][1]); pp[1] = pk2(s[2 * k2][2], s[2 * k2][3]); pp[2] = pk2(s[2 * k2 + 1][0], s[2 * k2 + 1][1]); pp[3] = pk2(s[2 * k2 + 1][2], s[2 * k2 + 1][3]);
                    const bf16x8 pb = __builtin_bit_cast(bf16x8, pp);
#pragma unroll
                    for (int d = 0; d < 4; ++d) o[g][c][d] = MFMA16(vf[k2][d], pb, o[g][c][d]);
                    ol[g][c] = MFMA16(onesf, pb, ol[g][c]);
                }
            }
        { bf16_t* Kn = Kb + ((t + 1) & 1) * A_TILE + soff; bf16_t* Vn = Vb + ((t + 1) & 1) * A_TILE + soff;
            *(u32x4*)Kn = kw; *(u32x4*)Vn = vw; }
    };
#ifndef EMU
    __builtin_amdgcn_s_waitcnt(0x0F70);
#endif
    for (int t = 0; t < T; t += 2) { tile_step(t, kr0, vr0, kr1, vr1); if (t + 1 < T) tile_step(t + 1, kr1, vr1, kr0, vr0); }
#undef A_LOAD
#pragma unroll
    for (int g = 0; g < 2; ++g) {
        float linv[NC];
#pragma unroll
        for (int c = 0; c < NC; ++c) linv[c] = 1.0f / ol[g][c][0];
        f32x4 val[4]; float ss = 0.f;
#pragma unroll
        for (int d = 0; d < 4; ++d) {
            if (NC == 2) val[d] = o[g][0][d] * linv[0] - lam * (o[g][NC - 1][d] * linv[NC - 1]); else val[d] = o[g][0][d] * linv[0];
            ss += val[d][0] * val[d][0] + val[d][1] * val[d][1] + val[d][2] * val[d][2] + val[d][3] * val[d][3];
        }
        float rs = 1.0f;
        if (NC == 2) { ss = grp_sum(ss); rs = fin_scale / sqrtf(ss * (1.0f / 64.0f) + 1e-6f); }
        bf16_t* orow = outp + (size_t)(g * 128 + wv * 16 + fr) * 1024;
#pragma unroll
        for (int d = 0; d < 4; ++d) { f32x4 v = val[d] * rs; if (NC == 2) v = v * *(const f32x4*)(norm_g + d * 16 + fq * 4);
            u32x2 ov; ov[0] = pk2(v[0], v[1]); ov[1] = pk2(v[2], v[3]); *(u32x2*)(orow + d * 16 + fq * 4) = ov; }
    }
    __syncthreads();
}

DI void ret_kv_unit(const Params& p, const WS& w, int layer, int b, int h, int ci, char* smem) {
    bf16_t* Kr = (bf16_t*)smem; bf16_t* V0 = Kr + 128 * 72; bf16_t* V1 = V0 + 128 * 72;
    const int tid = tidx(), lane = tid & 63, wv = tid >> 6, fr = lane & 15, fq = lane >> 4; const bool isc = ci < NCC; const int row0 = isc ? RL + b * CTX + ci * 128 : b * SEQ + (ci - NCC) * 128;
    const float lg0 = -softplusf_(-p.ret_decay[(layer * 2 + 0) * 4 + h]) * LOG2E, lg1 = -softplusf_(-p.ret_decay[(layer * 2 + 1) * 4 + h]) * LOG2E;
    __syncthreads();
    for (int i = tid; i < 128 * 8; i += NT) { const int j = i >> 3, c8 = i & 7; const bf16_t* src = w.p + (size_t)(row0 + j) * PW + h * 64 + c8 * 8;
        *(u32x4*)(Kr + j * 72 + c8 * 8) = *(const u32x4*)(src + C_RK); const u32x4 vv = *(const u32x4*)(src + C_RV);
        const float d0 = ex2(lg0 * (float)(127 - j)), d1 = ex2(lg1 * (float)j); u32x4 a, c;
#pragma unroll
        for (int q = 0; q < 4; ++q) { const float lo = __uint_as_float(vv[q] << 16), hi = __uint_as_float(vv[q] & 0xffff0000u); a[q] = pk2(lo * d0, hi * d0); c[q] = pk2(lo * d1, hi * d1); }
        *(u32x4*)(V0 + j * 72 + c8 * 8) = a; *(u32x4*)(V1 + j * 72 + c8 * 8) = c; }
    __syncthreads();
    const int dir = wv >> 2, et = wv & 3; const bf16_t* Vd = dir ? V1 : V0; const int toff = (fq * 8 + (fr >> 2)) * 72 + (fr & 3) * 4;
    f32x4 acc[4];
#pragma unroll
    for (int n = 0; n < 4; ++n) acc[n] = (f32x4){0.f, 0.f, 0.f, 0.f};
#pragma unroll
    for (int ks = 0; ks < 4; ++ks) {
        const s16x4 va = lds_tr16(Vd + toff + (ks * 32) * 72 + et * 16), vb = lds_tr16(Vd + toff + (ks * 32 + 4) * 72 + et * 16); const bf16x8 vfr = __builtin_shufflevector(va, vb, 0, 1, 2, 3, 4, 5, 6, 7);
#pragma unroll
        for (int n = 0; n < 4; ++n) { const s16x4 ka = lds_tr16(Kr + toff + (ks * 32) * 72 + n * 16), kb = lds_tr16(Kr + toff + (ks * 32 + 4) * 72 + n * 16);
            acc[n] = MFMA16(vfr, __builtin_shufflevector(ka, kb, 0, 1, 2, 3, 4, 5, 6, 7), acc[n]); }
    }
    bf16_t* ob = w.rkv + ((size_t)((b * 4 + h) * 2 + dir) * NCHR + ci) * 4096;
#pragma unroll
    for (int n = 0; n < 4; ++n) { u32x2 o; o[0] = pk2(acc[n][0], acc[n][1]); o[1] = pk2(acc[n][2], acc[n][3]); *(u32x2*)(ob + (n * 16 + fr) * 64 + et * 16 + fq * 4) = o; }
}
DI void ret_scan(const Params& p, const WS& w, int layer) {
    for (int i = bidx() * NT + tidx(); i < NB * 4 * 2 * 2048; i += gridDim.x * NT) {
        const int chain = i >> 11, el = (i & 2047) * 2, d = chain & 1, h = (chain >> 1) & 3;
        const float x = p.ret_decay[(layer * 2 + d) * 4 + h]; const float cd = ex2(-softplusf_(-x) * LOG2E * 128.0f);
        unsigned kv[NCHR];
#pragma unroll
        for (int st = 0; st < NCHR; ++st) { const int ci = d == 0 ? st : (st < NCC ? NCC - 1 - st : NCC + (NLC - 1 - (st - NCC))); kv[st] = *(const unsigned*)(w.rkv + ((size_t)chain * NCHR + ci) * 4096 + el); }
        float s0 = 0.f, s1 = 0.f;
#pragma unroll
        for (int st = 0; st < NCHR; ++st) { const int ci = d == 0 ? st : (st < NCC ? NCC - 1 - st : NCC + (NLC - 1 - (st - NCC))); *(unsigned*)(w.rs + ((size_t)chain * NCHR + ci) * 4096 + el) = pk2(s0, s1);
            s0 = s0 * cd + bf_lo(kv[st]); s1 = s1 * cd + bf_hi(kv[st]); }
    }
}
constexpr int RO_KS = 72, RO_VS = 136;
DI void ret_out_unit(const Params& p, const WS& w, int layer, int b, int h, int ci, char* smem) {
    bf16_t* Ks = (bf16_t*)smem; bf16_t* Vr = Ks + 128 * RO_KS; bf16_t* Sr = Vr + 128 * RO_KS;
    const int tid = tidx(), lane = tid & 63, wv = tid >> 6, fr = lane & 15, fq = lane >> 4;
    const bool isc = ci < NCC; const int row0 = isc ? RL + b * CTX + ci * 128 : b * SEQ + (ci - NCC) * 128;
    __syncthreads();
    for (int i = tid; i < 128 * 8; i += NT) { const int j = i >> 3, c8 = i & 7; const bf16_t* src = w.p + (size_t)(row0 + j) * PW + h * 64 + c8 * 8;
        *(u32x4*)(Ks + j * RO_KS + c8 * 8) = *(const u32x4*)(src + C_RK); *(u32x4*)(Vr + j * RO_KS + c8 * 8) = *(const u32x4*)(src + C_RV); }
    for (int i = tid; i < 2 * 64 * 8; i += NT) { const int d = i >> 9, dk = (i >> 3) & 63, e8 = i & 7; const bf16_t* src = w.rs + ((size_t)((b * 4 + h) * 2 + d) * NCHR + ci) * 4096 + dk * 64 + e8 * 8;
        *(u32x4*)(Sr + (d * 64 + dk) * RO_KS + e8 * 8) = *(const u32x4*)src; }
    __syncthreads();
    const float lg0 = -softplusf_(-p.ret_decay[(layer * 2 + 0) * 4 + h]) * LOG2E, lg1 = -softplusf_(-p.ret_decay[(layer * 2 + 1) * 4 + h]) * LOG2E;
    const int qi = wv * 16 + fr;
    const int voff = (fq * 4 + (fr >> 2)) * RO_KS + (fr & 3) * 4;
    const int soffs = (fq * 8 + (fr >> 2)) * RO_KS + (fr & 3) * 4;
    bf16x8 qf[2];
#pragma unroll
    for (int i = 0; i < 2; ++i) qf[i] = *(const bf16x8*)(w.p + (size_t)(row0 + qi) * PW + C_RQ + h * 64 + i * 32 + fq * 8);
    f32x4 o[4], t0[4], t1[4];
#pragma unroll
    for (int d = 0; d < 4; ++d) { o[d] = (f32x4){0.f, 0.f, 0.f, 0.f}; t0[d] = o[d]; t1[d] = o[d]; }
#pragma unroll
    for (int k2 = 0; k2 < 4; ++k2) {
        f32x4 s[2];
#pragma unroll
        for (int q = 0; q < 2; ++q) { const int kt = 2 * k2 + q;
            const bf16x8 k0 = *(const bf16x8*)(Ks + (kt * 16 + fr) * RO_KS + fq * 8), k1 = *(const bf16x8*)(Ks + (kt * 16 + fr) * RO_KS + 32 + fq * 8);
            s[q] = MFMA16(k1, qf[1], MFMA16(k0, qf[0], (f32x4){0.f, 0.f, 0.f, 0.f}));
#pragma unroll
            for (int j = 0; j < 4; ++j) { const int kj = kt * 16 + fq * 4 + j, dl = qi - kj; const float dm = dl > 0 ? ex2(lg0 * (float)dl) : (dl < 0 ? ex2(lg1 * (float)(-dl)) : 2.0f); s[q][j] *= dm; } }
        u32x4 pp; pp[0] = pk2(s[0][0], s[0][1]); pp[1] = pk2(s[0][2], s[0][3]); pp[2] = pk2(s[1][0], s[1][1]); pp[3] = pk2(s[1][2], s[1][3]);
        const bf16x8 pb = __builtin_bit_cast(bf16x8, pp);
#pragma unroll
        for (int d = 0; d < 4; ++d) { const s16x4 v0 = lds_tr16(Vr + voff + (2 * k2) * 16 * RO_KS + d * 16), v1 = lds_tr16(Vr + voff + (2 * k2 + 1) * 16 * RO_KS + d * 16);
            o[d] = MFMA16(__builtin_shufflevector(v0, v1, 0, 1, 2, 3, 4, 5, 6, 7), pb, o[d]); }
    }
#pragma unroll
    for (int d = 0; d < 4; ++d)
#pragma unroll
        for (int ks = 0; ks < 2; ++ks) {
            const s16x4 a0 = lds_tr16(Sr + soffs + (ks * 32) * RO_KS + d * 16), a1 = lds_tr16(Sr + soffs + (ks * 32 + 4) * RO_KS + d * 16);
            const s16x4 b0 = lds_tr16(Sr + soffs + (64 + ks * 32) * RO_KS + d * 16), b1 = lds_tr16(Sr + soffs + (64 + ks * 32 + 4) * RO_KS + d * 16);
            t0[d] = MFMA16(__builtin_shufflevector(a0, a1, 0, 1, 2, 3, 4, 5, 6, 7), qf[ks], t0[d]); t1[d] = MFMA16(__builtin_shufflevector(b0, b1, 0, 1, 2, 3, 4, 5, 6, 7), qf[ks], t1[d]); }
    const float qd0 = ex2(lg0 * (float)(qi + 1)), qd1 = ex2(lg1 * (float)(128 - qi));
    float ss = 0.f;
#pragma unroll
    for (int d = 0; d < 4; ++d) { o[d] = o[d] + qd0 * t0[d] + qd1 * t1[d]; ss += o[d][0] * o[d][0] + o[d][1] * o[d][1] + o[d][2] * o[d][2] + o[d][3] * o[d][3]; }
    ss = grp_sum(ss);
    const float rs = 1.0f / sqrtf(ss * (1.0f / 64.0f) + 1e-6f);
    const bf16_t* gp = w.p + (size_t)(row0 + qi) * PW + C_RG + h * 64; bf16_t* op = w.mix + (size_t)(row0 + qi) * 1024 + h * 64;
#pragma unroll
    for (int d = 0; d < 4; ++d) { const u32x2 gv = *(const u32x2*)(gp + d * 16 + fq * 4);
        const float g0 = __uint_as_float(gv[0] << 16), g1 = __uint_as_float(gv[0] & 0xffff0000u), g2 = __uint_as_float(gv[1] << 16), g3 = __uint_as_float(gv[1] & 0xffff0000u);
        u32x2 ov; ov[0] = pk2(o[d][0] * rs * siluf(g0), o[d][1] * rs * siluf(g1)); ov[1] = pk2(o[d][2] * rs * siluf(g2), o[d][3] * rs * siluf(g3)); *(u32x2*)(op + d * 16 + fq * 4) = ov; }
}

constexpr int GS = 68, GNA = 72, GDI = 24;
DI bf16x8 pack8f(const float* p) {
    const f32x4 a = *(const f32x4*)p, b = *(const f32x4*)(p + 4); u32x4 r; r[0] = pk2(a[0], a[1]); r[1] = pk2(a[2], a[3]); r[2] = pk2(b[0], b[1]); r[3] = pk2(b[2], b[3]); return __builtin_bit_cast(bf16x8, r);
}
DI void gdn_prep_unit(const Params& p, const WS& w, int layer, int b, int h, int cg, char* smem) {
    float* Qs = (float*)smem; float* Ks = Qs + 64 * GS; float* Vs = Ks + 64 * GS; float* Raw = Vs + 64 * GS;
    float* KK = Raw; float* QK = KK + 64 * GS; float* gt = Raw + 66 * 192;
    bf16_t* NA = (bf16_t*)(gt + 384); bf16_t* DIm = NA + 2 * 64 * GNA;
    const int tid = tidx(), lane = tid & 63, wv = tid >> 6, fr = lane & 15, fq = lane >> 4;
    const bool isc = cg < NCG; const int nseq = isc ? CTX : SEQ, t0 = (isc ? cg : cg - NCG) * 64, base = isc ? RL + b * CTX : b * SEQ;
    __syncthreads();
    for (int i = tid; i < 66 * 24; i += NT) { const int tt = i / 24, c8 = i % 24, part = c8 >> 3, tok = t0 - 1 + tt; u32x4 v = (u32x4){0u, 0u, 0u, 0u};
        if (tok >= 0 && tok < nseq) v = *(const u32x4*)(w.p + (size_t)(base + tok) * PW + C_GQKV + part * 256 + h * 64 + (c8 & 7) * 8);
        { *(f32x4*)(Raw + tt * 192 + c8 * 8) = (f32x4){bf_lo(v[0]), bf_hi(v[0]), bf_lo(v[1]), bf_hi(v[1])}; *(f32x4*)(Raw + tt * 192 + c8 * 8 + 4) = (f32x4){bf_lo(v[2]), bf_hi(v[2]), bf_lo(v[3]), bf_hi(v[3])}; } }
    if (tid < 128) { const int dr = tid >> 6, s = tid & 63; const float* ga = w.gab + (size_t)(base + t0 + s) * 16;
        gt[dr * 64 + s] = -__expf(p.gdn_a_log[(layer * 2 + dr) * 4 + h]) * softplusf_(ga[dr * 4 + h] + p.gdn_dt_bias[(layer * 2 + dr) * 4 + h]);
        gt[128 + dr * 64 + s] = sigmoidf_(ga[8 + dr * 4 + h]); }
    __syncthreads();
    if (tid < 384) {
        const int ch = tid % 192, half = tid / 192, part = ch >> 6, d = ch & 63, chg = part * 256 + h * 64 + d; const float* cw = p.gdn_conv + (size_t)layer * 3 * 768 + chg;
        const float w0 = cw[0], w1 = cw[768], w2 = cw[1536]; float* dst = (part == 0 ? Qs : (part == 1 ? Ks : Vs)) + d;
        float x0 = Raw[(half * 32) * 192 + ch], x1 = Raw[(half * 32 + 1) * 192 + ch];
#pragma unroll 8
        for (int s = half * 32; s < half * 32 + 32; ++s) { const float x2 = Raw[(s + 2) * 192 + ch]; dst[s * GS] = siluf(w0 * x0 + w1 * x1 + w2 * x2); x0 = x1; x1 = x2; }
    } else if (tid >= 384 && tid < 512) {
        const int dr = (tid - 384) >> 6, sl = tid & 63; float a = gt[dr * 64 + (dr ? 63 - sl : sl)];
#pragma unroll
        for (int dd = 1; dd < 64; dd <<= 1) { const float o = lane_shfl_f(a, sl >= dd ? sl - dd : sl); if (sl >= dd) a += o; }
        gt[256 + dr * 64 + sl] = a; }
    __syncthreads();
#pragma unroll
    for (int pass = 0; pass < 2; ++pass) {
        float* rowp = (pass == 0 ? Qs : Ks) + (tid >> 3) * GS + (tid & 7) * 8; f32x4 x0 = *(const f32x4*)rowp, x1 = *(const f32x4*)(rowp + 4);
        float ss = x0[0] * x0[0] + x0[1] * x0[1] + x0[2] * x0[2] + x0[3] * x0[3] + x1[0] * x1[0] + x1[1] * x1[1] + x1[2] * x1[2] + x1[3] * x1[3];
        ss = sum8(ss); const float rs = (1.0f / sqrtf(ss + 1e-6f)) * (pass == 0 ? 0.125f : 1.0f);
        *(f32x4*)rowp = x0 * rs; *(f32x4*)(rowp + 4) = x1 * rs; }
    __syncthreads();
#pragma unroll
    for (int tt = 0; tt < 4; ++tt) { const int t = wv * 4 + tt, which = t >> 4, mt = (t >> 2) & 3, nt = t & 3; const float* Am = which ? Qs : Ks;
        f32x4 d = (f32x4){0.f, 0.f, 0.f, 0.f};
#pragma unroll
        for (int ks = 0; ks < 2; ++ks) d = MFMA16(pack8f(Am + (mt * 16 + fr) * GS + ks * 32 + fq * 8), pack8f(Ks + (nt * 16 + fr) * GS + ks * 32 + fq * 8), d);
        float* G = which ? QK : KK;
#pragma unroll
        for (int jj = 0; jj < 4; ++jj) G[(mt * 16 + fq * 4 + jj) * GS + nt * 16 + fr] = d[jj]; }
    __syncthreads();
    for (int i = tid; i < 2 * 2048; i += NT) { const int dr = i >> 11, s = (i >> 5) & 63, s2 = (i & 31) * 2, ts = dr ? 63 - s : s; float v0 = 0.f, v1 = 0.f;
        const float nb = -gt[128 + dr * 64 + ts], gs = gt[256 + dr * 64 + s];
        if (s > s2) v0 = nb * KK[ts * GS + (dr ? 63 - s2 : s2)] * __expf(gs - gt[256 + dr * 64 + s2]);
        if (s > s2 + 1) v1 = nb * KK[ts * GS + (dr ? 62 - s2 : s2 + 1)] * __expf(gs - gt[256 + dr * 64 + s2 + 1]);
        *(unsigned*)(NA + (dr * 64 + s) * GNA + s2) = pk2(v0, v1); }
    __syncthreads();
    if (tid < 128) {
        const int dr = tid >> 6, blk = (tid >> 4) & 3, c = tid & 15; const bf16_t* Ab = NA + (dr * 64 + blk * 16) * GNA + blk * 16; float x[16];
#pragma unroll
        for (int r = 0; r < 16; ++r) { float a = (r == c) ? 1.0f : 0.0f;
            const u32x4 lo = *(const u32x4*)(Ab + r * GNA), hi = *(const u32x4*)(Ab + r * GNA + 8);
#pragma unroll
            for (int r2 = 0; r2 < r; ++r2) { const unsigned wd = r2 < 8 ? lo[r2 >> 1] : hi[(r2 - 8) >> 1]; a += __uint_as_float((r2 & 1) ? (wd & 0xffff0000u) : (wd << 16)) * x[r2]; }
            x[r] = a; DIm[((dr * 4 + blk) * 16 + r) * GDI + c] = f2bf(a); }
    }
    __syncthreads();
    const size_t cbase = (size_t)((b * 4 + h) * 2) * NCHG;
#pragma unroll 1
    for (int tk = 0; tk < 2; ++tk) {
        const int task = wv + tk * 8, dr = task >> 3, ntile = task & 7, col = ntile * 16 + fr; const bool isw = ntile >= 4;
        const int sc = dr == 0 ? cg : (cg < NCG ? NCG - 1 - cg : NCG + (NLG - 1 - (cg - NCG))); const size_t ch = cbase + (size_t)dr * NCHG + sc;
        const float* gg = gt + 256 + dr * 64; const float* bt = gt + 128 + dr * 64; const float* Rm = isw ? Ks + (col - 64) : Vs + col;
        u32x2 xb[4];
#pragma unroll
        for (int i = 0; i < 4; ++i) {
            f32x4 acc;
#pragma unroll
            for (int jj = 0; jj < 4; ++jj) { const int sidx = 16 * i + fq * 4 + jj, ts = dr ? 63 - sidx : sidx; float r = bt[ts] * Rm[ts * GS]; if (isw) r *= __expf(gg[sidx]); acc[jj] = r; }
#pragma unroll
            for (int j0 = 0; j0 < i; j0 += 2) {
                const u32x2 a0 = *(const u32x2*)(NA + (dr * 64 + 16 * i + fr) * GNA + 16 * j0 + fq * 4);
                u32x2 a1 = (u32x2){0u, 0u}, b1 = (u32x2){0u, 0u};
                if (j0 + 1 < i) { a1 = *(const u32x2*)(NA + (dr * 64 + 16 * i + fr) * GNA + 16 * (j0 + 1) + fq * 4); b1 = xb[j0 + 1]; }
                u32x4 av; av[0] = a0[0]; av[1] = a0[1]; av[2] = a1[0]; av[3] = a1[1]; u32x4 bv; bv[0] = xb[j0][0]; bv[1] = xb[j0][1]; bv[2] = b1[0]; bv[3] = b1[1];
                acc = MFMA16(__builtin_bit_cast(bf16x8, av), __builtin_bit_cast(bf16x8, bv), acc);
            }
            const u32x2 dd = *(const u32x2*)(DIm + ((dr * 4 + i) * 16 + fr) * GDI + fq * 4);
            u32x4 av; av[0] = dd[0]; av[1] = dd[1]; av[2] = 0u; av[3] = 0u; u32x4 bv; bv[0] = pk2(acc[0], acc[1]); bv[1] = pk2(acc[2], acc[3]); bv[2] = 0u; bv[3] = 0u;
            const f32x4 x = MFMA16(__builtin_bit_cast(bf16x8, av), __builtin_bit_cast(bf16x8, bv), (f32x4){0.f, 0.f, 0.f, 0.f});
            xb[i][0] = pk2(x[0], x[1]); xb[i][1] = pk2(x[2], x[3]);
            if (!isw) *(u32x2*)(w.gub + ch * 4096 + (size_t)col * 64 + 16 * i + fq * 4) = xb[i];
            else { bf16_t* wp = w.gw + ch * 4096 + (size_t)(16 * i + fq * 4) * 64 + (col - 64);
#pragma unroll
                for (int jj = 0; jj < 4; ++jj) wp[jj * 64] = f2bf(x[jj]); }
        }
    }
    for (int i = tid; i < 2 * 1024; i += NT) {
        const int dr = i >> 10, s = (i >> 4) & 63, c = (i & 15) * 4, ts = dr ? 63 - s : s; const float* gg = gt + 256 + dr * 64;
        const int sc = dr == 0 ? cg : (cg < NCG ? NCG - 1 - cg : NCG + (NLG - 1 - (cg - NCG))); const size_t ch = cbase + (size_t)dr * NCHG + sc;
        const float gs = gg[s], es = __expf(gs), g63 = gg[63];
        float qg[4], qk[4], kt[4];
#pragma unroll
        for (int k = 0; k < 4; ++k) { const int cc = c + k, tc = dr ? 63 - cc : cc; const float gc = gg[cc];
            qg[k] = Qs[ts * GS + cc] * es; qk[k] = s >= cc ? QK[ts * GS + tc] * __expf(gs - gc) : 0.f; kt[k] = Ks[tc * GS + s] * __expf(g63 - gc); }
        u32x2 o; o[0] = pk2(qg[0], qg[1]); o[1] = pk2(qg[2], qg[3]); *(u32x2*)(w.gqg + ch * 4096 + s * 64 + c) = o;
        o[0] = pk2(qk[0], qk[1]); o[1] = pk2(qk[2], qk[3]); *(u32x2*)(w.gqk + ch * 4096 + s * 64 + c) = o;
        o[0] = pk2(kt[0], kt[1]); o[1] = pk2(kt[2], kt[3]); *(u32x2*)(w.gkt + ch * 4096 + s * 64 + c) = o;
        if (s == 0 && c == 0) w.gcd[ch] = __expf(g63); }
}
struct GdnOps { bf16x8 aw[2], aqg[2], aqk[2], akt[2]; u32x2 ub; float cd; };
DI void gdn_load_ops(GdnOps& g, const WS& w, size_t ch, int wv, int fr, int fq, int vs) {
#pragma unroll
    for (int ks = 0; ks < 2; ++ks) { const size_t o = ch * 4096 + (size_t)(wv * 16 + fr) * 64 + ks * 32 + fq * 8;
        g.aw[ks] = *(const bf16x8*)(w.gw + o); g.aqg[ks] = *(const bf16x8*)(w.gqg + o); g.aqk[ks] = *(const bf16x8*)(w.gqk + o); g.akt[ks] = *(const bf16x8*)(w.gkt + o); }
    g.ub = *(const u32x2*)(w.gub + ch * 4096 + (size_t)(vs * 16 + fr) * 64 + wv * 16 + fq * 4); g.cd = w.gcd[ch];
}
DI void gdn_scan_step(const GdnOps& g, f32x4& sacc, bf16_t* Sp, bf16_t* Up, const WS& w, int rbase, int dr, int h, int vs, int wv, int fr, int fq) {
    { u32x2 sv; sv[0] = pk2(sacc[0], sacc[1]); sv[1] = pk2(sacc[2], sacc[3]); *(u32x2*)(Sp + fr * 72 + wv * 16 + fq * 4) = sv; }
    LDS_BARRIER();
    bf16x8 sb[2]; f32x4 u = (f32x4){0.f, 0.f, 0.f, 0.f};
#pragma unroll
    for (int ks = 0; ks < 2; ++ks) { sb[ks] = *(const bf16x8*)(Sp + fr * 72 + ks * 32 + fq * 8); u = MFMA16(g.aw[ks], sb[ks], u); }
    u = (f32x4){bf_lo(g.ub[0]), bf_hi(g.ub[0]), bf_lo(g.ub[1]), bf_hi(g.ub[1])} - u;
    { u32x2 uvv; uvv[0] = pk2(u[0], u[1]); uvv[1] = pk2(u[2], u[3]); *(u32x2*)(Up + fr * 72 + wv * 16 + fq * 4) = uvv; }
    LDS_BARRIER();
    f32x4 oo = (f32x4){0.f, 0.f, 0.f, 0.f}, sn = sacc * g.cd;
#pragma unroll
    for (int ks = 0; ks < 2; ++ks) { const bf16x8 ubf = *(const bf16x8*)(Up + fr * 72 + ks * 32 + fq * 8);
        oo = MFMA16(g.aqg[ks], sb[ks], oo); oo = MFMA16(g.aqk[ks], ubf, oo); sn = MFMA16(g.akt[ks], ubf, sn); }
    sacc = sn;
    {
        const bool ev = (fr & 1) == 0;
        const float r0 = lane_xor1_f(ev ? oo[2] : oo[0]), r1 = lane_xor1_f(ev ? oo[3] : oo[1]);
        const unsigned p0 = ev ? pk2(oo[0], r0) : pk2(r0, oo[2]), p1 = ev ? pk2(oo[1], r1) : pk2(r1, oo[3]);
#pragma unroll
        for (int q = 0; q < 2; ++q) { const int s = wv * 16 + fq * 4 + (ev ? 0 : 2) + q, tok = dr ? 63 - s : s;
            *(unsigned*)(w.og + ((size_t)dr * R + rbase + tok) * 256 + h * 64 + vs * 16 + (fr & 14)) = q ? p1 : p0; }
    }
}
DI void gdn_scan_unit(const Params& p, const WS& w, int layer, int b, int h, int dr, int vs, char* smem) {
    static_assert(NCHG % 4 == 0, "scan ring assumes a multiple of 4 chunks");
    bf16_t* Sb = (bf16_t*)smem; bf16_t* Ub = Sb + 2 * 16 * 72;
    const int tid = tidx(), lane = tid & 63, wv = tid >> 6, fr = lane & 15, fq = lane >> 4;
    const size_t cb = (size_t)((b * 4 + h) * 2 + dr) * NCHG;
    __syncthreads();
    if (wv < 4) {
        f32x4 sacc = (f32x4){0.f, 0.f, 0.f, 0.f};
        GdnOps r0, r1, r2, r3;
        gdn_load_ops(r0, w, cb, wv, fr, fq, vs); gdn_load_ops(r1, w, cb + 1, wv, fr, fq, vs); gdn_load_ops(r2, w, cb + 2, wv, fr, fq, vs); gdn_load_ops(r3, w, cb + 3, wv, fr, fq, vs);
#define GDN_STEP(RG, K) do { const int sc_ = sc + (K); const int cgi = dr == 0 ? sc_ : (sc_ < NCG ? NCG - 1 - sc_ : NCG + (NLG - 1 - (sc_ - NCG))); \
        gdn_scan_step(RG, sacc, Sb + (K & 1) * 16 * 72, Ub + (K & 1) * 16 * 72, w, cgi < NCG ? RL + b * CTX + cgi * 64 : b * SEQ + (cgi - NCG) * 64, dr, h, vs, wv, fr, fq); \
        gdn_load_ops(RG, w, cb + (sc_ + 4 < NCHG ? sc_ + 4 : NCHG - 1), wv, fr, fq, vs); } while (0)
#pragma unroll 1
        for (int sc = 0; sc < NCHG; sc += 4) { GDN_STEP(r0, 0); GDN_STEP(r1, 1); GDN_STEP(r2, 2); GDN_STEP(r3, 3); }
#undef GDN_STEP
    } else {
#pragma unroll 1
        for (int sc = 0; sc < NCHG; ++sc) { LDS_BARRIER(); LDS_BARRIER(); }
    }
    __syncthreads();
}
DI void gdn_finish(const Params& p, const WS& w, int layer, int skip) {
    const int lane = tidx() & 63, wv = tidx() >> 6; const int nrows = layer == DEPTH - 1 ? RL : R;
    if (bidx() < skip) return;
    for (int row = (bidx() - skip) * 8 + wv; row < nrows; row += (gridDim.x - skip) * 8) {
        const u32x2 av = *(const u32x2*)(w.og + (size_t)row * 256 + lane * 4), cv = *(const u32x2*)(w.og + ((size_t)R + row) * 256 + lane * 4);
        const f32x4 o = (f32x4){bf_lo(av[0]) + bf_lo(cv[0]), bf_hi(av[0]) + bf_hi(cv[0]), bf_lo(av[1]) + bf_lo(cv[1]), bf_hi(av[1]) + bf_hi(cv[1])};
        float ss = o[0] * o[0] + o[1] * o[1] + o[2] * o[2] + o[3] * o[3];
        ss = sum16(ss);
        const float rs = 1.0f / sqrtf(ss * (1.0f / 64.0f) + 1e-6f); const f32x4 ng = *(const f32x4*)(p.gdn_norm + layer * 64 + (lane & 15) * 4);
        const u32x2 gv = *(const u32x2*)(w.p + (size_t)row * PW + C_GG + lane * 4);
        const float g0 = __uint_as_float(gv[0] << 16), g1 = __uint_as_float(gv[0] & 0xffff0000u), g2 = __uint_as_float(gv[1] << 16), g3 = __uint_as_float(gv[1] & 0xffff0000u);
        u32x2 ov; ov[0] = pk2(o[0] * rs * ng[0] * siluf(g0), o[1] * rs * ng[1] * siluf(g1)); ov[1] = pk2(o[2] * rs * ng[2] * siluf(g2), o[3] * rs * ng[3] * siluf(g3));
        *(u32x2*)(w.mix + (size_t)row * 1024 + 512 + lane * 4) = ov;
    }
}

DI void phase_diff(const Params& p, int layer, char* smem) {
    const WS w = ws_of(p.ws); const bool full_ctx = layer < DEPTH - 1;
    constexpr int QB = SEQ / 256, QC = CTX / 256;
    const int n_diff = NB * 4 * QB, n_diffc = full_ctx ? NB * 4 * QC : 0;
    int lyr = layer;
#ifndef EMU
    asm volatile("" : "+s"(lyr));
#endif
    const float lam_init = 0.8f - 0.6f * __expf(-0.3f * (float)lyr);
    float lam; { const float* lp = p.diff_lambda + layer * 128; const int ln = tidx() & 63; float s1 = 0.f, s2 = 0.f; if (ln < 32) { s1 = lp[ln] * lp[32 + ln]; s2 = lp[64 + ln] * lp[96 + ln]; }
        s1 = wsum(s1); s2 = wsum(s2); lam = __expf(s1) - __expf(s2) + lam_init; }
    for (int r0 = bidx(); r0 < n_diff + n_diffc; r0 += gridDim.x) {
        int r = r0; if (r0 < n_diff && (NB * 4) % 8 == 0) { const int x = r0 & 7, y = r0 >> 3, bh = x + 8 * (y / QB), qb_ = y % QB; r = bh * QB + qb_; }
        const bool isc = r >= n_diff; const int rr = isc ? r - n_diff : r, nq = isc ? QC : QB, qb = rr % nq, h = (rr / nq) & 3, b = rr / (nq * 4);
        const int qrow = (isc ? RL + b * CTX : b * SEQ) + qb * 256;
        attn_unit<2>(w.p, qrow, C_DQ + h * 64, C_DK + h * 64, C_DV + h * 64, isc ? RL + b * CTX : b * SEQ, isc ? CTX / 64 : SEQ / 64, 0, false, RL + b * CTX, isc ? 0 : CTX / 64, 0,
                     -1e30f, 0.f, lam, 1.0f - lam_init, p.diff_norm + layer * 64, w.mix + (size_t)qrow * 1024 + 256 + h * 64, smem);
    }
}
DI void phase_swa(const Params& p, int layer, char* smem) {
    const WS w = ws_of(p.ws); const bool full_ctx = layer < DEPTH - 1;
    constexpr int QB = SEQ / 256, QC = CTX / 256;
    const int n_swa = NB * 4 * QB, n_swac = full_ctx ? NB * 4 * QC : 0;
    for (int r0 = bidx(); r0 < n_swa + n_swac; r0 += gridDim.x) {
        int r = r0; if (r0 < n_swa && (NB * 4) % 8 == 0) { const int x = r0 & 7, y = r0 >> 3, bh = x + 8 * (y / QB), qb_ = y % QB; r = bh * QB + qb_; }
        const bool isc = r >= n_swa; const int rr = isc ? r - n_swa : r, nq = isc ? QC : QB, qb = rr % nq, hh = (rr / nq) & 3, b = rr / (nq * 4), hk = hh >> 1;
        const int qrow = (isc ? RL + b * CTX : b * SEQ) + qb * 256;
        const int ks = qb * 256 - 128 < 0 ? 0 : qb * 256 - 128, ke = qb * 256 + 384 > SEQ ? SEQ : qb * 256 + 384;
        attn_unit<1>(w.p, qrow, C_SQ + hh * 64, C_SK + hk * 64, C_SV + hk * 64, isc ? RL + b * CTX : b * SEQ + ks, isc ? CTX / 64 : (ke - ks) / 64, isc ? 0 : ks, !isc, RL + b * CTX, isc ? 0 : CTX / 64, qb * 256,
                     p.swa_sink[layer * 4 + hh] * LOG2E, 1.0f, 0.f, 1.0f, nullptr, w.mix + (size_t)qrow * 1024 + 768 + hh * 64, smem);
    }
}
DI void phase_gdnp(const Params& p, int layer, char* smem) {
    const WS w = ws_of(p.ws);
    for (int r = bidx(); r < NB * 4 * NCHG; r += gridDim.x) { const int cg = r % NCHG, h = (r / NCHG) & 3, b = r / (NCHG * 4); gdn_prep_unit(p, w, layer, b, h, cg, smem); }
}
DI void phase_rkv(const Params& p, int layer, char* smem) {
    const WS w = ws_of(p.ws);
    const int G = gridDim.x;
    for (int r = (bidx() + G / 2) % G; r < NB * 4 * NCHR; r += G) { const int ci = r % NCHR, h = (r / NCHR) & 3, b = r / (NCHR * 4); ret_kv_unit(p, w, layer, b, h, ci, smem); }
}
DI void phase_mix2(const Params& p, int layer, char* smem) {
    const WS w = ws_of(p.ws);
    for (int u = bidx(); u < NB * 4 * 2 * 4; u += gridDim.x) {
        const int x = u & 7, y = u >> 3, vs = y & 3, chain = x + 8 * (y >> 2), dr = chain & 1, h = (chain >> 1) & 3, b = chain >> 3;
        gdn_scan_unit(p, w, layer, b, h, dr, vs, smem); }
    ret_scan(p, w, layer);
}
DI void phase_mix3(const Params& p, int layer, char* smem) {
    const WS w = ws_of(p.ws); const bool full_ctx = layer < DEPTH - 1;
    for (int u = bidx(); u < NB * 4 * NCHR; u += gridDim.x) { const int ci = u % NCHR, h = (u / NCHR) & 3, b = u / (NCHR * 4); if (ci < NCC && !full_ctx) continue; ret_out_unit(p, w, layer, b, h, ci, smem); }
    const int G = gridDim.x, nun = NB * 4 * (full_ctx ? NCHR : NLC), rem = nun % G;
    gdn_finish(p, w, layer, (rem > 0 && rem <= G / 2) ? rem : 0);
}

DI int block_sum(int v, int* red) {
    const int lane = tidx() & 63, wv = tidx() >> 6;
    const int s = wsum_i(v);
    __syncthreads(); if (lane == 0) red[wv] = s; __syncthreads();
    int t = 0;
#pragma unroll
    for (int i = 0; i < 8; ++i) t += red[i];
    return t;
}
DI int block_exscan(int v, int* red) {
    const int lane = tidx() & 63, wv = tidx() >> 6;
    int s = v;
#pragma unroll
    for (int d = 1; d < 64; d <<= 1) { const int o = lane_shfl_i(s, lane >= d ? lane - d : lane); if (lane >= d) s += o; }
    __syncthreads(); if (lane == 63) red[wv] = s; __syncthreads();
    int off = 0;
#pragma unroll
    for (int i = 0; i < 8; ++i) if (i < wv) off += red[i];
    return off + s - v;
}
template <int N, int CAP> DI void topk_unit(const WS& w, const float* __restrict__ aff, int rowbase, int slotbase, int e, int* red) {
    constexpr int PT = (N + NT - 1) / NT;
    const int tid = tidx(); unsigned key[PT];
#pragma unroll
    for (int i = 0; i < PT; ++i) { const int n = tid * PT + i; key[i] = n < N ? __float_as_uint(aff[n]) : 0u; }
    unsigned T = 0u;
    for (int bit = 30; bit >= 0; --bit) { const unsigned cand = T | (1u << bit); int c = 0;
#pragma unroll
        for (int i = 0; i < PT; ++i) c += (tid * PT + i < N && key[i] >= cand) ? 1 : 0;
        if (block_sum(c, red) >= CAP) T = cand; }
    int cg = 0, ce = 0;
#pragma unroll
    for (int i = 0; i < PT; ++i) { const bool in = tid * PT + i < N; cg += (in && key[i] > T) ? 1 : 0; ce += (in && key[i] == T) ? 1 : 0; }
    const int need = CAP - block_sum(cg, red); const int eoff = block_exscan(ce, red);
    int sel = 0, er = eoff; bool flag[PT];
#pragma unroll
    for (int i = 0; i < PT; ++i) { const bool in = tid * PT + i < N; bool f = in && key[i] > T; if (in && key[i] == T) { f = er < need; ++er; } flag[i] = f; sel += f ? 1 : 0; }
    int slot = block_exscan(sel, red);
    int* selrow = red + 32;
#pragma unroll
    for (int i = 0; i < PT; ++i) { const int n = tid * PT + i; int iv = -1;
        if (n < N) { if (flag[i]) { iv = slotbase + slot; w.idx[(size_t)e * ROWS_E + iv] = rowbase + n; w.wgt[(size_t)e * ROWS_E + iv] = __uint_as_float(key[i]); selrow[slot] = rowbase + n; ++slot; }
            w.inv[(size_t)(rowbase + n) * 16 + e] = iv; } }
    __syncthreads();
}
DI void phase_topk(const Params& p, int layer, char* smem) {
    const WS w = ws_of(p.ws); int* red = (int*)smem; const bool full_ctx = layer < DEPTH - 1;
    for (int u = bidx(); u < 2 * NB * 16; u += gridDim.x) {
        const bool isc = u >= NB * 16; const int v = isc ? u - NB * 16 : u, b = v >> 4, e = v & 15;
        if (!isc) topk_unit<SEQ, CAPL>(w, w.aff + ((size_t)b * 16 + e) * SEQ, b * SEQ, b * CAPL, e, red);
        else if (full_ctx) topk_unit<CTX, CAPC>(w, w.aff + (size_t)RL * 16 + ((size_t)b * 16 + e) * CTX, RL + b * CTX, NB * CAPL + b * CAPC, e, red);
        else { for (int i = tidx(); i < CAPC; i += NT) { w.idx[(size_t)e * ROWS_E + NB * CAPL + b * CAPC + i] = 0; w.wgt[(size_t)e * ROWS_E + NB * CAPL + b * CAPC + i] = 0.f; } }
    }
    {
        const int G = gridDim.x, c = bidx(), first = G > NB * 16 ? NB * 16 : 0;
        if (c >= first) { __syncthreads(); cvt_stream<4>(p, w, smem, layer, c - first, G - first); }
    }
}

enum { PH_CVT = 0, PH_INIT, PH_INPROJ, PH_PREP, PH_DIFF, PH_MIX2, PH_MIX3, PH_OUTPROJ, PH_LN0, PH_TOPK, PH_MOE1, PH_MOE2, PH_LN1, PH_SWA, PH_GDNP, PH_RKV };
#ifdef EMU
#define SMEM_PTR(s) char* s = emu::B->lds
#else
extern __shared__ __attribute__((aligned(16))) char dyn_smem[];
#define SMEM_PTR(s) char* s = dyn_smem
#endif
template <int PH> DI void run_phase(const Params& p, int layer, char* smem) {
    if (PH == PH_CVT) phase_cvt(p, smem);
    else if (PH == PH_INIT) phase_rows<0>(p, 0, smem);
    else if (PH == PH_INPROJ) phase_inproj(p, layer, smem);
    else if (PH == PH_PREP) phase_prep(p, layer, smem);
    else if (PH == PH_DIFF) phase_diff(p, layer, smem);
    else if (PH == PH_SWA) phase_swa(p, layer, smem);
    else if (PH == PH_GDNP) phase_gdnp(p, layer, smem);
    else if (PH == PH_RKV) phase_rkv(p, layer, smem);
    else if (PH == PH_MIX2) phase_mix2(p, layer, smem);
    else if (PH == PH_MIX3) phase_mix3(p, layer, smem);
    else if (PH == PH_OUTPROJ) phase_outproj(p, layer, smem);
    else if (PH == PH_LN0) phase_rows<1>(p, layer, smem);
    else if (PH == PH_TOPK) phase_topk(p, layer, smem);
    else if (PH == PH_MOE1) phase_moe1(p, layer, smem);
    else if (PH == PH_MOE2) phase_moe2(p, layer, smem);
    else if (PH == PH_LN1) phase_rows<2>(p, layer, smem);
}
constexpr int LDS_BYTES = 8 * G_HT * 2 + 2048;
template <int PH> __global__ void __launch_bounds__(NT, 2) k_phase(Params p, int layer) { SMEM_PTR(smem); run_phase<PH>(p, layer, smem); }

#ifdef EMU
void (*emu_hook)(const char* tag, int layer, char* ws) = nullptr;
#define HOOK(t, l) do { if (emu_hook) emu_hook(t, l, (char*)d_ws); } while (0)
#else
#define HOOK(t, l)
#endif
template <int PH> static void launch_phase1(const Params& p, int layer, int grid, hipStream_t stream);
template <int PH> static void launch_phase(const Params& p, int layer, int grid, hipStream_t stream) { launch_phase1<PH>(p, layer, grid, stream); if ((PROBE_REP >> PH) & 1) launch_phase1<PH>(p, layer, grid, stream); }
template <int PH> static void launch_phase1(const Params& p, int layer, int grid, hipStream_t stream) {
#ifndef EMU
    static bool done = false; if (!done) { hipFuncSetAttribute((const void*)k_phase<PH>, hipFuncAttributeMaxDynamicSharedMemorySize, LDS_BYTES); done = true; }
#endif
    hipLaunchKernelGGL(k_phase<PH>, dim3(grid), dim3(NT), LDS_BYTES, stream, p, layer);
}

#ifndef MK_MULTI
#define MK_MULTI 0
#endif
#ifdef EMU
#define PHASE(PH, l) run_phase<PH>(p, l, emu::B->lds)
#define GRID_BARRIER() do { XcdBarrier bar_; bar_.bar = (unsigned*)(p.ws + OFF_BAR); xcd_barrier(bar_); } while (0)
#else
typedef const __attribute__((address_space(4))) Params* KParams;
DI KParams kparams() { KParams kp = (KParams)__builtin_amdgcn_kernarg_segment_ptr(); asm volatile("" : "+s"(kp)); return kp; }
template <int PH> DI void run_phase_k(int layer) { const Params* gp = (const Params*)kparams(); const Params p = *gp; run_phase<PH>(p, layer, dyn_smem); }
DI void grid_barrier_k() { XcdBarrier b; b.bar = (unsigned*)(kparams()->ws + OFF_BAR); b.x = xb_xcc_id(); b.st = (volatile LAS unsigned*)&dyn_smem[8 * G_HT * 2]; xcd_barrier(b); }
#define PHASE(PH, l) run_phase_k<PH>(l)
#define GRID_BARRIER() grid_barrier_k()
#endif
#if !MK_MULTI
__global__ void __launch_bounds__(NT, 2) k_mega(Params p) {
#ifndef EMU
    {   volatile LAS unsigned* st = (volatile LAS unsigned*)&dyn_smem[8 * G_HT * 2];
        if (threadIdx.x == 0) { st[0] = 0u; st[1] = 0u; st[2] = 0u; st[3] = 0u; }
        __syncthreads();
        (void)xcd_barrier_post((unsigned*)(kparams()->ws + OFF_BAR), st); }
#endif
#define PHASE_R(PH, l) do { PHASE(PH, l); if ((PROBE_REP >> PH) & 1) { GRID_BARRIER(); PHASE(PH, l); } } while (0)
    PHASE_R(PH_CVT, 0); GRID_BARRIER();
    PHASE_R(PH_INIT, 0); GRID_BARRIER();
    for (int l = 0; l < DEPTH; ++l) {
        PHASE_R(PH_INPROJ, l); GRID_BARRIER();
        PHASE_R(PH_DIFF, l); PHASE_R(PH_SWA, l); PHASE_R(PH_GDNP, l); PHASE_R(PH_RKV, l); GRID_BARRIER();
        PHASE_R(PH_MIX2, l); GRID_BARRIER();
        PHASE_R(PH_MIX3, l); GRID_BARRIER();
        PHASE_R(PH_OUTPROJ, l); GRID_BARRIER();
        PHASE(PH_LN0, l); GRID_BARRIER();
        PHASE_R(PH_TOPK, l); GRID_BARRIER();
        PHASE_R(PH_MOE1, l); GRID_BARRIER();
        PHASE_R(PH_MOE2, l); GRID_BARRIER();
        PHASE(PH_LN1, l); if (l + 1 < DEPTH) GRID_BARRIER();
    }
}
#endif

extern "C" void kernel_launch(void* const* d_in, const int* in_sizes, int n_in, void* d_out, int out_size, void* d_ws, size_t ws_size, hipStream_t stream) {
    Params p{};
    const float* const* in = (const float* const*)d_in;
    p.x = in[0]; p.c = in[1]; p.ctx = in[2]; p.c_ctx = in[3]; p.ada_w = in[4]; p.ada_b = in[5]; p.w_in = in[6]; p.w_out = in[7]; p.ret_decay = in[8]; p.diff_lambda = in[9];
    p.diff_norm = in[10]; p.gdn_conv = in[11]; p.gdn_a_log = in[12]; p.gdn_dt_bias = in[13]; p.gdn_norm = in[14]; p.swa_sink = in[15]; p.ln_g = in[16]; p.ln_b = in[17];
    p.router_w = in[18]; p.w_gate = in[19]; p.w_up = in[20]; p.w_down = in[21]; p.out = (float*)d_out; p.ws = (char*)d_ws;
    static int cus = 0;
    if (!cus) { int dev = 0; hipGetDevice(&dev); hipDeviceGetAttribute(&cus, hipDeviceAttributeMultiprocessorCount, dev); if (cus <= 0) cus = 256; }
    const int grid = cus;
#if MK_MULTI
    launch_phase<PH_CVT>(p, 0, grid, stream); HOOK("cvt", 0);
    launch_phase<PH_INIT>(p, 0, grid, stream); HOOK("init", 0);
    for (int l = 0; l < DEPTH; ++l) {
        launch_phase<PH_INPROJ>(p, l, grid, stream); HOOK("inproj", l);
        launch_phase<PH_DIFF>(p, l, grid, stream); launch_phase<PH_SWA>(p, l, grid, stream); launch_phase<PH_GDNP>(p, l, grid, stream); launch_phase<PH_RKV>(p, l, grid, stream);
        launch_phase<PH_MIX2>(p, l, grid, stream);
        launch_phase<PH_MIX3>(p, l, grid, stream); HOOK("mix", l);
        launch_phase<PH_OUTPROJ>(p, l, grid, stream);
        launch_phase<PH_LN0>(p, l, grid, stream); HOOK("ln0", l);
        launch_phase<PH_TOPK>(p, l, grid, stream);
        launch_phase<PH_MOE1>(p, l, grid, stream);
        launch_phase<PH_MOE2>(p, l, grid, stream);
        launch_phase<PH_LN1>(p, l, grid, stream); HOOK("ln1", l);
    }
#else
    hipMemsetAsync((char*)d_ws + OFF_BAR, 0, XCD_BAR_WORDS * sizeof(unsigned), stream);
#ifndef EMU
    static bool attr = false; if (!attr) { hipFuncSetAttribute((const void*)k_mega, hipFuncAttributeMaxDynamicSharedMemorySize, LDS_BYTES); attr = true; }
#endif
    hipLaunchKernelGGL(k_mega, dim3(grid), dim3(NT), LDS_BYTES, stream, p);
#endif
}
```
